# Optimizing an MI355X kernel written in HIP

```python
import math
import jax, jax.numpy as jnp
from jax import lax
import numpy as np


D_MODEL = 4096
BATCH = 1
SEQ = 16384
DEPTH = 4

CHUNK = 64
Q_BLOCK = 128
HEAD_DIM = 128
N_DIFF = D_MODEL // 1024
N_MLSTM = D_MODEL // 1024
MLSTM_DV = 2 * HEAD_DIM
N_RET = D_MODEL // 1024
RET_DV = 2 * HEAD_DIM
N_SB = D_MODEL // 512
D_FF = D_MODEL
PLE_DIM = 256
PLE_GATE_RANK = 256
QK_CONV = 4
FFN_CONV = 3
ROPE_THETA = 10000.0
EPS = 1e-6
A_QK = N_DIFF * 2 * HEAD_DIM
A_V = N_DIFF * 2 * HEAD_DIM
B_QK = N_MLSTM * HEAD_DIM
B_V = N_MLSTM * MLSTM_DV
C_QK = N_RET * HEAD_DIM
C_V = N_RET * RET_DV
D_QKV = N_SB * HEAD_DIM
EVEN_SIZES = (A_QK, A_QK, A_V, B_QK, B_QK, B_V, B_V, N_MLSTM, N_MLSTM)
ODD_SIZES = (C_QK, C_QK, C_V, C_V, D_QKV, D_QKV, D_QKV)
IN_EVEN = sum(EVEN_SIZES)
IN_ODD = sum(ODD_SIZES)
EVEN_MIX = A_V + B_V
ODD_MIX = C_V + D_QKV

kernel_name = 'hybrid_streaming_encoder'


def rmsnorm(x, g):
    xf = x.astype(jnp.float32)
    y = xf * lax.rsqrt(jnp.mean(xf * xf, axis=-1, keepdims=True) + EPS)
    return (y * g.astype(jnp.float32)).astype(x.dtype)


def split_cols(x, sizes):
    outs, off = [], 0
    for s in sizes:
        outs.append(x[..., off:off + s])
        off += s
    return outs


def rope_tables(S):
    inv = ROPE_THETA ** (-jnp.arange(0, HEAD_DIM, 2, dtype=jnp.float32) / HEAD_DIM)
    ang = jnp.arange(S, dtype=jnp.float32)[:, None] * inv[None, :]
    return jnp.cos(ang)[None, :, None, :], jnp.sin(ang)[None, :, None, :]


def rope(x, cos, sin):
    x1, x2 = jnp.split(x, 2, axis=-1)
    return jnp.concatenate([x1 * cos - x2 * sin, x2 * cos + x1 * sin], axis=-1).astype(x.dtype)


def causal_dwconv(x, w, b):
    K, S = w.shape[0], x.shape[1]
    xp = jnp.pad(x, ((0, 0), (K - 1, 0), (0, 0)))
    return b + sum(w[k] * xp[:, k:k + S] for k in range(K))


def to_chunks(a):
    B, S, H = a.shape[:3]
    a = a.reshape((B, S // CHUNK, CHUNK, H) + a.shape[3:])
    return jnp.moveaxis(jnp.moveaxis(a, 1, 0), 3, 2)


def from_chunks(a):
    a = jnp.moveaxis(jnp.moveaxis(a, 2, 3), 0, 1)
    B, nc, L, H, D = a.shape
    return a.reshape(B, nc * L, H, D)


def diff_attention(q, k, v, lam, lam_init, g_sub):
    B, S, H = q.shape[:3]
    outs = []
    for bi in range(S // Q_BLOCK):
        q0 = bi * Q_BLOCK
        kend = q0 + Q_BLOCK
        s = jnp.einsum('bqhmd,bkhmd->bhmqk', q[:, q0:kend], k[:, :kend]).astype(jnp.float32) * HEAD_DIM ** -0.5
        qchunk = (q0 + jnp.arange(Q_BLOCK)) // CHUNK
        kchunk = jnp.arange(kend) // CHUNK
        s = jnp.where(kchunk[None, :] <= qchunk[:, None], s, -jnp.inf)
        pr = jax.nn.softmax(s, axis=-1)
        w = pr[:, :, 0] - lam * pr[:, :, 1]
        outs.append(jnp.einsum('bhqk,bkhe->bqhe', w.astype(v.dtype), v[:, :kend]))
    out = jnp.concatenate(outs, axis=1)
    return (rmsnorm(out, g_sub) * (1.0 - lam_init)).reshape(B, S, H * 2 * HEAD_DIM)


def mlstm(q, k, v, i_pre, f_pre, g_norm):
    B, S, H, Dk = q.shape
    Dv = v.shape[-1]
    L = CHUNK
    qc = to_chunks(q.astype(jnp.float32) * Dk ** -0.5)
    kc = to_chunks(k.astype(jnp.float32))
    vc = to_chunks(v.astype(jnp.float32))
    lic = to_chunks(i_pre.astype(jnp.float32))
    lfc = to_chunks(jax.nn.log_sigmoid(f_pre.astype(jnp.float32)))
    tril = jnp.tril(jnp.ones((L, L), bool))

    def step(carry, xs):
        C, n, m = carry
        qi, ki, vi, li, lf = xs
        b = jnp.cumsum(lf, axis=-1)
        dm = jnp.where(tril, b[..., :, None] - b[..., None, :] + li[..., None, :], -jnp.inf)
        inter = b + m[..., None]
        m_t = jnp.maximum(inter, jnp.max(dm, axis=-1))
        w_intra = jnp.exp(dm - m_t[..., None])
        w_inter = jnp.exp(inter - m_t)
        s = jnp.einsum('bhtd,bhsd->bhts', qi, ki) * w_intra
        num = jnp.einsum('bhts,bhse->bhte', s, vi) + w_inter[..., None] * jnp.einsum('bhtd,bhde->bhte', qi, C)
        nq = jnp.sum(s, axis=-1) + w_inter * jnp.einsum('bhtd,bhd->bht', qi, n)
        den = jnp.maximum(jnp.abs(nq), jnp.exp(-m_t))
        h = num / den[..., None]
        bl = b[..., -1]
        g = bl[..., None] - b + li
        m_new = jnp.maximum(bl + m, jnp.max(g, axis=-1))
        wk = jnp.exp(g - m_new[..., None])
        dec = jnp.exp(bl + m - m_new)
        C = dec[..., None, None] * C + jnp.einsum('bhs,bhsd,bhse->bhde', wk, ki, vi)
        n = dec[..., None] * n + jnp.einsum('bhs,bhsd->bhd', wk, ki)
        return (C, n, m_new), h

    init = (jnp.zeros((B, H, Dk, Dv), jnp.float32), jnp.zeros((B, H, Dk), jnp.float32), jnp.zeros((B, H), jnp.float32))
    _, h = lax.scan(step, init, (qc, kc, vc, lic, lfc))
    h = from_chunks(h)
    return rmsnorm(h, g_norm).astype(v.dtype).reshape(B, S, H * Dv)


def retention(q, k, v, g_norm):
    B, S, H, Dk = q.shape
    Dv = v.shape[-1]
    L = CHUNK
    log_g = jnp.log(1.0 - 2.0 ** (-5.0 - jnp.arange(H, dtype=jnp.float32)))
    idx = jnp.arange(L, dtype=jnp.float32)
    diff = idx[:, None] - idx[None, :]
    dmask = jnp.where(diff >= 0, jnp.exp(jnp.maximum(diff, 0.0) * log_g[:, None, None]), 0.0)
    q_dec = jnp.exp((idx + 1.0) * log_g[:, None])
    k_dec = jnp.exp((L - 1.0 - idx) * log_g[:, None])
    c_dec = jnp.exp(L * log_g)
    qc = to_chunks(q.astype(jnp.float32))
    kc = to_chunks(k.astype(jnp.float32) * Dk ** -0.5)
    vc = to_chunks(v.astype(jnp.float32))

    def step(R, xs):
        qi, ki, vi = xs
        s = jnp.einsum('bhtd,bhsd->bhts', qi, ki) * dmask
        o = jnp.einsum('bhts,bhse->bhte', s, vi) + q_dec[..., None] * jnp.einsum('bhtd,bhde->bhte', qi, R)
        R = c_dec[:, None, None] * R + jnp.einsum('bhsd,bhse->bhde', ki * k_dec[..., None], vi)
        return R, o

    _, o = lax.scan(step, jnp.zeros((B, H, Dk, Dv), jnp.float32), (qc, kc, vc))
    o = from_chunks(o)
    return rmsnorm(o, g_norm).astype(v.dtype).reshape(B, S, H * Dv)


def stick_breaking(q, k, v):
    B, S, H, Dh = q.shape
    outs = []
    for bi in range(S // Q_BLOCK):
        q0 = bi * Q_BLOCK
        kend = q0 + Q_BLOCK
        z = jnp.einsum('bqhd,bkhd->bhqk', q[:, q0:kend], k[:, :kend]).astype(jnp.float32) * Dh ** -0.5
        qpos = q0 + jnp.arange(Q_BLOCK)
        kpos = jnp.arange(kend)
        strict = kpos[None, :] < qpos[:, None]
        log_keep = jnp.where(strict, jax.nn.log_sigmoid(-z), 0.0)
        between = lax.cumsum(log_keep, axis=3, reverse=True) - log_keep
        a = jnp.where(strict, jnp.exp(jax.nn.log_sigmoid(z) + between), 0.0)
        outs.append(jnp.einsum('bhqk,bkhd->bqhd', a.astype(v.dtype), v[:, :kend]))
    return jnp.concatenate(outs, axis=1).reshape(B, S, H * Dh)


def even_mixer(u, w_in, w_out, lam_p, lam_init, g_diff, w_cqk, b_cqk, b_i, b_f, g_ml, cos, sin):
    B, S, _ = u.shape
    aq, ak, av, bq, bk, bv, bo, bi, bf = split_cols(u @ w_in, EVEN_SIZES)
    aq = rope(aq.reshape(B, S, 2 * N_DIFF, HEAD_DIM), cos, sin).reshape(B, S, N_DIFF, 2, HEAD_DIM)
    ak = rope(ak.reshape(B, S, 2 * N_DIFF, HEAD_DIM), cos, sin).reshape(B, S, N_DIFF, 2, HEAD_DIM)
    lp = lam_p.astype(jnp.float32)
    lam = jnp.exp(jnp.sum(lp[0] * lp[1])) - jnp.exp(jnp.sum(lp[2] * lp[3])) + lam_init
    ya = diff_attention(aq, ak, av.reshape(B, S, N_DIFF, 2 * HEAD_DIM), lam, lam_init, g_diff)
    qk = jax.nn.silu(causal_dwconv(jnp.concatenate([bq, bk], axis=-1), w_cqk, b_cqk))
    bq, bk = jnp.split(qk, 2, axis=-1)
    yb = mlstm(bq.reshape(B, S, N_MLSTM, HEAD_DIM), bk.reshape(B, S, N_MLSTM, HEAD_DIM),
               bv.reshape(B, S, N_MLSTM, MLSTM_DV), bi + b_i, bf + b_f, g_ml)
    yb = yb * jax.nn.sigmoid(bo)
    return jnp.concatenate([ya, yb], axis=-1) @ w_out


def odd_mixer(u, w_in, w_out, g_ret, cos, sin):
    B, S, _ = u.shape
    cq, ck, cv, cg, dq, dk, dv = split_cols(u @ w_in, ODD_SIZES)
    cq = rope(cq.reshape(B, S, N_RET, HEAD_DIM), cos, sin)
    ck = rope(ck.reshape(B, S, N_RET, HEAD_DIM), cos, sin)
    yc = retention(cq, ck, cv.reshape(B, S, N_RET, RET_DV), g_ret) * jax.nn.silu(cg)
    yd = stick_breaking(dq.reshape(B, S, N_SB, HEAD_DIM), dk.reshape(B, S, N_SB, HEAD_DIM),
                        dv.reshape(B, S, N_SB, HEAD_DIM))
    return jnp.concatenate([yc, yd], axis=-1) @ w_out


def conv_ffn(u, w_up, w_conv, b_conv, w_down):
    h = causal_dwconv(u @ w_up, w_conv, b_conv)
    a, b = jnp.split(h, 2, axis=-1)
    return (jax.nn.gelu(a) * b) @ w_down


def setup_inputs(seed: int = 0) -> dict:
    key = jax.random.key(seed)
    ks = jax.random.split(key, 26)
    NE = (DEPTH + 1) // 2
    NO = DEPTH // 2
    f32 = jnp.float32

    def dense(k, shape):
        return jax.random.normal(k, shape, f32) * shape[-2] ** -0.5

    def gain(k, shape):
        return 1.0 + 0.02 * jax.random.normal(k, shape, f32)

    def small(k, shape, s=0.02):
        return s * jax.random.normal(k, shape, f32)

    return {
        'x': jax.random.normal(ks[0], (BATCH, SEQ, D_MODEL), f32),
        'p': jax.random.normal(ks[1], (DEPTH, BATCH, SEQ, PLE_DIM), f32),
        'w_in_even': dense(ks[2], (NE, D_MODEL, IN_EVEN)),
        'w_out_even': dense(ks[3], (NE, EVEN_MIX, D_MODEL)),
        'diff_lambda': small(ks[4], (NE, 4, HEAD_DIM), 0.1),
        'g_diff_sub': gain(ks[5], (NE, 2 * HEAD_DIM)),
        'w_conv_qk': jax.random.normal(ks[6], (NE, QK_CONV, 2 * B_QK), f32) * QK_CONV ** -0.5,
        'b_conv_qk': small(ks[7], (NE, 2 * B_QK)),
        'b_igate': small(ks[8], (NE, N_MLSTM), 0.1),
        'b_fgate': jnp.linspace(3.0, 6.0, N_MLSTM, dtype=f32)[None, :] + small(ks[9], (NE, N_MLSTM), 0.1),
        'g_mlstm_head': gain(ks[10], (NE, MLSTM_DV)),
        'w_in_odd': dense(ks[11], (NO, D_MODEL, IN_ODD)),
        'w_out_odd': dense(ks[12], (NO, ODD_MIX, D_MODEL)),
        'g_ret_head': gain(ks[13], (NO, RET_DV)),
        'g_mix_pre': gain(ks[14], (DEPTH, D_MODEL)),
        'g_mix_post': gain(ks[15], (DEPTH, D_MODEL)),
        'g_ffn_pre': gain(ks[16], (DEPTH, D_MODEL)),
        'g_ffn_post': gain(ks[17], (DEPTH, D_MODEL)),
        'w_ffn_up': dense(ks[18], (DEPTH, D_MODEL, 2 * D_FF)),
        'w_ffn_conv': jax.random.normal(ks[19], (DEPTH, FFN_CONV, 2 * D_FF), f32) * FFN_CONV ** -0.5,
        'b_ffn_conv': small(ks[20], (DEPTH, 2 * D_FF)),
        'w_ffn_down': dense(ks[21], (DEPTH, D_FF, D_MODEL)),
        'g_ple': gain(ks[22], (DEPTH, D_MODEL)),
        'w_ple_gate_down': dense(ks[23], (DEPTH, D_MODEL, PLE_GATE_RANK)),
        'w_ple_gate_up': dense(ks[24], (DEPTH, PLE_GATE_RANK, D_MODEL)),
        'w_ple_proj': dense(ks[25], (DEPTH, PLE_DIM, D_MODEL)),
    }


def reference(x, p, w_in_even, w_out_even, diff_lambda, g_diff_sub, w_conv_qk, b_conv_qk, b_igate, b_fgate,
              g_mlstm_head, w_in_odd, w_out_odd, g_ret_head, g_mix_pre, g_mix_post, g_ffn_pre, g_ffn_post,
              w_ffn_up, w_ffn_conv, b_ffn_conv, w_ffn_down, g_ple, w_ple_gate_down, w_ple_gate_up, w_ple_proj):
    B, S, _ = x.shape
    cos, sin = rope_tables(S)
    h = x
    for i in range(DEPTH):
        j = i // 2
        u = rmsnorm(h, g_mix_pre[i])
        if i % 2 == 0:
            lam_init = 0.8 - 0.6 * math.exp(-0.3 * i)
            mix = even_mixer(u, w_in_even[j], w_out_even[j], diff_lambda[j], lam_init, g_diff_sub[j],
                             w_conv_qk[j], b_conv_qk[j], b_igate[j], b_fgate[j], g_mlstm_head[j], cos, sin)
        else:
            mix = odd_mixer(u, w_in_odd[j], w_out_odd[j], g_ret_head[j], cos, sin)
        h = h + rmsnorm(mix, g_mix_post[i])
        f = conv_ffn(rmsnorm(h, g_ffn_pre[i]), w_ffn_up[i], w_ffn_conv[i], b_ffn_conv[i], w_ffn_down[i])
        h = h + rmsnorm(f, g_ffn_post[i])
        gate = jax.nn.sigmoid((rmsnorm(h, g_ple[i]) @ w_ple_gate_down[i]) @ w_ple_gate_up[i])
        h = h + gate * (p[i] @ w_ple_proj[i])
    return h
```

```cpp
#include <hip/hip_runtime.h>
#include <cstdio>
#include <cstdint>
namespace pg8 {
#define PG8_LAS __attribute__((address_space(3)))
typedef unsigned short bf16_t;
typedef short bf16x8 __attribute__((ext_vector_type(8)));
typedef float f32x4 __attribute__((ext_vector_type(4)));
typedef unsigned u32x4 __attribute__((ext_vector_type(4)));
constexpr int BM = 256, BK = 64, HALF = 128, HTB = HALF * BK * 2  , STAGE_BYTES = 8 * HTB, NXCD = 8, WGM = 8;

__host__ __device__ __forceinline__ int lds_byte(int r, int c) { const int st = (r >> 4) * 2 + (c >> 5), rr = r & 15, cc = c & 31, ob = rr * 64 + cc * 2; return st * 1024 + (ob ^ (((ob >> 9) & 1) << 5)); }
__host__ __device__ __forceinline__ void stage_rc(int b, int& R, int& C) { const int st = b / 1024, sb = b % 1024, swz = sb ^ (((sb >> 9) & 1) << 5); R = (st >> 1) * 16 + swz / 64; C = (st & 1) * 32 + (swz % 64) / 2; }
__host__ __device__ __forceinline__ int perm32(int rho) { const int n = rho >> 4, i = rho & 15; return 8 * (i >> 2) + 4 * n + (i & 3); }

struct Unit { int pm, pn, which; };
struct Gemm { const bf16_t* A; const bf16_t* Bt; int M, N, K; long dA, dB; };

struct StaticOrder {
    int nM, nN, nwg, G, c;
    __host__ __device__ void init(int M, int N, int G_, int c_) { nM = M / BM; nN = N / BM; nwg = nM * nN; G = G_; c = c_; }
    __host__ __device__ bool next(int i, Unit& u) const {
        const long L = (long)i * G + c; if (L >= nwg) return false;
        int wgid = (int)L; { const int q = nwg / NXCD, r = nwg % NXCD, xcd = wgid % NXCD, off = wgid / NXCD; wgid = (xcd < r ? xcd * (q + 1) : r * (q + 1) + (xcd - r) * q) + off; }
        const int nig = WGM * nN, gid = wgid / nig, fm = gid * WGM, gsz = (nM - fm) < WGM ? (nM - fm) : WGM;
        u.pm = fm + ((wgid % nig) % gsz); u.pn = (wgid % nig) / gsz; u.which = 0; return true;
    }
    __device__ __forceinline__ void a_ready(const Unit&) const {}
    __device__ __forceinline__ void done(const Unit&) const {}
};

__device__ __forceinline__ float fq_sum(float v) {
    auto a = __builtin_amdgcn_permlane16_swap(__float_as_uint(v), __float_as_uint(v), false, false); v = __uint_as_float(a[0]) + __uint_as_float(a[1]);
    auto b = __builtin_amdgcn_permlane32_swap(__float_as_uint(v), __float_as_uint(v), false, false); return __uint_as_float(b[0]) + __uint_as_float(b[1]); }
#ifndef USE_F16
#define USE_F16 1
#endif
typedef float f32x2_t __attribute__((ext_vector_type(2))); typedef __bf16 bf16x2_t __attribute__((ext_vector_type(2)));
typedef _Float16 h16x2_t __attribute__((ext_vector_type(2))); typedef _Float16 h16x8_t __attribute__((ext_vector_type(8)));
#if USE_F16
__device__ __forceinline__ unsigned cvt_pk_bf16(float lo, float hi) { f32x2_t v = {lo, hi}; h16x2_t b = __builtin_convertvector(v, h16x2_t); return __builtin_bit_cast(unsigned, b); }
__device__ __forceinline__ float unpk_lo(unsigned w) { return (float)__builtin_bit_cast(h16x2_t, w)[0]; }
__device__ __forceinline__ float unpk_hi(unsigned w) { return (float)__builtin_bit_cast(h16x2_t, w)[1]; }
#define MFMA16(a, b, c) __builtin_amdgcn_mfma_f32_16x16x32_f16(__builtin_bit_cast(pg8::h16x8_t, (a)), __builtin_bit_cast(pg8::h16x8_t, (b)), (c), 0, 0, 0)
#define MFMA32(a, b, c) __builtin_amdgcn_mfma_f32_32x32x16_f16(__builtin_bit_cast(pg8::h16x8_t, (a)), __builtin_bit_cast(pg8::h16x8_t, (b)), (c), 0, 0, 0)
#else
__device__ __forceinline__ unsigned cvt_pk_bf16(float lo, float hi) { f32x2_t v = {lo, hi}; bf16x2_t b = __builtin_convertvector(v, bf16x2_t); return __builtin_bit_cast(unsigned, b); }
__device__ __forceinline__ float unpk_lo(unsigned w) { return __uint_as_float(w << 16); }
__device__ __forceinline__ float unpk_hi(unsigned w) { return __uint_as_float(w & 0xffff0000u); }
#define MFMA16(a, b, c) __builtin_amdgcn_mfma_f32_16x16x32_bf16((a), (b), (c), 0, 0, 0)
#define MFMA32(a, b, c) __builtin_amdgcn_mfma_f32_32x32x16_bf16((a), (b), (c), 0, 0, 0)
#endif

struct EpiProj {
    static constexpr bool PERM = true, AFTER_DRAIN = false;
    bf16_t* O; int ldc; const float* rs; const float* cs; const float* sn; int rope_tiles;
    __device__ __forceinline__ void operator()(const f32x4 (&acc)[2][2][4][2], const Unit& u, int wr, int wc, int fr_in, int fq_in) const {
        int fr = fr_in, fq = fq_in; asm volatile("; EPI_ENTRY" : "+v"(fr), "+v"(fq));
        const int row0 = u.pm * BM + wr * 64 + fr, col0 = u.pn * BM + wc * 32 + 8 * fq;
        const bool rope = u.pn < rope_tiles; const int i0 = (wc * 32 + 8 * fq) >> 1;
#pragma unroll
        for (int ai = 0; ai < 2; ++ai)
#pragma unroll
            for (int m = 0; m < 4; ++m) { const int row = row0 + ai * HALF + m * 16; const float r = rs[row];
                f32x4 c4 = (f32x4){1.f, 1.f, 1.f, 1.f}, s4 = (f32x4){0.f, 0.f, 0.f, 0.f};
                if (rope) { c4 = *(const f32x4*)(cs + (size_t)row * 64 + i0); s4 = *(const f32x4*)(sn + (size_t)row * 64 + i0); }
                bf16_t* rowp = O + (size_t)row * ldc + col0;
#pragma unroll
                for (int bj = 0; bj < 2; ++bj) { const f32x4 v0 = acc[ai][bj][m][0] * r, v1 = acc[ai][bj][m][1] * r;
                    f32x4 o0, o1;
                    o0[0] = v0[0] * c4[0] - v0[1] * s4[0]; o0[1] = v0[1] * c4[0] + v0[0] * s4[0];
                    o0[2] = v0[2] * c4[1] - v0[3] * s4[1]; o0[3] = v0[3] * c4[1] + v0[2] * s4[1];
                    o1[0] = v1[0] * c4[2] - v1[1] * s4[2]; o1[1] = v1[1] * c4[2] + v1[0] * s4[2];
                    o1[2] = v1[2] * c4[3] - v1[3] * s4[3]; o1[3] = v1[3] * c4[3] + v1[2] * s4[3];
                    u32x4 w; w.x = cvt_pk_bf16(o0[0], o0[1]); w.y = cvt_pk_bf16(o0[2], o0[3]); w.z = cvt_pk_bf16(o1[0], o1[1]); w.w = cvt_pk_bf16(o1[2], o1[3]);
                    *(u32x4*)(rowp + bj * HALF) = w; } }
    }
};
struct EpiY {
    static constexpr bool PERM = true, AFTER_DRAIN = false;
    bf16_t* O; int ldc; float* ssp;
    __device__ __forceinline__ void operator()(const f32x4 (&acc)[2][2][4][2], const Unit& u, int wr, int wc, int fr_in, int fq_in) const {
        int fr = fr_in, fq = fq_in; asm volatile("; EPI_ENTRY" : "+v"(fr), "+v"(fq));
        const int row0 = u.pm * BM + wr * 64 + fr, col0 = u.pn * BM + wc * 32 + 8 * fq;
#pragma unroll
        for (int ai = 0; ai < 2; ++ai)
#pragma unroll
            for (int m = 0; m < 4; ++m) { const int row = row0 + ai * HALF + m * 16; bf16_t* rowp = O + (size_t)row * ldc + col0; float s = 0.f;
#pragma unroll
                for (int bj = 0; bj < 2; ++bj) { const f32x4 v0 = acc[ai][bj][m][0], v1 = acc[ai][bj][m][1];
                    s += (v0[0] * v0[0] + v0[1] * v0[1]) + (v0[2] * v0[2] + v0[3] * v0[3]) + (v1[0] * v1[0] + v1[1] * v1[1]) + (v1[2] * v1[2] + v1[3] * v1[3]);
                    u32x4 w; w.x = cvt_pk_bf16(v0[0], v0[1]); w.y = cvt_pk_bf16(v0[2], v0[3]); w.z = cvt_pk_bf16(v1[0], v1[1]); w.w = cvt_pk_bf16(v1[2], v1[3]);
                    *(u32x4*)(rowp + bj * HALF) = w; }
                s = fq_sum(s);
                if (fq == 0) ssp[(size_t)row * 64 + u.pn * 4 + wc] = s; }
    }
};
struct EpiPle {
    static constexpr bool PERM = true, AFTER_DRAIN = false;
    bf16_t* G; float* H; bf16_t* HB; float* ssp;
    __device__ __forceinline__ void operator()(const f32x4 (&acc)[2][2][4][2], const Unit& u, int wr, int wc, int fr_in, int fq_in) const {
        int fr = fr_in, fq = fq_in; asm volatile("; EPI_ENTRY" : "+v"(fr), "+v"(fq));
        const unsigned row0 = (unsigned)(u.pm * BM + wr * 64 + fr), col0 = (unsigned)(u.pn * BM + wc * 32 + 8 * fq);
        char* Gc = (char*)G + (size_t)(u.pm * 16 + u.pn) * 131072u + (unsigned)(wr * 4 + wc) * 16384u; char* Hc = (char*)H; char* HBc = (char*)HB;
        const unsigned goff = (unsigned)(fq * 16 + fr) * 16u;
        if (u.which == 0) {
#pragma unroll
            for (int ai = 0; ai < 2; ++ai)
#pragma unroll
                for (int m = 0; m < 4; ++m) {
#pragma unroll
                    for (int bj = 0; bj < 2; ++bj) { f32x4 v0 = acc[ai][bj][m][0], v1 = acc[ai][bj][m][1];
#pragma unroll
                        for (int e = 0; e < 4; ++e) { v0[e] = __builtin_amdgcn_rcpf(1.f + __expf(-v0[e])); v1[e] = __builtin_amdgcn_rcpf(1.f + __expf(-v1[e])); }
                        u32x4 w; w.x = cvt_pk_bf16(v0[0], v0[1]); w.y = cvt_pk_bf16(v0[2], v0[3]); w.z = cvt_pk_bf16(v1[0], v1[1]); w.w = cvt_pk_bf16(v1[2], v1[3]);
                        *(u32x4*)(Gc + (unsigned)(((ai * 4 + m) * 2 + bj) * 1024) + goff) = w; } }
        } else {
            asm volatile("s_waitcnt vmcnt(0)" ::: "memory");
#pragma unroll
            for (int ai = 0; ai < 2; ++ai)
#pragma unroll
                for (int m = 0; m < 4; ++m) { const unsigned row = row0 + ai * HALF + m * 16, off = row * 4096u + col0; float s = 0.f;
#pragma unroll
                    for (int bj = 0; bj < 2; ++bj) { const unsigned ob = off + bj * HALF; const u32x4 gw = *(const u32x4*)(Gc + (unsigned)(((ai * 4 + m) * 2 + bj) * 1024) + goff);
                        const f32x4 h0 = *(const f32x4*)(Hc + (unsigned)(ob * 4u)), h1 = *(const f32x4*)(Hc + (unsigned)(ob * 4u + 16u));
                        f32x4 g0, g1; g0[0] = unpk_lo(gw.x); g0[1] = unpk_hi(gw.x); g0[2] = unpk_lo(gw.y); g0[3] = unpk_hi(gw.y);
                        g1[0] = unpk_lo(gw.z); g1[1] = unpk_hi(gw.z); g1[2] = unpk_lo(gw.w); g1[3] = unpk_hi(gw.w);
                        const f32x4 v0 = h0 + g0 * acc[ai][bj][m][0], v1 = h1 + g1 * acc[ai][bj][m][1];
                        s += (v0[0] * v0[0] + v0[1] * v0[1]) + (v0[2] * v0[2] + v0[3] * v0[3]) + (v1[0] * v1[0] + v1[1] * v1[1]) + (v1[2] * v1[2] + v1[3] * v1[3]);
                        *(f32x4*)(Hc + (unsigned)(ob * 4u)) = v0; *(f32x4*)(Hc + (unsigned)(ob * 4u + 16u)) = v1;
                        u32x4 w; w.x = cvt_pk_bf16(v0[0], v0[1]); w.y = cvt_pk_bf16(v0[2], v0[3]); w.z = cvt_pk_bf16(v1[0], v1[1]); w.w = cvt_pk_bf16(v1[2], v1[3]);
                        *(u32x4*)(HBc + (unsigned)(ob * 2u)) = w; asm volatile("" ::: "memory"); }
                    s = fq_sum(s);
                    if (fq == 0) ssp[(size_t)row * 64 + u.pn * 4 + wc] = s;
                    asm volatile("" ::: "memory"); }
        }
    }
};
struct EpiPleDbg {
    static constexpr bool PERM = true, AFTER_DRAIN = false;
    bf16_t* G; bf16_t* G2;
    __device__ __forceinline__ void operator()(const f32x4 (&acc)[2][2][4][2], const Unit& u, int wr, int wc, int fr, int fq) const {
        const int row0 = u.pm * BM + wr * 64 + fr, col0 = u.pn * BM + wc * 32 + 8 * fq; bf16_t* O = u.which ? G2 : G;
#pragma unroll
        for (int ai = 0; ai < 2; ++ai)
#pragma unroll
            for (int m = 0; m < 4; ++m) { const int row = row0 + ai * HALF + m * 16; bf16_t* rowp = O + (size_t)row * 4096 + col0;
#pragma unroll
                for (int bj = 0; bj < 2; ++bj) { const f32x4 v0 = acc[ai][bj][m][0], v1 = acc[ai][bj][m][1];
                    u32x4 w; w.x = cvt_pk_bf16(v0[0], v0[1]); w.y = cvt_pk_bf16(v0[2], v0[3]); w.z = cvt_pk_bf16(v1[0], v1[1]); w.w = cvt_pk_bf16(v1[2], v1[3]);
                    *(u32x4*)(rowp + bj * HALF) = w; } }
    }
};
struct PleOrder {
    int G, c, ntile;
    __device__ __forceinline__ bool next(int i, Unit& u) const { const int tl = (i >> 1) * G + c; if (tl >= ntile) return false; u.pm = tl >> 4; u.pn = tl & 15; u.which = i & 1; return true; }
    __device__ __forceinline__ void a_ready(const Unit&) const {}
    __device__ __forceinline__ void done(const Unit&) const {}
};
template <class Epi, class Sched, bool ALIGN_EPI = false, bool SP2 = false>
__device__ __forceinline__ void gemm_phase(PG8_LAS unsigned char* lds, const Gemm g, const Sched& S, const Epi& E, int wave_in) {
    int lane_o; asm volatile("v_mbcnt_lo_u32_b32 %0, -1, 0\n\tv_mbcnt_hi_u32_b32 %0, -1, %0 ; LANE_ID" : "=v"(lane_o)); const int wid = wave_in, lane = lane_o, tid = wid * 64 + lane, wr = wid >> 2, wc = wid & 3, fr = lane & 15, fq = lane >> 4;
    const int K = g.K, nt = K / BK;
    unsigned voffA[2], voffB[2];
#pragma unroll
    for (int i = 0; i < 2; ++i) { int R, C; stage_rc(tid * 16 + i * 8192, R, C); const int Rb = Epi::PERM ? ((R & ~31) + perm32(R & 31)) : R;
        voffA[i] = (unsigned)(R * K + C) * 2u; voffB[i] = (unsigned)(Rb * K + C) * 2u; }
    const size_t kstep = (size_t)(BK * 2);
    const size_t hstep = (size_t)HALF * K * 2;
    const size_t tstep = 2 * hstep;
    const unsigned ldsw = (unsigned)wid * 1024u;
    const int aoff = lds_byte(wr * 64 + fr, fq * 8), boff = lds_byte(wc * 32 + fr, fq * 8);
#define PG8_SA(b, h) (((b) * 2 + (h)) * HTB)
#define PG8_SB(b, h) ((4 + (b) * 2 + (h)) * HTB)
#define PG8_STAGE(bufoff, gbase, voff) do { _Pragma("unroll") for (int _i = 0; _i < 2; ++_i) \
        __builtin_amdgcn_global_load_lds((const unsigned*)((const char*)(gbase) + (voff)[_i]), (PG8_LAS unsigned*)(lds + (bufoff) + ldsw + _i * 8192), 16, 0, 0); } while (0)
#define PG8_LDA(dst, b, h) do { _Pragma("unroll") for (int m = 0; m < 4; ++m) _Pragma("unroll") for (int k = 0; k < 2; ++k) dst[m][k] = *(const PG8_LAS bf16x8*)(lds + PG8_SA(b, h) + aoff + m * 2048 + k * 1024); } while (0)
#define PG8_LDB(dst, b, h) do { _Pragma("unroll") for (int n = 0; n < 2; ++n) _Pragma("unroll") for (int k = 0; k < 2; ++k) dst[n][k] = *(const PG8_LAS bf16x8*)(lds + PG8_SB(b, h) + boff + n * 2048 + k * 1024); } while (0)
#define PG8_MMA(ai, bj, At, Bt) do { __builtin_amdgcn_s_setprio(1); _Pragma("unroll") for (int m = 0; m < 4; ++m) _Pragma("unroll") for (int n = 0; n < 2; ++n) _Pragma("unroll") for (int k = 0; k < 2; ++k) \
        acc[ai][bj][m][n] = MFMA16(Bt[n][k], At[m][k], acc[ai][bj][m][n]); __builtin_amdgcn_s_setprio(0); } while (0)
#define PG8_WAIT_V(n) asm volatile("s_waitcnt vmcnt(" #n ")" ::: "memory")
#define PG8_WAIT_L(n) asm volatile("s_waitcnt lgkmcnt(" #n ")" ::: "memory")
#define PG8_BAR __builtin_amdgcn_s_barrier()
#define PG8_SCHED __builtin_amdgcn_sched_barrier(0)
    Unit cur, nxt; int ui = 0;
    if (!S.next(0, cur)) return;
    f32x4 acc[2][2][4][2];
#pragma unroll
    for (int a = 0; a < 2; ++a)
#pragma unroll
        for (int b = 0; b < 2; ++b)
#pragma unroll
            for (int m = 0; m < 4; ++m)
#pragma unroll
                for (int n = 0; n < 2; ++n) acc[a][b][m][n] = (f32x4){0.f, 0.f, 0.f, 0.f};
    bf16x8 At[4][2], B0[2][2], B1[2][2];
    const char* cA = (const char*)g.A + (size_t)cur.pm * tstep + (size_t)cur.which * (size_t)g.dA; const char* cB = (const char*)g.Bt + (size_t)cur.pn * tstep + (size_t)cur.which * (size_t)g.dB;
    S.a_ready(cur);
    if constexpr (SP2) {
        PG8_STAGE(PG8_SB(0, 0), cB, voffB); PG8_STAGE(PG8_SB(0, 1), cB + hstep, voffB); PG8_STAGE(PG8_SA(0, 0), cA, voffA); PG8_STAGE(PG8_SA(0, 1), cA + hstep, voffA);
        if (wr == 1) PG8_BAR;
        PG8_WAIT_V(2); PG8_BAR;
        PG8_STAGE(PG8_SB(1, 0), cB + kstep, voffB); PG8_STAGE(PG8_SA(1, 0), cA + kstep, voffA); PG8_STAGE(PG8_SB(1, 1), cB + hstep + kstep, voffB);
        PG8_WAIT_V(6); PG8_BAR;
    } else {
        PG8_STAGE(PG8_SB(0, 0), cB, voffB); PG8_STAGE(PG8_SA(0, 0), cA, voffA); PG8_STAGE(PG8_SB(0, 1), cB + hstep, voffB); PG8_STAGE(PG8_SA(0, 1), cA + hstep, voffA);
        if (wr == 1) PG8_BAR;
        PG8_WAIT_V(4); PG8_BAR;
        PG8_STAGE(PG8_SB(1, 0), cB + kstep, voffB); PG8_STAGE(PG8_SA(1, 0), cA + kstep, voffA); PG8_STAGE(PG8_SB(1, 1), cB + hstep + kstep, voffB);
        PG8_WAIT_V(6); PG8_BAR;
    }
    for (;;) {
        const bool has_next = S.next(ui + 1, nxt);
        const char* nA = has_next ? (const char*)g.A + (size_t)nxt.pm * tstep + (size_t)nxt.which * (size_t)g.dA : cA; const char* nB = has_next ? (const char*)g.Bt + (size_t)nxt.pn * tstep + (size_t)nxt.which * (size_t)g.dB : cB;
        for (int t = 0; t < nt; t += 2) {
            const bool last = (t == nt - 2);
            const char* a1 = cA + (size_t)(t + 1) * kstep;
            const char* a2 = last ? nA : cA + (size_t)(t + 2) * kstep; const char* b2 = last ? nB : cB + (size_t)(t + 2) * kstep;
            const char* a3 = a2 + kstep; const char* b3 = b2 + kstep;
            if (last && has_next) S.a_ready(nxt);
            if constexpr (SP2) {
            PG8_LDB(B0, 0, 0); PG8_LDB(B1, 0, 1); PG8_SCHED; PG8_LDA(At, 0, 0); PG8_STAGE(PG8_SA(1, 1), a1 + hstep, voffA);
            PG8_WAIT_V(8); PG8_WAIT_L(0); PG8_BAR; PG8_MMA(0, 0, At, B0); PG8_MMA(0, 1, At, B1); PG8_BAR; PG8_SCHED;
            PG8_LDA(At, 0, 1); PG8_STAGE(PG8_SB(0, 0), b2, voffB); PG8_STAGE(PG8_SB(0, 1), b2 + hstep, voffB); PG8_STAGE(PG8_SA(0, 0), a2, voffA);
            PG8_WAIT_V(8); PG8_WAIT_L(0); PG8_BAR; PG8_MMA(1, 0, At, B0); PG8_MMA(1, 1, At, B1); PG8_BAR; PG8_SCHED;
            PG8_LDB(B0, 1, 0); PG8_LDB(B1, 1, 1); PG8_SCHED; PG8_LDA(At, 1, 0); PG8_STAGE(PG8_SA(0, 1), a2 + hstep, voffA);
            PG8_WAIT_V(8); PG8_WAIT_L(0); PG8_BAR; PG8_MMA(0, 0, At, B0); PG8_MMA(0, 1, At, B1); PG8_BAR; PG8_SCHED;
            PG8_LDA(At, 1, 1); PG8_STAGE(PG8_SB(1, 0), b3, voffB); PG8_STAGE(PG8_SB(1, 1), b3 + hstep, voffB); PG8_STAGE(PG8_SA(1, 0), a3, voffA);
            PG8_WAIT_V(8); PG8_WAIT_L(0); PG8_BAR; PG8_MMA(1, 0, At, B0); PG8_MMA(1, 1, At, B1); PG8_BAR; PG8_SCHED;
            } else {
            PG8_LDB(B0, 0, 0); PG8_SCHED; PG8_LDA(At, 0, 0); PG8_STAGE(PG8_SA(1, 1), a1 + hstep, voffA);
            PG8_WAIT_L(8); PG8_BAR; PG8_WAIT_L(0); PG8_MMA(0, 0, At, B0); PG8_BAR; PG8_SCHED;
            PG8_LDB(B1, 0, 1); PG8_STAGE(PG8_SB(0, 0), b2, voffB);
            PG8_BAR; PG8_WAIT_L(0); PG8_MMA(0, 1, At, B1); PG8_BAR;
            PG8_LDA(At, 0, 1); PG8_STAGE(PG8_SA(0, 0), a2, voffA);
            PG8_BAR; PG8_WAIT_L(0); PG8_MMA(1, 0, At, B0); PG8_BAR; PG8_SCHED;
            PG8_STAGE(PG8_SB(0, 1), b2 + hstep, voffB);
            PG8_WAIT_V(6); PG8_BAR; PG8_MMA(1, 1, At, B1); PG8_BAR;
            PG8_LDB(B0, 1, 0); PG8_SCHED; PG8_LDA(At, 1, 0); PG8_STAGE(PG8_SA(0, 1), a2 + hstep, voffA);
            PG8_WAIT_L(8); PG8_BAR; PG8_WAIT_L(0); PG8_MMA(0, 0, At, B0); PG8_BAR; PG8_SCHED;
            PG8_LDB(B1, 1, 1); PG8_STAGE(PG8_SB(1, 0), b3, voffB);
            PG8_BAR; PG8_WAIT_L(0); PG8_MMA(0, 1, At, B1); PG8_BAR;
            PG8_LDA(At, 1, 1); PG8_STAGE(PG8_SA(1, 0), a3, voffA);
            PG8_BAR; PG8_WAIT_L(0); PG8_MMA(1, 0, At, B0); PG8_BAR; PG8_SCHED;
            PG8_STAGE(PG8_SB(1, 1), b3 + hstep, voffB);
            PG8_WAIT_V(6); PG8_BAR; PG8_MMA(1, 1, At, B1); PG8_BAR;
            }
        }
        if constexpr (ALIGN_EPI) { if (wr == 0) PG8_BAR; }
        if constexpr (!Epi::AFTER_DRAIN) { E(acc, cur, wr, wc, fr, fq); S.done(cur); }
        if (!has_next) break;
#pragma unroll
        for (int a = 0; a < 2; ++a)
#pragma unroll
            for (int b = 0; b < 2; ++b)
#pragma unroll
                for (int m = 0; m < 4; ++m)
#pragma unroll
                    for (int n = 0; n < 2; ++n) acc[a][b][m][n] = (f32x4){0.f, 0.f, 0.f, 0.f};
        cur = nxt; cA = nA; cB = nB; ++ui;
        if constexpr (ALIGN_EPI) { if (wr == 1) PG8_BAR; }
    }
    PG8_WAIT_V(0);
    if constexpr (!ALIGN_EPI) { if (wr == 0) PG8_BAR; }
    PG8_BAR;
    if constexpr (Epi::AFTER_DRAIN) { E.fused(acc, cur, wr, wc, fr, fq, lds, wid, lane); S.done(cur); }
#undef PG8_SA
#undef PG8_SB
#undef PG8_STAGE
#undef PG8_LDA
#undef PG8_LDB
#undef PG8_MMA
#undef PG8_WAIT_V
#undef PG8_WAIT_L
#undef PG8_BAR
#undef PG8_SCHED
}
}

constexpr int S_ = 16384, DM = 4096, NUP = 8192, NIN = 6144, NMIX = 2048, PLED = 256, DEPTH_ = 4, NCH = S_ / 64;
constexpr float EPS_ = 1e-6f;
constexpr int NWAVES = 8;
constexpr size_t MiB = 1u << 20;
constexpr size_t WS_CTL = 0, CTL_ZERO_BYTES = 1 * MiB;
constexpr size_t WS_RIN = 1 * MiB;
constexpr size_t WS_LAM = 1 * MiB + 65536;
constexpr size_t WS_CHS = 1 * MiB + 131072;
constexpr size_t WS_GPRE = 2 * MiB;
constexpr size_t WS_DN = 3 * MiB;
constexpr size_t WS_NH = 3 * MiB + 524288;
constexpr size_t WS_SSP = 4 * MiB;
constexpr size_t WS_COS = 8 * MiB, WS_SIN = 12 * MiB;
constexpr size_t WS_G1 = 16 * MiB;
constexpr size_t WS_PB = 24 * MiB;
constexpr size_t WS_QKC = 56 * MiB;
constexpr size_t WS_HB = 88 * MiB;
constexpr size_t WS_PROJ = 216 * MiB;
constexpr size_t WS_YMIX = 408 * MiB;
constexpr size_t WS_MIXO = 472 * MiB;
constexpr size_t WS_UP = 600 * MiB;
constexpr size_t WS_ACT = 856 * MiB;
constexpr size_t WS_OD = 984 * MiB;
constexpr size_t WS_DC = 1048 * MiB;
constexpr size_t WS_CH = 1176 * MiB;
constexpr size_t WS_WIN = 1240 * MiB;
constexpr size_t WS_WOUT = 1432 * MiB;
constexpr size_t WS_WUP = 1496 * MiB;
constexpr size_t WS_WDN = 1752 * MiB;
constexpr size_t WS_WPD = 1880 * MiB;
constexpr size_t WS_WPU = 1888 * MiB;
constexpr size_t WS_WPP = 1896 * MiB;
constexpr size_t WS_WG = 1904 * MiB;
constexpr size_t WS_END = 1905 * MiB;
constexpr int CW_BAR = 4096;
constexpr int CW_Q = 16384;
constexpr int RING_BYTES = 131072;
constexpr int LDSCTL_OFF = RING_BYTES, MISC_OFF = LDSCTL_OFF + 320;
constexpr int LDS_BYTES = 147456;

#define GAS __attribute__((address_space(1)))
#define LAS __attribute__((address_space(3)))
typedef unsigned short bf16;
typedef unsigned v4u __attribute__((ext_vector_type(4)));
typedef unsigned v2u __attribute__((ext_vector_type(2)));
typedef float f32x4 __attribute__((ext_vector_type(4)));
typedef float f32x16 __attribute__((ext_vector_type(16)));
typedef short bf16x8 __attribute__((ext_vector_type(8)));
typedef short s16x4 __attribute__((ext_vector_type(4)));
typedef GAS unsigned gu32;
#define RLX_AGENT __ATOMIC_RELAXED, __HIP_MEMORY_SCOPE_AGENT
#define LDS_WAIT() asm volatile("s_waitcnt lgkmcnt(0)" ::: "memory")
#define VM_WAIT() asm volatile("s_waitcnt vmcnt(0)" ::: "memory")
__device__ __forceinline__ unsigned pk2(float lo, float hi) { return pg8::cvt_pk_bf16(lo, hi); }
__device__ __forceinline__ unsigned f2bf(float f) { return pg8::cvt_pk_bf16(f, 0.f) & 0xffffu; }
__device__ __forceinline__ float bflo(unsigned w) { return pg8::unpk_lo(w); }
__device__ __forceinline__ float bfhi(unsigned w) { return pg8::unpk_hi(w); }
__device__ __forceinline__ float h2f(unsigned short b) { return pg8::unpk_lo((unsigned)b); }
#define dppf(v, ctrl) __builtin_bit_cast(float, __builtin_amdgcn_update_dpp(0, __builtin_bit_cast(int, (float)(v)), (ctrl), 0xf, 0xf, true))
#define DPP_X1 0xB1
#define DPP_X2 0x4E
#define DPP_HM 0x141
#define DPP_RM 0x140
__device__ __forceinline__ float x16_sum(float v) { auto rr = __builtin_amdgcn_permlane16_swap(__float_as_uint(v), __float_as_uint(v), false, false); return __uint_as_float(rr[0]) + __uint_as_float(rr[1]); }
__device__ __forceinline__ float x16_max(float v) { auto rr = __builtin_amdgcn_permlane16_swap(__float_as_uint(v), __float_as_uint(v), false, false); return fmaxf(__uint_as_float(rr[0]), __uint_as_float(rr[1])); }
__device__ __forceinline__ float swap_sum(float v) { auto rr = __builtin_amdgcn_permlane32_swap(__float_as_uint(v), __float_as_uint(v), false, false); return __uint_as_float(rr[0]) + __uint_as_float(rr[1]); }
__device__ __forceinline__ float swap_max(float v) { auto rr = __builtin_amdgcn_permlane32_swap(__float_as_uint(v), __float_as_uint(v), false, false); return fmaxf(__uint_as_float(rr[0]), __uint_as_float(rr[1])); }
__device__ __forceinline__ float wave_sum(float v) { v += dppf(v, DPP_X1); v += dppf(v, DPP_X2); v += dppf(v, DPP_HM); v += dppf(v, DPP_RM); v = x16_sum(v); return swap_sum(v); }
__device__ __forceinline__ float wave_max(float v) { v = fmaxf(v, dppf(v, DPP_X1)); v = fmaxf(v, dppf(v, DPP_X2)); v = fmaxf(v, dppf(v, DPP_HM)); v = fmaxf(v, dppf(v, DPP_RM)); v = x16_max(v); return swap_max(v); }
__device__ __forceinline__ int crow(int r, int hi) { return (r & 3) + 8 * (r >> 2) + 4 * hi; }
#define KSWZ(row, colB) ((row) * 256 + ((colB) ^ (((row) & 7) << 4)))
#define TRRD(dst, base, off) asm volatile("ds_read_b64_tr_b16 %0, %1 offset:%2" : "=&v"(dst) : "v"(base), "i"(off) : "memory")
__device__ __forceinline__ bf16x8 mk8(s16x4 l, s16x4 h) { return (bf16x8){l[0], l[1], l[2], l[3], h[0], h[1], h[2], h[3]}; }
__device__ __forceinline__ bf16x8 pack8f(const float* p) { v4u w; w.x = pk2(p[0], p[1]); w.y = pk2(p[2], p[3]); w.z = pk2(p[4], p[5]); w.w = pk2(p[6], p[7]); return __builtin_bit_cast(bf16x8, w); }

#define XB_TMO      128
#define XB_XCNT(j)  (256  + 64 * (j))
#define XB_XSUB(j)  (1280 + 64 * (j))
#define XB_XGEN(j)  (2304 + 64 * (j))
#define XB_TOP      3328
#define XB_TOPGEN   3392
#define XCD_BAR_WORDS 3456
#define XB_SPIN_CAP (1u << 18)

__device__ __forceinline__ unsigned xb_ld(unsigned* p)              { return __hip_atomic_load(p, __ATOMIC_RELAXED, __HIP_MEMORY_SCOPE_AGENT); }
__device__ __forceinline__ unsigned xb_add(unsigned* p, unsigned v) { return __hip_atomic_fetch_add(p, v, __ATOMIC_RELAXED, __HIP_MEMORY_SCOPE_AGENT); }
__device__ __forceinline__ unsigned xb_xcc_id() { return (unsigned)__builtin_amdgcn_s_getreg((3 << 11) | 20) & 0xFu; }
#define XB_SPIN(cond, bar) do { unsigned _sp = 0; while (cond) { __builtin_amdgcn_s_sleep(1); \
    if ((++_sp & 255u) == 0u) { if (xb_ld(&(bar)[XB_TMO])) break; if (_sp > XB_SPIN_CAP) { atomicAdd(&(bar)[XB_TMO], 1u); break; } } } } while (0)

struct XcdBarrier {
    unsigned* bar; unsigned x;
    volatile LAS unsigned* st;
};

__device__ __forceinline__ XcdBarrier xcd_barrier_post(unsigned* bar, volatile LAS unsigned* st) {
    XcdBarrier b; b.bar = bar; b.x = xb_xcc_id(); b.st = st;
    if (threadIdx.x == 0) (void)xb_add(&bar[XB_XCNT(b.x)], 1u);
    return b;
}
__device__ __forceinline__ void xcd_barrier_complete(unsigned* bar, unsigned x, unsigned& nloc, unsigned& nx) {
    const unsigned G = gridDim.x * gridDim.y * gridDim.z;
    unsigned sum, cnt, mine, sp = 0u;
    for (;;) {
        sum = 0u; cnt = 0u; mine = 0u;
#pragma unroll
        for (unsigned j = 0; j < 16; ++j) { const unsigned c = xb_ld(&bar[XB_XCNT(j)]); sum += c; cnt += (c > 0u) ? 1u : 0u; mine = (j == x) ? c : mine; }
        if (sum == G) break;
        __builtin_amdgcn_s_sleep(1);
        if ((++sp & 255u) == 0u) { if (xb_ld(&bar[XB_TMO])) break; if (sp > XB_SPIN_CAP) { atomicAdd(&bar[XB_TMO], 1u); break; } }
    }
    nloc = mine > 0u ? mine : 1u; nx = cnt > 0u ? cnt : 1u;
}

__device__ __forceinline__ void xcd_barrier(const XcdBarrier& b) {
    asm volatile("s_waitcnt vmcnt(0)" ::: "memory");
    __syncthreads();
    if (threadIdx.x == 0) {
        unsigned* bar = b.bar;
        __builtin_amdgcn_s_waitcnt(0);
        unsigned nloc = b.st[0], nx = b.st[1];
        if (nloc == 0u) { xcd_barrier_complete(bar, b.x, nloc, nx); b.st[0] = nloc; b.st[1] = nx; }
        const unsigned old = xb_add(&bar[XB_XSUB(b.x)], 1u);
        const unsigned gen = old / nloc;
        if (old + 1u == (gen + 1u) * nloc) {
            __builtin_amdgcn_fence(__ATOMIC_RELEASE, "agent");
            asm volatile("s_waitcnt vmcnt(0)" ::: "memory");
            const unsigned og = xb_add(&bar[XB_TOP], 1u);
            const unsigned tg = og / nx;
            if (og + 1u == (tg + 1u) * nx) xb_add(&bar[XB_TOPGEN], 1u);
            else XB_SPIN(xb_ld(&bar[XB_TOPGEN]) == tg, bar);
            __builtin_amdgcn_fence(__ATOMIC_ACQUIRE, "agent");
            xb_add(&bar[XB_XGEN(b.x)], 1u);
            asm volatile("s_waitcnt vmcnt(0)" ::: "memory");
        } else {
            XB_SPIN(xb_ld(&bar[XB_XGEN(b.x)]) == gen, bar);
            __builtin_amdgcn_fence(__ATOMIC_ACQUIRE, "agent");
            asm volatile("s_waitcnt vmcnt(0)" ::: "memory");
        }
    }
    __syncthreads();
}

#ifndef DBG_PERTURB
#define DBG_PERTURB 0
#endif
struct Params { const float* in[26]; float* out; unsigned char* ws; int ph_lo, ph_hi, pert, pad; };
enum { I_X = 0, I_P, I_WINE, I_WOUTE, I_DLAM, I_GDIFF, I_WCQK, I_BCQK, I_BIG, I_BFG, I_GML, I_WINO, I_WOUTO, I_GRET, I_GMPRE, I_GMPOST, I_GFPRE, I_GFPOST, I_WUP, I_WFC, I_BFC, I_WDN, I_GPLE, I_WPD, I_WPU, I_WPP };

typedef const __attribute__((address_space(4))) Params* KParams;
struct Frame {
    LAS unsigned char* lds;
    int tid, lane, wave, G, bid;
};
#define LANE_ID_ASM() ({ int l__; asm volatile("v_mbcnt_lo_u32_b32 %0, -1, 0\n\tv_mbcnt_hi_u32_b32 %0, -1, %0 ; LANE_ID" : "=v"(l__)); l__; })
#define PHASE_ENTRY(F) Frame F = F##_in; { const int l_ = LANE_ID_ASM(); F.lane = l_; F.tid = F.wave * 64 + l_; }

__device__ __forceinline__ void p0_transpose_item(const float* W, int ldw, int K, int N, bf16* WT, const float* gain, int rope_cols, LAS float* scr, int item, int lane) {
    const int nblk = N / 32, kb = item / nblk, nb = item % nblk, k0 = 64 * kb, n0 = 32 * nb;
    const int j = lane & 31, np = n0 + j;
    int nl = np; if (np < rope_cols) { const int hb = np & ~127, jj = np & 127; nl = hb + (jj & 1) * 64 + (jj >> 1); }
#pragma unroll 8
    for (int i = 0; i < 32; ++i) { const int kk = 2 * i + (lane >> 5); float v = W[(size_t)(k0 + kk) * ldw + nl]; if (gain) v *= gain[k0 + kk]; scr[kk * 33 + j] = v; }
    LDS_WAIT(); asm volatile("" ::: "memory");
    const int c = lane & 7;
#pragma unroll
    for (int jq = 0; jq < 4; ++jq) { const int n = (lane >> 3) + 8 * jq; const LAS float* s = scr + (8 * c) * 33 + n;
        v4u o; o.x = pk2(s[0 * 33], s[1 * 33]); o.y = pk2(s[2 * 33], s[3 * 33]); o.z = pk2(s[4 * 33], s[5 * 33]); o.w = pk2(s[6 * 33], s[7 * 33]);
        *(GAS v4u*)(WT + (size_t)(n0 + n) * K + k0 + 8 * c) = o; }
    LDS_WAIT(); asm volatile("" ::: "memory");
}
__device__ __forceinline__ void p0_prologue(const Frame& F_in, KParams P) { PHASE_ENTRY(F);
    unsigned char* ws = P->ws;
    LAS float* scr = (LAS float*)(F.lds + F.wave * 16384);
    const int gw = F.bid * NWAVES + F.wave, NGW = F.G * NWAVES;
    constexpr int I_IN = 64 * 192, I_OUT = 32 * 128, I_UP = 64 * 256, I_DN = 64 * 128, I_PD = 64 * 8, I_PU = 4 * 128, I_PP = 4 * 128;
    constexpr int I_LAYER = I_IN + I_OUT + I_UP + I_DN + I_PD + I_PU + I_PP;
    for (int it = gw; it < DEPTH_ * I_LAYER; it += NGW) {
        const int L = it / I_LAYER; int r = it - L * I_LAYER; const int j = L >> 1; const bool ev = (L & 1) == 0;
        if (r < I_IN) { const float* W = ev ? P->in[I_WINE] + (size_t)j * DM * 6152 : P->in[I_WINO] + (size_t)j * DM * 6144;
            p0_transpose_item(W, ev ? 6152 : 6144, DM, NIN, (bf16*)(ws + WS_WIN) + (size_t)L * NIN * DM, P->in[I_GMPRE] + (size_t)L * DM, ev ? 2048 : 1024, scr, r, F.lane); continue; } r -= I_IN;
        if (r < I_OUT) { const float* W = (ev ? P->in[I_WOUTE] : P->in[I_WOUTO]) + (size_t)j * NMIX * DM;
            p0_transpose_item(W, DM, NMIX, DM, (bf16*)(ws + WS_WOUT) + (size_t)L * DM * NMIX, nullptr, 0, scr, r, F.lane); continue; } r -= I_OUT;
        if (r < I_UP) { p0_transpose_item(P->in[I_WUP] + (size_t)L * DM * NUP, NUP, DM, NUP, (bf16*)(ws + WS_WUP) + (size_t)L * NUP * DM, P->in[I_GFPRE] + (size_t)L * DM, 0, scr, r, F.lane); continue; } r -= I_UP;
        if (r < I_DN) { p0_transpose_item(P->in[I_WDN] + (size_t)L * DM * DM, DM, DM, DM, (bf16*)(ws + WS_WDN) + (size_t)L * DM * DM, nullptr, 0, scr, r, F.lane); continue; } r -= I_DN;
        if (r < I_PD) { p0_transpose_item(P->in[I_WPD] + (size_t)L * DM * PLED, PLED, DM, PLED, (bf16*)(ws + WS_WPD) + (size_t)L * PLED * DM, P->in[I_GPLE] + (size_t)L * DM, 0, scr, r, F.lane); continue; } r -= I_PD;
        if (r < I_PU) { p0_transpose_item(P->in[I_WPU] + (size_t)L * PLED * DM, DM, PLED, DM, (bf16*)(ws + WS_WPU) + (size_t)L * DM * PLED, nullptr, 0, scr, r, F.lane); continue; } r -= I_PU;
        p0_transpose_item(P->in[I_WPP] + (size_t)L * PLED * DM, DM, PLED, DM, (bf16*)(ws + WS_WPP) + (size_t)L * DM * PLED, nullptr, 0, scr, r, F.lane);
    }
    const int gt = F.bid * (NWAVES * 64) + F.tid, NGT = F.G * NWAVES * 64;
    for (int e = gt; e < 2 * DM; e += NGT) { const int j = e / DM, k = e - j * DM; const float g = P->in[I_GMPRE][(size_t)(2 * j) * DM + k]; const float* w = P->in[I_WINE] + ((size_t)j * DM + k) * 6152 + 6144;
        bf16* o = (bf16*)(ws + WS_WG) + (size_t)j * 8 * DM + k;
#pragma unroll
        for (int c = 0; c < 8; ++c) o[(size_t)c * DM] = (bf16)f2bf(g * w[c]); }
    for (size_t e = gt; e < (size_t)DEPTH_ * S_ * PLED / 8; e += NGT) { const f32x4 a = *(const f32x4*)(P->in[I_P] + e * 8), b = *(const f32x4*)(P->in[I_P] + e * 8 + 4);
        v4u o; o.x = pk2(a[0], a[1]); o.y = pk2(a[2], a[3]); o.z = pk2(b[0], b[1]); o.w = pk2(b[2], b[3]); *(v4u*)((bf16*)(ws + WS_PB) + e * 8) = o; }
    for (int e = gt; e < S_ * 64; e += NGT) { const int t = e >> 6, i = e & 63;
        const float finv = (float)exp2(-(double)i * (13.287712379549449 / 64.0)); const float ang = (float)t * finv; const double ad = (double)ang;
        const double n = rint(ad * 0.63661977236758134308); const double r = (ad - n * 1.57079632679489655800e+00) - n * 6.12323399573676603587e-17; const double r2 = r * r;
        double sn = r * (1.0 + r2 * (-1.0 / 6 + r2 * (1.0 / 120 + r2 * (-1.0 / 5040 + r2 * (1.0 / 362880 + r2 * (-1.0 / 39916800 + r2 * (1.0 / 6227020800.0)))))));
        double cs = 1.0 + r2 * (-0.5 + r2 * (1.0 / 24 + r2 * (-1.0 / 720 + r2 * (1.0 / 40320 + r2 * (-1.0 / 3628800 + r2 * (1.0 / 479001600.0))))));
        const int q = ((int)n) & 3; double c2 = cs, s2 = sn; if (q == 1) { c2 = -sn; s2 = cs; } else if (q == 2) { c2 = -cs; s2 = -sn; } else if (q == 3) { c2 = sn; s2 = -cs; }
        ((float*)(ws + WS_COS))[e] = (float)c2; ((float*)(ws + WS_SIN))[e] = (float)s2; }
    if (F.bid == 0 && F.wave == 0) {
        for (int j = 0; j < 2; ++j) { const float* lp = P->in[I_DLAM] + (size_t)j * 512; const int d = F.lane * 2;
            const float s1 = wave_sum(lp[d] * lp[128 + d] + lp[d + 1] * lp[128 + d + 1]), s2 = wave_sum(lp[256 + d] * lp[384 + d] + lp[256 + d + 1] * lp[384 + d + 1]);
            const float li = 0.8f - 0.6f * expf(-0.3f * (float)(2 * j));
            if (F.lane == 0) { ((float*)(ws + WS_LAM))[2 * j] = expf(s1) - expf(s2) + li; ((float*)(ws + WS_LAM))[2 * j + 1] = li; } }
    }
    for (int row = gw; row < S_; row += NGW) { const float* xr = P->in[I_X] + (size_t)row * DM; bf16* hr = (bf16*)(ws + WS_HB) + (size_t)row * DM; float ss = 0.f;
#pragma unroll
        for (int jj = 0; jj < 8; ++jj) { const int c = (jj * 64 + F.lane) * 8; const f32x4 a = *(const f32x4*)(xr + c), b = *(const f32x4*)(xr + c + 4);
            ss += (a[0] * a[0] + a[1] * a[1]) + (a[2] * a[2] + a[3] * a[3]) + (b[0] * b[0] + b[1] * b[1]) + (b[2] * b[2] + b[3] * b[3]);
            f32x4 a2 = a, b2 = b;
#if DBG_PERTURB
            if (P->pert) { for (int q = 0; q < 4; ++q) { unsigned hx = (unsigned)(row * 4096 + c + q) * 2654435761u; hx ^= hx >> 15; a2[q] *= 1.f + ((float)(hx & 1023u) - 511.5f) * 2e-6f; hx = (unsigned)(row * 4096 + c + 4 + q) * 2654435761u; hx ^= hx >> 15; b2[q] *= 1.f + ((float)(hx & 1023u) - 511.5f) * 2e-6f; } }
#endif
            v4u o; o.x = pk2(a2[0], a2[1]); o.y = pk2(a2[2], a2[3]); o.z = pk2(b2[0], b2[1]); o.w = pk2(b2[2], b2[3]); *(v4u*)(hr + c) = o; }
        const float tot = wave_sum(ss); if (F.lane == 0) ((float*)(ws + WS_RIN))[row] = rsqrtf(tot * (1.f / DM) + EPS_); }
}

__device__ __forceinline__ void gates_pass(const Frame& F_in, const bf16* hb, const bf16* wg, const float* rin, float* gpre) { PHASE_ENTRY(F);
    const int gw = F.bid * NWAVES + F.wave, NGW = F.G * NWAVES;
    for (int rg = gw; rg < S_ / 8; rg += NGW) { const int t0 = rg * 8;
        float acc[8][8];
#pragma unroll
        for (int a = 0; a < 8; ++a)
#pragma unroll
            for (int b = 0; b < 8; ++b) acc[a][b] = 0.f;
        for (int jj = 0; jj < 8; ++jj) { const int k = (jj * 64 + F.lane) * 8;
            v4u w[8];
#pragma unroll
            for (int c = 0; c < 8; ++c) w[c] = *(const v4u*)(wg + (size_t)c * DM + k);
#pragma unroll
            for (int r = 0; r < 8; ++r) { const v4u x = *(const v4u*)(hb + (size_t)(t0 + r) * DM + k);
#pragma unroll
                for (int c = 0; c < 8; ++c) acc[r][c] += (bflo(x.x) * bflo(w[c].x) + bfhi(x.x) * bfhi(w[c].x)) + (bflo(x.y) * bflo(w[c].y) + bfhi(x.y) * bfhi(w[c].y))
                                                        + (bflo(x.z) * bflo(w[c].z) + bfhi(x.z) * bfhi(w[c].z)) + (bflo(x.w) * bflo(w[c].w) + bfhi(x.w) * bfhi(w[c].w)); } }
        float mine = 0.f;
#pragma unroll
        for (int r = 0; r < 8; ++r)
#pragma unroll
            for (int c = 0; c < 8; ++c) { const float s = wave_sum(acc[r][c]); if (F.lane == r * 8 + c) mine = s; }
        gpre[(size_t)t0 * 8 + F.lane] = mine * rin[t0 + (F.lane >> 3)]; }
}
__device__ __forceinline__ void resid_pass(const Frame& F_in, const float* hin, const bf16* y, const float* ssp, const float* g, float* hout, bf16* hb, float* rout) { PHASE_ENTRY(F);
    const int gw = F.bid * NWAVES + F.wave, NGW = F.G * NWAVES;
    for (int row = gw; row < S_; row += NGW) {
        const float ry = rsqrtf(wave_sum(ssp[(size_t)row * 64 + F.lane]) * (1.f / DM) + EPS_);
        const float* hr = hin + (size_t)row * DM; const bf16* yr = y + (size_t)row * DM; float* ho = hout + (size_t)row * DM; bf16* hbr = hb + (size_t)row * DM; float ss = 0.f;
#pragma unroll
        for (int jj = 0; jj < 8; ++jj) { const int c = (jj * 64 + F.lane) * 8; const f32x4 a = *(const f32x4*)(hr + c), b = *(const f32x4*)(hr + c + 4); const v4u yv = *(const v4u*)(yr + c);
            const f32x4 ga = *(const f32x4*)(g + c), gb = *(const f32x4*)(g + c + 4);
            f32x4 oa, ob; oa[0] = a[0] + bflo(yv.x) * ry * ga[0]; oa[1] = a[1] + bfhi(yv.x) * ry * ga[1]; oa[2] = a[2] + bflo(yv.y) * ry * ga[2]; oa[3] = a[3] + bfhi(yv.y) * ry * ga[3];
            ob[0] = b[0] + bflo(yv.z) * ry * gb[0]; ob[1] = b[1] + bfhi(yv.z) * ry * gb[1]; ob[2] = b[2] + bflo(yv.w) * ry * gb[2]; ob[3] = b[3] + bfhi(yv.w) * ry * gb[3];
            ss += (oa[0] * oa[0] + oa[1] * oa[1]) + (oa[2] * oa[2] + oa[3] * oa[3]) + (ob[0] * ob[0] + ob[1] * ob[1]) + (ob[2] * ob[2] + ob[3] * ob[3]);
            *(f32x4*)(ho + c) = oa; *(f32x4*)(ho + c + 4) = ob;
            v4u o; o.x = pk2(oa[0], oa[1]); o.y = pk2(oa[2], oa[3]); o.z = pk2(ob[0], ob[1]); o.w = pk2(ob[2], ob[3]); *(v4u*)(hbr + c) = o; }
        const float tot = wave_sum(ss); if (F.lane == 0) rout[row] = rsqrtf(tot * (1.f / DM) + EPS_); }
}
__device__ __forceinline__ void rin_pass(const Frame& F_in, const float* ssp, float* rout) { PHASE_ENTRY(F);
    const int gw = F.bid * NWAVES + F.wave, NGW = F.G * NWAVES;
    for (int row = gw; row < S_; row += NGW) { const float tot = wave_sum(ssp[(size_t)row * 64 + F.lane]); if (F.lane == 0) rout[row] = rsqrtf(tot * (1.f / DM) + EPS_); }
}
__device__ __forceinline__ float gelu_tanh(float x) { const float u = 0.7978845608028654f * (x + 0.044715f * x * x * x); return x * __builtin_amdgcn_rcpf(1.f + __expf(-2.f * u)); }
__device__ __forceinline__ void convffn_pass(const Frame& F_in, const bf16* up, const float* wc, const float* bc, bf16* act) { PHASE_ENTRY(F);
    const int c0 = F.tid * 8;
    float wa[3][8], wb[3][8], ba[8], bb[8];
#pragma unroll
    for (int k = 0; k < 3; ++k)
#pragma unroll
        for (int e = 0; e < 8; ++e) { wa[k][e] = wc[(size_t)k * NUP + c0 + e]; wb[k][e] = wc[(size_t)k * NUP + 4096 + c0 + e]; }
#pragma unroll
    for (int e = 0; e < 8; ++e) { ba[e] = bc[c0 + e]; bb[e] = bc[4096 + c0 + e]; }
    for (int rb = F.bid; rb < S_ / 64; rb += F.G) { const int t0 = rb * 64;
        v4u a2 = (v4u){0u, 0u, 0u, 0u}, a1 = a2, b2 = a2, b1 = a2;
        if (t0 > 0) { a2 = *(const v4u*)(up + (size_t)(t0 - 2) * NUP + c0); b2 = *(const v4u*)(up + (size_t)(t0 - 2) * NUP + 4096 + c0);
                      a1 = *(const v4u*)(up + (size_t)(t0 - 1) * NUP + c0); b1 = *(const v4u*)(up + (size_t)(t0 - 1) * NUP + 4096 + c0); }
#pragma unroll 2
        for (int t = t0; t < t0 + 64; ++t) { const v4u a0 = *(const v4u*)(up + (size_t)t * NUP + c0), b0 = *(const v4u*)(up + (size_t)t * NUP + 4096 + c0);
            float o[8];
            const unsigned A2[4] = {a2.x, a2.y, a2.z, a2.w}, A1[4] = {a1.x, a1.y, a1.z, a1.w}, A0[4] = {a0.x, a0.y, a0.z, a0.w};
            const unsigned B2[4] = {b2.x, b2.y, b2.z, b2.w}, B1[4] = {b1.x, b1.y, b1.z, b1.w}, B0[4] = {b0.x, b0.y, b0.z, b0.w};
#pragma unroll
            for (int e = 0; e < 8; ++e) { const int q = e >> 1; const bool hi = e & 1;
                const float xa2 = hi ? bfhi(A2[q]) : bflo(A2[q]), xa1 = hi ? bfhi(A1[q]) : bflo(A1[q]), xa0 = hi ? bfhi(A0[q]) : bflo(A0[q]);
                const float xb2 = hi ? bfhi(B2[q]) : bflo(B2[q]), xb1 = hi ? bfhi(B1[q]) : bflo(B1[q]), xb0 = hi ? bfhi(B0[q]) : bflo(B0[q]);
                const float ya = ba[e] + wa[0][e] * xa2 + wa[1][e] * xa1 + wa[2][e] * xa0, yb = bb[e] + wb[0][e] * xb2 + wb[1][e] * xb1 + wb[2][e] * xb0;
                o[e] = gelu_tanh(ya) * yb; }
            v4u ov; ov.x = pk2(o[0], o[1]); ov.y = pk2(o[2], o[3]); ov.z = pk2(o[4], o[5]); ov.w = pk2(o[6], o[7]);
            *(v4u*)(act + (size_t)t * DM + c0) = ov;
            a2 = a1; a1 = a0; b2 = b1; b1 = b0; } }
}
__device__ __forceinline__ void diffcomb_pass(const Frame& F_in, const bf16* od, const float* g, const float* lamv, bf16* ymix) { PHASE_ENTRY(F);
    const int gw = F.bid * NWAVES + F.wave, NGW = F.G * NWAVES; const float lam = lamv[0], sc = 1.f - lamv[1];
    const f32x4 g4 = *(const f32x4*)(g + F.lane * 4);
    for (int it = gw; it < S_ * 4; it += NGW) { const int t = it >> 2, h = it & 3;
        const v2u a = *(const v2u*)(od + ((size_t)t * 8 + 2 * h) * 256 + F.lane * 4), b = *(const v2u*)(od + ((size_t)t * 8 + 2 * h + 1) * 256 + F.lane * 4);
        f32x4 d; d[0] = bflo(a.x) - lam * bflo(b.x); d[1] = bfhi(a.x) - lam * bfhi(b.x); d[2] = bflo(a.y) - lam * bflo(b.y); d[3] = bfhi(a.y) - lam * bfhi(b.y);
        const float r = rsqrtf(wave_sum((d[0] * d[0] + d[1] * d[1]) + (d[2] * d[2] + d[3] * d[3])) * (1.f / 256.f) + EPS_) * sc;
        v2u o; o.x = pk2(d[0] * r * g4[0], d[1] * r * g4[1]); o.y = pk2(d[2] * r * g4[2], d[3] * r * g4[3]);
        *(v2u*)(ymix + (size_t)t * NMIX + h * 256 + F.lane * 4) = o; }
}

constexpr int AT_VSTR = 320, AT_VT = 64 * AT_VSTR, AT_KT = 16384;
constexpr float AT_C2 = 0.08838834764831845f * 1.4426950408889634f;
template <int MODE>
__device__ __forceinline__ void attn_unit(LAS unsigned char* lds, int wave_in, const bf16* Qp, const bf16* Kp, const bf16* Vp, int ldp, int qb, bf16* Op, int ldo) {
    const int lane_o = LANE_ID_ASM();
    const int wid = wave_in, lane = lane_o, tid = wid * 64 + lane, r32 = lane & 31, hi = lane >> 5;
    const int P0 = qb * 256, qrow = P0 + 32 * wid + r32, jd = (P0 + 32 * wid) >> 6, NT = 4 * qb + 4;
    bf16x8 qr[8];
#pragma unroll
    for (int s = 0; s < 8; ++s) qr[s] = *(const bf16x8*)(Qp + (size_t)qrow * ldp + 16 * s + 8 * hi);
    const int sr = tid >> 4, sc = (tid & 15) * 8;
    const int kws = KSWZ(sr, sc * 2), vws = sr * AT_VSTR + sc * 2;
    const unsigned ldsb = (unsigned)(uintptr_t)lds;
    const unsigned vrb = ldsb + (unsigned)((4 * hi + ((lane >> 2) & 3)) * AT_VSTR + (16 * ((lane >> 4) & 1) + 4 * (lane & 3)) * 2);
    LAS unsigned char* kb[4];
#pragma unroll
    for (int dd = 0; dd < 4; ++dd) kb[dd] = lds + 2 * AT_VT + KSWZ(r32, (dd * 16 + hi * 8) * 2);
    v4u sk0, sk1, sv0, sv1;
#define AT_LOAD(j) do { const size_t g0 = (size_t)((j) * 64 + sr) * ldp + sc; sk0 = *(const v4u*)(Kp + g0); sk1 = *(const v4u*)(Kp + g0 + (size_t)32 * ldp); sv0 = *(const v4u*)(Vp + g0); sv1 = *(const v4u*)(Vp + g0 + (size_t)32 * ldp); } while (0)
#define AT_WRITE(b) do { *(LAS v4u*)(lds + 2 * AT_VT + (b) * AT_KT + kws) = sk0; *(LAS v4u*)(lds + 2 * AT_VT + (b) * AT_KT + kws + 32 * 256) = sk1; \
                         *(LAS v4u*)(lds + (b) * AT_VT + vws) = sv0; *(LAS v4u*)(lds + (b) * AT_VT + vws + 32 * AT_VSTR) = sv1; } while (0)
#define AT_JT(t) (MODE == 0 ? (t) : NT - 1 - (t))
    f32x16 o[4];
#pragma unroll
    for (int d = 0; d < 4; ++d)
#pragma unroll
        for (int r = 0; r < 16; ++r) o[d][r] = 0.f;
    float m_run = -1e30f, l_run = 0.f, carry = 1.f;
    __syncthreads();
    AT_LOAD(AT_JT(0)); AT_WRITE(0);
    __syncthreads();
    for (int t = 0; t < NT; ++t) {
        const int j = AT_JT(t), b = t & 1;
        if (t + 1 < NT) AT_LOAD(AT_JT(t + 1));
        if (j <= jd) {
            f32x16 p0, p1;
#pragma unroll
            for (int r = 0; r < 16; ++r) { p0[r] = 0.f; p1[r] = 0.f; }
#pragma unroll
            for (int d0 = 0; d0 < 8; ++d0) { const LAS unsigned char* a = kb[d0 & 3] + b * AT_KT + (d0 >> 2) * 128;
                const bf16x8 k0 = *(const LAS bf16x8*)a, k1 = *(const LAS bf16x8*)(a + 32 * 256);
                p0 = MFMA32(k0, qr[d0], p0);
                p1 = MFMA32(k1, qr[d0], p1); }
            bf16x8 pk[4];
            if (MODE == 0) {
                float pm = p0[0];
#pragma unroll
                for (int r = 1; r < 16; ++r) pm = fmaxf(pm, p0[r]);
#pragma unroll
                for (int r = 0; r < 16; ++r) pm = fmaxf(pm, p1[r]);
                pm = swap_max(pm);
                if (!__all((pm - m_run) * AT_C2 <= 8.f)) { const float mn = fmaxf(m_run, pm), al = __builtin_amdgcn_exp2f((m_run - mn) * AT_C2); m_run = mn; l_run *= al;
#pragma unroll
                    for (int d = 0; d < 4; ++d)
#pragma unroll
                        for (int r = 0; r < 16; ++r) o[d][r] *= al; }
                const float mb = -m_run * AT_C2; float ps = 0.f;
#pragma unroll
                for (int r = 0; r < 16; ++r) { p0[r] = __builtin_amdgcn_exp2f(fmaf(p0[r], AT_C2, mb)); p1[r] = __builtin_amdgcn_exp2f(fmaf(p1[r], AT_C2, mb)); ps += p0[r] + p1[r]; }
                l_run += swap_sum(ps);
            } else {
                float kp[32];
#pragma unroll
                for (int r = 0; r < 16; ++r) { kp[r] = __builtin_amdgcn_rcpf(1.f + __builtin_amdgcn_exp2f(p0[r] * AT_C2)); kp[16 + r] = __builtin_amdgcn_rcpf(1.f + __builtin_amdgcn_exp2f(p1[r] * AT_C2)); }
                if (j == jd) { const int qrel = qrow - 64 * j;
#pragma unroll
                    for (int r = 0; r < 16; ++r) { if (crow(r, hi) >= qrel) kp[r] = 1.f; if (32 + crow(r, hi) >= qrel) kp[16 + r] = 1.f; } }
                float all[16];
#pragma unroll
                for (int q = 0; q < 8; ++q) { const float gp = (kp[4 * q] * kp[4 * q + 1]) * (kp[4 * q + 2] * kp[4 * q + 3]);
                    auto rr = __builtin_amdgcn_permlane32_swap(__float_as_uint(gp), __float_as_uint(gp), false, false); all[2 * q] = __uint_as_float(rr[0]); all[2 * q + 1] = __uint_as_float(rr[1]); }
                float T[16]; T[15] = carry;
#pragma unroll
                for (int g = 14; g >= 0; --g) T[g] = T[g + 1] * all[g + 1];
                carry = T[0] * all[0];
#pragma unroll
                for (int q = 0; q < 8; ++q) { const float s3 = T[2 * q + 1] * (hi ? 1.f : all[2 * q + 1]), s2 = s3 * kp[4 * q + 3], s1 = s2 * kp[4 * q + 2], s0 = s1 * kp[4 * q + 1];
                    const float a0 = (1.f - kp[4 * q]) * s0, a1 = (1.f - kp[4 * q + 1]) * s1, a2 = (1.f - kp[4 * q + 2]) * s2, a3 = (1.f - kp[4 * q + 3]) * s3;
                    if (q < 4) { p0[4 * q] = a0; p0[4 * q + 1] = a1; p0[4 * q + 2] = a2; p0[4 * q + 3] = a3; } else { p1[4 * q - 16] = a0; p1[4 * q - 15] = a1; p1[4 * q - 14] = a2; p1[4 * q - 13] = a3; } }
            }
            { v4u w;
              w.x = pk2(p0[0], p0[1]); w.y = pk2(p0[2], p0[3]); w.z = pk2(p0[4], p0[5]); w.w = pk2(p0[6], p0[7]); pk[0] = __builtin_bit_cast(bf16x8, w);
              w.x = pk2(p0[8], p0[9]); w.y = pk2(p0[10], p0[11]); w.z = pk2(p0[12], p0[13]); w.w = pk2(p0[14], p0[15]); pk[1] = __builtin_bit_cast(bf16x8, w);
              w.x = pk2(p1[0], p1[1]); w.y = pk2(p1[2], p1[3]); w.z = pk2(p1[4], p1[5]); w.w = pk2(p1[6], p1[7]); pk[2] = __builtin_bit_cast(bf16x8, w);
              w.x = pk2(p1[8], p1[9]); w.y = pk2(p1[10], p1[11]); w.z = pk2(p1[12], p1[13]); w.w = pk2(p1[14], p1[15]); pk[3] = __builtin_bit_cast(bf16x8, w); }
            const unsigned vb = vrb + (unsigned)(b * AT_VT);
#define AT_PV(d0, ks) do { s16x4 l_, h_; TRRD(l_, vb, (ks) * 16 * AT_VSTR + (d0) * 64); TRRD(h_, vb, ((ks) * 16 + 8) * AT_VSTR + (d0) * 64); asm volatile("s_waitcnt lgkmcnt(0)" : "+v"(l_), "+v"(h_) :: "memory"); \
                o[d0] = MFMA32(mk8(l_, h_), pk[ks], o[d0]); } while (0)
#define AT_PVD(d0) do { AT_PV(d0, 0); AT_PV(d0, 1); AT_PV(d0, 2); AT_PV(d0, 3); } while (0)
            AT_PVD(0); AT_PVD(1); AT_PVD(2); AT_PVD(3);
#undef AT_PVD
#undef AT_PV
        }
        if (t + 1 < NT) AT_WRITE(b ^ 1);
        __syncthreads();
    }
    const float inv = (MODE == 0) ? __builtin_amdgcn_rcpf(l_run) : 1.f;
    bf16* orow = Op + (size_t)qrow * ldo;
#pragma unroll
    for (int d = 0; d < 4; ++d)
#pragma unroll
        for (int rg = 0; rg < 4; ++rg) { v2u w; w.x = pk2(o[d][4 * rg] * inv, o[d][4 * rg + 1] * inv); w.y = pk2(o[d][4 * rg + 2] * inv, o[d][4 * rg + 3] * inv);
            *(v2u*)(orow + 32 * d + 8 * rg + 4 * hi) = w; }
#undef AT_LOAD
#undef AT_WRITE
#undef AT_JT
}
template <int MODE>
__device__ __forceinline__ void attn_phase(const Frame& F_in, gu32* qhead, const bf16* proj, bf16* outp) { PHASE_ENTRY(F);
    volatile LAS unsigned* slot = (volatile LAS unsigned*)(F.lds + MISC_OFF + 64);
    constexpr int NU = (MODE == 0) ? 1024 : 512;
    for (;;) {
        __syncthreads();
        if (F.tid == 0) *slot = __hip_atomic_fetch_add(qhead, 1u, RLX_AGENT);
        __syncthreads();
        const int u = (int)*slot;
        if (u >= NU) break;
        if (MODE == 0) { const int qb = 63 - (u >> 4), hm = (u >> 1) & 7, vh = u & 1;
            attn_unit<0>(F.lds, F.wave, proj + hm * 128, proj + 1024 + hm * 128, proj + 2048 + (hm >> 1) * 256 + vh * 128, NIN, qb, outp + hm * 256 + vh * 128, 2048);
        } else { const int qb = 63 - (u >> 3), h = u & 7;
            attn_unit<1>(F.lds, F.wave, proj + 3072 + h * 128, proj + 4096 + h * 128, proj + 5120 + h * 128, NIN, qb, outp + 1024 + h * 128, NMIX); }
    }
}

constexpr float LIN_SC = 0.08838834764831845f;
constexpr int LK_STR = 320, LV_STR = 576;
struct LinArgs {
    const bf16* proj; bf16* qkc; const float* gpre; const float* b_i; const float* b_f; const float* wconv; const float* bconv; const float* gnorm;
    float* chs; float* dC; bf16* CH; float* dn; float* nh; bf16* ymix;
};
__device__ __forceinline__ float wave_prefix_sum(float v, int lane, LAS float* scr) { scr[lane] = v; LDS_WAIT(); asm volatile("" ::: "memory"); float b = 0.f;
    for (int s = 0; s < 64; ++s) { const float x = scr[s]; b += (s <= lane) ? x : 0.f; } LDS_WAIT(); asm volatile("" ::: "memory"); return b; }
__device__ __forceinline__ float wave_prefix_max(float v, int lane, LAS float* scr) { scr[lane] = v; LDS_WAIT(); asm volatile("" ::: "memory"); float b = v;
    for (int s = 0; s < 64; ++s) { const float x = scr[s]; b = (s <= lane) ? fmaxf(b, x) : b; } LDS_WAIT(); asm volatile("" ::: "memory"); return b; }
template <bool ML>
__device__ __forceinline__ void lin_gates(const LinArgs& A, int t0, int h, int lane, LAS float* scr, float& li, float& b) {
    if (ML) { const float f = A.gpre[(size_t)(t0 + lane) * 8 + 4 + h] + A.b_f[h]; li = A.gpre[(size_t)(t0 + lane) * 8 + h] + A.b_i[h];
        const float lf = fminf(f, 0.f) - __logf(1.f + __expf(-fabsf(f))); b = wave_prefix_sum(lf, lane, scr);
    } else { const float lg = (h == 0) ? -0.0317486983145803f : (h == 1) ? -0.015748356968139168f : (h == 2) ? -0.007843177461025893f : -0.003913899321136329f;   li = 0.f; b = (float)(lane + 1) * lg; }
}
template <bool ML>
__device__ __forceinline__ void lin_local(const Frame& F_in, const LinArgs& A) { PHASE_ENTRY(F);
    LAS unsigned char* lds = F.lds; const int tid = F.tid, lane = F.lane, wid = F.wave, hi = lane >> 5;
    LAS unsigned char* Kt = lds; LAS unsigned char* Vt = lds + 64 * LK_STR; LAS float* wks = (LAS float*)(lds + 64 * LK_STR + 64 * LV_STR);
    const int sr = tid >> 4, sc = (tid & 15) * 8;
    for (int u = F.bid; u < NCH * 4; u += F.G) { const int c = u >> 2, h = u & 3, t0 = c * 64;
        __syncthreads();
        if (wid == 0) { float li, b; lin_gates<ML>(A, t0, h, lane, wks, li, b); wks[lane] = b; LDS_WAIT(); asm volatile("" ::: "memory"); const float bl = wks[63]; LDS_WAIT(); asm volatile("" ::: "memory"); const float g = bl - b + li; const float a = ML ? wave_max(g) : 0.f;
            wks[lane] = __expf(g - a) * LIN_SC; if (lane == 0) { A.chs[c * 4 + h] = bl; A.chs[NCH * 4 + c * 4 + h] = a; } }
        __syncthreads();
#pragma unroll
        for (int rr = 0; rr < 2; ++rr) { const int s = sr + 32 * rr, t = t0 + s; const float wk = wks[s];
            if (ML) {
#pragma unroll
                for (int X = 0; X < 2; ++X) { const int ch = X * 512 + 128 * h + sc; float y[8];
#pragma unroll
                    for (int e = 0; e < 8; ++e) y[e] = A.bconv[ch + e];
#pragma unroll
                    for (int tap = 0; tap < 4; ++tap) { const int tt = t - 3 + tap; v4u x = (v4u){0u, 0u, 0u, 0u}; if (tt >= 0) x = *(const v4u*)(A.proj + (size_t)tt * NIN + 3072 + ch);
                        const f32x4 w0 = *(const f32x4*)(A.wconv + (size_t)tap * 1024 + ch), w1 = *(const f32x4*)(A.wconv + (size_t)tap * 1024 + ch + 4);
                        y[0] += w0[0] * bflo(x.x); y[1] += w0[1] * bfhi(x.x); y[2] += w0[2] * bflo(x.y); y[3] += w0[3] * bfhi(x.y);
                        y[4] += w1[0] * bflo(x.z); y[5] += w1[1] * bfhi(x.z); y[6] += w1[2] * bflo(x.w); y[7] += w1[3] * bfhi(x.w); }
#pragma unroll
                    for (int e = 0; e < 8; ++e) y[e] = y[e] * __builtin_amdgcn_rcpf(1.f + __expf(-y[e]));
                    v4u o; o.x = pk2(y[0], y[1]); o.y = pk2(y[2], y[3]); o.z = pk2(y[4], y[5]); o.w = pk2(y[6], y[7]);
                    *(v4u*)(A.qkc + (size_t)t * 1024 + ch) = o;
                    if (X == 1) { v4u k; k.x = pk2(y[0] * wk, y[1] * wk); k.y = pk2(y[2] * wk, y[3] * wk); k.z = pk2(y[4] * wk, y[5] * wk); k.w = pk2(y[6] * wk, y[7] * wk);
                        *(LAS v4u*)(Kt + s * LK_STR + sc * 2) = k; } }
            } else { const v4u x = *(const v4u*)(A.proj + (size_t)t * NIN + 512 + 128 * h + sc);
                v4u k; k.x = pk2(bflo(x.x) * wk, bfhi(x.x) * wk); k.y = pk2(bflo(x.y) * wk, bfhi(x.y) * wk); k.z = pk2(bflo(x.z) * wk, bfhi(x.z) * wk); k.w = pk2(bflo(x.w) * wk, bfhi(x.w) * wk);
                *(LAS v4u*)(Kt + s * LK_STR + sc * 2) = k; }
            const bf16* vp = A.proj + (size_t)t * NIN + (ML ? 4096 : 1024) + 256 * h + sc;
            *(LAS v4u*)(Vt + s * LV_STR + sc * 2) = *(const v4u*)vp; *(LAS v4u*)(Vt + s * LV_STR + (128 + sc) * 2) = *(const v4u*)(vp + 128); }
        __syncthreads();
        const unsigned rowb = (unsigned)(8 * hi + ((lane >> 2) & 3)), colb = (unsigned)(16 * ((lane >> 4) & 1) + 4 * (lane & 3));
        const unsigned vb = (unsigned)(uintptr_t)Vt + rowb * LV_STR + (32 * wid + colb) * 2, kbs = (unsigned)(uintptr_t)Kt + rowb * LK_STR + colb * 2;
        bf16x8 av[4];
#define L1_A(ks) do { s16x4 l_, h_; TRRD(l_, vb, (ks) * 16 * LV_STR); TRRD(h_, vb, ((ks) * 16 + 4) * LV_STR); asm volatile("s_waitcnt lgkmcnt(0)" : "+v"(l_), "+v"(h_) :: "memory"); av[ks] = mk8(l_, h_); } while (0)
        L1_A(0); L1_A(1); L1_A(2); L1_A(3);
#undef L1_A
        f32x16 acc[4];
#pragma unroll
        for (int d = 0; d < 4; ++d)
#pragma unroll
            for (int r = 0; r < 16; ++r) acc[d][r] = 0.f;
#define L1_B(d0, ks) do { s16x4 l_, h_; TRRD(l_, kbs, (ks) * 16 * LK_STR + (d0) * 64); TRRD(h_, kbs, ((ks) * 16 + 4) * LK_STR + (d0) * 64); asm volatile("s_waitcnt lgkmcnt(0)" : "+v"(l_), "+v"(h_) :: "memory"); \
            acc[d0] = MFMA32(av[ks], mk8(l_, h_), acc[d0]); } while (0)
#define L1_BD(d0) do { L1_B(d0, 0); L1_B(d0, 1); L1_B(d0, 2); L1_B(d0, 3); } while (0)
        L1_BD(0); L1_BD(1); L1_BD(2); L1_BD(3);
#undef L1_BD
#undef L1_B
        float* dcp = A.dC + ((size_t)(c * 4 + h) * 128) * 256;
#pragma unroll
        for (int d0 = 0; d0 < 4; ++d0)
#pragma unroll
            for (int rg = 0; rg < 4; ++rg) *(f32x4*)(dcp + (size_t)(32 * d0 + (lane & 31)) * 256 + 32 * wid + 8 * rg + 4 * hi) = (f32x4){acc[d0][4 * rg], acc[d0][4 * rg + 1], acc[d0][4 * rg + 2], acc[d0][4 * rg + 3]};
        if (ML && tid < 128) { float s = 0.f;
#pragma unroll 8
            for (int q = 0; q < 64; ++q) s += h2f(*(const LAS unsigned short*)(Kt + q * LK_STR + tid * 2));
            A.dn[(size_t)(c * 4 + h) * 128 + tid] = s; }
    }
}
template <bool ML>
__device__ __forceinline__ void lin_scan(const Frame& F_in, const LinArgs& A) { PHASE_ENTRY(F);
    for (int blk = F.bid; blk < 256; blk += F.G) { const int h = blk >> 6, idx = (blk & 63) * 512 + F.tid; const bool lead = (blk & 63) == 0;
        float C = 0.f, m = 0.f;
        for (int c0 = 0; c0 < NCH; c0 += 8) { float x[8];
#pragma unroll
            for (int u = 0; u < 8; ++u) x[u] = A.dC[(size_t)((c0 + u) * 4 + h) * 32768 + idx];
#pragma unroll
            for (int u = 0; u < 8; ++u) { const int c = c0 + u; A.CH[(size_t)(c * 4 + h) * 32768 + idx] = (bf16)f2bf(C); if (lead && F.tid == 0) A.chs[2 * NCH * 4 + c * 4 + h] = m;
                const float bl = A.chs[c * 4 + h], a = A.chs[NCH * 4 + c * 4 + h], mn = fmaxf(bl + m, a); C = __expf(bl + m - mn) * C + __expf(a - mn) * x[u]; m = mn; } }
        if (ML && lead && F.tid < 128) { float n = 0.f; m = 0.f;
            for (int c = 0; c < NCH; ++c) { A.nh[(size_t)(c * 4 + h) * 128 + F.tid] = n; const float x = A.dn[(size_t)(c * 4 + h) * 128 + F.tid];
                const float bl = A.chs[c * 4 + h], a = A.chs[NCH * 4 + c * 4 + h], mn = fmaxf(bl + m, a); n = __expf(bl + m - mn) * n + __expf(a - mn) * x; m = mn; } }
    }
}
template <bool ML>
__device__ __forceinline__ void lin_out(const Frame& F_in, const LinArgs& A) { PHASE_ENTRY(F);
    LAS unsigned char* lds = F.lds; const int tid = F.tid, lane = F.lane, wid = F.wave, r32 = lane & 31, hi = lane >> 5;
    LAS unsigned char* Kt = lds; LAS unsigned char* Vt = lds + 16384; LAS unsigned char* Ct = lds + 16384 + 64 * LV_STR;
    LAS float* vs = (LAS float*)(lds + 126976); LAS float* Mt = vs + 64; LAS float* Bt = vs + 128; LAS float* nhs = vs + 192; LAS float* ssq = vs + 320;
    const int sr = tid >> 4, sc = (tid & 15) * 8, tb = wid & 1, eq = wid >> 1, tl = 32 * tb + r32;
    for (int u = F.bid; u < NCH * 4; u += F.G) { const int c = u >> 2, h = u & 3, t0 = c * 64;
        const float mc = ML ? A.chs[2 * NCH * 4 + c * 4 + h] : 0.f;
        __syncthreads();
        if (wid == 0) { float li, b; lin_gates<ML>(A, t0, h, lane, ssq, li, b); const float v = li - b, uu = wave_prefix_max(v, lane, ssq); vs[lane] = v; Mt[lane] = fmaxf(mc, uu); Bt[lane] = b; }
        if (ML && wid >= 2 && wid < 4) nhs[tid - 128] = A.nh[(size_t)(c * 4 + h) * 128 + tid - 128];
        const bf16* kp = ML ? A.qkc + (size_t)t0 * 1024 + 512 + 128 * h : A.proj + (size_t)t0 * NIN + 512 + 128 * h; const int kld = ML ? 1024 : NIN;
#pragma unroll
        for (int rr = 0; rr < 2; ++rr) { const int s = sr + 32 * rr;
            *(LAS v4u*)(Kt + KSWZ(s, sc * 2)) = *(const v4u*)(kp + (size_t)s * kld + sc);
            const bf16* vp = A.proj + (size_t)(t0 + s) * NIN + (ML ? 4096 : 1024) + 256 * h + sc;
            *(LAS v4u*)(Vt + s * LV_STR + sc * 2) = *(const v4u*)vp; *(LAS v4u*)(Vt + s * LV_STR + (128 + sc) * 2) = *(const v4u*)(vp + 128); }
        const bf16* chp = A.CH + (size_t)(c * 4 + h) * 32768;
#pragma unroll
        for (int i = 0; i < 8; ++i) { const int ck = tid + 512 * i, d = ck >> 5, e0 = (ck & 31) * 8; *(LAS v4u*)(Ct + d * LV_STR + e0 * 2) = *(const v4u*)(chp + (size_t)d * 256 + e0); }
        const bf16* qp = (ML ? A.qkc + (size_t)(t0 + tl) * 1024 + 128 * h : A.proj + (size_t)(t0 + tl) * NIN + 128 * h) + 8 * hi;
        bf16x8 qr[8];
#pragma unroll
        for (int s = 0; s < 8; ++s) qr[s] = *(const bf16x8*)(qp + 16 * s);
        __syncthreads();
        const float Mme = Mt[tl], bme = Bt[tl], wint = __expf(mc - Mme);
        f32x16 p[2]; float nq = 0.f;
#pragma unroll
        for (int sb = 0; sb < 2; ++sb) {
#pragma unroll
            for (int r = 0; r < 16; ++r) p[sb][r] = 0.f;
            if (sb <= tb) {
#pragma unroll
                for (int d0 = 0; d0 < 8; ++d0) { const bf16x8 kf = *(const LAS bf16x8*)(Kt + KSWZ(32 * sb + r32, (16 * d0 + 8 * hi) * 2)); p[sb] = MFMA32(kf, qr[d0], p[sb]); }
#pragma unroll
                for (int r = 0; r < 16; ++r) { const int s = 32 * sb + crow(r, hi); const float w = (s <= tl) ? __expf(vs[s] - Mme) * LIN_SC : 0.f; p[sb][r] *= w; nq += p[sb][r]; }
            }
        }
        bf16x8 pk[4];
        { v4u w;
          w.x = pk2(p[0][0], p[0][1]); w.y = pk2(p[0][2], p[0][3]); w.z = pk2(p[0][4], p[0][5]); w.w = pk2(p[0][6], p[0][7]); pk[0] = __builtin_bit_cast(bf16x8, w);
          w.x = pk2(p[0][8], p[0][9]); w.y = pk2(p[0][10], p[0][11]); w.z = pk2(p[0][12], p[0][13]); w.w = pk2(p[0][14], p[0][15]); pk[1] = __builtin_bit_cast(bf16x8, w);
          w.x = pk2(p[1][0], p[1][1]); w.y = pk2(p[1][2], p[1][3]); w.z = pk2(p[1][4], p[1][5]); w.w = pk2(p[1][6], p[1][7]); pk[2] = __builtin_bit_cast(bf16x8, w);
          w.x = pk2(p[1][8], p[1][9]); w.y = pk2(p[1][10], p[1][11]); w.z = pk2(p[1][12], p[1][13]); w.w = pk2(p[1][14], p[1][15]); pk[3] = __builtin_bit_cast(bf16x8, w); }
        bf16x8 qw[8]; float qn = 0.f;
#pragma unroll
        for (int s = 0; s < 8; ++s) { const v4u x = __builtin_bit_cast(v4u, qr[s]); float f[8] = {bflo(x.x), bfhi(x.x), bflo(x.y), bfhi(x.y), bflo(x.z), bfhi(x.z), bflo(x.w), bfhi(x.w)};
            if (ML) {
#pragma unroll
                for (int e = 0; e < 8; ++e) qn += f[e] * nhs[16 * s + 8 * hi + e]; }
#pragma unroll
            for (int e = 0; e < 8; ++e) f[e] *= wint;
            qw[s] = pack8f(f); }
        nq = swap_sum(nq) + wint * swap_sum(qn);
        const unsigned q4 = (unsigned)((lane >> 2) & 3), colb = (unsigned)(16 * ((lane >> 4) & 1) + 4 * (lane & 3));
        const unsigned vb = (unsigned)(uintptr_t)Vt + (4 * hi + q4) * LV_STR + (64 * eq + colb) * 2;
        const unsigned cb0 = (unsigned)(uintptr_t)Ct + (8 * hi + q4) * LV_STR + (64 * eq + colb) * 2, cb1 = cb0 + 64 * LV_STR;
        f32x16 acc[2];
#pragma unroll
        for (int eb = 0; eb < 2; ++eb)
#pragma unroll
            for (int r = 0; r < 16; ++r) acc[eb][r] = 0.f;
#define L3_V(eb, ks) do { s16x4 l_, h_; TRRD(l_, vb, (ks) * 16 * LV_STR + (eb) * 64); TRRD(h_, vb, ((ks) * 16 + 8) * LV_STR + (eb) * 64); asm volatile("s_waitcnt lgkmcnt(0)" : "+v"(l_), "+v"(h_) :: "memory"); \
            acc[eb] = MFMA32(mk8(l_, h_), pk[ks], acc[eb]); } while (0)
#define L3_C(eb, s, base, so) do { s16x4 l_, h_; TRRD(l_, base, (so) * 16 * LV_STR + (eb) * 64); TRRD(h_, base, ((so) * 16 + 4) * LV_STR + (eb) * 64); asm volatile("s_waitcnt lgkmcnt(0)" : "+v"(l_), "+v"(h_) :: "memory"); \
            acc[eb] = MFMA32(mk8(l_, h_), qw[s], acc[eb]); } while (0)
#define L3_E(eb) do { L3_V(eb, 0); L3_V(eb, 1); if (tb) { L3_V(eb, 2); L3_V(eb, 3); } \
            L3_C(eb, 0, cb0, 0); L3_C(eb, 1, cb0, 1); L3_C(eb, 2, cb0, 2); L3_C(eb, 3, cb0, 3); L3_C(eb, 4, cb1, 0); L3_C(eb, 5, cb1, 1); L3_C(eb, 6, cb1, 2); L3_C(eb, 7, cb1, 3); } while (0)
        L3_E(0); L3_E(1);
#undef L3_E
#undef L3_C
#undef L3_V
        float dinv = 1.f;
        if (ML) dinv = __builtin_amdgcn_rcpf(fmaxf(fabsf(nq), __expf(-(bme + Mme))));
        float ss = 0.f;
#pragma unroll
        for (int eb = 0; eb < 2; ++eb)
#pragma unroll
            for (int r = 0; r < 16; ++r) { acc[eb][r] *= dinv; ss += acc[eb][r] * acc[eb][r]; }
        ss = swap_sum(ss);
        if (hi == 0) ssq[eq * 64 + tl] = ss;
        __syncthreads();
        const float rn = rsqrtf(((ssq[tl] + ssq[64 + tl]) + (ssq[128 + tl] + ssq[192 + tl])) * (1.f / 256.f) + EPS_);
        const bf16* gp = A.proj + (size_t)(t0 + tl) * NIN + (ML ? 5120 : 2048) + 256 * h; bf16* yp = A.ymix + (size_t)(t0 + tl) * NMIX + (ML ? 1024 : 0) + 256 * h;
#pragma unroll
        for (int eb = 0; eb < 2; ++eb)
#pragma unroll
            for (int rg = 0; rg < 4; ++rg) { const int e = 64 * eq + 32 * eb + 8 * rg + 4 * hi; const v2u gw = *(const v2u*)(gp + e); const f32x4 gn = *(const f32x4*)(A.gnorm + e);
                float gt[4] = {bflo(gw.x), bfhi(gw.x), bflo(gw.y), bfhi(gw.y)}, o[4];
#pragma unroll
                for (int k = 0; k < 4; ++k) { const float sg = __builtin_amdgcn_rcpf(1.f + __expf(-gt[k])); const float gate = ML ? sg : gt[k] * sg; o[k] = acc[eb][4 * rg + k] * rn * gn[k] * gate; }
                v2u w; w.x = pk2(o[0], o[1]); w.y = pk2(o[2], o[3]); *(v2u*)(yp + e) = w; }
    }
}

#ifndef MK_SPLIT
#define MK_SPLIT 0
#endif
constexpr int PH_PER_LAYER = 16, N_PHASES = 1 + PH_PER_LAYER * DEPTH_;
__global__ void __launch_bounds__(NWAVES * 64, 2) fwd_kernel(Params P) {
    extern __shared__ __attribute__((aligned(16))) unsigned char lds_raw[];
    Frame F0; F0.lds = (LAS unsigned char*)lds_raw; F0.tid = threadIdx.x; F0.lane = F0.tid & 63; F0.wave = __builtin_amdgcn_readfirstlane(F0.tid >> 6); F0.G = gridDim.x; F0.bid = blockIdx.x;
    volatile LAS unsigned* MISC = (volatile LAS unsigned*)(F0.lds + MISC_OFF);
    for (int u = F0.tid; u < (LDS_BYTES - LDSCTL_OFF) / 4; u += NWAVES * 64) ((LAS unsigned*)(F0.lds + LDSCTL_OFF))[u] = 0u;
    __syncthreads();
    gu32* ctl = (gu32*)(P.ws + WS_CTL);
    XcdBarrier bar; bar.bar = (unsigned*)ctl + CW_BAR; bar.x = 0; bar.st = nullptr;
    if (!MK_SPLIT) bar = xcd_barrier_post((unsigned*)ctl + CW_BAR, MISC + 8);
    const int lo = P.ph_lo, hi = P.ph_hi;
#ifndef PHMASK
#define PHMASK 0xffffffffu
#endif
#define IN(k) (lo <= (k) && (k) < hi)
#define INM(k, n) (((PHMASK >> (n)) & 1u) && IN(k))
#define SEAM(k) do { if (!MK_SPLIT && lo <= (k) && (k) + 1 < hi) xcd_barrier(bar); } while (0)
#define PHASE_PTRS() KParams Pk = (KParams)__builtin_amdgcn_kernarg_segment_ptr(); Frame F = F0; asm volatile("; PHASE_PTRS" : "+s"(Pk), "+s"(F.G), "+s"(F.bid), "+s"(F.wave)); unsigned char* ws = Pk->ws; float* out = Pk->out; \
    bf16* hb = (bf16*)(ws + WS_HB); bf16* proj = (bf16*)(ws + WS_PROJ); bf16* ymix = (bf16*)(ws + WS_YMIX); bf16* mixo = (bf16*)(ws + WS_MIXO); bf16* upb = (bf16*)(ws + WS_UP); \
    bf16* act = (bf16*)(ws + WS_ACT); bf16* od = (bf16*)(ws + WS_OD); bf16* g1 = (bf16*)(ws + WS_G1); bf16* qkc = (bf16*)(ws + WS_QKC); \
    float* rin = (float*)(ws + WS_RIN); float* ssp = (float*)(ws + WS_SSP); float* gpre = (float*)(ws + WS_GPRE); \
    const float* cst = (const float*)(ws + WS_COS); const float* snt = (const float*)(ws + WS_SIN); \
    (void)out; (void)hb; (void)proj; (void)ymix; (void)mixo; (void)upb; (void)act; (void)od; (void)g1; (void)qkc; (void)rin; (void)ssp; (void)gpre; (void)cst; (void)snt
#define LIN_ARGS() LinArgs LA; LA.proj = proj; LA.qkc = qkc; LA.gpre = gpre; LA.b_i = Pk->in[I_BIG] + j * 4; LA.b_f = Pk->in[I_BFG] + j * 4; LA.wconv = Pk->in[I_WCQK] + (size_t)j * 4096; LA.bconv = Pk->in[I_BCQK] + (size_t)j * 1024; \
    LA.gnorm = ev ? Pk->in[I_GML] + j * 256 : Pk->in[I_GRET] + j * 256; LA.chs = (float*)(ws + WS_CHS); LA.dC = (float*)(ws + WS_DC); LA.CH = (bf16*)(ws + WS_CH); LA.dn = (float*)(ws + WS_DN); LA.nh = (float*)(ws + WS_NH); LA.ymix = ymix

    if (INM(0, 31)) { PHASE_PTRS(); p0_prologue(F, Pk); }
    SEAM(0);
#pragma unroll 1
    for (int L = 0; L < DEPTH_; ++L) {
        const int pbase = 1 + PH_PER_LAYER * L, j = L >> 1; const bool ev = (L & 1) == 0;
        if (INM(pbase + 0, 0)) { PHASE_PTRS();
            if (ev) gates_pass(F, hb, (const bf16*)(ws + WS_WG) + (size_t)j * 8 * DM, rin, gpre);
            pg8::Gemm g{hb, (const bf16*)(ws + WS_WIN) + (size_t)L * NIN * DM, S_, NIN, DM, 0, 0}; pg8::StaticOrder S; S.init(S_, NIN, F.G, F.bid);
            pg8::EpiProj E{proj, NIN, rin, cst, snt, ev ? 8 : 4};
            pg8::gemm_phase<pg8::EpiProj, pg8::StaticOrder, true, true>(F.lds, g, S, E, F.wave);
        }
        SEAM(pbase + 0);
        if (INM(pbase + 1, 1)) { PHASE_PTRS(); LIN_ARGS(); if (ev) lin_local<true>(F, LA); else lin_local<false>(F, LA); }
        SEAM(pbase + 1);
        if (INM(pbase + 2, 2)) { PHASE_PTRS(); LIN_ARGS(); if (ev) lin_scan<true>(F, LA); else lin_scan<false>(F, LA); }
        SEAM(pbase + 2);
        if (INM(pbase + 3, 3)) { PHASE_PTRS(); LIN_ARGS();
#ifndef P3MASK
#define P3MASK 15
#endif
            if (ev) { if (P3MASK & 1) lin_out<true>(F, LA); if (P3MASK & 2) attn_phase<0>(F, ctl + CW_Q + 64 * L, proj, od); }
            else { if (P3MASK & 4) lin_out<false>(F, LA); if (P3MASK & 8) attn_phase<1>(F, ctl + CW_Q + 64 * L, proj, ymix); }
        }
        SEAM(pbase + 3);
        if (ev) { if (INM(pbase + 4, 4)) { PHASE_PTRS(); diffcomb_pass(F, od, Pk->in[I_GDIFF] + j * 256, (const float*)(ws + WS_LAM) + 2 * j, ymix); } SEAM(pbase + 4); }
        if (INM(pbase + 5, 5)) { PHASE_PTRS();
            pg8::Gemm g{ymix, (const bf16*)(ws + WS_WOUT) + (size_t)L * DM * NMIX, S_, DM, NMIX, 0, 0}; pg8::StaticOrder S; S.init(S_, DM, F.G, F.bid);
            pg8::EpiY E{mixo, DM, ssp};
            pg8::gemm_phase<pg8::EpiY, pg8::StaticOrder, true, true>(F.lds, g, S, E, F.wave);
        }
        SEAM(pbase + 5);
        if (INM(pbase + 6, 6)) { PHASE_PTRS(); resid_pass(F, L == 0 ? Pk->in[I_X] : out, mixo, ssp, Pk->in[I_GMPOST] + (size_t)L * DM, out, hb, rin); }
        SEAM(pbase + 6);
        if (INM(pbase + 7, 7)) { PHASE_PTRS();
            pg8::Gemm g{hb, (const bf16*)(ws + WS_WUP) + (size_t)L * NUP * DM, S_, NUP, DM, 0, 0}; pg8::StaticOrder S; S.init(S_, NUP, F.G, F.bid);
            pg8::EpiProj E{upb, NUP, rin, cst, snt, 0};
            pg8::gemm_phase<pg8::EpiProj, pg8::StaticOrder, true, true>(F.lds, g, S, E, F.wave);
        }
        SEAM(pbase + 7);
        if (INM(pbase + 8, 8)) { PHASE_PTRS(); convffn_pass(F, upb, Pk->in[I_WFC] + (size_t)L * 3 * NUP, Pk->in[I_BFC] + (size_t)L * NUP, act); }
        SEAM(pbase + 8);
        if (INM(pbase + 9, 9)) { PHASE_PTRS();
            pg8::Gemm g{act, (const bf16*)(ws + WS_WDN) + (size_t)L * DM * DM, S_, DM, DM, 0, 0}; pg8::StaticOrder S; S.init(S_, DM, F.G, F.bid);
            pg8::EpiY E{mixo, DM, ssp};
            pg8::gemm_phase<pg8::EpiY, pg8::StaticOrder, true, true>(F.lds, g, S, E, F.wave);
        }
        SEAM(pbase + 9);
        if (INM(pbase + 10, 10)) { PHASE_PTRS(); resid_pass(F, out, mixo, ssp, Pk->in[I_GFPOST] + (size_t)L * DM, out, hb, rin); }
        SEAM(pbase + 10);
        if (INM(pbase + 11, 11)) { PHASE_PTRS();
            pg8::Gemm g{hb, (const bf16*)(ws + WS_WPD) + (size_t)L * PLED * DM, S_, PLED, DM, 0, 0}; pg8::StaticOrder S; S.init(S_, PLED, F.G, F.bid);
            pg8::EpiProj E{g1, PLED, rin, cst, snt, 0};
            pg8::gemm_phase<pg8::EpiProj, pg8::StaticOrder, true, true>(F.lds, g, S, E, F.wave);
        }
        SEAM(pbase + 11);
        if (INM(pbase + 12, 12)) { PHASE_PTRS();
            int Kp = PLED; asm volatile("; opaque K (keeps the K-loop rolled)" : "+s"(Kp));
            pg8::Gemm g{g1, (const bf16*)(ws + WS_WPU) + (size_t)L * DM * PLED, S_, DM, Kp, (long)(WS_PB - WS_G1) + (long)L * S_ * PLED * 2, (long)(WS_WPP - WS_WPU)};
#ifndef DBG_PLE_PLAIN
#define DBG_PLE_PLAIN 0
#endif
#if DBG_PLE_PLAIN == 1
            pg8::StaticOrder S; S.init(S_, DM, F.G, F.bid); pg8::EpiY E{mixo, DM, ssp};
            pg8::gemm_phase<pg8::EpiY, pg8::StaticOrder, true, true>(F.lds, g, S, E, F.wave);
#elif DBG_PLE_PLAIN == 2
            pg8::PleOrder S{F.G, F.bid, (S_ / 256) * (DM / 256)}; pg8::EpiPleDbg E{mixo, act};
            pg8::gemm_phase<pg8::EpiPleDbg, pg8::PleOrder, true, true>(F.lds, g, S, E, F.wave);
#else
            pg8::PleOrder S{F.G, F.bid, (S_ / 256) * (DM / 256)};
            pg8::EpiPle E{mixo, out, hb, ssp};
            pg8::gemm_phase<pg8::EpiPle, pg8::PleOrder, true, true>(F.lds, g, S, E, F.wave);
#endif
        }
        SEAM(pbase + 12);
        if (L + 1 < DEPTH_) { if (INM(pbase + 13, 13)) { PHASE_PTRS(); rin_pass(F, ssp, rin); } SEAM(pbase + 13); }
    }
#undef IN
#undef INM
#undef SEAM
}

#ifndef DBG_STOP
#define DBG_STOP 0
#endif
#if DBG_STOP
__global__ void dbg_fold(const unsigned* ws, size_t nwords, float* out, int keep_out) {
    for (size_t i = (size_t)blockIdx.x * blockDim.x + threadIdx.x; i < (size_t)S_ * DM; i += (size_t)gridDim.x * blockDim.x) { float acc = keep_out ? out[i] : 0.f;
        for (size_t w = (1u << 18) + i; w < nwords; w += (size_t)S_ * DM) { const unsigned x = ws[w]; acc += (float)(x & 0xffffu) * (1.f / 65536.f) + (float)(x >> 16) * (1.f / 65536.f); }
        out[i] = acc; }
}
#endif
#ifndef DBG_CHECK
#define DBG_CHECK 0
#endif
#ifndef DBG_LAYER
#define DBG_LAYER 0
#endif

#if DBG_CHECK
#ifndef DBG_DIGIT_SCALE
#define DBG_DIGIT_SCALE (10.f)
#endif
#ifndef DBG_LINSTAT
#define DBG_LINSTAT 0
#endif
#ifndef DBG_TOL
#define DBG_TOL (0.08f)
#endif
__device__ __forceinline__ unsigned hsh(unsigned x) { x ^= x >> 16; x *= 0x7feb352du; x ^= x >> 15; x *= 0x846ca68bu; x ^= x >> 16; return x; }
__device__ __forceinline__ float bf2f(bf16 b) { return h2f(b); }
__device__ __forceinline__ float blk_sum(float v, float* sh) {
    v = wave_sum(v); __syncthreads(); if ((threadIdx.x & 63) == 0) sh[threadIdx.x >> 6] = v; __syncthreads(); float t = 0.f; for (int i = 0; i < (int)(blockDim.x >> 6); ++i) t += sh[i]; __syncthreads(); return t; }
__device__ __forceinline__ float blk_max(float v, float* sh) {
    v = wave_max(v); __syncthreads(); if ((threadIdx.x & 63) == 0) sh[threadIdx.x >> 6] = v; __syncthreads(); float t = sh[0]; for (int i = 1; i < (int)(blockDim.x >> 6); ++i) t = fmaxf(t, sh[i]); __syncthreads(); return t; }
__device__ __forceinline__ void rep_err(float* errs, int code, float got, float ref, float atol) { const float e = (atol < 0.01f) ? fabsf(got - ref) / (fabsf(ref) + atol) : fabsf(got - ref) / (1.f + 0.1f * fabsf(ref)); atomicMax((int*)errs + code, __float_as_int(e >= 0.f ? e : 1e9f)); }
__global__ void chk_gemm(const float* Af, const bf16* Ab, int K, const float* gain, const float* rs, int recompute_rs, const float* W, int ldw, int N, int rope_cols, const float* cs, const float* sn,
                         const bf16* out, int ldo, float* errs, int code, unsigned seed) {
    __shared__ float sh[8];
    const unsigned s = blockIdx.x; const int row = hsh(seed + 2 * s) % S_, pc = hsh(seed + 2 * s + 1) % N;
    int col = pc, col2 = -1, half = 0, pi = 0;
    if (pc < rope_cols) { const int hb = pc & ~127, jj = pc & 127; pi = jj >> 1; half = jj & 1; col = hb + half * 64 + pi; col2 = hb + (1 - half) * 64 + pi; }
    float d1 = 0.f, d2 = 0.f, ss = 0.f;
    for (int k = threadIdx.x; k < K; k += blockDim.x) { const float a = Af ? Af[(size_t)row * K + k] : bf2f(Ab[(size_t)row * K + k]); ss += a * a; const float ag = gain ? a * gain[k] : a;
        d1 += ag * W[(size_t)k * ldw + col]; if (col2 >= 0) d2 += ag * W[(size_t)k * ldw + col2]; }
    d1 = blk_sum(d1, sh); d2 = blk_sum(d2, sh); ss = blk_sum(ss, sh);
    float r = rs ? rs[row] : 1.f; if (recompute_rs) r = rsqrtf(ss / K + EPS_);
    float ref = d1 * r; if (col2 >= 0) { const float c = cs[(size_t)row * 64 + pi], sv = sn[(size_t)row * 64 + pi]; ref = half == 0 ? (d1 * c - d2 * sv) * r : (d1 * c + d2 * sv) * r; }
    if (threadIdx.x == 0) rep_err(errs, code, bf2f(out[(size_t)row * ldo + pc]), ref, 0.25f);
}
__global__ void chk_gates(const float* h, const float* gain, const float* W, const float* gpre, float* errs, int code) {
    __shared__ float sh[8]; const int row = hsh(777 + blockIdx.x) % S_, c = blockIdx.x & 7; float d = 0.f, ss = 0.f;
    for (int k = threadIdx.x; k < DM; k += blockDim.x) { const float a = h[(size_t)row * DM + k]; ss += a * a; d += a * gain[k] * W[(size_t)k * 6152 + 6144 + c]; }
    d = blk_sum(d, sh); ss = blk_sum(ss, sh); if (threadIdx.x == 0) rep_err(errs, code, gpre[(size_t)row * 8 + c], d * rsqrtf(ss / DM + EPS_), 0.1f);
}
__global__ void chk_ssp(const bf16* y, const float* ssp, float* errs, int code) {
    __shared__ float sh[8]; const int row = hsh(4242 + blockIdx.x) % S_; float ss = 0.f, pp = 0.f;
    for (int k = threadIdx.x; k < DM; k += blockDim.x) { const float a = bf2f(y[(size_t)row * DM + k]); ss += a * a; }
    if (threadIdx.x < 64) pp = ssp[(size_t)row * 64 + threadIdx.x];
    ss = blk_sum(ss, sh); pp = blk_sum(pp, sh); if (threadIdx.x == 0) rep_err(errs, code, pp, ss, 1e-3f);
}
__global__ void chk_resid(const float* hin, const bf16* y, const float* g, const float* hout, const float* rin, float* errs, int code) {
    __shared__ float sh[8]; const int row = hsh(999 + blockIdx.x) % S_; float ss = 0.f;
    for (int k = threadIdx.x; k < DM; k += blockDim.x) { const float a = bf2f(y[(size_t)row * DM + k]); ss += a * a; }
    ss = blk_sum(ss, sh); const float ry = rsqrtf(ss / DM + EPS_); float s2 = 0.f, em = 0.f;
    for (int k = threadIdx.x; k < DM; k += blockDim.x) { const float ref = hin[(size_t)row * DM + k] + bf2f(y[(size_t)row * DM + k]) * ry * g[k]; s2 += ref * ref; em = fmaxf(em, fabsf(hout[(size_t)row * DM + k] - ref) / (1.f + 0.1f * fabsf(ref))); }
    s2 = blk_sum(s2, sh); em = blk_max(em, sh);
    if (threadIdx.x == 0) { atomicMax((int*)errs + code, __float_as_int(em)); rep_err(errs, code, rin[row], rsqrtf(s2 / DM + EPS_), 1e-3f); }
}
__global__ void chk_conv(const bf16* up, const float* wc, const float* bc, const bf16* act, float* errs, int code) {
    const unsigned s = blockIdx.x * blockDim.x + threadIdx.x; const int t = hsh(31337 + 2 * s) % S_, c = hsh(31338 + 2 * s) % DM; float ya = bc[c], yb = bc[4096 + c];
    for (int k = 0; k < 3; ++k) { const int tt = t - 2 + k; if (tt >= 0) { ya += wc[(size_t)k * NUP + c] * bf2f(up[(size_t)tt * NUP + c]); yb += wc[(size_t)k * NUP + 4096 + c] * bf2f(up[(size_t)tt * NUP + 4096 + c]); } }
    const float u = 0.7978845608028654f * (ya + 0.044715f * ya * ya * ya), ref = 0.5f * ya * (1.f + tanhf(u)) * yb;
    rep_err(errs, code, bf2f(act[(size_t)t * DM + c]), ref, 0.1f);
}
__global__ void chk_diffattn(const bf16* proj, const bf16* od, float* scratch, float* errs, int code) {
    __shared__ float sh[8]; const int t = (blockIdx.x == 0) ? 5 : (blockIdx.x == 1) ? 16383 : hsh(55 + blockIdx.x) % S_, hm = blockIdx.x & 7, kend = 64 * (t / 64 + 1); float* sc = scratch + (size_t)blockIdx.x * S_;
    const bf16* q = proj + (size_t)t * NIN + hm * 128; float mx = -1e30f;
    for (int key = threadIdx.x; key < kend; key += blockDim.x) { const bf16* k = proj + (size_t)key * NIN + 1024 + hm * 128; float d = 0.f; for (int i = 0; i < 128; ++i) d += bf2f(q[i]) * bf2f(k[i]); d *= 0.08838834764831845f; sc[key] = d; mx = fmaxf(mx, d); }
    mx = blk_max(mx, sh); float sm = 0.f;
    for (int key = threadIdx.x; key < kend; key += blockDim.x) { const float p = __expf(sc[key] - mx); sc[key] = p; sm += p; }
    sm = blk_sum(sm, sh); const int e = threadIdx.x; float o = 0.f;
    for (int key = 0; key < kend; ++key) o += sc[key] * bf2f(proj[(size_t)key * NIN + 2048 + (hm >> 1) * 256 + e]);
    const float rr = sqrtf(blk_sum((o / sm) * (o / sm), sh) / 256.f) + 1e-3f;
    float em = fabsf(bf2f(od[((size_t)t * 8 + hm) * 256 + e]) - o / sm) / rr; em = blk_max(em, sh);
    if (threadIdx.x == 0) atomicMax((int*)errs + code, __float_as_int(em));
}
__global__ void chk_stick(const bf16* proj, const bf16* ymix, float* errs, int code) {
    __shared__ float sh[8]; const int t = (blockIdx.x == 0) ? 0 : (blockIdx.x == 1) ? 1 : (blockIdx.x == 2) ? 16383 : (blockIdx.x == 3) ? 64 : hsh(66 + blockIdx.x) % S_, h = blockIdx.x & 7, e = threadIdx.x;
    const bf16* q = proj + (size_t)t * NIN + 3072 + h * 128; float carry = 1.f, o = 0.f;
    for (int s = t - 1; s >= 0 && carry > 1e-20f; --s) { const bf16* k = proj + (size_t)s * NIN + 4096 + h * 128; float d = 0.f; for (int i = 0; i < 128; ++i) d += bf2f(q[i]) * bf2f(k[i]); d *= 0.08838834764831845f;
        const float beta = 1.f / (1.f + __expf(-d)); o += beta * carry * bf2f(proj[(size_t)s * NIN + 5120 + h * 128 + e]); carry *= (1.f - beta); }
    const float rr = sqrtf(blk_sum(o * o, sh) / 128.f) + 1e-3f;
    float em = fabsf(bf2f(ymix[(size_t)t * NMIX + 1024 + h * 128 + e]) - o) / rr; em = blk_max(em, sh);
    if (threadIdx.x == 0) atomicMax((int*)errs + code, __float_as_int(em));
}
__global__ void chk_lin_naive(const bf16* proj, const float* gpre, const float* b_i, const float* b_f, const float* wconv, const float* bconv, int ml, float* hn) {
    __shared__ float sh[8]; const int e = blockIdx.x, h = blockIdx.y, d = threadIdx.x; float C = 0.f, n = 0.f, m = 0.f;
    const float lg = logf(1.f - exp2f(-5.f - (float)h));
    for (int t = 0; t < S_; ++t) { float q, k, v, lf, li;
        if (ml) { float yq = bconv[128 * h + d], yk = bconv[512 + 128 * h + d];
            for (int tap = 0; tap < 4; ++tap) { const int tt = t - 3 + tap; if (tt >= 0) { yq += wconv[tap * 1024 + 128 * h + d] * bf2f(proj[(size_t)tt * NIN + 3072 + 128 * h + d]); yk += wconv[tap * 1024 + 512 + 128 * h + d] * bf2f(proj[(size_t)tt * NIN + 3584 + 128 * h + d]); } }
            q = yq / (1.f + __expf(-yq)) * 0.08838834764831845f; k = yk / (1.f + __expf(-yk)); v = bf2f(proj[(size_t)t * NIN + 4096 + 256 * h + e]);
            const float f = gpre[(size_t)t * 8 + 4 + h] + b_f[h]; li = gpre[(size_t)t * 8 + h] + b_i[h]; lf = fminf(f, 0.f) - log1pf(__expf(-fabsf(f)));
        } else { q = bf2f(proj[(size_t)t * NIN + 128 * h + d]); k = bf2f(proj[(size_t)t * NIN + 512 + 128 * h + d]) * 0.08838834764831845f; v = bf2f(proj[(size_t)t * NIN + 1024 + 256 * h + e]); lf = lg; li = 0.f; }
        const float mn = ml ? fmaxf(lf + m, li) : 0.f; const float fd = __expf(lf + m - mn), ii = __expf(li - mn); m = mn;
        C = fd * C + ii * k * v; n = fd * n + ii * k;
        const float num = blk_sum(q * C, sh), nq = blk_sum(q * n, sh);
        if (d == 0) hn[((size_t)h * S_ + t) * 256 + e] = ml ? num / fmaxf(fabsf(nq), __expf(-m)) : num; }
}
__global__ void chk_lin_cmp(const float* hn, const bf16* proj, const float* gnorm, int ml, const bf16* ymix, float* errs, int code) {
    __shared__ float sh[8]; const int t = (blockIdx.x < 4) ? blockIdx.x * 63 : hsh(88 + blockIdx.x) % S_, h = blockIdx.x & 3, e = threadIdx.x;
    const float x = hn[((size_t)h * S_ + t) * 256 + e]; const float ss = blk_sum(x * x, sh); const float gt = bf2f(proj[(size_t)t * NIN + (ml ? 5120 : 2048) + 256 * h + e]), sg = 1.f / (1.f + __expf(-gt));
    const float ref = x * rsqrtf(ss / 256.f + EPS_) * gnorm[e] * (ml ? sg : gt * sg);
    const float rr = sqrtf(blk_sum(ref * ref, sh) / 256.f) + 1e-3f;
    float em = fabsf(bf2f(ymix[(size_t)t * NMIX + (ml ? 1024 : 0) + 256 * h + e]) - ref) / rr; em = blk_max(em, sh);
    if (threadIdx.x == 0) { atomicMax((int*)errs + code, __float_as_int(em));
#if DBG_LINSTAT
        if (em > 0.05f) atomicAdd((int*)errs + 20, 1); if (em > 0.1f) atomicAdd((int*)errs + 21 + h, 1); if (em > 0.1f && t < 4096) atomicAdd((int*)errs + 25, 1); if (em > 0.1f && (t & 63) < 32) atomicAdd((int*)errs + 26, 1);
#endif
    }
}
__global__ void chk_diffcomb(const bf16* od, const float* lp, const float* g, float lam_init, const bf16* ymix, float* errs, int code) {
    __shared__ float sh[8]; const int t = hsh(99 + blockIdx.x) % S_, h = blockIdx.x & 3, e = threadIdx.x;
    const float s1 = blk_sum(e < 128 ? lp[e] * lp[128 + e] : 0.f, sh), s2 = blk_sum(e < 128 ? lp[256 + e] * lp[384 + e] : 0.f, sh), lam = expf(s1) - expf(s2) + lam_init;
    const float dlt = bf2f(od[((size_t)t * 8 + 2 * h) * 256 + e]) - lam * bf2f(od[((size_t)t * 8 + 2 * h + 1) * 256 + e]); const float ss = blk_sum(dlt * dlt, sh);
    const float ref = dlt * rsqrtf(ss / 256.f + EPS_) * g[e] * (1.f - lam_init);
    const float rr = sqrtf(blk_sum(ref * ref, sh) / 256.f) + 1e-3f;
    float em = fabsf(bf2f(ymix[(size_t)t * NMIX + 256 * h + e]) - ref) / rr; em = blk_max(em, sh);
    if (threadIdx.x == 0) atomicMax((int*)errs + code, __float_as_int(em));
}
__global__ void chk_ple(const float* hold, const bf16* g1, const float* Wu, const float* pin, const float* Wp, const float* hnew, float* errs, int code) {
    __shared__ float sh[8]; const int row = hsh(1234 + 2 * blockIdx.x) % S_, col = hsh(1235 + 2 * blockIdx.x) % DM; const int k = threadIdx.x;
    const float a = blk_sum(bf2f(g1[(size_t)row * 256 + k]) * Wu[(size_t)k * DM + col], sh), b = blk_sum(pin[(size_t)row * 256 + k] * Wp[(size_t)k * DM + col], sh);
    if (threadIdx.x == 0) rep_err(errs, code, hnew[(size_t)row * DM + col], hold[(size_t)row * DM + col] + b / (1.f + __expf(-a)), 0.25f);
}
__global__ void chk_ple2(const float* hold, const bf16* g1, const float* Wu, const float* pin, const float* Wp, const float* hnew, const bf16* G, float* errs, int code) {
    __shared__ float sh[8]; const int row = hsh(1234 + 2 * blockIdx.x) % S_, col = hsh(1235 + 2 * blockIdx.x) % DM; const int k = threadIdx.x;
    const float a = blk_sum(bf2f(g1[(size_t)row * 256 + k]) * Wu[(size_t)k * DM + col], sh), b = blk_sum(pin[(size_t)row * 256 + k] * Wp[(size_t)k * DM + col], sh);
    if (threadIdx.x == 0) { (void)G; rep_err(errs, code, hnew[(size_t)row * DM + col], hold[(size_t)row * DM + col] + b / (1.f + __expf(-a)), 0.25f); }
}
__global__ void chk_final(const float* errs, float* out, float tol) {
#if DBG_LINSTAT
    { const int* ie = (const int*)errs; const int sel = DBG_LINSTAT; int v = 0;
      if (sel == 1) v = ie[20]; else if (sel >= 2 && sel <= 5) v = ie[21 + sel - 2]; else if (sel == 6) v = ie[25]; else v = ie[26];
      const float cc = 1000.f + (float)v * 10.f;
      for (size_t i = (size_t)blockIdx.x * blockDim.x + threadIdx.x; i < (size_t)S_ * DM; i += (size_t)gridDim.x * blockDim.x) out[i] = cc; return; }
#endif
    float c = 0.f; for (int k = 1; k <= 9; ++k) { const float e = errs[k]; if (e > tol) { c = 1000.f * k + 100.f * fminf(9.f, floorf(e * DBG_DIGIT_SCALE)); break; } }
    if (c > 0.f) for (size_t i = (size_t)blockIdx.x * blockDim.x + threadIdx.x; i < (size_t)S_ * DM; i += (size_t)gridDim.x * blockDim.x) out[i] = c;
}
#endif

#if DBG_CHECK
__global__ void chk_rin(const float* h, const float* rin, float* errs, int code) { __shared__ float sh[8]; const int row = hsh(2020 + blockIdx.x) % S_; float ss = 0.f;
    for (int k = threadIdx.x; k < DM; k += blockDim.x) { const float a = h[(size_t)row * DM + k]; ss += a * a; } ss = blk_sum(ss, sh); if (threadIdx.x == 0) rep_err(errs, code, rin[row], rsqrtf(ss / DM + EPS_), 1e-3f); }
static void dbg_checks(int k, int before, void* const* d_in, void* d_out, void* d_ws, hipStream_t st) {
    const int r = (k - 1) % PH_PER_LAYER, L = (k - 1) / PH_PER_LAYER, j = L >> 1; const bool ev = (L & 1) == 0;
    if (k < 1 || L != DBG_LAYER) return;
    unsigned char* ws = (unsigned char*)d_ws; float* errs = (float*)(ws + 512 * 1024); float* out = (float*)d_out; float* tmp = (float*)(ws + WS_UP);
    const float* const* in = (const float* const*)d_in;
    bf16* proj = (bf16*)(ws + WS_PROJ); bf16* ymix = (bf16*)(ws + WS_YMIX); bf16* mixo = (bf16*)(ws + WS_MIXO); bf16* hb = (bf16*)(ws + WS_HB); bf16* upb = (bf16*)(ws + WS_UP); bf16* act = (bf16*)(ws + WS_ACT);
    bf16* od = (bf16*)(ws + WS_OD); bf16* g1 = (bf16*)(ws + WS_G1); float* rin = (float*)(ws + WS_RIN); float* ssp = (float*)(ws + WS_SSP); float* gpre = (float*)(ws + WS_GPRE);
    const float* cst = (const float*)(ws + WS_COS); const float* snt = (const float*)(ws + WS_SIN);
    const float* hin0 = (L == 0) ? in[I_X] : (const float*)out;
    if (before) { if ((DBG_CHECK == 1 && r == 6 && L > 0) || (DBG_CHECK == 2 && (r == 10 || r == 12))) (void)hipMemcpyAsync(tmp, out, (size_t)S_ * DM * 4, hipMemcpyDeviceToDevice, st); return; }
    if (DBG_CHECK == 1) {
        if (r == 0) { const float* W = ev ? in[I_WINE] + (size_t)j * DM * 6152 : in[I_WINO] + (size_t)j * DM * 6144;
            hipLaunchKernelGGL(chk_gemm, dim3(16384), dim3(256), 0, st, hin0, (const bf16*)nullptr, DM, in[I_GMPRE] + (size_t)L * DM, (const float*)nullptr, 1, W, ev ? 6152 : 6144, NIN, ev ? 2048 : 1024, cst, snt, (const bf16*)proj, NIN, errs, 1, 11u);
            if (ev) hipLaunchKernelGGL(chk_gates, dim3(4096), dim3(256), 0, st, hin0, in[I_GMPRE] + (size_t)L * DM, in[I_WINE] + (size_t)j * DM * 6152, (const float*)gpre, errs, 2); }
        if (r == 3) { float* hn = (float*)(ws + WS_UP); float* scr = (float*)(ws + WS_UP + 128 * MiB);
            if (ev) { hipLaunchKernelGGL(chk_diffattn, dim3(1024), dim3(256), 0, st, (const bf16*)proj, (const bf16*)od, scr, errs, 3);
                hipLaunchKernelGGL(chk_lin_naive, dim3(256, 4), dim3(128), 0, st, (const bf16*)proj, (const float*)gpre, in[I_BIG] + j * 4, in[I_BFG] + j * 4, in[I_WCQK] + (size_t)j * 4096, in[I_BCQK] + (size_t)j * 1024, 1, hn);
                hipLaunchKernelGGL(chk_lin_cmp, dim3(8192), dim3(256), 0, st, (const float*)hn, (const bf16*)proj, in[I_GML] + j * 256, 1, (const bf16*)ymix, errs, 4);
            } else { hipLaunchKernelGGL(chk_stick, dim3(1024), dim3(128), 0, st, (const bf16*)proj, (const bf16*)ymix, errs, 3);
                hipLaunchKernelGGL(chk_lin_naive, dim3(256, 4), dim3(128), 0, st, (const bf16*)proj, (const float*)gpre, in[I_BIG], in[I_BFG], in[I_WCQK], in[I_BCQK], 0, hn);
                hipLaunchKernelGGL(chk_lin_cmp, dim3(8192), dim3(256), 0, st, (const float*)hn, (const bf16*)proj, in[I_GRET] + j * 256, 0, (const bf16*)ymix, errs, 4); } }
        if (r == 4 && ev) hipLaunchKernelGGL(chk_diffcomb, dim3(8192), dim3(256), 0, st, (const bf16*)od, in[I_DLAM] + (size_t)j * 512, in[I_GDIFF] + j * 256, 0.8f - 0.6f * expf(-0.3f * (float)L), (const bf16*)ymix, errs, 5);
        if (r == 5) { const float* W = (ev ? in[I_WOUTE] : in[I_WOUTO]) + (size_t)j * NMIX * DM;
            hipLaunchKernelGGL(chk_gemm, dim3(16384), dim3(256), 0, st, (const float*)nullptr, (const bf16*)ymix, NMIX, (const float*)nullptr, (const float*)nullptr, 0, W, DM, DM, 0, cst, snt, (const bf16*)mixo, DM, errs, 6, 22u);
            hipLaunchKernelGGL(chk_ssp, dim3(4096), dim3(256), 0, st, (const bf16*)mixo, (const float*)ssp, errs, 6); }
        if (r == 6) hipLaunchKernelGGL(chk_resid, dim3(4096), dim3(256), 0, st, L == 0 ? in[I_X] : (const float*)tmp, (const bf16*)mixo, in[I_GMPOST] + (size_t)L * DM, (const float*)out, (const float*)rin, errs, 7);
        if (r == 7) hipLaunchKernelGGL(chk_gemm, dim3(16384), dim3(256), 0, st, (const float*)nullptr, (const bf16*)hb, DM, in[I_GFPRE] + (size_t)L * DM, (const float*)rin, 0, in[I_WUP] + (size_t)L * DM * NUP, NUP, NUP, 0, cst, snt, (const bf16*)upb, NUP, errs, 8, 33u);
        if (r == 8) hipLaunchKernelGGL(chk_conv, dim3(4096), dim3(256), 0, st, (const bf16*)upb, in[I_WFC] + (size_t)L * 3 * NUP, in[I_BFC] + (size_t)L * NUP, (const bf16*)act, errs, 9);
    } else {
        if (r == 9) { hipLaunchKernelGGL(chk_gemm, dim3(16384), dim3(256), 0, st, (const float*)nullptr, (const bf16*)act, DM, (const float*)nullptr, (const float*)nullptr, 0, in[I_WDN] + (size_t)L * DM * DM, DM, DM, 0, cst, snt, (const bf16*)mixo, DM, errs, 1, 44u);
            hipLaunchKernelGGL(chk_ssp, dim3(4096), dim3(256), 0, st, (const bf16*)mixo, (const float*)ssp, errs, 1); }
        if (r == 10) hipLaunchKernelGGL(chk_resid, dim3(4096), dim3(256), 0, st, (const float*)tmp, (const bf16*)mixo, in[I_GFPOST] + (size_t)L * DM, (const float*)out, (const float*)rin, errs, 2);
        if (r == 11) hipLaunchKernelGGL(chk_gemm, dim3(16384), dim3(256), 0, st, (const float*)nullptr, (const bf16*)hb, DM, in[I_GPLE] + (size_t)L * DM, (const float*)rin, 0, in[I_WPD] + (size_t)L * DM * PLED, PLED, PLED, 0, cst, snt, (const bf16*)g1, PLED, errs, 3, 55u);
        if (r == 12 && DBG_PLE_PLAIN == 2) hipLaunchKernelGGL(chk_gemm, dim3(16384), dim3(256), 0, st, (const float*)nullptr, (const bf16*)(ws + WS_PB) + (size_t)L * S_ * PLED, PLED, (const float*)nullptr, (const float*)nullptr, 0, in[I_WPP] + (size_t)L * PLED * DM, DM, DM, 0, cst, snt, (const bf16*)act, DM, errs, 5, 77u);
        if (r == 12 && DBG_PLE_PLAIN) hipLaunchKernelGGL(chk_gemm, dim3(16384), dim3(256), 0, st, (const float*)nullptr, (const bf16*)g1, PLED, (const float*)nullptr, (const float*)nullptr, 0, in[I_WPU] + (size_t)L * PLED * DM, DM, DM, 0, cst, snt, (const bf16*)mixo, DM, errs, 4, 66u);
        if (r == 12 && !DBG_PLE_PLAIN) { hipLaunchKernelGGL(chk_ple2, dim3(16384), dim3(256), 0, st, (const float*)tmp, (const bf16*)g1, in[I_WPU] + (size_t)L * PLED * DM, in[I_P] + (size_t)L * S_ * PLED, in[I_WPP] + (size_t)L * PLED * DM, (const float*)out, (const bf16*)mixo, errs, 4);
            hipLaunchKernelGGL(chk_ple, dim3(16384), dim3(256), 0, st, (const float*)tmp, (const bf16*)g1, in[I_WPU] + (size_t)L * PLED * DM, in[I_P] + (size_t)L * S_ * PLED, in[I_WPP] + (size_t)L * PLED * DM, (const float*)out, errs, 5); }
        if (r == 13) hipLaunchKernelGGL(chk_rin, dim3(4096), dim3(256), 0, st, (const float*)out, (const float*)rin, errs, 7);
    }
}
#endif
#ifndef DBG_NOPERT
#define DBG_NOPERT 0
#endif
#if DBG_PERTURB
__global__ void dbg_save(const float* out, bf16* sav) { for (size_t i = (size_t)blockIdx.x * blockDim.x + threadIdx.x; i < (size_t)S_ * DM; i += (size_t)gridDim.x * blockDim.x) sav[i] = (bf16)f2bf(out[i]); }
__global__ void dbg_cmp(const float* out, const bf16* sav, float* res) {
    __shared__ float sh[8]; const int row = blockIdx.x; float m = 0.f;
    for (int k = threadIdx.x; k < DM; k += blockDim.x) m = fmaxf(m, fabsf(out[(size_t)row * DM + k] - h2f(sav[(size_t)row * DM + k])));
    m = wave_max(m); __syncthreads(); if ((threadIdx.x & 63) == 0) sh[threadIdx.x >> 6] = m; __syncthreads();
    if (threadIdx.x == 0) { m = fmaxf(fmaxf(sh[0], sh[1]), fmaxf(sh[2], sh[3])); res[16 + row] = m; atomicMax((int*)res, __float_as_int(m)); }
}
__global__ void dbg_ysave(const bf16* ymix, bf16* sav) { for (int i = blockIdx.x * blockDim.x + threadIdx.x; i < 64 * NMIX; i += gridDim.x * blockDim.x) sav[i] = ymix[i]; }
__global__ void dbg_ycmp(const bf16* ymix, const bf16* sav, float* res, int L) {
    for (int i = blockIdx.x * blockDim.x + threadIdx.x; i < 64 * NMIX; i += gridDim.x * blockDim.x) { const float d = fabsf(h2f(ymix[i]) - h2f(sav[i]));
        atomicMax((int*)res + 1 + L, __float_as_int(d)); if (L == 0) atomicMax((unsigned long long*)(res + 1000), ((unsigned long long)__float_as_uint(d) << 32) | (unsigned)i); atomicMax((int*)res + 100 + L * 8 + ((i % NMIX) >> 8), __float_as_int(d)); atomicMax((int*)res + 200 + L * 64 + i / NMIX, __float_as_int(d)); }
}
__global__ void dbg_fetch(const bf16* ymix, float* res) { const unsigned i = ((const unsigned*)res)[1000]; res[1002] = h2f(ymix[i]); }
__global__ void dbg_rep(const float* res, float* out) {
    __shared__ float cc; if (threadIdx.x == 0) { const float mx = res[0]; int rw = 0; for (int r = 0; r < S_; ++r) if (res[16 + r] == mx) { rw = r; break; }
        int cnt = 0; for (int r = 0; r < S_; ++r) if (res[16 + r] > 0.5f * mx) ++cnt;
        if (DBG_PERTURB >= 5) { int Lf = 9, cb = 0, rw2 = 0; float md = 0.f; for (int L = 0; L < 4; ++L) if (res[1 + L] > 0.1f) { Lf = L; break; }
            if (Lf < 4) { for (int b = 0; b < 8; ++b) if (res[100 + Lf * 8 + b] > md) { md = res[100 + Lf * 8 + b]; cb = b; } md = 0.f; for (int r = 0; r < 64; ++r) if (res[200 + Lf * 64 + r] > md) { md = res[200 + Lf * 64 + r]; rw2 = r; } }
            cc = (DBG_PERTURB == 5) ? 1000.f * (Lf + 1) + 100.f * cb : (DBG_PERTURB == 6) ? 1000.f * (Lf + 1) + 100.f * fminf(9.f, (float)rw2) : (DBG_PERTURB == 11) ? 1000.f + 100.f * (float)rw2 : (DBG_PERTURB == 12) ? 1000.f + 30.f * (float)(((const unsigned*)res)[1000] % NMIX & 255) : (DBG_PERTURB == 13) ? 1000.f + 1000.f * fabsf(res[1002]) : 1000.f + 1000.f * res[1 + (DBG_PERTURB - 7)]; }
        else cc = (DBG_PERTURB == 1) ? 1000.f + mx * 1000.f : (DBG_PERTURB == 2) ? 1000.f + (float)rw * (9000.f / 16384.f) : (DBG_PERTURB == 3) ? 1000.f + (float)(rw & 1023) * (9000.f / 1024.f) : 1000.f + (float)cnt * 10.f; }
    __syncthreads(); const float c = cc;
    for (size_t i = (size_t)blockIdx.x * blockDim.x + threadIdx.x; i < (size_t)S_ * DM; i += (size_t)gridDim.x * blockDim.x) out[i] = c;
}
#endif
extern "C" void kernel_launch(void* const* d_in, const int* in_sizes, int n_in, void* d_out, int out_size, void* d_ws, size_t ws_size, hipStream_t stream) {
    static int grid = 0;
    if (grid == 0) {
        if (n_in != 26 || out_size != S_ * DM || ws_size < WS_END + (DBG_PERTURB ? 132 * MiB : 0)) { fprintf(stderr, "kernel_launch: unexpected shapes (n_in %d, out %d, ws %zu < %zu); nothing launched\n", n_in, out_size, ws_size, (size_t)WS_END); grid = -1; return; }
        int dev = 0, cus = 0, per_cu = 0;
        if (hipGetDevice(&dev) != hipSuccess || hipDeviceGetAttribute(&cus, hipDeviceAttributeMultiprocessorCount, dev) != hipSuccess) { grid = -1; return; }
        if (hipFuncSetAttribute((const void*)fwd_kernel, hipFuncAttributeMaxDynamicSharedMemorySize, LDS_BYTES) != hipSuccess) { fprintf(stderr, "kernel_launch: hipFuncSetAttribute failed\n"); grid = -1; return; }
        if (hipOccupancyMaxActiveBlocksPerMultiprocessor(&per_cu, (const void*)fwd_kernel, NWAVES * 64, LDS_BYTES) != hipSuccess || per_cu < 1) { fprintf(stderr, "kernel_launch: occupancy query says %d blocks per CU\n", per_cu); (void)hipGetLastError(); }
        grid = cus;
    }
    if (grid < 0) return;
    (void)hipMemsetAsync((char*)d_ws + WS_CTL, 0, CTL_ZERO_BYTES, stream);
    Params p{};
    for (int i = 0; i < 26; ++i) p.in[i] = (const float*)d_in[i];
    p.out = (float*)d_out; p.ws = (unsigned char*)d_ws;
#if MK_SPLIT
#if DBG_PERTURB
    for (int rep = 0; rep < 2; ++rep) { p.pert = DBG_NOPERT ? 0 : rep;
#endif
    for (int k = 0; k < N_PHASES; ++k) { const int r = (k - 1) % PH_PER_LAYER, L = (k - 1) / PH_PER_LAYER;
        if (k > 0 && (r > 13 || (r == 4 && (L & 1)) || (r == 13 && L == DEPTH_ - 1))) continue;
        if (DBG_STOP && k >= DBG_STOP) break;
#if DBG_CHECK
        dbg_checks(k, 1, d_in, d_out, d_ws, stream);
#endif
        p.ph_lo = k; p.ph_hi = k + 1; hipLaunchKernelGGL(fwd_kernel, dim3(grid), dim3(NWAVES * 64), LDS_BYTES, stream, p);
#if DBG_CHECK
        dbg_checks(k, 0, d_in, d_out, d_ws, stream);
#endif
#if DBG_PERTURB
        { const int r_ = (k - 1) % PH_PER_LAYER, L_ = (k - 1) / PH_PER_LAYER; if (k >= 1 && ((r_ == 4 && !(L_ & 1)) || (r_ == 3 && (L_ & 1)))) { bf16* ys = (bf16*)((char*)d_ws + WS_END + 128 * MiB) + (size_t)L_ * 64 * NMIX;
            if (rep == 0) hipLaunchKernelGGL(dbg_ysave, dim3(64), dim3(256), 0, stream, (const bf16*)((char*)d_ws + WS_YMIX), ys);
            else { hipLaunchKernelGGL(dbg_ycmp, dim3(64), dim3(256), 0, stream, (const bf16*)((char*)d_ws + WS_YMIX), (const bf16*)ys, (float*)((char*)d_ws + 512 * 1024), L_); if (L_ == 0) hipLaunchKernelGGL(dbg_fetch, dim3(1), dim3(1), 0, stream, (const bf16*)((char*)d_ws + WS_YMIX), (float*)((char*)d_ws + 512 * 1024)); } } }
#endif
    }
#if DBG_PERTURB
    if (rep == 0) { (void)hipMemsetAsync((char*)d_ws + WS_CTL, 0, CTL_ZERO_BYTES, stream); hipLaunchKernelGGL(dbg_save, dim3(2048), dim3(256), 0, stream, (const float*)d_out, (bf16*)((char*)d_ws + WS_END)); }
    else { float* res = (float*)((char*)d_ws + 512 * 1024); hipLaunchKernelGGL(dbg_cmp, dim3(S_), dim3(256), 0, stream, (const float*)d_out, (const bf16*)((char*)d_ws + WS_END), res); hipLaunchKernelGGL(dbg_rep, dim3(2048), dim3(256), 0, stream, (const float*)res, (float*)d_out); }
    }
#endif
#if DBG_CHECK
    hipLaunchKernelGGL(chk_final, dim3(2048), dim3(256), 0, stream, (const float*)((char*)d_ws + 512 * 1024), (float*)d_out, DBG_TOL);
#endif
#else
    p.ph_lo = 0; p.ph_hi = N_PHASES;
    hipLaunchKernelGGL(fwd_kernel, dim3(grid), dim3(NWAVES * 64), LDS_BYTES, stream, p);
#endif
#if DBG_STOP
    hipLaunchKernelGGL(dbg_fold, dim3(2048), dim3(256), 0, stream, (const unsigned*)d_ws, (size_t)(WS_END / 4), (float*)d_out, DBG_STOP > 7 ? 1 : 0);
#endif
    const hipError_t le = hipPeekAtLastError();
    if (le != hipSuccess) fprintf(stderr, "kernel_launch: launch failed: %s\n", hipGetErrorName(le));
}
```

```cpp
#ifndef RES_LO
#define RES_LO 0
#endif
#include <hip/hip_runtime.h>
#include <cstdio>
#include <cstdint>
namespace pg8 {
#define PG8_LAS __attribute__((address_space(3)))
typedef unsigned short bf16_t;
typedef short bf16x8 __attribute__((ext_vector_type(8)));
typedef float f32x4 __attribute__((ext_vector_type(4)));
typedef unsigned u32x4 __attribute__((ext_vector_type(4)));
constexpr int BM = 256, BK = 64, HALF = 128, HTB = HALF * BK * 2  , STAGE_BYTES = 8 * HTB, NXCD = 8, WGM = 8;

__host__ __device__ __forceinline__ int lds_byte(int r, int c) { const int st = (r >> 4) * 2 + (c >> 5), rr = r & 15, cc = c & 31, ob = rr * 64 + cc * 2; return st * 1024 + (ob ^ (((ob >> 9) & 1) << 5)); }
__host__ __device__ __forceinline__ void stage_rc(int b, int& R, int& C) { const int st = b / 1024, sb = b % 1024, swz = sb ^ (((sb >> 9) & 1) << 5); R = (st >> 1) * 16 + swz / 64; C = (st & 1) * 32 + (swz % 64) / 2; }
__host__ __device__ __forceinline__ int perm32(int rho) { const int n = rho >> 4, i = rho & 15; return 8 * (i >> 2) + 4 * n + (i & 3); }

struct Unit { int pm, pn, which; };
struct Gemm { const bf16_t* A; const bf16_t* Bt; int M, N, K; long dA, dB; int ld; };

struct StaticOrder {
    int nM, nN, nwg, G, c;
    __host__ __device__ void init(int M, int N, int G_, int c_) { nM = M / BM; nN = N / BM; nwg = nM * nN; G = G_; c = c_; }
    __host__ __device__ bool next(int i, Unit& u) const {
        const long L = (long)i * G + c; if (L >= nwg) return false;
        int wgid = (int)L; { const int q = nwg / NXCD, r = nwg % NXCD, xcd = wgid % NXCD, off = wgid / NXCD; wgid = (xcd < r ? xcd * (q + 1) : r * (q + 1) + (xcd - r) * q) + off; }
        const int nig = WGM * nN, gid = wgid / nig, fm = gid * WGM, gsz = (nM - fm) < WGM ? (nM - fm) : WGM;
        u.pm = fm + ((wgid % nig) % gsz); u.pn = (wgid % nig) / gsz; u.which = 0; return true;
    }
    __device__ __forceinline__ void a_ready(const Unit&) const {}
    __device__ __forceinline__ void done(const Unit&) const {}
};

__device__ __forceinline__ float fq_sum(float v) {
    auto a = __builtin_amdgcn_permlane16_swap(__float_as_uint(v), __float_as_uint(v), false, false); v = __uint_as_float(a[0]) + __uint_as_float(a[1]);
    auto b = __builtin_amdgcn_permlane32_swap(__float_as_uint(v), __float_as_uint(v), false, false); return __uint_as_float(b[0]) + __uint_as_float(b[1]); }
#ifndef USE_F16
#define USE_F16 1
#endif
typedef float f32x2_t __attribute__((ext_vector_type(2))); typedef __bf16 bf16x2_t __attribute__((ext_vector_type(2)));
typedef _Float16 h16x2_t __attribute__((ext_vector_type(2))); typedef _Float16 h16x8_t __attribute__((ext_vector_type(8)));
#if USE_F16
__device__ __forceinline__ unsigned cvt_pk_bf16(float lo, float hi) { f32x2_t v = {lo, hi}; h16x2_t b = __builtin_convertvector(v, h16x2_t); return __builtin_bit_cast(unsigned, b); }
__device__ __forceinline__ float unpk_lo(unsigned w) { return (float)__builtin_bit_cast(h16x2_t, w)[0]; }
__device__ __forceinline__ float unpk_hi(unsigned w) { return (float)__builtin_bit_cast(h16x2_t, w)[1]; }
#define MFMA16(a, b, c) __builtin_amdgcn_mfma_f32_16x16x32_f16(__builtin_bit_cast(pg8::h16x8_t, (a)), __builtin_bit_cast(pg8::h16x8_t, (b)), (c), 0, 0, 0)
#define MFMA32(a, b, c) __builtin_amdgcn_mfma_f32_32x32x16_f16(__builtin_bit_cast(pg8::h16x8_t, (a)), __builtin_bit_cast(pg8::h16x8_t, (b)), (c), 0, 0, 0)
#else
__device__ __forceinline__ unsigned cvt_pk_bf16(float lo, float hi) { f32x2_t v = {lo, hi}; bf16x2_t b = __builtin_convertvector(v, bf16x2_t); return __builtin_bit_cast(unsigned, b); }
__device__ __forceinline__ float unpk_lo(unsigned w) { return __uint_as_float(w << 16); }
__device__ __forceinline__ float unpk_hi(unsigned w) { return __uint_as_float(w & 0xffff0000u); }
#define MFMA16(a, b, c) __builtin_amdgcn_mfma_f32_16x16x32_bf16((a), (b), (c), 0, 0, 0)
#define MFMA32(a, b, c) __builtin_amdgcn_mfma_f32_32x32x16_bf16((a), (b), (c), 0, 0, 0)
#endif

struct EpiProj {
    static constexpr bool PERM = true, AFTER_DRAIN = false;
    bf16_t* O; int ldc; const float* rs; const float* cs; const float* sn; int rope_tiles;
    __device__ __forceinline__ void operator()(const f32x4 (&acc)[2][2][4][2], const Unit& u, int wr, int wc, int fr_in, int fq_in) const {
        int fr = fr_in, fq = fq_in; asm volatile("; EPI_ENTRY" : "+v"(fr), "+v"(fq));
        const int row0 = u.pm * BM + wr * 64 + fr, col0 = u.pn * BM + wc * 32 + 8 * fq;
        const bool rope = u.pn < rope_tiles; const int i0 = (wc * 32 + 8 * fq) >> 1;
#pragma unroll
        for (int ai = 0; ai < 2; ++ai)
#pragma unroll
            for (int m = 0; m < 4; ++m) { const int row = row0 + ai * HALF + m * 16; const float r = rs[row];
                f32x4 c4 = (f32x4){1.f, 1.f, 1.f, 1.f}, s4 = (f32x4){0.f, 0.f, 0.f, 0.f};
                if (rope) { c4 = *(const f32x4*)(cs + (size_t)row * 64 + i0); s4 = *(const f32x4*)(sn + (size_t)row * 64 + i0); }
                bf16_t* rowp = O + (size_t)row * ldc + col0;
#pragma unroll
                for (int bj = 0; bj < 2; ++bj) { const f32x4 v0 = acc[ai][bj][m][0] * r, v1 = acc[ai][bj][m][1] * r;
                    f32x4 o0, o1;
                    o0[0] = v0[0] * c4[0] - v0[1] * s4[0]; o0[1] = v0[1] * c4[0] + v0[0] * s4[0];
                    o0[2] = v0[2] * c4[1] - v0[3] * s4[1]; o0[3] = v0[3] * c4[1] + v0[2] * s4[1];
                    o1[0] = v1[0] * c4[2] - v1[1] * s4[2]; o1[1] = v1[1] * c4[2] + v1[0] * s4[2];
                    o1[2] = v1[2] * c4[3] - v1[3] * s4[3]; o1[3] = v1[3] * c4[3] + v1[2] * s4[3];
                    u32x4 w; w.x = cvt_pk_bf16(o0[0], o0[1]); w.y = cvt_pk_bf16(o0[2], o0[3]); w.z = cvt_pk_bf16(o1[0], o1[1]); w.w = cvt_pk_bf16(o1[2], o1[3]);
                    *(u32x4*)(rowp + bj * HALF) = w; } }
    }
};
struct EpiY {
    static constexpr bool PERM = true, AFTER_DRAIN = false;
    bf16_t* O; int ldc; float* ssp;
    __device__ __forceinline__ void operator()(const f32x4 (&acc)[2][2][4][2], const Unit& u, int wr, int wc, int fr_in, int fq_in) const {
        int fr = fr_in, fq = fq_in; asm volatile("; EPI_ENTRY" : "+v"(fr), "+v"(fq));
        const int row0 = u.pm * BM + wr * 64 + fr, col0 = u.pn * BM + wc * 32 + 8 * fq;
#pragma unroll
        for (int ai = 0; ai < 2; ++ai)
#pragma unroll
            for (int m = 0; m < 4; ++m) { const int row = row0 + ai * HALF + m * 16; bf16_t* rowp = O + (size_t)row * ldc + col0; float s = 0.f;
#pragma unroll
                for (int bj = 0; bj < 2; ++bj) { const f32x4 v0 = acc[ai][bj][m][0], v1 = acc[ai][bj][m][1];
                    s += (v0[0] * v0[0] + v0[1] * v0[1]) + (v0[2] * v0[2] + v0[3] * v0[3]) + (v1[0] * v1[0] + v1[1] * v1[1]) + (v1[2] * v1[2] + v1[3] * v1[3]);
                    u32x4 w; w.x = cvt_pk_bf16(v0[0], v0[1]); w.y = cvt_pk_bf16(v0[2], v0[3]); w.z = cvt_pk_bf16(v1[0], v1[1]); w.w = cvt_pk_bf16(v1[2], v1[3]);
                    *(u32x4*)(rowp + bj * HALF) = w; }
                s = fq_sum(s);
                if (fq == 0) ssp[(size_t)row * 64 + u.pn * 4 + wc] = s; }
    }
};
struct EpiPle {
    static constexpr bool PERM = true, AFTER_DRAIN = false;
    bf16_t* G; bf16_t* HI; bf16_t* LO; float* OUT32; float* ssp;
    __device__ __forceinline__ void operator()(const f32x4 (&acc)[2][2][4][2], const Unit& u, int wr, int wc, int fr_in, int fq_in) const {
        int fr = fr_in, fq = fq_in; asm volatile("; EPI_ENTRY" : "+v"(fr), "+v"(fq));
        const unsigned row0 = (unsigned)(u.pm * BM + wr * 64 + fr), col0 = (unsigned)(u.pn * BM + wc * 32 + 8 * fq);
        char* Gc = (char*)G + (size_t)(u.pm * 16 + u.pn) * 131072u + (unsigned)(wr * 4 + wc) * 16384u; char* HIc = (char*)HI; char* LOc = (char*)LO; char* Oc = (char*)OUT32;
        const unsigned goff = (unsigned)(fq * 16 + fr) * 16u;
        if (u.which == 0) {
#pragma unroll
            for (int ai = 0; ai < 2; ++ai)
#pragma unroll
                for (int m = 0; m < 4; ++m) {
                    u32x4 w;
#pragma unroll
                    for (int bj = 0; bj < 2; ++bj) { f32x4 v0 = acc[ai][bj][m][0], v1 = acc[ai][bj][m][1]; unsigned q0 = 0u, q1 = 0u;
#pragma unroll
                        for (int e = 0; e < 4; ++e) { q0 |= (unsigned)(__builtin_amdgcn_rcpf(1.f + __expf(-v0[e])) * 255.f + 0.5f) << (8 * e); q1 |= (unsigned)(__builtin_amdgcn_rcpf(1.f + __expf(-v1[e])) * 255.f + 0.5f) << (8 * e); }
                        if (bj == 0) { w.x = q0; w.y = q1; } else { w.z = q0; w.w = q1; } }
                    *(u32x4*)(Gc + (unsigned)((ai * 4 + m) * 1024) + goff) = w; }
        } else {
            asm volatile("s_waitcnt vmcnt(0)" ::: "memory");
#pragma unroll
            for (int ai = 0; ai < 2; ++ai)
#pragma unroll
                for (int m = 0; m < 4; ++m) { const unsigned row = row0 + ai * HALF + m * 16, off = row * 4096u + col0; float s = 0.f; const u32x4 gq = *(const u32x4*)(Gc + (unsigned)((ai * 4 + m) * 1024) + goff);
#pragma unroll
                    for (int bj = 0; bj < 2; ++bj) { const unsigned ob = off + bj * HALF; const unsigned qa = bj ? gq.z : gq.x, qb = bj ? gq.w : gq.y;
                        const u32x4 hw = *(const u32x4*)(HIc + (unsigned)(ob * 2u)); u32x4 lw = {0u, 0u, 0u, 0u}; if (RES_LO) lw = *(const u32x4*)(LOc + (unsigned)(ob * 2u));
                        f32x4 g0, g1, h0, h1; g0[0] = (float)(qa & 255u) * (1.f / 255.f); g0[1] = (float)((qa >> 8) & 255u) * (1.f / 255.f); g0[2] = (float)((qa >> 16) & 255u) * (1.f / 255.f); g0[3] = (float)(qa >> 24) * (1.f / 255.f);
                        g1[0] = (float)(qb & 255u) * (1.f / 255.f); g1[1] = (float)((qb >> 8) & 255u) * (1.f / 255.f); g1[2] = (float)((qb >> 16) & 255u) * (1.f / 255.f); g1[3] = (float)(qb >> 24) * (1.f / 255.f);
                        h0[0] = unpk_lo(hw.x) + unpk_lo(lw.x); h0[1] = unpk_hi(hw.x) + unpk_hi(lw.x); h0[2] = unpk_lo(hw.y) + unpk_lo(lw.y); h0[3] = unpk_hi(hw.y) + unpk_hi(lw.y);
                        h1[0] = unpk_lo(hw.z) + unpk_lo(lw.z); h1[1] = unpk_hi(hw.z) + unpk_hi(lw.z); h1[2] = unpk_lo(hw.w) + unpk_lo(lw.w); h1[3] = unpk_hi(hw.w) + unpk_hi(lw.w);
                        const f32x4 v0 = h0 + g0 * acc[ai][bj][m][0], v1 = h1 + g1 * acc[ai][bj][m][1];
                        s += (v0[0] * v0[0] + v0[1] * v0[1]) + (v0[2] * v0[2] + v0[3] * v0[3]) + (v1[0] * v1[0] + v1[1] * v1[1]) + (v1[2] * v1[2] + v1[3] * v1[3]);
                        u32x4 w; w.x = cvt_pk_bf16(v0[0], v0[1]); w.y = cvt_pk_bf16(v0[2], v0[3]); w.z = cvt_pk_bf16(v1[0], v1[1]); w.w = cvt_pk_bf16(v1[2], v1[3]);
                        if (OUT32) { *(f32x4*)(Oc + (unsigned)(ob * 4u)) = v0; *(f32x4*)(Oc + (unsigned)(ob * 4u + 16u)) = v1; }
                        else { u32x4 wl; wl.x = cvt_pk_bf16(v0[0] - unpk_lo(w.x), v0[1] - unpk_hi(w.x)); wl.y = cvt_pk_bf16(v0[2] - unpk_lo(w.y), v0[3] - unpk_hi(w.y));
                            wl.z = cvt_pk_bf16(v1[0] - unpk_lo(w.z), v1[1] - unpk_hi(w.z)); wl.w = cvt_pk_bf16(v1[2] - unpk_lo(w.w), v1[3] - unpk_hi(w.w));
                            *(u32x4*)(HIc + (unsigned)(ob * 2u)) = w; if (RES_LO) *(u32x4*)(LOc + (unsigned)(ob * 2u)) = wl; }
                        asm volatile("" ::: "memory"); }
                    s = fq_sum(s);
                    if (fq == 0) ssp[(size_t)row * 64 + u.pn * 4 + wc] = s;
                    asm volatile("" ::: "memory"); }
        }
    }
};
struct EpiPart {
    static constexpr bool PERM = true, AFTER_DRAIN = false;
    bf16_t* part;
    __device__ __forceinline__ void operator()(const f32x4 (&acc)[2][2][4][2], const Unit& u, int wr, int wc, int fr, int fq) const {
        const int row0 = u.pm * BM + wr * 64 + fr, col0 = wc * 32 + 8 * fq; bf16_t* base = part + (size_t)u.which * 16384 * 256;
#pragma unroll
        for (int ai = 0; ai < 2; ++ai)
#pragma unroll
            for (int m = 0; m < 4; ++m) { bf16_t* rowp = base + (size_t)(row0 + ai * HALF + m * 16) * 256 + col0;
#pragma unroll
                for (int bj = 0; bj < 2; ++bj) { const f32x4 v0 = acc[ai][bj][m][0], v1 = acc[ai][bj][m][1];
                    u32x4 w; w.x = cvt_pk_bf16(v0[0], v0[1]); w.y = cvt_pk_bf16(v0[2], v0[3]); w.z = cvt_pk_bf16(v1[0], v1[1]); w.w = cvt_pk_bf16(v1[2], v1[3]); *(u32x4*)(rowp + bj * HALF) = w; } }
    }
};
struct SplitKOrder {
    int G, c, nunit;
    __device__ __forceinline__ bool next(int i, Unit& u) const { const int L = i * G + c; if (L >= nunit) return false; u.pm = L >> 2; u.pn = 0; u.which = L & 3; return true; }
    __device__ __forceinline__ void a_ready(const Unit&) const {}
    __device__ __forceinline__ void done(const Unit&) const {}
};
struct EpiPleDbg {
    static constexpr bool PERM = true, AFTER_DRAIN = false;
    bf16_t* G; bf16_t* G2;
    __device__ __forceinline__ void operator()(const f32x4 (&acc)[2][2][4][2], const Unit& u, int wr, int wc, int fr, int fq) const {
        const int row0 = u.pm * BM + wr * 64 + fr, col0 = u.pn * BM + wc * 32 + 8 * fq; bf16_t* O = u.which ? G2 : G;
#pragma unroll
        for (int ai = 0; ai < 2; ++ai)
#pragma unroll
            for (int m = 0; m < 4; ++m) { const int row = row0 + ai * HALF + m * 16; bf16_t* rowp = O + (size_t)row * 4096 + col0;
#pragma unroll
                for (int bj = 0; bj < 2; ++bj) { const f32x4 v0 = acc[ai][bj][m][0], v1 = acc[ai][bj][m][1];
                    u32x4 w; w.x = cvt_pk_bf16(v0[0], v0[1]); w.y = cvt_pk_bf16(v0[2], v0[3]); w.z = cvt_pk_bf16(v1[0], v1[1]); w.w = cvt_pk_bf16(v1[2], v1[3]);
                    *(u32x4*)(rowp + bj * HALF) = w; } }
    }
};
struct PleOrder {
    int G, c, ntile;
    __device__ __forceinline__ bool next(int i, Unit& u) const { const int tl = (i >> 1) * G + c; if (tl >= ntile) return false; u.pm = tl >> 4; u.pn = tl & 15; u.which = i & 1; return true; }
    __device__ __forceinline__ void a_ready(const Unit&) const {}
    __device__ __forceinline__ void done(const Unit&) const {}
};
template <class Epi, class Sched, bool ALIGN_EPI = false, bool SP2 = false>
__device__ __forceinline__ void gemm_phase(PG8_LAS unsigned char* lds, const Gemm g, const Sched& S, const Epi& E, int wave_in) {
    int lane_o; asm volatile("v_mbcnt_lo_u32_b32 %0, -1, 0\n\tv_mbcnt_hi_u32_b32 %0, -1, %0 ; LANE_ID" : "=v"(lane_o)); const int wid = wave_in, lane = lane_o, tid = wid * 64 + lane, wr = wid >> 2, wc = wid & 3, fr = lane & 15, fq = lane >> 4;
    const int K = g.ld ? g.ld : g.K, nt = g.K / BK;
    unsigned voffA[2], voffB[2];
#pragma unroll
    for (int i = 0; i < 2; ++i) { int R, C; stage_rc(tid * 16 + i * 8192, R, C); const int Rb = Epi::PERM ? ((R & ~31) + perm32(R & 31)) : R;
        voffA[i] = (unsigned)(R * K + C) * 2u; voffB[i] = (unsigned)(Rb * K + C) * 2u; }
    const size_t kstep = (size_t)(BK * 2);
    const size_t hstep = (size_t)HALF * K * 2;
    const size_t tstep = 2 * hstep;
    const unsigned ldsw = (unsigned)wid * 1024u;
    const int aoff = lds_byte(wr * 64 + fr, fq * 8), boff = lds_byte(wc * 32 + fr, fq * 8);
#define PG8_SA(b, h) (((b) * 2 + (h)) * HTB)
#define PG8_SB(b, h) ((4 + (b) * 2 + (h)) * HTB)
#define PG8_STAGE(bufoff, gbase, voff) do { _Pragma("unroll") for (int _i = 0; _i < 2; ++_i) \
        __builtin_amdgcn_global_load_lds((const unsigned*)((const char*)(gbase) + (voff)[_i]), (PG8_LAS unsigned*)(lds + (bufoff) + ldsw + _i * 8192), 16, 0, 0); } while (0)
#define PG8_LDA(dst, b, h) do { _Pragma("unroll") for (int m = 0; m < 4; ++m) _Pragma("unroll") for (int k = 0; k < 2; ++k) dst[m][k] = *(const PG8_LAS bf16x8*)(lds + PG8_SA(b, h) + aoff + m * 2048 + k * 1024); } while (0)
#define PG8_LDB(dst, b, h) do { _Pragma("unroll") for (int n = 0; n < 2; ++n) _Pragma("unroll") for (int k = 0; k < 2; ++k) dst[n][k] = *(const PG8_LAS bf16x8*)(lds + PG8_SB(b, h) + boff + n * 2048 + k * 1024); } while (0)
#define PG8_MMA(ai, bj, At, Bt) do { __builtin_amdgcn_s_setprio(1); _Pragma("unroll") for (int m = 0; m < 4; ++m) _Pragma("unroll") for (int n = 0; n < 2; ++n) _Pragma("unroll") for (int k = 0; k < 2; ++k) \
        acc[ai][bj][m][n] = MFMA16(Bt[n][k], At[m][k], acc[ai][bj][m][n]); __builtin_amdgcn_s_setprio(0); } while (0)
#define PG8_WAIT_V(n) asm volatile("s_waitcnt vmcnt(" #n ")" ::: "memory")
#define PG8_WAIT_L(n) asm volatile("s_waitcnt lgkmcnt(" #n ")" ::: "memory")
#define PG8_BAR __builtin_amdgcn_s_barrier()
#define PG8_SCHED __builtin_amdgcn_sched_barrier(0)
    Unit cur, nxt; int ui = 0;
    if (!S.next(0, cur)) return;
    f32x4 acc[2][2][4][2];
#pragma unroll
    for (int a = 0; a < 2; ++a)
#pragma unroll
        for (int b = 0; b < 2; ++b)
#pragma unroll
            for (int m = 0; m < 4; ++m)
#pragma unroll
                for (int n = 0; n < 2; ++n) acc[a][b][m][n] = (f32x4){0.f, 0.f, 0.f, 0.f};
    bf16x8 At[4][2], B0[2][2], B1[2][2];
    const char* cA = (const char*)g.A + (size_t)cur.pm * tstep + (size_t)cur.which * (size_t)g.dA; const char* cB = (const char*)g.Bt + (size_t)cur.pn * tstep + (size_t)cur.which * (size_t)g.dB;
    S.a_ready(cur);
    if constexpr (SP2) {
        PG8_STAGE(PG8_SB(0, 0), cB, voffB); PG8_STAGE(PG8_SB(0, 1), cB + hstep, voffB); PG8_STAGE(PG8_SA(0, 0), cA, voffA); PG8_STAGE(PG8_SA(0, 1), cA + hstep, voffA);
        if (wr == 1) PG8_BAR;
        PG8_WAIT_V(2); PG8_BAR;
        PG8_STAGE(PG8_SB(1, 0), cB + kstep, voffB); PG8_STAGE(PG8_SA(1, 0), cA + kstep, voffA); PG8_STAGE(PG8_SB(1, 1), cB + hstep + kstep, voffB);
        PG8_WAIT_V(6); PG8_BAR;
    } else {
        PG8_STAGE(PG8_SB(0, 0), cB, voffB); PG8_STAGE(PG8_SA(0, 0), cA, voffA); PG8_STAGE(PG8_SB(0, 1), cB + hstep, voffB); PG8_STAGE(PG8_SA(0, 1), cA + hstep, voffA);
        if (wr == 1) PG8_BAR;
        PG8_WAIT_V(4); PG8_BAR;
        PG8_STAGE(PG8_SB(1, 0), cB + kstep, voffB); PG8_STAGE(PG8_SA(1, 0), cA + kstep, voffA); PG8_STAGE(PG8_SB(1, 1), cB + hstep + kstep, voffB);
        PG8_WAIT_V(6); PG8_BAR;
    }
    for (;;) {
        const bool has_next = S.next(ui + 1, nxt);
        const char* nA = has_next ? (const char*)g.A + (size_t)nxt.pm * tstep + (size_t)nxt.which * (size_t)g.dA : cA; const char* nB = has_next ? (const char*)g.Bt + (size_t)nxt.pn * tstep + (size_t)nxt.which * (size_t)g.dB : cB;
        for (int t = 0; t < nt; t += 2) {
            const bool last = (t == nt - 2);
            const char* a1 = cA + (size_t)(t + 1) * kstep;
            const char* a2 = last ? nA : cA + (size_t)(t + 2) * kstep; const char* b2 = last ? nB : cB + (size_t)(t + 2) * kstep;
            const char* a3 = a2 + kstep; const char* b3 = b2 + kstep;
            if (last && has_next) S.a_ready(nxt);
            if constexpr (SP2) {
            PG8_LDB(B0, 0, 0); PG8_LDB(B1, 0, 1); PG8_SCHED; PG8_LDA(At, 0, 0); PG8_STAGE(PG8_SA(1, 1), a1 + hstep, voffA);
            PG8_WAIT_V(8); PG8_WAIT_L(0); PG8_BAR; PG8_MMA(0, 0, At, B0); PG8_MMA(0, 1, At, B1); PG8_BAR; PG8_SCHED;
            PG8_LDA(At, 0, 1); PG8_STAGE(PG8_SB(0, 0), b2, voffB); PG8_STAGE(PG8_SB(0, 1), b2 + hstep, voffB); PG8_STAGE(PG8_SA(0, 0), a2, voffA);
            PG8_WAIT_V(8); PG8_WAIT_L(0); PG8_BAR; PG8_MMA(1, 0, At, B0); PG8_MMA(1, 1, At, B1); PG8_BAR; PG8_SCHED;
            PG8_LDB(B0, 1, 0); PG8_LDB(B1, 1, 1); PG8_SCHED; PG8_LDA(At, 1, 0); PG8_STAGE(PG8_SA(0, 1), a2 + hstep, voffA);
            PG8_WAIT_V(8); PG8_WAIT_L(0); PG8_BAR; PG8_MMA(0, 0, At, B0); PG8_MMA(0, 1, At, B1); PG8_BAR; PG8_SCHED;
            PG8_LDA(At, 1, 1); PG8_STAGE(PG8_SB(1, 0), b3, voffB); PG8_STAGE(PG8_SB(1, 1), b3 + hstep, voffB); PG8_STAGE(PG8_SA(1, 0), a3, voffA);
            PG8_WAIT_V(8); PG8_WAIT_L(0); PG8_BAR; PG8_MMA(1, 0, At, B0); PG8_MMA(1, 1, At, B1); PG8_BAR; PG8_SCHED;
            } else {
            PG8_LDB(B0, 0, 0); PG8_SCHED; PG8_LDA(At, 0, 0); PG8_STAGE(PG8_SA(1, 1), a1 + hstep, voffA);
            PG8_WAIT_L(8); PG8_BAR; PG8_WAIT_L(0); PG8_MMA(0, 0, At, B0); PG8_BAR; PG8_SCHED;
            PG8_LDB(B1, 0, 1); PG8_STAGE(PG8_SB(0, 0), b2, voffB);
            PG8_BAR; PG8_WAIT_L(0); PG8_MMA(0, 1, At, B1); PG8_BAR;
            PG8_LDA(At, 0, 1); PG8_STAGE(PG8_SA(0, 0), a2, voffA);
            PG8_BAR; PG8_WAIT_L(0); PG8_MMA(1, 0, At, B0); PG8_BAR; PG8_SCHED;
            PG8_STAGE(PG8_SB(0, 1), b2 + hstep, voffB);
            PG8_WAIT_V(6); PG8_BAR; PG8_MMA(1, 1, At, B1); PG8_BAR;
            PG8_LDB(B0, 1, 0); PG8_SCHED; PG8_LDA(At, 1, 0); PG8_STAGE(PG8_SA(0, 1), a2 + hstep, voffA);
            PG8_WAIT_L(8); PG8_BAR; PG8_WAIT_L(0); PG8_MMA(0, 0, At, B0); PG8_BAR; PG8_SCHED;
            PG8_LDB(B1, 1, 1); PG8_STAGE(PG8_SB(1, 0), b3, voffB);
            PG8_BAR; PG8_WAIT_L(0); PG8_MMA(0, 1, At, B1); PG8_BAR;
            PG8_LDA(At, 1, 1); PG8_STAGE(PG8_SA(1, 0), a3, voffA);
            PG8_BAR; PG8_WAIT_L(0); PG8_MMA(1, 0, At, B0); PG8_BAR; PG8_SCHED;
            PG8_STAGE(PG8_SB(1, 1), b3 + hstep, voffB);
            PG8_WAIT_V(6); PG8_BAR; PG8_MMA(1, 1, At, B1); PG8_BAR;
            }
        }
        if constexpr (ALIGN_EPI) { if (wr == 0) PG8_BAR; }
        if constexpr (!Epi::AFTER_DRAIN) { E(acc, cur, wr, wc, fr, fq); S.done(cur); }
        if (!has_next) break;
#pragma unroll
        for (int a = 0; a < 2; ++a)
#pragma unroll
            for (int b = 0; b < 2; ++b)
#pragma unroll
                for (int m = 0; m < 4; ++m)
#pragma unroll
                    for (int n = 0; n < 2; ++n) acc[a][b][m][n] = (f32x4){0.f, 0.f, 0.f, 0.f};
        cur = nxt; cA = nA; cB = nB; ++ui;
        if constexpr (ALIGN_EPI) { if (wr == 1) PG8_BAR; }
    }
    PG8_WAIT_V(0);
    if constexpr (!ALIGN_EPI) { if (wr == 0) PG8_BAR; }
    PG8_BAR;
    if constexpr (Epi::AFTER_DRAIN) { E.fused(acc, cur, wr, wc, fr, fq, lds, wid, lane); S.done(cur); }
#undef PG8_SA
#undef PG8_SB
#undef PG8_STAGE
#undef PG8_LDA
#undef PG8_LDB
#undef PG8_MMA
#undef PG8_WAIT_V
#undef PG8_WAIT_L
#undef PG8_BAR
#undef PG8_SCHED
}
}

constexpr int S_ = 16384, DM = 4096, NUP = 8192, NIN = 6144, NMIX = 2048, PLED = 256, DEPTH_ = 4, NCH = S_ / 64;
constexpr float EPS_ = 1e-6f;
constexpr int NWAVES = 8;
constexpr size_t MiB = 1u << 20;
constexpr size_t WS_CTL = 0, CTL_ZERO_BYTES = 1 * MiB;
constexpr size_t WS_RIN = 1 * MiB;
constexpr size_t WS_LAM = 1 * MiB + 65536;
constexpr size_t WS_CHS = 1 * MiB + 131072;
constexpr size_t WS_GPRE = 2 * MiB;
constexpr size_t WS_DN = 3 * MiB;
constexpr size_t WS_NH = 3 * MiB + 524288;
constexpr size_t WS_SSP = 4 * MiB;
constexpr size_t WS_COS = 8 * MiB, WS_SIN = 12 * MiB;
constexpr size_t WS_G1 = 16 * MiB;
constexpr size_t WS_PB = 24 * MiB;
constexpr size_t WS_QKC = 56 * MiB;
constexpr size_t WS_HB = 88 * MiB;
constexpr size_t WS_PROJ = 216 * MiB;
constexpr size_t WS_YMIX = 408 * MiB;
constexpr size_t WS_MIXO = 472 * MiB;
constexpr size_t WS_UP = 600 * MiB;
constexpr size_t WS_ACT = 856 * MiB;
constexpr size_t WS_OD = 984 * MiB;
constexpr size_t WS_DC = 1048 * MiB;
constexpr size_t WS_CH = 1176 * MiB;
constexpr size_t WS_WIN = 1240 * MiB;
constexpr size_t WS_WOUT = 1432 * MiB;
constexpr size_t WS_WUP = 1496 * MiB;
constexpr size_t WS_WDN = 1752 * MiB;
constexpr size_t WS_WPD = 1880 * MiB;
constexpr size_t WS_WPU = 1888 * MiB;
constexpr size_t WS_WPP = 1896 * MiB;
constexpr size_t WS_WG = 1904 * MiB;
constexpr size_t WS_LO = 1905 * MiB;
constexpr size_t WS_END = 2033 * MiB;
constexpr int CW_BAR = 4096;
constexpr int CW_Q = 16384;
constexpr int RING_BYTES = 131072;
constexpr int LDSCTL_OFF = RING_BYTES, MISC_OFF = LDSCTL_OFF + 320;
constexpr int LDS_BYTES = 151552;

#define GAS __attribute__((address_space(1)))
#define LAS __attribute__((address_space(3)))
typedef unsigned short bf16;
typedef unsigned v4u __attribute__((ext_vector_type(4)));
typedef unsigned v2u __attribute__((ext_vector_type(2)));
typedef float f32x4 __attribute__((ext_vector_type(4)));
typedef float f32x16 __attribute__((ext_vector_type(16)));
typedef short bf16x8 __attribute__((ext_vector_type(8)));
typedef short s16x4 __attribute__((ext_vector_type(4)));
typedef GAS unsigned gu32;
#define RLX_AGENT __ATOMIC_RELAXED, __HIP_MEMORY_SCOPE_AGENT
#define LDS_WAIT() asm volatile("s_waitcnt lgkmcnt(0)" ::: "memory")
#define VM_WAIT() asm volatile("s_waitcnt vmcnt(0)" ::: "memory")
__device__ __forceinline__ unsigned pk2(float lo, float hi) { return pg8::cvt_pk_bf16(lo, hi); }
__device__ __forceinline__ unsigned f2bf(float f) { return pg8::cvt_pk_bf16(f, 0.f) & 0xffffu; }
__device__ __forceinline__ float bflo(unsigned w) { return pg8::unpk_lo(w); }
__device__ __forceinline__ float bfhi(unsigned w) { return pg8::unpk_hi(w); }
__device__ __forceinline__ float h2f(unsigned short b) { return pg8::unpk_lo((unsigned)b); }
#define dppf(v, ctrl) __builtin_bit_cast(float, __builtin_amdgcn_update_dpp(0, __builtin_bit_cast(int, (float)(v)), (ctrl), 0xf, 0xf, true))
#define DPP_X1 0xB1
#define DPP_X2 0x4E
#define DPP_HM 0x141
#define DPP_RM 0x140
__device__ __forceinline__ float x16_sum(float v) { auto rr = __builtin_amdgcn_permlane16_swap(__float_as_uint(v), __float_as_uint(v), false, false); return __uint_as_float(rr[0]) + __uint_as_float(rr[1]); }
__device__ __forceinline__ float x16_max(float v) { auto rr = __builtin_amdgcn_permlane16_swap(__float_as_uint(v), __float_as_uint(v), false, false); return fmaxf(__uint_as_float(rr[0]), __uint_as_float(rr[1])); }
__device__ __forceinline__ float swap_sum(float v) { auto rr = __builtin_amdgcn_permlane32_swap(__float_as_uint(v), __float_as_uint(v), false, false); return __uint_as_float(rr[0]) + __uint_as_float(rr[1]); }
__device__ __forceinline__ float swap_max(float v) { auto rr = __builtin_amdgcn_permlane32_swap(__float_as_uint(v), __float_as_uint(v), false, false); return fmaxf(__uint_as_float(rr[0]), __uint_as_float(rr[1])); }
__device__ __forceinline__ float wave_sum(float v) { v += dppf(v, DPP_X1); v += dppf(v, DPP_X2); v += dppf(v, DPP_HM); v += dppf(v, DPP_RM); v = x16_sum(v); return swap_sum(v); }
__device__ __forceinline__ float wave_max(float v) { v = fmaxf(v, dppf(v, DPP_X1)); v = fmaxf(v, dppf(v, DPP_X2)); v = fmaxf(v, dppf(v, DPP_HM)); v = fmaxf(v, dppf(v, DPP_RM)); v = x16_max(v); return swap_max(v); }
__device__ __forceinline__ int crow(int r, int hi) { return (r & 3) + 8 * (r >> 2) + 4 * hi; }
#define KSWZ(row, colB) ((row) * 256 + ((colB) ^ (((row) & 15) << 4)))
#define TRRD(dst, base, off) asm volatile("ds_read_b64_tr_b16 %0, %1 offset:%2" : "=&v"(dst) : "v"(base), "i"(off) : "memory")
__device__ __forceinline__ bf16x8 mk8(s16x4 l, s16x4 h) { return (bf16x8){l[0], l[1], l[2], l[3], h[0], h[1], h[2], h[3]}; }
__device__ __forceinline__ bf16x8 pack8f(const float* p) { v4u w; w.x = pk2(p[0], p[1]); w.y = pk2(p[2], p[3]); w.z = pk2(p[4], p[5]); w.w = pk2(p[6], p[7]); return __builtin_bit_cast(bf16x8, w); }

#define XB_TMO      128
#define XB_XCNT(j)  (256  + 64 * (j))
#define XB_XSUB(j)  (1280 + 64 * (j))
#define XB_XGEN(j)  (2304 + 64 * (j))
#define XB_TOP      3328
#define XB_TOPGEN   3392
#define XCD_BAR_WORDS 3456
#define XB_SPIN_CAP (1u << 18)

__device__ __forceinline__ unsigned xb_ld(unsigned* p)              { return __hip_atomic_load(p, __ATOMIC_RELAXED, __HIP_MEMORY_SCOPE_AGENT); }
__device__ __forceinline__ unsigned xb_add(unsigned* p, unsigned v) { return __hip_atomic_fetch_add(p, v, __ATOMIC_RELAXED, __HIP_MEMORY_SCOPE_AGENT); }
__device__ __forceinline__ unsigned xb_xcc_id() { return (unsigned)__builtin_amdgcn_s_getreg((3 << 11) | 20) & 0xFu; }
#define XB_SPIN(cond, bar) do { unsigned _sp = 0; while (cond) { __builtin_amdgcn_s_sleep(1); \
    if ((++_sp & 255u) == 0u) { if (xb_ld(&(bar)[XB_TMO])) break; if (_sp > XB_SPIN_CAP) { atomicAdd(&(bar)[XB_TMO], 1u); break; } } } } while (0)

struct XcdBarrier {
    unsigned* bar; unsigned x;
    volatile LAS unsigned* st;
};

__device__ __forceinline__ XcdBarrier xcd_barrier_post(unsigned* bar, volatile LAS unsigned* st) {
    XcdBarrier b; b.bar = bar; b.x = xb_xcc_id(); b.st = st;
    if (threadIdx.x == 0) (void)xb_add(&bar[XB_XCNT(b.x)], 1u);
    return b;
}
__device__ __forceinline__ void xcd_barrier_complete(unsigned* bar, unsigned x, unsigned& nloc, unsigned& nx) {
    const unsigned G = gridDim.x * gridDim.y * gridDim.z;
    unsigned sum, cnt, mine, sp = 0u;
    for (;;) {
        sum = 0u; cnt = 0u; mine = 0u;
#pragma unroll
        for (unsigned j = 0; j < 16; ++j) { const unsigned c = xb_ld(&bar[XB_XCNT(j)]); sum += c; cnt += (c > 0u) ? 1u : 0u; mine = (j == x) ? c : mine; }
        if (sum == G) break;
        __builtin_amdgcn_s_sleep(1);
        if ((++sp & 255u) == 0u) { if (xb_ld(&bar[XB_TMO])) break; if (sp > XB_SPIN_CAP) { atomicAdd(&bar[XB_TMO], 1u); break; } }
    }
    nloc = mine > 0u ? mine : 1u; nx = cnt > 0u ? cnt : 1u;
}

__device__ __forceinline__ void xcd_barrier(const XcdBarrier& b) {
    asm volatile("s_waitcnt vmcnt(0)" ::: "memory");
    __syncthreads();
    if (threadIdx.x == 0) {
        unsigned* bar = b.bar;
        __builtin_amdgcn_s_waitcnt(0);
        unsigned nloc = b.st[0], nx = b.st[1];
        if (nloc == 0u) { xcd_barrier_complete(bar, b.x, nloc, nx); b.st[0] = nloc; b.st[1] = nx; }
        const unsigned old = xb_add(&bar[XB_XSUB(b.x)], 1u);
        const unsigned gen = old / nloc;
        if (old + 1u == (gen + 1u) * nloc) {
            __builtin_amdgcn_fence(__ATOMIC_RELEASE, "agent");
            asm volatile("s_waitcnt vmcnt(0)" ::: "memory");
            const unsigned og = xb_add(&bar[XB_TOP], 1u);
            const unsigned tg = og / nx;
            if (og + 1u == (tg + 1u) * nx) xb_add(&bar[XB_TOPGEN], 1u);
            else XB_SPIN(xb_ld(&bar[XB_TOPGEN]) == tg, bar);
            __builtin_amdgcn_fence(__ATOMIC_ACQUIRE, "agent");
            xb_add(&bar[XB_XGEN(b.x)], 1u);
            asm volatile("s_waitcnt vmcnt(0)" ::: "memory");
        } else {
            XB_SPIN(xb_ld(&bar[XB_XGEN(b.x)]) == gen, bar);
            __builtin_amdgcn_fence(__ATOMIC_ACQUIRE, "agent");
            asm volatile("s_waitcnt vmcnt(0)" ::: "memory");
        }
    }
    __syncthreads();
}

#ifndef DBG_PERTURB
#define DBG_PERTURB 0
#endif
struct Params { const float* in[26]; float* out; unsigned char* ws; int ph_lo, ph_hi, pert, pad; };
enum { I_X = 0, I_P, I_WINE, I_WOUTE, I_DLAM, I_GDIFF, I_WCQK, I_BCQK, I_BIG, I_BFG, I_GML, I_WINO, I_WOUTO, I_GRET, I_GMPRE, I_GMPOST, I_GFPRE, I_GFPOST, I_WUP, I_WFC, I_BFC, I_WDN, I_GPLE, I_WPD, I_WPU, I_WPP };

typedef const __attribute__((address_space(4))) Params* KParams;
struct Frame {
    LAS unsigned char* lds;
    int tid, lane, wave, G, bid;
};
#define LANE_ID_ASM() ({ int l__; asm volatile("v_mbcnt_lo_u32_b32 %0, -1, 0\n\tv_mbcnt_hi_u32_b32 %0, -1, %0 ; LANE_ID" : "=v"(l__)); l__; })
#define PHASE_ENTRY(F) Frame F = F##_in; { const int l_ = LANE_ID_ASM(); F.lane = l_; F.tid = F.wave * 64 + l_; }

__device__ __forceinline__ void p0_transpose_item(const float* W, int ldw, int K, int N, bf16* WT, const float* gain, int rope_cols, LAS float* scr, int item, int lane) {
    const int nblk = N / 64, kb = item / nblk, nb = item % nblk, k0 = 64 * kb, n0 = 64 * nb;
    const int r4 = lane >> 4, q = lane & 15;
    int lcol, pbase, pstep;
    if (n0 < rope_cols) { const int hb = n0 & ~127, run = q >> 3, i4 = (q & 7) * 4; lcol = hb + run * 64 + ((n0 & 127) >> 1) + i4; pbase = 2 * i4 + run; pstep = 2; }
    else { lcol = n0 + 4 * q; pbase = 4 * q; pstep = 1; }
    f32x4 v[16];
#pragma unroll
    for (int i = 0; i < 16; ++i) v[i] = *(const f32x4*)(W + (size_t)(k0 + 4 * i + r4) * ldw + lcol);
#pragma unroll
    for (int i = 0; i < 16; ++i) { const int kk = 4 * i + r4; const float g = gain ? gain[k0 + kk] : 1.f; LAS float* d = scr + kk * 64;
        d[(pbase + kk) & 63] = v[i][0] * g; d[(pbase + pstep + kk) & 63] = v[i][1] * g; d[(pbase + 2 * pstep + kk) & 63] = v[i][2] * g; d[(pbase + 3 * pstep + kk) & 63] = v[i][3] * g; }
    LDS_WAIT(); asm volatile("" ::: "memory");
    const int c = lane & 7;
#pragma unroll
    for (int jq = 0; jq < 8; ++jq) { const int n = (lane >> 3) + 8 * jq; const LAS float* s = scr + (8 * c) * 64; const int nc = n + 8 * c;
        v4u o; o.x = pk2(s[0 * 64 + ((nc + 0) & 63)], s[1 * 64 + ((nc + 1) & 63)]); o.y = pk2(s[2 * 64 + ((nc + 2) & 63)], s[3 * 64 + ((nc + 3) & 63)]);
        o.z = pk2(s[4 * 64 + ((nc + 4) & 63)], s[5 * 64 + ((nc + 5) & 63)]); o.w = pk2(s[6 * 64 + ((nc + 6) & 63)], s[7 * 64 + ((nc + 7) & 63)]);
        *(GAS v4u*)(WT + (size_t)(n0 + n) * K + k0 + 8 * c) = o; }
    LDS_WAIT(); asm volatile("" ::: "memory");
}
__device__ __forceinline__ void p0_prologue(const Frame& F_in, KParams P) { PHASE_ENTRY(F);
    unsigned char* ws = P->ws;
    LAS float* scr = (LAS float*)(F.lds + F.wave * 16384);
    const int gw = F.bid * NWAVES + F.wave, NGW = F.G * NWAVES;
    constexpr int I_IN = 64 * 96, I_OUT = 32 * 64, I_UP = 64 * 128, I_DN = 64 * 64, I_PD = 64 * 4, I_PU = 4 * 64, I_PP = 4 * 64;
    constexpr int I_LAYER = I_IN + I_OUT + I_UP + I_DN + I_PD + I_PU + I_PP;
    for (int it = gw; it < DEPTH_ * I_LAYER; it += NGW) {
        const int L = it / I_LAYER; int r = it - L * I_LAYER; const int j = L >> 1; const bool ev = (L & 1) == 0;
        if (r < I_IN) { const float* W = ev ? P->in[I_WINE] + (size_t)j * DM * 6152 : P->in[I_WINO] + (size_t)j * DM * 6144;
            p0_transpose_item(W, ev ? 6152 : 6144, DM, NIN, (bf16*)(ws + WS_WIN) + (size_t)L * NIN * DM, P->in[I_GMPRE] + (size_t)L * DM, ev ? 2048 : 1024, scr, r, F.lane); continue; } r -= I_IN;
        if (r < I_OUT) { const float* W = (ev ? P->in[I_WOUTE] : P->in[I_WOUTO]) + (size_t)j * NMIX * DM;
            p0_transpose_item(W, DM, NMIX, DM, (bf16*)(ws + WS_WOUT) + (size_t)L * DM * NMIX, nullptr, 0, scr, r, F.lane); continue; } r -= I_OUT;
        if (r < I_UP) { p0_transpose_item(P->in[I_WUP] + (size_t)L * DM * NUP, NUP, DM, NUP, (bf16*)(ws + WS_WUP) + (size_t)L * NUP * DM, P->in[I_GFPRE] + (size_t)L * DM, 0, scr, r, F.lane); continue; } r -= I_UP;
        if (r < I_DN) { p0_transpose_item(P->in[I_WDN] + (size_t)L * DM * DM, DM, DM, DM, (bf16*)(ws + WS_WDN) + (size_t)L * DM * DM, nullptr, 0, scr, r, F.lane); continue; } r -= I_DN;
        if (r < I_PD) { p0_transpose_item(P->in[I_WPD] + (size_t)L * DM * PLED, PLED, DM, PLED, (bf16*)(ws + WS_WPD) + (size_t)L * PLED * DM, P->in[I_GPLE] + (size_t)L * DM, 0, scr, r, F.lane); continue; } r -= I_PD;
        if (r < I_PU) { p0_transpose_item(P->in[I_WPU] + (size_t)L * PLED * DM, DM, PLED, DM, (bf16*)(ws + WS_WPU) + (size_t)L * DM * PLED, nullptr, 0, scr, r, F.lane); continue; } r -= I_PU;
        p0_transpose_item(P->in[I_WPP] + (size_t)L * PLED * DM, DM, PLED, DM, (bf16*)(ws + WS_WPP) + (size_t)L * DM * PLED, nullptr, 0, scr, r, F.lane);
    }
    { const int l2_ = LANE_ID_ASM(); F.lane = l2_; F.tid = F.wave * 64 + l2_; }
    const int gt = F.bid * (NWAVES * 64) + F.tid, NGT = F.G * NWAVES * 64;
    for (int e = gt; e < 2 * DM; e += NGT) { const int j = e / DM, k = e - j * DM; const float g = P->in[I_GMPRE][(size_t)(2 * j) * DM + k]; const float* w = P->in[I_WINE] + ((size_t)j * DM + k) * 6152 + 6144;
        bf16* o = (bf16*)(ws + WS_WG) + (size_t)j * 8 * DM + k;
#pragma unroll
        for (int c = 0; c < 8; ++c) o[(size_t)c * DM] = (bf16)f2bf(g * w[c]); }
    for (size_t e = gt; e < (size_t)DEPTH_ * S_ * PLED / 8; e += NGT) { const f32x4 a = *(const f32x4*)(P->in[I_P] + e * 8), b = *(const f32x4*)(P->in[I_P] + e * 8 + 4);
        v4u o; o.x = pk2(a[0], a[1]); o.y = pk2(a[2], a[3]); o.z = pk2(b[0], b[1]); o.w = pk2(b[2], b[3]); *(v4u*)((bf16*)(ws + WS_PB) + e * 8) = o; }
    for (int e = gt; e < S_ * 64; e += NGT) { const int t = e >> 6, i = e & 63;
        const float finv = (float)exp2(-(double)i * (13.287712379549449 / 64.0)); const float ang = (float)t * finv; const double ad = (double)ang;
        const double n = rint(ad * 0.63661977236758134308); const double r = (ad - n * 1.57079632679489655800e+00) - n * 6.12323399573676603587e-17; const double r2 = r * r;
        double sn = r * (1.0 + r2 * (-1.0 / 6 + r2 * (1.0 / 120 + r2 * (-1.0 / 5040 + r2 * (1.0 / 362880 + r2 * (-1.0 / 39916800 + r2 * (1.0 / 6227020800.0)))))));
        double cs = 1.0 + r2 * (-0.5 + r2 * (1.0 / 24 + r2 * (-1.0 / 720 + r2 * (1.0 / 40320 + r2 * (-1.0 / 3628800 + r2 * (1.0 / 479001600.0))))));
        const int q = ((int)n) & 3; double c2 = cs, s2 = sn; if (q == 1) { c2 = -sn; s2 = cs; } else if (q == 2) { c2 = -cs; s2 = -sn; } else if (q == 3) { c2 = sn; s2 = -cs; }
        ((float*)(ws + WS_COS))[e] = (float)c2; ((float*)(ws + WS_SIN))[e] = (float)s2; }
    if (F.bid == 0 && F.wave == 0) {
        for (int j = 0; j < 2; ++j) { const float* lp = P->in[I_DLAM] + (size_t)j * 512; const int d = F.lane * 2;
            const float s1 = wave_sum(lp[d] * lp[128 + d] + lp[d + 1] * lp[128 + d + 1]), s2 = wave_sum(lp[256 + d] * lp[384 + d] + lp[256 + d + 1] * lp[384 + d + 1]);
            const float li = 0.8f - 0.6f * expf(-0.3f * (float)(2 * j));
            if (F.lane == 0) { ((float*)(ws + WS_LAM))[2 * j] = expf(s1) - expf(s2) + li; ((float*)(ws + WS_LAM))[2 * j + 1] = li; } }
    }
    for (int row = gw; row < S_; row += NGW) { const float* xr = P->in[I_X] + (size_t)row * DM; bf16* hr = (bf16*)(ws + WS_HB) + (size_t)row * DM; float ss = 0.f;
#pragma unroll
        for (int jj = 0; jj < 8; ++jj) { const int c = (jj * 64 + F.lane) * 8; const f32x4 a = *(const f32x4*)(xr + c), b = *(const f32x4*)(xr + c + 4);
            ss += (a[0] * a[0] + a[1] * a[1]) + (a[2] * a[2] + a[3] * a[3]) + (b[0] * b[0] + b[1] * b[1]) + (b[2] * b[2] + b[3] * b[3]);
            f32x4 a2 = a, b2 = b;
#if DBG_PERTURB
            if (P->pert) { for (int q = 0; q < 4; ++q) { unsigned hx = (unsigned)(row * 4096 + c + q) * 2654435761u; hx ^= hx >> 15; a2[q] *= 1.f + ((float)(hx & 1023u) - 511.5f) * 2e-6f; hx = (unsigned)(row * 4096 + c + 4 + q) * 2654435761u; hx ^= hx >> 15; b2[q] *= 1.f + ((float)(hx & 1023u) - 511.5f) * 2e-6f; } }
#endif
            v4u o; o.x = pk2(a2[0], a2[1]); o.y = pk2(a2[2], a2[3]); o.z = pk2(b2[0], b2[1]); o.w = pk2(b2[2], b2[3]); *(v4u*)(hr + c) = o; }
        const float tot = wave_sum(ss); if (F.lane == 0) ((float*)(ws + WS_RIN))[row] = rsqrtf(tot * (1.f / DM) + EPS_); }
}

__device__ __forceinline__ void gates_pass(const Frame& F_in, const bf16* hb, const bf16* wg, const float* rin, float* gpre) { PHASE_ENTRY(F);
    const int gw = F.bid * NWAVES + F.wave, NGW = F.G * NWAVES;
    for (int rg = gw; rg < S_ / 8; rg += NGW) { const int t0 = rg * 8;
        float acc[8][8];
#pragma unroll
        for (int a = 0; a < 8; ++a)
#pragma unroll
            for (int b = 0; b < 8; ++b) acc[a][b] = 0.f;
        for (int jj = 0; jj < 8; ++jj) { const int k = (jj * 64 + F.lane) * 8;
            v4u w[8];
#pragma unroll
            for (int c = 0; c < 8; ++c) w[c] = *(const v4u*)(wg + (size_t)c * DM + k);
#pragma unroll
            for (int r = 0; r < 8; ++r) { const v4u x = *(const v4u*)(hb + (size_t)(t0 + r) * DM + k);
#pragma unroll
                for (int c = 0; c < 8; ++c) acc[r][c] += (bflo(x.x) * bflo(w[c].x) + bfhi(x.x) * bfhi(w[c].x)) + (bflo(x.y) * bflo(w[c].y) + bfhi(x.y) * bfhi(w[c].y))
                                                        + (bflo(x.z) * bflo(w[c].z) + bfhi(x.z) * bfhi(w[c].z)) + (bflo(x.w) * bflo(w[c].w) + bfhi(x.w) * bfhi(w[c].w)); } }
        float mine = 0.f;
#pragma unroll
        for (int r = 0; r < 8; ++r)
#pragma unroll
            for (int c = 0; c < 8; ++c) { const float s = wave_sum(acc[r][c]); if (F.lane == r * 8 + c) mine = s; }
        gpre[(size_t)t0 * 8 + F.lane] = mine * rin[t0 + (F.lane >> 3)]; }
}
__device__ __forceinline__ void resid_pass(const Frame& F_in, const float* hin32, const bf16* y, const float* ssp, const float* g, bf16* hi, bf16* lo, float* rout) { PHASE_ENTRY(F);
    const int gw = F.bid * NWAVES + F.wave, NGW = F.G * NWAVES;
    for (int row = gw; row < S_; row += NGW) {
        const float ry = rsqrtf(wave_sum(ssp[(size_t)row * 64 + F.lane]) * (1.f / DM) + EPS_);
        const bf16* yr = y + (size_t)row * DM; bf16* hir = hi + (size_t)row * DM; bf16* lor = lo + (size_t)row * DM; float ss = 0.f;
#pragma unroll
        for (int jj = 0; jj < 8; ++jj) { const int c = (jj * 64 + F.lane) * 8; float hv[8];
            if (hin32) { const f32x4 a = *(const f32x4*)(hin32 + (size_t)row * DM + c), b = *(const f32x4*)(hin32 + (size_t)row * DM + c + 4); hv[0] = a[0]; hv[1] = a[1]; hv[2] = a[2]; hv[3] = a[3]; hv[4] = b[0]; hv[5] = b[1]; hv[6] = b[2]; hv[7] = b[3]; }
            else { const v4u h1 = *(const v4u*)(hir + c); v4u l1 = {0u, 0u, 0u, 0u}; if (RES_LO) l1 = *(const v4u*)(lor + c);
                hv[0] = bflo(h1.x) + bflo(l1.x); hv[1] = bfhi(h1.x) + bfhi(l1.x); hv[2] = bflo(h1.y) + bflo(l1.y); hv[3] = bfhi(h1.y) + bfhi(l1.y);
                hv[4] = bflo(h1.z) + bflo(l1.z); hv[5] = bfhi(h1.z) + bfhi(l1.z); hv[6] = bflo(h1.w) + bflo(l1.w); hv[7] = bfhi(h1.w) + bfhi(l1.w); }
            const v4u yv = *(const v4u*)(yr + c); const f32x4 ga = *(const f32x4*)(g + c), gb = *(const f32x4*)(g + c + 4);
            hv[0] += bflo(yv.x) * ry * ga[0]; hv[1] += bfhi(yv.x) * ry * ga[1]; hv[2] += bflo(yv.y) * ry * ga[2]; hv[3] += bfhi(yv.y) * ry * ga[3];
            hv[4] += bflo(yv.z) * ry * gb[0]; hv[5] += bfhi(yv.z) * ry * gb[1]; hv[6] += bflo(yv.w) * ry * gb[2]; hv[7] += bfhi(yv.w) * ry * gb[3];
#pragma unroll
            for (int q = 0; q < 8; ++q) ss += hv[q] * hv[q];
            v4u oh; oh.x = pk2(hv[0], hv[1]); oh.y = pk2(hv[2], hv[3]); oh.z = pk2(hv[4], hv[5]); oh.w = pk2(hv[6], hv[7]);
            v4u ol; ol.x = pk2(hv[0] - bflo(oh.x), hv[1] - bfhi(oh.x)); ol.y = pk2(hv[2] - bflo(oh.y), hv[3] - bfhi(oh.y)); ol.z = pk2(hv[4] - bflo(oh.z), hv[5] - bfhi(oh.z)); ol.w = pk2(hv[6] - bflo(oh.w), hv[7] - bfhi(oh.w));
            *(v4u*)(hir + c) = oh; if (RES_LO) *(v4u*)(lor + c) = ol; }
        const float tot = wave_sum(ss); if (F.lane == 0) rout[row] = rsqrtf(tot * (1.f / DM) + EPS_); }
}
__device__ __forceinline__ void rin_pass(const Frame& F_in, const float* ssp, float* rout) { PHASE_ENTRY(F);
    const int gw = F.bid * NWAVES + F.wave, NGW = F.G * NWAVES;
    for (int row = gw; row < S_; row += NGW) { const float tot = wave_sum(ssp[(size_t)row * 64 + F.lane]); if (F.lane == 0) rout[row] = rsqrtf(tot * (1.f / DM) + EPS_); }
}
__device__ __forceinline__ void pled_combine(const Frame& F_in, const bf16* part, const float* rin, bf16* g1) { PHASE_ENTRY(F);
    const int gt = F.bid * (NWAVES * 64) + F.tid, NGT = F.G * NWAVES * 64;
    for (int it = gt; it < S_ * PLED / 8; it += NGT) { const int row = it >> 5; const size_t o = (size_t)it * 8; const float r = rin[row];
        float a[8] = {0.f, 0.f, 0.f, 0.f, 0.f, 0.f, 0.f, 0.f};
#pragma unroll
        for (int w = 0; w < 4; ++w) { const v4u x = *(const v4u*)(part + (size_t)w * S_ * PLED + o);
            a[0] += bflo(x.x); a[1] += bfhi(x.x); a[2] += bflo(x.y); a[3] += bfhi(x.y); a[4] += bflo(x.z); a[5] += bfhi(x.z); a[6] += bflo(x.w); a[7] += bfhi(x.w); }
        v4u ov; ov.x = pk2(a[0] * r, a[1] * r); ov.y = pk2(a[2] * r, a[3] * r); ov.z = pk2(a[4] * r, a[5] * r); ov.w = pk2(a[6] * r, a[7] * r);
        *(v4u*)(g1 + o) = ov; }
}
__device__ __forceinline__ float gelu_tanh(float x) { const float u = 0.7978845608028654f * (x + 0.044715f * x * x * x); return x * __builtin_amdgcn_rcpf(1.f + __expf(-2.f * u)); }
__device__ __forceinline__ void convffn_pass(const Frame& F_in, const bf16* up, const float* wc, const float* bc, bf16* act) { PHASE_ENTRY(F);
    const int c0 = F.tid * 8;
    float wa[3][8], wb[3][8], ba[8], bb[8];
#pragma unroll
    for (int k = 0; k < 3; ++k)
#pragma unroll
        for (int e = 0; e < 8; ++e) { wa[k][e] = wc[(size_t)k * NUP + c0 + e]; wb[k][e] = wc[(size_t)k * NUP + 4096 + c0 + e]; }
#pragma unroll
    for (int e = 0; e < 8; ++e) { ba[e] = bc[c0 + e]; bb[e] = bc[4096 + c0 + e]; }
    for (int rb = F.bid; rb < S_ / 64; rb += F.G) { const int t0 = rb * 64;
        v4u a2 = (v4u){0u, 0u, 0u, 0u}, a1 = a2, b2 = a2, b1 = a2;
        if (t0 > 0) { a2 = *(const v4u*)(up + (size_t)(t0 - 2) * NUP + c0); b2 = *(const v4u*)(up + (size_t)(t0 - 2) * NUP + 4096 + c0);
                      a1 = *(const v4u*)(up + (size_t)(t0 - 1) * NUP + c0); b1 = *(const v4u*)(up + (size_t)(t0 - 1) * NUP + 4096 + c0); }
#pragma unroll 2
        for (int t = t0; t < t0 + 64; ++t) { const v4u a0 = *(const v4u*)(up + (size_t)t * NUP + c0), b0 = *(const v4u*)(up + (size_t)t * NUP + 4096 + c0);
            float o[8];
            const unsigned A2[4] = {a2.x, a2.y, a2.z, a2.w}, A1[4] = {a1.x, a1.y, a1.z, a1.w}, A0[4] = {a0.x, a0.y, a0.z, a0.w};
            const unsigned B2[4] = {b2.x, b2.y, b2.z, b2.w}, B1[4] = {b1.x, b1.y, b1.z, b1.w}, B0[4] = {b0.x, b0.y, b0.z, b0.w};
#pragma unroll
            for (int e = 0; e < 8; ++e) { const int q = e >> 1; const bool hi = e & 1;
                const float xa2 = hi ? bfhi(A2[q]) : bflo(A2[q]), xa1 = hi ? bfhi(A1[q]) : bflo(A1[q]), xa0 = hi ? bfhi(A0[q]) : bflo(A0[q]);
                const float xb2 = hi ? bfhi(B2[q]) : bflo(B2[q]), xb1 = hi ? bfhi(B1[q]) : bflo(B1[q]), xb0 = hi ? bfhi(B0[q]) : bflo(B0[q]);
                const float ya = ba[e] + wa[0][e] * xa2 + wa[1][e] * xa1 + wa[2][e] * xa0, yb = bb[e] + wb[0][e] * xb2 + wb[1][e] * xb1 + wb[2][e] * xb0;
                o[e] = gelu_tanh(ya) * yb; }
            v4u ov; ov.x = pk2(o[0], o[1]); ov.y = pk2(o[2], o[3]); ov.z = pk2(o[4], o[5]); ov.w = pk2(o[6], o[7]);
            *(v4u*)(act + (size_t)t * DM + c0) = ov;
            a2 = a1; a1 = a0; b2 = b1; b1 = b0; } }
}
__device__ __forceinline__ void diffcomb_pass(const Frame& F_in, const bf16* od, const float* g, const float* lamv, bf16* ymix) { PHASE_ENTRY(F);
    const int gw = F.bid * NWAVES + F.wave, NGW = F.G * NWAVES; const float lam = lamv[0], sc = 1.f - lamv[1];
    const f32x4 g4 = *(const f32x4*)(g + F.lane * 4);
    for (int it = gw; it < S_ * 4; it += NGW) { const int t = it >> 2, h = it & 3;
        const v2u a = *(const v2u*)(od + ((size_t)t * 8 + 2 * h) * 256 + F.lane * 4), b = *(const v2u*)(od + ((size_t)t * 8 + 2 * h + 1) * 256 + F.lane * 4);
        f32x4 d; d[0] = bflo(a.x) - lam * bflo(b.x); d[1] = bfhi(a.x) - lam * bfhi(b.x); d[2] = bflo(a.y) - lam * bflo(b.y); d[3] = bfhi(a.y) - lam * bfhi(b.y);
        const float r = rsqrtf(wave_sum((d[0] * d[0] + d[1] * d[1]) + (d[2] * d[2] + d[3] * d[3])) * (1.f / 256.f) + EPS_) * sc;
        v2u o; o.x = pk2(d[0] * r * g4[0], d[1] * r * g4[1]); o.y = pk2(d[2] * r * g4[2], d[3] * r * g4[3]);
        *(v2u*)(ymix + (size_t)t * NMIX + h * 256 + F.lane * 4) = o; }
}

constexpr int AT_KT = 16384, AT_NVS = 3;
constexpr float AT_C2 = 0.08838834764831845f * 1.4426950408889634f;
template <int MODE, int NV, int GRP, int ABL = 0>
__device__ __forceinline__ void attn_unit(LAS unsigned char* lds, int wave_in, const bf16* Qp, const bf16* Kp, const bf16* Vp, int ldp, int qb, bf16* Op, int ldo) {
    constexpr bool LAG = GRP != 0, grpB = GRP == 2;
    constexpr bool KSM = (MODE == 0 && NV == 2 && GRP == 1 && ABL == 0);
    constexpr int AT_KB = AT_NVS * (64 * (256 * NV + 64)), AT_KS = (NV == 2) ? 22528 : AT_KT;
    static_assert(NV != 2 || (AT_KB + AT_KT <= LDSCTL_OFF && AT_KB + AT_KS >= LDSCTL_OFF + 2048 && AT_KB + AT_KS + AT_KT <= LDS_BYTES), "LDS map");
    constexpr int AT_VSTR = 256 * NV + 64, AT_VT = 64 * AT_VSTR;
    const int lane_o = LANE_ID_ASM();
    const int wid = wave_in, lane = lane_o, tid = wid * 64 + lane, r32 = lane & 31, hi = lane >> 5;
    const int P0 = qb * 256, qrow = P0 + 32 * wid + r32, jd = (P0 + 32 * wid) >> 6, NT = 4 * qb + 4;
    bf16x8 qr[8];
#pragma unroll
    for (int s = 0; s < 8; ++s) qr[s] = *(const bf16x8*)(Qp + (size_t)qrow * ldp + 16 * s + 8 * hi);
    const unsigned ldsb = (unsigned)(uintptr_t)lds;
    const unsigned vrb = ldsb + (unsigned)((4 * hi + ((lane >> 2) & 3)) * AT_VSTR + (16 * ((lane >> 4) & 1) + 4 * (lane & 3)) * 2);
    constexpr int NPV = AT_VT / 1024, NPW = (NPV + 7) / 8, VCH = AT_VSTR / 16;
    unsigned kof[2], vof[NPW];
#pragma unroll
    for (int i = 0; i < 2; ++i) { const int rr = 4 * i + (lane >> 4); kof[i] = (unsigned)((8 * wid + rr) * ldp + (((lane & 15) ^ ((8 * wid + rr) & 15)) * 8)) * 2u; }
#pragma unroll
    for (int i = 0; i < NPW; ++i) { const int u = (wid + 8 * i) * 64 + lane, row = u / VCH, cc = u - row * VCH; vof[i] = (unsigned)(row * ldp) * 2u + (unsigned)((cc < 16 * NV ? cc : 0) * 16); }
#define AT_DMAK(j, sl) do { const char* g_ = (const char*)(Kp + (size_t)(j) * 64 * ldp); _Pragma("unroll") for (int i_ = 0; i_ < 2; ++i_) \
        __builtin_amdgcn_global_load_lds((const unsigned*)(g_ + kof[i_]), (LAS unsigned*)(lds + AT_KB + (sl) * AT_KS + (2 * wid + i_) * 1024), 16, 0, 0); } while (0)
#define AT_DMAV(j, sl) do { const char* g_ = (const char*)(Vp + (size_t)(j) * 64 * ldp); _Pragma("unroll") for (int i_ = 0; i_ < NPW; ++i_) if (wid + 8 * i_ < NPV) \
        __builtin_amdgcn_global_load_lds((const unsigned*)(g_ + vof[i_]), (LAS unsigned*)(lds + (sl) * AT_VT + (wid + 8 * i_) * 1024), 16, 0, 0); } while (0)
#define AT_JT(t) (MODE == 0 ? (t) : NT - 1 - (t))
    f32x16 o[4 * NV];
#pragma unroll
    for (int d = 0; d < 4 * NV; ++d)
#pragma unroll
        for (int r = 0; r < 16; ++r) o[d][r] = 0.f;
    float m_run = -1e30f, l_run = 0.f, carry = 1.f;
    volatile LAS float* cmx = (volatile LAS float*)(lds + LDSCTL_OFF + 1024);
    __syncthreads();
    AT_DMAK(AT_JT(0), 0); AT_DMAV(AT_JT(0), 0);
    VM_WAIT();
    __syncthreads();
#define AT_KRD(i) asm volatile("ds_read_b128 %0, %1 offset:%2" : "=&v"(kq[i]) : "v"(kb[(i) >> 1]), "i"(((i) & 1) * 32 * 256) : "memory")
#define AT_KWT(i, N) asm volatile("s_waitcnt lgkmcnt(" #N ")" : "+v"(kq[i]) :: "memory")
#define AT_KMM(i) do { if ((i) & 1) p1 = MFMA32(kq[i], qr[(i) >> 1], p1); else p0 = MFMA32(kq[i], qr[(i) >> 1], p0); __builtin_amdgcn_sched_barrier(0); } while (0)
#define AT_QK(bb) do { \
        unsigned kb[8];                             \
        { int rl = lane; asm volatile("" : "+v"(rl)); const int r32b = rl & 31, hib = rl >> 5; \
          _Pragma("unroll") for (int dd = 0; dd < 8; ++dd) kb[dd] = ldsb + (unsigned)(AT_KB + (bb) * AT_KS + KSWZ(r32b, (dd * 16 + hib * 8) * 2)); } \
        bf16x8 kq[16]; \
        AT_KRD(0); AT_KRD(1); AT_KRD(2); AT_KRD(3); AT_KRD(4); AT_KRD(5); \
        AT_KRD(6); AT_KWT(0, 6); AT_KMM(0); AT_KRD(7); AT_KWT(1, 6); AT_KMM(1); AT_KRD(8); AT_KWT(2, 6); AT_KMM(2); AT_KRD(9); AT_KWT(3, 6); AT_KMM(3); \
        AT_KRD(10); AT_KWT(4, 6); AT_KMM(4); AT_KRD(11); AT_KWT(5, 6); AT_KMM(5); AT_KRD(12); AT_KWT(6, 6); AT_KMM(6); AT_KRD(13); AT_KWT(7, 6); AT_KMM(7); \
        AT_KRD(14); AT_KWT(8, 6); AT_KMM(8); AT_KRD(15); AT_KWT(9, 6); AT_KMM(9); AT_KWT(10, 5); AT_KMM(10); AT_KWT(11, 4); AT_KMM(11); \
        AT_KWT(12, 3); AT_KMM(12); AT_KWT(13, 2); AT_KMM(13); AT_KWT(14, 1); AT_KMM(14); AT_KWT(15, 0); AT_KMM(15); } while (0)
#define AT_RD(d0, L0, H0, L1, H1, L2, H2, L3, H3) do { TRRD(L0, vb, 0 * 16 * AT_VSTR + (d0) * 64); TRRD(H0, vb, (0 * 16 + 8) * AT_VSTR + (d0) * 64); TRRD(L1, vb, 1 * 16 * AT_VSTR + (d0) * 64); TRRD(H1, vb, (1 * 16 + 8) * AT_VSTR + (d0) * 64); \
        TRRD(L2, vb, 2 * 16 * AT_VSTR + (d0) * 64); TRRD(H2, vb, (2 * 16 + 8) * AT_VSTR + (d0) * 64); TRRD(L3, vb, 3 * 16 * AT_VSTR + (d0) * 64); TRRD(H3, vb, (3 * 16 + 8) * AT_VSTR + (d0) * 64); } while (0)
#define AT_WT(N, L0, H0, L1, H1, L2, H2, L3, H3) asm volatile("s_waitcnt lgkmcnt(" #N ")" : "+v"(L0), "+v"(H0), "+v"(L1), "+v"(H1), "+v"(L2), "+v"(H2), "+v"(L3), "+v"(H3) :: "memory")
#define AT_MM(d0, L0, H0, L1, H1, L2, H2, L3, H3) do { o[d0] = MFMA32(mk8(L0, H0), pk[0], o[d0]); o[d0] = MFMA32(mk8(L1, H1), pk[1], o[d0]); o[d0] = MFMA32(mk8(L2, H2), pk[2], o[d0]); o[d0] = MFMA32(mk8(L3, H3), pk[3], o[d0]); } while (0)
#define AT_RDA(d0) AT_RD(d0, a0, a1, a2, a3, a4, a5, a6, a7)
#define AT_RDB(d0) AT_RD(d0, b0, b1, b2, b3, b4, b5, b6, b7)
#define AT_WTA(N) AT_WT(N, a0, a1, a2, a3, a4, a5, a6, a7)
#define AT_WTB(N) AT_WT(N, b0, b1, b2, b3, b4, b5, b6, b7)
#define AT_MMA(d0) AT_MM(d0, a0, a1, a2, a3, a4, a5, a6, a7)
#define AT_MMB(d0) AT_MM(d0, b0, b1, b2, b3, b4, b5, b6, b7)
#define AT_PV(slot) do { const unsigned vb = vrb + (unsigned)((slot) * AT_VT); s16x4 a0, a1, a2, a3, a4, a5, a6, a7, b0, b1, b2, b3, b4, b5, b6, b7; \
        if (NV == 2) {                   \
            AT_RDA(0); AT_RDB(1); \
            AT_WTA(8); AT_MMA(0); AT_RDA(2); \
            AT_WTB(8); AT_MMB(1); AT_RDB(3); \
            AT_WTA(8); AT_MMA(2); AT_RDA(4); \
            AT_WTB(8); AT_MMB(3); AT_RDB(5); \
            AT_WTA(8); AT_MMA(4); AT_RDA(6); \
            AT_WTB(8); AT_MMB(5); AT_RDB(4 * NV - 1); \
            AT_WTA(8); AT_MMA(6); \
            AT_WTB(0); AT_MMB(4 * NV - 1); \
        } else { \
            AT_RDA(0); AT_RDB(1); \
            AT_WTA(8); AT_MMA(0); AT_RDA(2); \
            AT_WTB(8); AT_MMB(1); AT_RDB(3); \
            AT_WTA(8); AT_MMA(2); \
            AT_WTB(0); AT_MMB(3); } } while (0)
#define AT_VR(n) do { TRRD(fl[n], vb, ((n) >> 3) * 16 * AT_VSTR + ((n) & 7) * 64); TRRD(fh[n], vb, (((n) >> 3) * 16 + 8) * AT_VSTR + ((n) & 7) * 64); } while (0)
#define AT_VW(n, N) asm volatile("s_waitcnt lgkmcnt(" #N ")" : "+v"(fl[n]), "+v"(fh[n]) :: "memory")
#define AT_VM(n) o[(n) & 7] = MFMA32(mk8(fl[n], fh[n]), pk[(n) >> 3], o[(n) & 7])
#define AT_VE(n) do { p1[n] = __builtin_amdgcn_exp2f(fmaf(p1[n], AT_C2, mb)); ps += p1[n]; } while (0)
#define AT_VPK() do { v4u w_; w_.x = pk2(p1[0], p1[1]); w_.y = pk2(p1[2], p1[3]); w_.z = pk2(p1[4], p1[5]); w_.w = pk2(p1[6], p1[7]); pk[2] = __builtin_bit_cast(bf16x8, w_); \
        w_.x = pk2(p1[8], p1[9]); w_.y = pk2(p1[10], p1[11]); w_.z = pk2(p1[12], p1[13]); w_.w = pk2(p1[14], p1[15]); pk[3] = __builtin_bit_cast(bf16x8, w_); } while (0)
#define AT_PVK(slot) do { const unsigned vb = vrb + (unsigned)((slot) * AT_VT); s16x4 fl[32], fh[32]; AT_VR(0); AT_VR(1); AT_VR(2); AT_VR(3); \
        AT_VR(4); AT_VW(0, 8); AT_VM(0); AT_VE(0); \
        AT_VR(5); AT_VW(1, 8); AT_VM(1); AT_VE(1); \
        AT_VR(6); AT_VW(2, 8); AT_VM(2); AT_VE(2); \
        AT_VR(7); AT_VW(3, 8); AT_VM(3); AT_VE(3); \
        AT_VR(8); AT_VW(4, 8); AT_VM(4); AT_VE(4); \
        AT_VR(9); AT_VW(5, 8); AT_VM(5); AT_VE(5); \
        AT_VR(10); AT_VW(6, 8); AT_VM(6); AT_VE(6); \
        AT_VR(11); AT_VW(7, 8); AT_VM(7); AT_VE(7); \
        AT_VR(12); AT_VW(8, 8); AT_VM(8); AT_VE(8); \
        AT_VR(13); AT_VW(9, 8); AT_VM(9); AT_VE(9); \
        AT_VR(14); AT_VW(10, 8); AT_VM(10); AT_VE(10); \
        AT_VR(15); AT_VW(11, 8); AT_VM(11); AT_VE(11); \
        AT_VR(16); AT_VW(12, 8); AT_VM(12); AT_VE(12); \
        AT_VR(17); AT_VW(13, 8); AT_VM(13); AT_VE(13); \
        AT_VR(18); AT_VW(14, 8); AT_VM(14); AT_VE(14); \
        AT_VR(19); AT_VW(15, 8); AT_VM(15); AT_VE(15); \
        AT_VPK(); \
        AT_VR(20); AT_VW(16, 8); AT_VM(16); \
        AT_VR(21); AT_VW(17, 8); AT_VM(17); \
        AT_VR(22); AT_VW(18, 8); AT_VM(18); \
        AT_VR(23); AT_VW(19, 8); AT_VM(19); \
        AT_VR(24); AT_VW(20, 8); AT_VM(20); \
        AT_VR(25); AT_VW(21, 8); AT_VM(21); \
        AT_VR(26); AT_VW(22, 8); AT_VM(22); \
        AT_VR(27); AT_VW(23, 8); AT_VM(23); \
        AT_VR(28); AT_VW(24, 8); AT_VM(24); \
        AT_VR(29); AT_VW(25, 8); AT_VM(25); \
        AT_VR(30); AT_VW(26, 8); AT_VM(26); \
        AT_VR(31); AT_VW(27, 8); AT_VM(27); \
        AT_VW(28, 6); AT_VM(28); \
        AT_VW(29, 4); AT_VM(29); \
        AT_VW(30, 2); AT_VM(30); \
        AT_VW(31, 0); AT_VM(31); } while (0)
    bf16x8 pk[4]; bool pend = false;
    int vp = 2, vc = 0, vn = 1;
    for (int t = 0; t < NT; ++t) {
        const int j = AT_JT(t), b = t & 1; const bool act = (j <= jd);
        const bool more = t + 1 < NT; const int jn = AT_JT(t + 1);
        if (more && !(ABL & 8)) { AT_DMAK(jn, b ^ 1); AT_DMAV(jn, vn); }
        if (LAG && grpB) { if (pend && !(ABL & 4)) AT_PV(vp); }
        if (act) {
            f32x16 p0, p1;
#pragma unroll
            for (int r = 0; r < 16; ++r) { p0[r] = 0.f; p1[r] = 0.f; }
            if (!(ABL & 1)) AT_QK(b);
            if (ABL & 1) asm volatile("" : "+v"(p0), "+v"(p1));
            if (ABL & 2) { } else if (MODE == 0) {
                float pm = p0[0];
#pragma unroll
                for (int r = 1; r < 16; ++r) pm = fmaxf(pm, p0[r]);
#pragma unroll
                for (int r = 0; r < 16; ++r) pm = fmaxf(pm, p1[r]);
                pm = swap_max(pm);
                if (!__all((pm - m_run) * AT_C2 <= 8.f)) { const float mn = fmaxf(m_run, pm), al = __builtin_amdgcn_exp2f((m_run - mn) * AT_C2); m_run = mn; l_run *= al;
#pragma unroll
                    for (int d = 0; d < 4 * NV; ++d)
#pragma unroll
                        for (int r = 0; r < 16; ++r) o[d][r] *= al; }
                const float mb = -m_run * AT_C2; float ps = 0.f;
                if (KSM) {
#pragma unroll
                    for (int r = 0; r < 16; ++r) { p0[r] = __builtin_amdgcn_exp2f(fmaf(p0[r], AT_C2, mb)); ps += p0[r]; }
                    { v4u w; w.x = pk2(p0[0], p0[1]); w.y = pk2(p0[2], p0[3]); w.z = pk2(p0[4], p0[5]); w.w = pk2(p0[6], p0[7]); pk[0] = __builtin_bit_cast(bf16x8, w);
                      w.x = pk2(p0[8], p0[9]); w.y = pk2(p0[10], p0[11]); w.z = pk2(p0[12], p0[13]); w.w = pk2(p0[14], p0[15]); pk[1] = __builtin_bit_cast(bf16x8, w); }
                    AT_PVK(vc);
                } else {
#pragma unroll
                    for (int r = 0; r < 16; ++r) { p0[r] = __builtin_amdgcn_exp2f(fmaf(p0[r], AT_C2, mb)); p1[r] = __builtin_amdgcn_exp2f(fmaf(p1[r], AT_C2, mb)); ps += p0[r] + p1[r]; }
                }
                l_run += swap_sum(ps);
            } else {
                float up[32];
#pragma unroll
                for (int r = 0; r < 16; ++r) { up[r] = __builtin_amdgcn_exp2f(fminf(p0[r] * AT_C2, 30.f)); up[16 + r] = __builtin_amdgcn_exp2f(fminf(p1[r] * AT_C2, 30.f)); }
                if (j == jd) { const int qrel = qrow - 64 * j;
#pragma unroll
                    for (int r = 0; r < 16; ++r) { if (crow(r, hi) >= qrel) up[r] = 0.f; if (32 + crow(r, hi) >= qrel) up[16 + r] = 0.f; } }
                float all[16], e1[8], e2[8], e3[8];
#pragma unroll
                for (int q = 0; q < 8; ++q) { e1[q] = 1.f + up[4 * q]; e2[q] = e1[q] * (1.f + up[4 * q + 1]); e3[q] = e2[q] * (1.f + up[4 * q + 2]);
                    const float gp = __builtin_amdgcn_rcpf(e3[q] * (1.f + up[4 * q + 3]));
                    auto rr = __builtin_amdgcn_permlane32_swap(__float_as_uint(gp), __float_as_uint(gp), false, false); all[2 * q] = __uint_as_float(rr[0]); all[2 * q + 1] = __uint_as_float(rr[1]); }
                float T[16]; T[15] = carry;
#pragma unroll
                for (int g = 14; g >= 0; --g) T[g] = T[g + 1] * all[g + 1];
                carry = T[0] * all[0];
#pragma unroll
                for (int q = 0; q < 8; ++q) { const float tg = T[2 * q + 1] * (hi ? all[2 * q + 1] : all[2 * q + 1] * all[2 * q]);
                    const float a0 = up[4 * q] * tg, a1 = up[4 * q + 1] * e1[q] * tg, a2 = up[4 * q + 2] * e2[q] * tg, a3 = up[4 * q + 3] * e3[q] * tg;
                    if (q < 4) { p0[4 * q] = a0; p0[4 * q + 1] = a1; p0[4 * q + 2] = a2; p0[4 * q + 3] = a3; } else { p1[4 * q - 16] = a0; p1[4 * q - 15] = a1; p1[4 * q - 14] = a2; p1[4 * q - 13] = a3; } }
            }
            if (!KSM) { v4u w;
              w.x = pk2(p0[0], p0[1]); w.y = pk2(p0[2], p0[3]); w.z = pk2(p0[4], p0[5]); w.w = pk2(p0[6], p0[7]); pk[0] = __builtin_bit_cast(bf16x8, w);
              w.x = pk2(p0[8], p0[9]); w.y = pk2(p0[10], p0[11]); w.z = pk2(p0[12], p0[13]); w.w = pk2(p0[14], p0[15]); pk[1] = __builtin_bit_cast(bf16x8, w);
              w.x = pk2(p1[0], p1[1]); w.y = pk2(p1[2], p1[3]); w.z = pk2(p1[4], p1[5]); w.w = pk2(p1[6], p1[7]); pk[2] = __builtin_bit_cast(bf16x8, w);
              w.x = pk2(p1[8], p1[9]); w.y = pk2(p1[10], p1[11]); w.z = pk2(p1[12], p1[13]); w.w = pk2(p1[14], p1[15]); pk[3] = __builtin_bit_cast(bf16x8, w); }
            if (!KSM && !(LAG && grpB) && !(ABL & 4)) AT_PV(vc);
        }
        if (LAG && grpB) pend = act;
        VM_WAIT();
        if (MODE == 1) { const float cm = wave_max(carry); if (lane == 0) cmx[(t & 1) * 8 + wid] = cm; }
        __syncthreads();
        if (MODE == 1) { float cm = cmx[(t & 1) * 8];
#pragma unroll
            for (int w = 1; w < 8; ++w) cm = fmaxf(cm, cmx[(t & 1) * 8 + w]);
            if (cm < 1.4901161e-8f) break; }
        vp = vc; vc = vn; vn = (vn == AT_NVS - 1) ? 0 : vn + 1;
    }
    if (LAG && grpB && pend && !(ABL & 4)) AT_PV(vp);
#undef AT_PV
#undef AT_PVK
#undef AT_VR
#undef AT_VW
#undef AT_VM
#undef AT_VE
#undef AT_VPK
#undef AT_QK
#undef AT_RDA
#undef AT_RDB
#undef AT_WTA
#undef AT_WTB
#undef AT_MMA
#undef AT_MMB
#undef AT_RD
#undef AT_WT
#undef AT_MM
    const float inv = (MODE == 0) ? __builtin_amdgcn_rcpf(l_run) : 1.f;
    const int lane_e = LANE_ID_ASM(), hi_e = lane_e >> 5;
    bf16* orow = Op + (size_t)(P0 + 32 * wid + (lane_e & 31)) * ldo;
#pragma unroll
    for (int d = 0; d < 4 * NV; ++d)
#pragma unroll
        for (int rg = 0; rg < 4; ++rg) { v2u w; w.x = pk2(o[d][4 * rg] * inv, o[d][4 * rg + 1] * inv); w.y = pk2(o[d][4 * rg + 2] * inv, o[d][4 * rg + 3] * inv);
            *(v2u*)(orow + 32 * d + 8 * rg + 4 * hi_e) = w; }
#undef AT_DMAK
#undef AT_DMAV
#undef AT_KRD
#undef AT_KWT
#undef AT_KMM
#undef AT_JT
}
template <int MODE, int ABL = 0>
__device__ __forceinline__ void attn_phase(const Frame& F_in, gu32* qhead, const bf16* proj, bf16* outp) { PHASE_ENTRY(F);
    volatile LAS unsigned* slot = (volatile LAS unsigned*)(F.lds + MISC_OFF + 64);
    constexpr int NU = 512;
    for (;;) {
        __syncthreads();
        if (F.tid == 0) *slot = __hip_atomic_fetch_add(qhead, 1u, RLX_AGENT);
        __syncthreads();
        const int u = (int)*slot;
        if (u >= NU) break;
        const int qb = 63 - (u >> 3), h = u & 7;
        if (MODE == 0)
            attn_unit<0, 2, 1, ABL>(F.lds, F.wave, proj + h * 128, proj + 1024 + h * 128, proj + 2048 + (h >> 1) * 256, NIN, qb, outp + h * 256, 2048);
        else
            attn_unit<1, 1, 0>(F.lds, F.wave, proj + 3072 + h * 128, proj + 4096 + h * 128, proj + 5120 + h * 128, NIN, qb, outp + 1024 + h * 128, NMIX);
    }
}

constexpr float LIN_SC = 0.08838834764831845f;
constexpr int LK_STR = 320, LV_STR = 576;
struct LinArgs {
    const bf16* proj; bf16* qkc; const float* gpre; const float* b_i; const float* b_f; const float* wconv; const float* bconv; const float* gnorm;
    float* chs; bf16* dC; bf16* CH;
    float* dn; float* nh; bf16* ymix;
};
__device__ __forceinline__ float wave_prefix_sum(float v, int lane, LAS float* scr) { scr[lane] = v; LDS_WAIT(); asm volatile("" ::: "memory"); float b = 0.f;
    for (int s = 0; s < 64; ++s) { const float x = scr[s]; b += (s <= lane) ? x : 0.f; } LDS_WAIT(); asm volatile("" ::: "memory"); return b; }
__device__ __forceinline__ float wave_prefix_max(float v, int lane, LAS float* scr) { scr[lane] = v; LDS_WAIT(); asm volatile("" ::: "memory"); float b = v;
    for (int s = 0; s < 64; ++s) { const float x = scr[s]; b = (s <= lane) ? fmaxf(b, x) : b; } LDS_WAIT(); asm volatile("" ::: "memory"); return b; }
template <bool ML>
__device__ __forceinline__ void lin_gates(const LinArgs& A, int t0, int h, int lane, LAS float* scr, float& li, float& b) {
    if (ML) { const float f = A.gpre[(size_t)(t0 + lane) * 8 + 4 + h] + A.b_f[h]; li = A.gpre[(size_t)(t0 + lane) * 8 + h] + A.b_i[h];
        const float lf = fminf(f, 0.f) - __logf(1.f + __expf(-fabsf(f))); b = wave_prefix_sum(lf, lane, scr);
    } else { const float lg = (h == 0) ? -0.0317486983145803f : (h == 1) ? -0.015748356968139168f : (h == 2) ? -0.007843177461025893f : -0.003913899321136329f;   li = 0.f; b = (float)(lane + 1) * lg; }
}
template <bool ML>
__device__ __forceinline__ void lin_local(const Frame& F_in, const LinArgs& A) { PHASE_ENTRY(F);
    LAS unsigned char* lds = F.lds; const int tid = F.tid, lane = F.lane, wid = F.wave, hi = lane >> 5;
    LAS unsigned char* Kt = lds; LAS unsigned char* Vt = lds + 64 * LK_STR; LAS float* wks = (LAS float*)(lds + 64 * LK_STR + 64 * LV_STR);
    const int sr = tid >> 4, sc = (tid & 15) * 8;
    for (int u = F.bid; u < NCH * 4; u += F.G) { const int c = u >> 2, h = u & 3, t0 = c * 64;
        __syncthreads();
        if (wid == 0) { float li, b; lin_gates<ML>(A, t0, h, lane, wks, li, b); wks[lane] = b; LDS_WAIT(); asm volatile("" ::: "memory"); const float bl = wks[63]; LDS_WAIT(); asm volatile("" ::: "memory"); const float g = bl - b + li; const float a = ML ? wave_max(g) : 0.f;
            wks[lane] = __expf(g - a) * LIN_SC; if (lane == 0) { A.chs[c * 4 + h] = bl; A.chs[NCH * 4 + c * 4 + h] = a; } }
        __syncthreads();
#pragma unroll
        for (int rr = 0; rr < 2; ++rr) { const int s = sr + 32 * rr, t = t0 + s; const float wk = wks[s];
            if (ML) {
#pragma unroll
                for (int X = 0; X < 2; ++X) { const int ch = X * 512 + 128 * h + sc; float y[8];
#pragma unroll
                    for (int e = 0; e < 8; ++e) y[e] = A.bconv[ch + e];
#pragma unroll
                    for (int tap = 0; tap < 4; ++tap) { const int tt = t - 3 + tap; v4u x = (v4u){0u, 0u, 0u, 0u}; if (tt >= 0) x = *(const v4u*)(A.proj + (size_t)tt * NIN + 3072 + ch);
                        const f32x4 w0 = *(const f32x4*)(A.wconv + (size_t)tap * 1024 + ch), w1 = *(const f32x4*)(A.wconv + (size_t)tap * 1024 + ch + 4);
                        y[0] += w0[0] * bflo(x.x); y[1] += w0[1] * bfhi(x.x); y[2] += w0[2] * bflo(x.y); y[3] += w0[3] * bfhi(x.y);
                        y[4] += w1[0] * bflo(x.z); y[5] += w1[1] * bfhi(x.z); y[6] += w1[2] * bflo(x.w); y[7] += w1[3] * bfhi(x.w); }
#pragma unroll
                    for (int e = 0; e < 8; ++e) y[e] = y[e] * __builtin_amdgcn_rcpf(1.f + __expf(-y[e]));
                    v4u o; o.x = pk2(y[0], y[1]); o.y = pk2(y[2], y[3]); o.z = pk2(y[4], y[5]); o.w = pk2(y[6], y[7]);
                    *(v4u*)(A.qkc + (size_t)t * 1024 + ch) = o;
                    if (X == 1) { v4u k; k.x = pk2(y[0] * wk, y[1] * wk); k.y = pk2(y[2] * wk, y[3] * wk); k.z = pk2(y[4] * wk, y[5] * wk); k.w = pk2(y[6] * wk, y[7] * wk);
                        *(LAS v4u*)(Kt + s * LK_STR + sc * 2) = k; } }
            } else { const v4u x = *(const v4u*)(A.proj + (size_t)t * NIN + 512 + 128 * h + sc);
                v4u k; k.x = pk2(bflo(x.x) * wk, bfhi(x.x) * wk); k.y = pk2(bflo(x.y) * wk, bfhi(x.y) * wk); k.z = pk2(bflo(x.z) * wk, bfhi(x.z) * wk); k.w = pk2(bflo(x.w) * wk, bfhi(x.w) * wk);
                *(LAS v4u*)(Kt + s * LK_STR + sc * 2) = k; }
            const bf16* vp = A.proj + (size_t)t * NIN + (ML ? 4096 : 1024) + 256 * h + sc;
            *(LAS v4u*)(Vt + s * LV_STR + sc * 2) = *(const v4u*)vp; *(LAS v4u*)(Vt + s * LV_STR + (128 + sc) * 2) = *(const v4u*)(vp + 128); }
        __syncthreads();
        const unsigned rowb = (unsigned)(8 * hi + ((lane >> 2) & 3)), colb = (unsigned)(16 * ((lane >> 4) & 1) + 4 * (lane & 3));
        const unsigned vb = (unsigned)(uintptr_t)Vt + rowb * LV_STR + (32 * wid + colb) * 2, kbs = (unsigned)(uintptr_t)Kt + rowb * LK_STR + colb * 2;
        bf16x8 av[4];
#define L1_A(ks) do { s16x4 l_, h_; TRRD(l_, vb, (ks) * 16 * LV_STR); TRRD(h_, vb, ((ks) * 16 + 4) * LV_STR); asm volatile("s_waitcnt lgkmcnt(0)" : "+v"(l_), "+v"(h_) :: "memory"); av[ks] = mk8(l_, h_); } while (0)
        L1_A(0); L1_A(1); L1_A(2); L1_A(3);
#undef L1_A
        f32x16 acc[4];
#pragma unroll
        for (int d = 0; d < 4; ++d)
#pragma unroll
            for (int r = 0; r < 16; ++r) acc[d][r] = 0.f;
#define L1_B(d0, ks) do { s16x4 l_, h_; TRRD(l_, kbs, (ks) * 16 * LK_STR + (d0) * 64); TRRD(h_, kbs, ((ks) * 16 + 4) * LK_STR + (d0) * 64); asm volatile("s_waitcnt lgkmcnt(0)" : "+v"(l_), "+v"(h_) :: "memory"); \
            acc[d0] = MFMA32(av[ks], mk8(l_, h_), acc[d0]); } while (0)
#define L1_BD(d0) do { L1_B(d0, 0); L1_B(d0, 1); L1_B(d0, 2); L1_B(d0, 3); } while (0)
        L1_BD(0); L1_BD(1); L1_BD(2); L1_BD(3);
#undef L1_BD
#undef L1_B
        bf16* dcp = A.dC + ((size_t)(c * 4 + h) * 128) * 256;
#pragma unroll
        for (int d0 = 0; d0 < 4; ++d0)
#pragma unroll
            for (int rg = 0; rg < 4; ++rg) { v2u w; w.x = pk2(acc[d0][4 * rg], acc[d0][4 * rg + 1]); w.y = pk2(acc[d0][4 * rg + 2], acc[d0][4 * rg + 3]); *(v2u*)(dcp + (size_t)(32 * d0 + (lane & 31)) * 256 + 32 * wid + 8 * rg + 4 * hi) = w; }
        if (ML && tid < 128) { float s = 0.f;
#pragma unroll 8
            for (int q = 0; q < 64; ++q) s += h2f(*(const LAS unsigned short*)(Kt + q * LK_STR + tid * 2));
            A.dn[(size_t)(c * 4 + h) * 128 + tid] = s; }
    }
}
template <bool ML>
__device__ __forceinline__ void lin_scan(const Frame& F_in, const LinArgs& A) { PHASE_ENTRY(F);
    LAS float* decs = (LAS float*)F.lds; LAS float* inws = decs + NCH; LAS float* bls = decs + 2 * NCH; LAS float* acs = decs + 3 * NCH; LAS float* mss = decs + 4 * NCH;
    for (int blk = F.bid; blk < 256; blk += F.G) { const int h = blk >> 6, idx = (blk & 63) * 512 + F.tid; const bool lead = (blk & 63) == 0;
        __syncthreads();
        if (F.tid < NCH) { bls[F.tid] = A.chs[F.tid * 4 + h]; acs[F.tid] = A.chs[NCH * 4 + F.tid * 4 + h]; }
        __syncthreads();
        if (F.tid == 0) { float m = 0.f;
            for (int c0 = 0; c0 < NCH; c0 += 8) { float bl[8], aa[8];
#pragma unroll
                for (int i = 0; i < 8; ++i) { bl[i] = bls[c0 + i]; aa[i] = acs[c0 + i]; }
#pragma unroll
                for (int i = 0; i < 8; ++i) { mss[c0 + i] = m; m = fmaxf(bl[i] + m, aa[i]); } }
            mss[NCH] = m; }
        __syncthreads();
        if (F.tid < NCH) { const float m = mss[F.tid], mn = mss[F.tid + 1], bl = bls[F.tid], a = acs[F.tid]; decs[F.tid] = __expf(bl + m - mn); inws[F.tid] = __expf(a - mn); }
        __syncthreads();
        if (lead && F.tid < NCH) A.chs[2 * NCH * 4 + F.tid * 4 + h] = mss[F.tid];
        float C = 0.f;
        for (int c0 = 0; c0 < NCH; c0 += 32) { bf16 x[32];
#pragma unroll
            for (int u = 0; u < 32; ++u) x[u] = A.dC[(size_t)((c0 + u) * 4 + h) * 32768 + idx];
#pragma unroll
            for (int u = 0; u < 32; ++u) { const int c = c0 + u; A.CH[(size_t)(c * 4 + h) * 32768 + idx] = (bf16)f2bf(C); C = decs[c] * C + inws[c] * h2f(x[u]); } }
        if (ML && lead && F.tid < 128) { float n = 0.f;
            for (int c0 = 0; c0 < NCH; c0 += 32) { float x[32];
#pragma unroll
                for (int u = 0; u < 32; ++u) x[u] = A.dn[(size_t)((c0 + u) * 4 + h) * 128 + F.tid];
#pragma unroll
                for (int u = 0; u < 32; ++u) { const int c = c0 + u; A.nh[(size_t)(c * 4 + h) * 128 + F.tid] = n; n = decs[c] * n + inws[c] * x[u]; } } }
    }
}
template <bool ML>
__device__ __forceinline__ void lin_out(const Frame& F_in, const LinArgs& A) { PHASE_ENTRY(F);
    LAS unsigned char* lds = F.lds; const int tid = F.tid, lane = F.lane, wid = F.wave, r32 = lane & 31, hi = lane >> 5;
    LAS unsigned char* Kt = lds; LAS unsigned char* Vt = lds + 16384; LAS unsigned char* Ct = lds + 16384 + 64 * LV_STR;
    LAS float* vs = (LAS float*)(lds + 126976); LAS float* Mt = vs + 64; LAS float* Bt = vs + 128; LAS float* nhs = vs + 192; LAS float* ssq = vs + 320;
    const int sr = tid >> 4, sc = (tid & 15) * 8, tb = wid & 1, eq = wid >> 1, tl = 32 * tb + r32;
    for (int u = F.bid; u < NCH * 4; u += F.G) { const int c = u >> 2, h = u & 3, t0 = c * 64;
        const float mc = ML ? A.chs[2 * NCH * 4 + c * 4 + h] : 0.f;
        __syncthreads();
        const bf16* kp = ML ? A.qkc + (size_t)t0 * 1024 + 512 + 128 * h : A.proj + (size_t)t0 * NIN + 512 + 128 * h; const int kld = ML ? 1024 : NIN;
        v4u tk[2], tv[2][2], tc[8];
#pragma unroll
        for (int rr = 0; rr < 2; ++rr) { const int s = sr + 32 * rr;
            tk[rr] = *(const v4u*)(kp + (size_t)s * kld + sc);
            const bf16* vp = A.proj + (size_t)(t0 + s) * NIN + (ML ? 4096 : 1024) + 256 * h + sc;
            tv[rr][0] = *(const v4u*)vp; tv[rr][1] = *(const v4u*)(vp + 128); }
        const bf16* chp = A.CH + (size_t)(c * 4 + h) * 32768;
#pragma unroll
        for (int i = 0; i < 8; ++i) { const int ck = tid + 512 * i, d = ck >> 5, e0 = (ck & 31) * 8; tc[i] = *(const v4u*)(chp + (size_t)d * 256 + e0); }
        const bf16* qp = (ML ? A.qkc + (size_t)(t0 + tl) * 1024 + 128 * h : A.proj + (size_t)(t0 + tl) * NIN + 128 * h) + 8 * hi;
        bf16x8 qr[8];
#pragma unroll
        for (int s = 0; s < 8; ++s) qr[s] = *(const bf16x8*)(qp + 16 * s);
        asm volatile("" ::: "memory");
        if (wid == 0) { float li, b; lin_gates<ML>(A, t0, h, lane, ssq, li, b); const float v = li - b, uu = wave_prefix_max(v, lane, ssq); vs[lane] = v; Mt[lane] = fmaxf(mc, uu); Bt[lane] = b; }
        if (ML && wid >= 2 && wid < 4) nhs[tid - 128] = A.nh[(size_t)(c * 4 + h) * 128 + tid - 128];
#pragma unroll
        for (int rr = 0; rr < 2; ++rr) { const int s = sr + 32 * rr;
            *(LAS v4u*)(Kt + KSWZ(s, sc * 2)) = tk[rr];
            *(LAS v4u*)(Vt + s * LV_STR + sc * 2) = tv[rr][0]; *(LAS v4u*)(Vt + s * LV_STR + (128 + sc) * 2) = tv[rr][1]; }
#pragma unroll
        for (int i = 0; i < 8; ++i) { const int ck = tid + 512 * i, d = ck >> 5, e0 = (ck & 31) * 8; *(LAS v4u*)(Ct + d * LV_STR + e0 * 2) = tc[i]; }
        __syncthreads();
        const float Mme = Mt[tl], bme = Bt[tl], wint = __expf(mc - Mme);
        f32x16 p[2]; float nq = 0.f;
#pragma unroll
        for (int sb = 0; sb < 2; ++sb) {
#pragma unroll
            for (int r = 0; r < 16; ++r) p[sb][r] = 0.f;
            if (sb <= tb) {
#pragma unroll
                for (int d0 = 0; d0 < 8; ++d0) { const bf16x8 kf = *(const LAS bf16x8*)(Kt + KSWZ(32 * sb + r32, (16 * d0 + 8 * hi) * 2)); p[sb] = MFMA32(kf, qr[d0], p[sb]); }
#pragma unroll
                for (int r = 0; r < 16; ++r) { const int s = 32 * sb + crow(r, hi); const float w = (s <= tl) ? __expf(vs[s] - Mme) * LIN_SC : 0.f; p[sb][r] *= w; nq += p[sb][r]; }
            }
        }
        bf16x8 pk[4];
        { v4u w;
          w.x = pk2(p[0][0], p[0][1]); w.y = pk2(p[0][2], p[0][3]); w.z = pk2(p[0][4], p[0][5]); w.w = pk2(p[0][6], p[0][7]); pk[0] = __builtin_bit_cast(bf16x8, w);
          w.x = pk2(p[0][8], p[0][9]); w.y = pk2(p[0][10], p[0][11]); w.z = pk2(p[0][12], p[0][13]); w.w = pk2(p[0][14], p[0][15]); pk[1] = __builtin_bit_cast(bf16x8, w);
          w.x = pk2(p[1][0], p[1][1]); w.y = pk2(p[1][2], p[1][3]); w.z = pk2(p[1][4], p[1][5]); w.w = pk2(p[1][6], p[1][7]); pk[2] = __builtin_bit_cast(bf16x8, w);
          w.x = pk2(p[1][8], p[1][9]); w.y = pk2(p[1][10], p[1][11]); w.z = pk2(p[1][12], p[1][13]); w.w = pk2(p[1][14], p[1][15]); pk[3] = __builtin_bit_cast(bf16x8, w); }
        bf16x8 qw[8]; float qn = 0.f;
#pragma unroll
        for (int s = 0; s < 8; ++s) { const v4u x = __builtin_bit_cast(v4u, qr[s]); float f[8] = {bflo(x.x), bfhi(x.x), bflo(x.y), bfhi(x.y), bflo(x.z), bfhi(x.z), bflo(x.w), bfhi(x.w)};
            if (ML) {
#pragma unroll
                for (int e = 0; e < 8; ++e) qn += f[e] * nhs[16 * s + 8 * hi + e]; }
#pragma unroll
            for (int e = 0; e < 8; ++e) f[e] *= wint;
            qw[s] = pack8f(f); }
        nq = swap_sum(nq) + wint * swap_sum(qn);
        const unsigned q4 = (unsigned)((lane >> 2) & 3), colb = (unsigned)(16 * ((lane >> 4) & 1) + 4 * (lane & 3));
        const unsigned vb = (unsigned)(uintptr_t)Vt + (4 * hi + q4) * LV_STR + (64 * eq + colb) * 2;
        const unsigned cb0 = (unsigned)(uintptr_t)Ct + (8 * hi + q4) * LV_STR + (64 * eq + colb) * 2, cb1 = cb0 + 64 * LV_STR;
        f32x16 acc[2];
#pragma unroll
        for (int eb = 0; eb < 2; ++eb)
#pragma unroll
            for (int r = 0; r < 16; ++r) acc[eb][r] = 0.f;
        const bf16* gp = A.proj + (size_t)(t0 + tl) * NIN + (ML ? 5120 : 2048) + 256 * h;
        v2u gwv[2][4];
#pragma unroll
        for (int eb = 0; eb < 2; ++eb)
#pragma unroll
            for (int rg = 0; rg < 4; ++rg) { const int e = 64 * eq + 32 * eb + 8 * rg + 4 * hi; gwv[eb][rg] = *(const v2u*)(gp + e); }
#define L3_RV(i, eb, ks) do { TRRD(fl_[i], vb, (ks) * 16 * LV_STR + (eb) * 64); TRRD(fh_[i], vb, ((ks) * 16 + 8) * LV_STR + (eb) * 64); } while (0)
#define L3_RC(i, eb, base, so) do { TRRD(fl_[i], base, (so) * 16 * LV_STR + (eb) * 64); TRRD(fh_[i], base, ((so) * 16 + 4) * LV_STR + (eb) * 64); } while (0)
#define L3_W4() asm volatile("s_waitcnt lgkmcnt(0)" : "+v"(fl_[0]), "+v"(fh_[0]), "+v"(fl_[1]), "+v"(fh_[1]), "+v"(fl_[2]), "+v"(fh_[2]), "+v"(fl_[3]), "+v"(fh_[3]) :: "memory")
#define L3_W2() asm volatile("s_waitcnt lgkmcnt(0)" : "+v"(fl_[0]), "+v"(fh_[0]), "+v"(fl_[1]), "+v"(fh_[1]) :: "memory")
#define L3_E(eb) do { s16x4 fl_[4], fh_[4]; \
            if (tb) { L3_RV(0, eb, 0); L3_RV(1, eb, 1); L3_RV(2, eb, 2); L3_RV(3, eb, 3); L3_W4(); \
                acc[eb] = MFMA32(mk8(fl_[0], fh_[0]), pk[0], acc[eb]); acc[eb] = MFMA32(mk8(fl_[1], fh_[1]), pk[1], acc[eb]); acc[eb] = MFMA32(mk8(fl_[2], fh_[2]), pk[2], acc[eb]); acc[eb] = MFMA32(mk8(fl_[3], fh_[3]), pk[3], acc[eb]); } \
            else { L3_RV(0, eb, 0); L3_RV(1, eb, 1); L3_W2(); acc[eb] = MFMA32(mk8(fl_[0], fh_[0]), pk[0], acc[eb]); acc[eb] = MFMA32(mk8(fl_[1], fh_[1]), pk[1], acc[eb]); } \
            L3_RC(0, eb, cb0, 0); L3_RC(1, eb, cb0, 1); L3_RC(2, eb, cb0, 2); L3_RC(3, eb, cb0, 3); L3_W4(); \
            acc[eb] = MFMA32(mk8(fl_[0], fh_[0]), qw[0], acc[eb]); acc[eb] = MFMA32(mk8(fl_[1], fh_[1]), qw[1], acc[eb]); acc[eb] = MFMA32(mk8(fl_[2], fh_[2]), qw[2], acc[eb]); acc[eb] = MFMA32(mk8(fl_[3], fh_[3]), qw[3], acc[eb]); \
            L3_RC(0, eb, cb1, 0); L3_RC(1, eb, cb1, 1); L3_RC(2, eb, cb1, 2); L3_RC(3, eb, cb1, 3); L3_W4(); \
            acc[eb] = MFMA32(mk8(fl_[0], fh_[0]), qw[4], acc[eb]); acc[eb] = MFMA32(mk8(fl_[1], fh_[1]), qw[5], acc[eb]); acc[eb] = MFMA32(mk8(fl_[2], fh_[2]), qw[6], acc[eb]); acc[eb] = MFMA32(mk8(fl_[3], fh_[3]), qw[7], acc[eb]); } while (0)
        L3_E(0); L3_E(1);
#undef L3_RV
#undef L3_RC
#undef L3_W4
#undef L3_W2
#undef L3_E
        float dinv = 1.f;
        if (ML) dinv = __builtin_amdgcn_rcpf(fmaxf(fabsf(nq), __expf(-(bme + Mme))));
        float ss = 0.f;
#pragma unroll
        for (int eb = 0; eb < 2; ++eb)
#pragma unroll
            for (int r = 0; r < 16; ++r) { acc[eb][r] *= dinv; ss += acc[eb][r] * acc[eb][r]; }
        ss = swap_sum(ss);
        if (hi == 0) ssq[eq * 64 + tl] = ss;
        __syncthreads();
        const float rn = rsqrtf(((ssq[tl] + ssq[64 + tl]) + (ssq[128 + tl] + ssq[192 + tl])) * (1.f / 256.f) + EPS_);
        bf16* yp = A.ymix + (size_t)(t0 + tl) * NMIX + (ML ? 1024 : 0) + 256 * h;
#pragma unroll
        for (int eb = 0; eb < 2; ++eb)
#pragma unroll
            for (int rg = 0; rg < 4; ++rg) { const int e = 64 * eq + 32 * eb + 8 * rg + 4 * hi; const v2u gw = gwv[eb][rg]; const f32x4 gn = *(const f32x4*)(A.gnorm + e);
                float gt[4] = {bflo(gw.x), bfhi(gw.x), bflo(gw.y), bfhi(gw.y)}, o[4];
#pragma unroll
                for (int k = 0; k < 4; ++k) { const float sg = __builtin_amdgcn_rcpf(1.f + __expf(-gt[k])); const float gate = ML ? sg : gt[k] * sg; o[k] = acc[eb][4 * rg + k] * rn * gn[k] * gate; }
                v2u w; w.x = pk2(o[0], o[1]); w.y = pk2(o[2], o[3]); *(v2u*)(yp + e) = w; }
    }
}

#ifndef MK_SPLIT
#define MK_SPLIT 0
#endif
constexpr int PH_PER_LAYER = 16, N_PHASES = 1 + PH_PER_LAYER * DEPTH_;
__global__ void __launch_bounds__(NWAVES * 64, 2) fwd_kernel(Params P) {
    extern __shared__ __attribute__((aligned(16))) unsigned char lds_raw[];
    Frame F0; F0.lds = (LAS unsigned char*)lds_raw; F0.tid = threadIdx.x; F0.lane = F0.tid & 63; F0.wave = __builtin_amdgcn_readfirstlane(F0.tid >> 6); F0.G = gridDim.x; F0.bid = blockIdx.x;
    volatile LAS unsigned* MISC = (volatile LAS unsigned*)(F0.lds + MISC_OFF);
    for (int u = F0.tid; u < (LDS_BYTES - LDSCTL_OFF) / 4; u += NWAVES * 64) ((LAS unsigned*)(F0.lds + LDSCTL_OFF))[u] = 0u;
    __syncthreads();
    gu32* ctl = (gu32*)(P.ws + WS_CTL);
    XcdBarrier bar; bar.bar = (unsigned*)ctl + CW_BAR; bar.x = 0; bar.st = nullptr;
    if (!MK_SPLIT) bar = xcd_barrier_post((unsigned*)ctl + CW_BAR, MISC + 8);
    const int lo = P.ph_lo, hi = P.ph_hi;
#ifndef PHMASK
#define PHMASK 0xffffffffu
#endif
#ifndef DUPMASK
#define DUPMASK (0u)
#endif
#define DUPN(n) for (int rep_ = 0; rep_ < (((DUPMASK >> (n)) & 1u) ? 2 : 1); ++rep_)
#define IN(k) (lo <= (k) && (k) < hi)
#define INM(k, n) (((PHMASK >> (n)) & 1u) && IN(k))
#ifndef DBG_TIME
#define DBG_TIME 0
#endif
#if DBG_TIME
#define SEAM(k) do { if (!MK_SPLIT && lo <= (k) && (k) + 1 < hi) xcd_barrier(bar); if (F0.bid == 0 && F0.tid == 0) ((unsigned long long*)(P.ws + 768 * 1024))[(k) + 1] = wall_clock64(); } while (0)
#else
#define SEAM(k) do { if (!MK_SPLIT && lo <= (k) && (k) + 1 < hi) xcd_barrier(bar); } while (0)
#endif
#define PHASE_PTRS() KParams Pk = (KParams)__builtin_amdgcn_kernarg_segment_ptr(); Frame F = F0; asm volatile("; PHASE_PTRS" : "+s"(Pk), "+s"(F.G), "+s"(F.bid), "+s"(F.wave)); unsigned char* ws = Pk->ws; float* out = Pk->out; \
    bf16* hb = (bf16*)(ws + WS_HB); bf16* proj = (bf16*)(ws + WS_PROJ); bf16* ymix = (bf16*)(ws + WS_YMIX); bf16* mixo = (bf16*)(ws + WS_MIXO); bf16* upb = (bf16*)(ws + WS_UP); \
    bf16* act = (bf16*)(ws + WS_ACT); bf16* od = (bf16*)(ws + WS_OD); bf16* g1 = (bf16*)(ws + WS_G1); bf16* qkc = (bf16*)(ws + WS_QKC); \
    float* rin = (float*)(ws + WS_RIN); float* ssp = (float*)(ws + WS_SSP); float* gpre = (float*)(ws + WS_GPRE); \
    const float* cst = (const float*)(ws + WS_COS); const float* snt = (const float*)(ws + WS_SIN); \
    (void)out; (void)hb; (void)proj; (void)ymix; (void)mixo; (void)upb; (void)act; (void)od; (void)g1; (void)qkc; (void)rin; (void)ssp; (void)gpre; (void)cst; (void)snt
#define LIN_ARGS() LinArgs LA; LA.proj = proj; LA.qkc = qkc; LA.gpre = gpre; LA.b_i = Pk->in[I_BIG] + j * 4; LA.b_f = Pk->in[I_BFG] + j * 4; LA.wconv = Pk->in[I_WCQK] + (size_t)j * 4096; LA.bconv = Pk->in[I_BCQK] + (size_t)j * 1024; \
    LA.gnorm = ev ? Pk->in[I_GML] + j * 256 : Pk->in[I_GRET] + j * 256; LA.chs = (float*)(ws + WS_CHS); LA.dC = (bf16*)(ws + WS_DC); LA.CH = (bf16*)(ws + WS_CH); LA.dn = (float*)(ws + WS_DN); LA.nh = (float*)(ws + WS_NH); LA.ymix = ymix

#if DBG_TIME
    if (F0.bid == 0 && F0.tid == 0) ((unsigned long long*)(P.ws + 768 * 1024))[0] = wall_clock64();
#endif
    if (INM(0, 31)) DUPN(31) { PHASE_PTRS(); p0_prologue(F, Pk); }
    SEAM(0);
#pragma unroll 1
    for (int L = 0; L < DEPTH_; ++L) {
        const int pbase = 1 + PH_PER_LAYER * L, j = L >> 1; const bool ev = (L & 1) == 0;
        if (INM(pbase + 0, 0)) DUPN(0) { PHASE_PTRS();
            if (ev) gates_pass(F, hb, (const bf16*)(ws + WS_WG) + (size_t)j * 8 * DM, rin, gpre);
            pg8::Gemm g{hb, (const bf16*)(ws + WS_WIN) + (size_t)L * NIN * DM, S_, NIN, DM, 0, 0}; pg8::StaticOrder S; S.init(S_, NIN, F.G, F.bid);
            pg8::EpiProj E{proj, NIN, rin, cst, snt, ev ? 8 : 4};
            pg8::gemm_phase<pg8::EpiProj, pg8::StaticOrder, true, true>(F.lds, g, S, E, F.wave);
        }
        SEAM(pbase + 0);
        if (INM(pbase + 1, 1)) DUPN(1) { PHASE_PTRS(); LIN_ARGS(); if (ev) lin_local<true>(F, LA); else lin_local<false>(F, LA); }
        SEAM(pbase + 1);
        if (INM(pbase + 2, 2)) DUPN(2) { PHASE_PTRS(); LIN_ARGS(); if (ev) lin_scan<true>(F, LA); else lin_scan<false>(F, LA); }
        SEAM(pbase + 2);
        if (INM(pbase + 3, 3)) DUPN(3) { PHASE_PTRS(); LIN_ARGS();
#ifndef P3MASK
#define P3MASK 15
#endif
#ifndef P3ABL
#define P3ABL 0
#endif
#ifndef P3DUP
#define P3DUP 15
#endif
            const int p3m = rep_ ? (P3MASK & P3DUP) : P3MASK;
            if (ev) { if (p3m & 1) lin_out<true>(F, LA); if (p3m & 2) { if (rep_) attn_phase<0, P3ABL>(F, ctl + CW_Q + 64 * (L + 4 * rep_), proj, (bf16*)(ws + WS_UP)); else attn_phase<0>(F, ctl + CW_Q + 64 * (L + 4 * rep_), proj, od); } }
            else { if (p3m & 4) lin_out<false>(F, LA); if (p3m & 8) attn_phase<1>(F, ctl + CW_Q + 64 * (L + 4 * rep_), proj, ymix); }
        }
        SEAM(pbase + 3);
        if (ev) { if (INM(pbase + 4, 4)) DUPN(4) { PHASE_PTRS(); diffcomb_pass(F, od, Pk->in[I_GDIFF] + j * 256, (const float*)(ws + WS_LAM) + 2 * j, ymix); } SEAM(pbase + 4); }
        if (INM(pbase + 5, 5)) DUPN(5) { PHASE_PTRS();
            pg8::Gemm g{ymix, (const bf16*)(ws + WS_WOUT) + (size_t)L * DM * NMIX, S_, DM, NMIX, 0, 0}; pg8::StaticOrder S; S.init(S_, DM, F.G, F.bid);
            pg8::EpiY E{mixo, DM, ssp};
            pg8::gemm_phase<pg8::EpiY, pg8::StaticOrder, true, true>(F.lds, g, S, E, F.wave);
        }
        SEAM(pbase + 5);
        if (INM(pbase + 6, 6)) DUPN(6) { PHASE_PTRS(); resid_pass(F, (RES_LO && L == 0) ? Pk->in[I_X] : (const float*)nullptr, mixo, ssp, Pk->in[I_GMPOST] + (size_t)L * DM, hb, (bf16*)(ws + WS_LO), rin); }
        SEAM(pbase + 6);
        if (INM(pbase + 7, 7)) DUPN(7) { PHASE_PTRS();
            pg8::Gemm g{hb, (const bf16*)(ws + WS_WUP) + (size_t)L * NUP * DM, S_, NUP, DM, 0, 0}; pg8::StaticOrder S; S.init(S_, NUP, F.G, F.bid);
            pg8::EpiProj E{upb, NUP, rin, cst, snt, 0};
            pg8::gemm_phase<pg8::EpiProj, pg8::StaticOrder, true, true>(F.lds, g, S, E, F.wave);
        }
        SEAM(pbase + 7);
        if (INM(pbase + 8, 8)) DUPN(8) { PHASE_PTRS(); convffn_pass(F, upb, Pk->in[I_WFC] + (size_t)L * 3 * NUP, Pk->in[I_BFC] + (size_t)L * NUP, act); }
        SEAM(pbase + 8);
        if (INM(pbase + 9, 9)) DUPN(9) { PHASE_PTRS();
            pg8::Gemm g{act, (const bf16*)(ws + WS_WDN) + (size_t)L * DM * DM, S_, DM, DM, 0, 0}; pg8::StaticOrder S; S.init(S_, DM, F.G, F.bid);
            pg8::EpiY E{mixo, DM, ssp};
            pg8::gemm_phase<pg8::EpiY, pg8::StaticOrder, true, true>(F.lds, g, S, E, F.wave);
        }
        SEAM(pbase + 9);
        if (INM(pbase + 10, 10)) DUPN(10) { PHASE_PTRS(); resid_pass(F, (const float*)nullptr, mixo, ssp, Pk->in[I_GFPOST] + (size_t)L * DM, hb, (bf16*)(ws + WS_LO), rin); }
        SEAM(pbase + 10);
        if (INM(pbase + 11, 11)) DUPN(11) { PHASE_PTRS();
            pg8::Gemm g{hb, (const bf16*)(ws + WS_WPD) + (size_t)L * PLED * DM, S_, PLED, DM / 4, (long)(DM / 4) * 2, (long)(DM / 4) * 2, DM}; pg8::SplitKOrder S{F.G, F.bid, (S_ / 256) * 4};
            pg8::EpiPart E{(bf16*)(ws + WS_UP)};
            pg8::gemm_phase<pg8::EpiPart, pg8::SplitKOrder, true, true>(F.lds, g, S, E, F.wave);
        }
        SEAM(pbase + 11);
        if (INM(pbase + 12, 12)) DUPN(12) { PHASE_PTRS(); pled_combine(F, (const bf16*)(ws + WS_UP), rin, g1); }
        SEAM(pbase + 12);
        if (INM(pbase + 13, 13)) DUPN(13) { PHASE_PTRS();
            int Kp = PLED; asm volatile("; opaque K (keeps the K-loop rolled)" : "+s"(Kp));
            pg8::Gemm g{g1, (const bf16*)(ws + WS_WPU) + (size_t)L * DM * PLED, S_, DM, Kp, (long)(WS_PB - WS_G1) + (long)L * S_ * PLED * 2, (long)(WS_WPP - WS_WPU)};
#ifndef DBG_PLE_PLAIN
#define DBG_PLE_PLAIN 0
#endif
#if DBG_PLE_PLAIN == 1
            pg8::StaticOrder S; S.init(S_, DM, F.G, F.bid); pg8::EpiY E{mixo, DM, ssp};
            pg8::gemm_phase<pg8::EpiY, pg8::StaticOrder, true, true>(F.lds, g, S, E, F.wave);
#elif DBG_PLE_PLAIN == 2
            pg8::PleOrder S{F.G, F.bid, (S_ / 256) * (DM / 256)}; pg8::EpiPleDbg E{mixo, act};
            pg8::gemm_phase<pg8::EpiPleDbg, pg8::PleOrder, true, true>(F.lds, g, S, E, F.wave);
#else
            pg8::PleOrder S{F.G, F.bid, (S_ / 256) * (DM / 256)};
            pg8::EpiPle E{mixo, hb, (bf16*)(ws + WS_LO), L == DEPTH_ - 1 ? out : (float*)nullptr, ssp};
            pg8::gemm_phase<pg8::EpiPle, pg8::PleOrder, true, true>(F.lds, g, S, E, F.wave);
#endif
        }
        SEAM(pbase + 13);
        if (L + 1 < DEPTH_) { if (INM(pbase + 14, 14)) DUPN(14) { PHASE_PTRS(); rin_pass(F, ssp, rin); } SEAM(pbase + 14); }
    }
#undef IN
#undef INM
#undef SEAM
}

#ifndef DBG_STOP
#define DBG_STOP 0
#endif
#if DBG_STOP
__global__ void dbg_fold(const unsigned* ws, size_t nwords, float* out, int keep_out) {
    for (size_t i = (size_t)blockIdx.x * blockDim.x + threadIdx.x; i < (size_t)S_ * DM; i += (size_t)gridDim.x * blockDim.x) { float acc = keep_out ? out[i] : 0.f;
        for (size_t w = (1u << 18) + i; w < nwords; w += (size_t)S_ * DM) { const unsigned x = ws[w]; acc += (float)(x & 0xffffu) * (1.f / 65536.f) + (float)(x >> 16) * (1.f / 65536.f); }
        out[i] = acc; }
}
#endif
#ifndef DBG_CHECK
#define DBG_CHECK 0
#endif
#ifndef DBG_LAYER
#define DBG_LAYER 0
#endif

#if DBG_CHECK
__global__ void chk_rin(const float* h, const float* rin, float* errs, int code) { __shared__ float sh[8]; const int row = hsh(2020 + blockIdx.x) % S_; float ss = 0.f;
    for (int k = threadIdx.x; k < DM; k += blockDim.x) { const float a = h[(size_t)row * DM + k]; ss += a * a; } ss = blk_sum(ss, sh); if (threadIdx.x == 0) rep_err(errs, code, rin[row], rsqrtf(ss / DM + EPS_), 1e-3f); }
static void dbg_checks(int k, int before, void* const* d_in, void* d_out, void* d_ws, hipStream_t st) {
    const int r = (k - 1) % PH_PER_LAYER, L = (k - 1) / PH_PER_LAYER, j = L >> 1; const bool ev = (L & 1) == 0;
    if (k < 1 || L != DBG_LAYER) return;
    unsigned char* ws = (unsigned char*)d_ws; float* errs = (float*)(ws + 512 * 1024); float* out = (float*)d_out; float* tmp = (float*)(ws + WS_UP);
    const float* const* in = (const float* const*)d_in;
    bf16* proj = (bf16*)(ws + WS_PROJ); bf16* ymix = (bf16*)(ws + WS_YMIX); bf16* mixo = (bf16*)(ws + WS_MIXO); bf16* hb = (bf16*)(ws + WS_HB); bf16* upb = (bf16*)(ws + WS_UP); bf16* act = (bf16*)(ws + WS_ACT);
    bf16* od = (bf16*)(ws + WS_OD); bf16* g1 = (bf16*)(ws + WS_G1); float* rin = (float*)(ws + WS_RIN); float* ssp = (float*)(ws + WS_SSP); float* gpre = (float*)(ws + WS_GPRE);
    const float* cst = (const float*)(ws + WS_COS); const float* snt = (const float*)(ws + WS_SIN);
    const float* hin0 = (L == 0) ? in[I_X] : (const float*)out;
    if (before) { if ((DBG_CHECK == 1 && r == 6 && L > 0) || (DBG_CHECK == 2 && (r == 10 || r == 12))) (void)hipMemcpyAsync(tmp, out, (size_t)S_ * DM * 4, hipMemcpyDeviceToDevice, st); return; }
    if (DBG_CHECK == 1) {
        if (r == 0) { const float* W = ev ? in[I_WINE] + (size_t)j * DM * 6152 : in[I_WINO] + (size_t)j * DM * 6144;
            hipLaunchKernelGGL(chk_gemm, dim3(16384), dim3(256), 0, st, hin0, (const bf16*)nullptr, DM, in[I_GMPRE] + (size_t)L * DM, (const float*)nullptr, 1, W, ev ? 6152 : 6144, NIN, ev ? 2048 : 1024, cst, snt, (const bf16*)proj, NIN, errs, 1, 11u);
            if (ev) hipLaunchKernelGGL(chk_gates, dim3(4096), dim3(256), 0, st, hin0, in[I_GMPRE] + (size_t)L * DM, in[I_WINE] + (size_t)j * DM * 6152, (const float*)gpre, errs, 2); }
        if (r == 3) { float* hn = (float*)(ws + WS_UP); float* scr = (float*)(ws + WS_UP + 128 * MiB);
            if (ev) { hipLaunchKernelGGL(chk_diffattn, dim3(1024), dim3(256), 0, st, (const bf16*)proj, (const bf16*)od, scr, errs, 3);
                hipLaunchKernelGGL(chk_lin_naive, dim3(256, 4), dim3(128), 0, st, (const bf16*)proj, (const float*)gpre, in[I_BIG] + j * 4, in[I_BFG] + j * 4, in[I_WCQK] + (size_t)j * 4096, in[I_BCQK] + (size_t)j * 1024, 1, hn);
                hipLaunchKernelGGL(chk_lin_cmp, dim3(8192), dim3(256), 0, st, (const float*)hn, (const bf16*)proj, in[I_GML] + j * 256, 1, (const bf16*)ymix, errs, 4);
            } else { hipLaunchKernelGGL(chk_stick, dim3(1024), dim3(128), 0, st, (const bf16*)proj, (const bf16*)ymix, errs, 3);
                hipLaunchKernelGGL(chk_lin_naive, dim3(256, 4), dim3(128), 0, st, (const bf16*)proj, (const float*)gpre, in[I_BIG], in[I_BFG], in[I_WCQK], in[I_BCQK], 0, hn);
                hipLaunchKernelGGL(chk_lin_cmp, dim3(8192), dim3(256), 0, st, (const float*)hn, (const bf16*)proj, in[I_GRET] + j * 256, 0, (const bf16*)ymix, errs, 4); } }
        if (r == 4 && ev) hipLaunchKernelGGL(chk_diffcomb, dim3(8192), dim3(256), 0, st, (const bf16*)od, in[I_DLAM] + (size_t)j * 512, in[I_GDIFF] + j * 256, 0.8f - 0.6f * expf(-0.3f * (float)L), (const bf16*)ymix, errs, 5);
        if (r == 5) { const float* W = (ev ? in[I_WOUTE] : in[I_WOUTO]) + (size_t)j * NMIX * DM;
            hipLaunchKernelGGL(chk_gemm, dim3(16384), dim3(256), 0, st, (const float*)nullptr, (const bf16*)ymix, NMIX, (const float*)nullptr, (const float*)nullptr, 0, W, DM, DM, 0, cst, snt, (const bf16*)mixo, DM, errs, 6, 22u);
            hipLaunchKernelGGL(chk_ssp, dim3(4096), dim3(256), 0, st, (const bf16*)mixo, (const float*)ssp, errs, 6); }
        if (r == 6) hipLaunchKernelGGL(chk_resid, dim3(4096), dim3(256), 0, st, L == 0 ? in[I_X] : (const float*)tmp, (const bf16*)mixo, in[I_GMPOST] + (size_t)L * DM, (const float*)out, (const float*)rin, errs, 7);
        if (r == 7) hipLaunchKernelGGL(chk_gemm, dim3(16384), dim3(256), 0, st, (const float*)nullptr, (const bf16*)hb, DM, in[I_GFPRE] + (size_t)L * DM, (const float*)rin, 0, in[I_WUP] + (size_t)L * DM * NUP, NUP, NUP, 0, cst, snt, (const bf16*)upb, NUP, errs, 8, 33u);
        if (r == 8) hipLaunchKernelGGL(chk_conv, dim3(4096), dim3(256), 0, st, (const bf16*)upb, in[I_WFC] + (size_t)L * 3 * NUP, in[I_BFC] + (size_t)L * NUP, (const bf16*)act, errs, 9);
    } else {
        if (r == 9) { hipLaunchKernelGGL(chk_gemm, dim3(16384), dim3(256), 0, st, (const float*)nullptr, (const bf16*)act, DM, (const float*)nullptr, (const float*)nullptr, 0, in[I_WDN] + (size_t)L * DM * DM, DM, DM, 0, cst, snt, (const bf16*)mixo, DM, errs, 1, 44u);
            hipLaunchKernelGGL(chk_ssp, dim3(4096), dim3(256), 0, st, (const bf16*)mixo, (const float*)ssp, errs, 1); }
        if (r == 10) hipLaunchKernelGGL(chk_resid, dim3(4096), dim3(256), 0, st, (const float*)tmp, (const bf16*)mixo, in[I_GFPOST] + (size_t)L * DM, (const float*)out, (const float*)rin, errs, 2);
        if (r == 11) hipLaunchKernelGGL(chk_gemm, dim3(16384), dim3(256), 0, st, (const float*)nullptr, (const bf16*)hb, DM, in[I_GPLE] + (size_t)L * DM, (const float*)rin, 0, in[I_WPD] + (size_t)L * DM * PLED, PLED, PLED, 0, cst, snt, (const bf16*)g1, PLED, errs, 3, 55u);
        if (r == 12 && DBG_PLE_PLAIN == 2) hipLaunchKernelGGL(chk_gemm, dim3(16384), dim3(256), 0, st, (const float*)nullptr, (const bf16*)(ws + WS_PB) + (size_t)L * S_ * PLED, PLED, (const float*)nullptr, (const float*)nullptr, 0, in[I_WPP] + (size_t)L * PLED * DM, DM, DM, 0, cst, snt, (const bf16*)act, DM, errs, 5, 77u);
        if (r == 12 && DBG_PLE_PLAIN) hipLaunchKernelGGL(chk_gemm, dim3(16384), dim3(256), 0, st, (const float*)nullptr, (const bf16*)g1, PLED, (const float*)nullptr, (const float*)nullptr, 0, in[I_WPU] + (size_t)L * PLED * DM, DM, DM, 0, cst, snt, (const bf16*)mixo, DM, errs, 4, 66u);
        if (r == 12 && !DBG_PLE_PLAIN) { hipLaunchKernelGGL(chk_ple2, dim3(16384), dim3(256), 0, st, (const float*)tmp, (const bf16*)g1, in[I_WPU] + (size_t)L * PLED * DM, in[I_P] + (size_t)L * S_ * PLED, in[I_WPP] + (size_t)L * PLED * DM, (const float*)out, (const bf16*)mixo, errs, 4);
            hipLaunchKernelGGL(chk_ple, dim3(16384), dim3(256), 0, st, (const float*)tmp, (const bf16*)g1, in[I_WPU] + (size_t)L * PLED * DM, in[I_P] + (size_t)L * S_ * PLED, in[I_WPP] + (size_t)L * PLED * DM, (const float*)out, errs, 5); }
        if (r == 13) hipLaunchKernelGGL(chk_rin, dim3(4096), dim3(256), 0, st, (const float*)out, (const float*)rin, errs, 7);
    }
}
#endif
#ifndef DBG_NOPERT
#define DBG_NOPERT 0
#endif
#if DBG_PERTURB
__global__ void dbg_save(const float* out, bf16* sav) { for (size_t i = (size_t)blockIdx.x * blockDim.x + threadIdx.x; i < (size_t)S_ * DM; i += (size_t)gridDim.x * blockDim.x) sav[i] = (bf16)f2bf(out[i]); }
__global__ void dbg_cmp(const float* out, const bf16* sav, float* res) {
    __shared__ float sh[8]; const int row = blockIdx.x; float m = 0.f;
    for (int k = threadIdx.x; k < DM; k += blockDim.x) m = fmaxf(m, fabsf(out[(size_t)row * DM + k] - h2f(sav[(size_t)row * DM + k])));
    m = wave_max(m); __syncthreads(); if ((threadIdx.x & 63) == 0) sh[threadIdx.x >> 6] = m; __syncthreads();
    if (threadIdx.x == 0) { m = fmaxf(fmaxf(sh[0], sh[1]), fmaxf(sh[2], sh[3])); res[16 + row] = m; atomicMax((int*)res, __float_as_int(m)); }
}
__global__ void dbg_ysave(const bf16* ymix, bf16* sav) { for (int i = blockIdx.x * blockDim.x + threadIdx.x; i < 64 * NMIX; i += gridDim.x * blockDim.x) sav[i] = ymix[i]; }
__global__ void dbg_ycmp(const bf16* ymix, const bf16* sav, float* res, int L) {
    for (int i = blockIdx.x * blockDim.x + threadIdx.x; i < 64 * NMIX; i += gridDim.x * blockDim.x) { const float d = fabsf(h2f(ymix[i]) - h2f(sav[i]));
        atomicMax((int*)res + 1 + L, __float_as_int(d)); if (L == 0) atomicMax((unsigned long long*)(res + 1000), ((unsigned long long)__float_as_uint(d) << 32) | (unsigned)i); atomicMax((int*)res + 100 + L * 8 + ((i % NMIX) >> 8), __float_as_int(d)); atomicMax((int*)res + 200 + L * 64 + i / NMIX, __float_as_int(d)); }
}
__global__ void dbg_fetch(const bf16* ymix, float* res) { const unsigned i = ((const unsigned*)res)[1000]; res[1002] = h2f(ymix[i]); }
__global__ void dbg_rep(const float* res, float* out) {
    __shared__ float cc; if (threadIdx.x == 0) { const float mx = res[0]; int rw = 0; for (int r = 0; r < S_; ++r) if (res[16 + r] == mx) { rw = r; break; }
        int cnt = 0; for (int r = 0; r < S_; ++r) if (res[16 + r] > 0.5f * mx) ++cnt;
        if (DBG_PERTURB >= 5) { int Lf = 9, cb = 0, rw2 = 0; float md = 0.f; for (int L = 0; L < 4; ++L) if (res[1 + L] > 0.1f) { Lf = L; break; }
            if (Lf < 4) { for (int b = 0; b < 8; ++b) if (res[100 + Lf * 8 + b] > md) { md = res[100 + Lf * 8 + b]; cb = b; } md = 0.f; for (int r = 0; r < 64; ++r) if (res[200 + Lf * 64 + r] > md) { md = res[200 + Lf * 64 + r]; rw2 = r; } }
            cc = (DBG_PERTURB == 5) ? 1000.f * (Lf + 1) + 100.f * cb : (DBG_PERTURB == 6) ? 1000.f * (Lf + 1) + 100.f * fminf(9.f, (float)rw2) : (DBG_PERTURB == 11) ? 1000.f + 100.f * (float)rw2 : (DBG_PERTURB == 12) ? 1000.f + 30.f * (float)(((const unsigned*)res)[1000] % NMIX & 255) : (DBG_PERTURB == 13) ? 1000.f + 1000.f * fabsf(res[1002]) : 1000.f + 1000.f * res[1 + (DBG_PERTURB - 7)]; }
        else cc = (DBG_PERTURB == 1) ? 1000.f + mx * 1000.f : (DBG_PERTURB == 2) ? 1000.f + (float)rw * (9000.f / 16384.f) : (DBG_PERTURB == 3) ? 1000.f + (float)(rw & 1023) * (9000.f / 1024.f) : 1000.f + (float)cnt * 10.f; }
    __syncthreads(); const float c = cc;
    for (size_t i = (size_t)blockIdx.x * blockDim.x + threadIdx.x; i < (size_t)S_ * DM; i += (size_t)gridDim.x * blockDim.x) out[i] = c;
}
#endif
#if DBG_TIME
__global__ void dbg_time_rep(const unsigned long long* st, float* out) {
    __shared__ float cc; if (threadIdx.x == 0) { double us = 0.0; const int kind = DBG_TIME - 1;
        if (kind == 0) us = (double)(st[1] - st[0]) * 0.01; else if (kind == 20) us = (double)(st[1 + PH_PER_LAYER * (DEPTH_ - 1) + 13] - st[0]) * 0.01;
        else if (kind >= 30) { const int L = kind - 30; us = (double)(st[1 + 1 + PH_PER_LAYER * L + 3] - st[1 + PH_PER_LAYER * L + 3]) * 0.01; }
        else { const int r = kind - 1; for (int L = 0; L < DEPTH_; ++L) { const int k = 1 + PH_PER_LAYER * L + r; if ((r == 4 && (L & 1)) || (r == 13 && L == DEPTH_ - 1)) continue; unsigned long long prev = st[k]; int kp = k; while (prev == 0ull && kp > 0) prev = st[--kp]; us += (double)(st[k + 1] - prev) * 0.01; } }
        cc = (float)(us * 100.0); }
    __syncthreads(); const float c = cc;
    for (size_t i = (size_t)blockIdx.x * blockDim.x + threadIdx.x; i < (size_t)S_ * DM; i += (size_t)gridDim.x * blockDim.x) out[i] = c;
}
#endif
extern "C" void kernel_launch(void* const* d_in, const int* in_sizes, int n_in, void* d_out, int out_size, void* d_ws, size_t ws_size, hipStream_t stream) {
    static int grid = 0;
    if (grid == 0) {
        if (n_in != 26 || out_size != S_ * DM || ws_size < WS_END) { fprintf(stderr, "kernel_launch: unexpected shapes (n_in %d, out %d, ws %zu < %zu); nothing launched\n", n_in, out_size, ws_size, (size_t)WS_END); grid = -1; return; }
        int dev = 0, cus = 0, per_cu = 0;
        if (hipGetDevice(&dev) != hipSuccess || hipDeviceGetAttribute(&cus, hipDeviceAttributeMultiprocessorCount, dev) != hipSuccess) { grid = -1; return; }
        if (hipFuncSetAttribute((const void*)fwd_kernel, hipFuncAttributeMaxDynamicSharedMemorySize, LDS_BYTES) != hipSuccess) { fprintf(stderr, "kernel_launch: hipFuncSetAttribute failed\n"); grid = -1; return; }
        if (hipOccupancyMaxActiveBlocksPerMultiprocessor(&per_cu, (const void*)fwd_kernel, NWAVES * 64, LDS_BYTES) != hipSuccess || per_cu < 1) { fprintf(stderr, "kernel_launch: occupancy query says %d blocks per CU\n", per_cu); (void)hipGetLastError(); }
        grid = cus;
    }
    if (grid < 0) return;
    (void)hipMemsetAsync((char*)d_ws + WS_CTL, 0, CTL_ZERO_BYTES, stream);
    Params p{};
    for (int i = 0; i < 26; ++i) p.in[i] = (const float*)d_in[i];
    p.out = (float*)d_out; p.ws = (unsigned char*)d_ws;
#if MK_SPLIT
#if DBG_PERTURB
    for (int rep = 0; rep < 2; ++rep) { p.pert = DBG_NOPERT ? 0 : rep;
#endif
    for (int k = 0; k < N_PHASES; ++k) { const int r = (k - 1) % PH_PER_LAYER, L = (k - 1) / PH_PER_LAYER;
        if (k > 0 && (r > 14 || (r == 4 && (L & 1)) || (r == 14 && L == DEPTH_ - 1))) continue;
        if (DBG_STOP && k >= DBG_STOP) break;
#if DBG_CHECK
        dbg_checks(k, 1, d_in, d_out, d_ws, stream);
#endif
        p.ph_lo = k; p.ph_hi = k + 1; hipLaunchKernelGGL(fwd_kernel, dim3(grid), dim3(NWAVES * 64), LDS_BYTES, stream, p);
#if DBG_CHECK
        dbg_checks(k, 0, d_in, d_out, d_ws, stream);
#endif
#if DBG_PERTURB
        { const int r_ = (k - 1) % PH_PER_LAYER, L_ = (k - 1) / PH_PER_LAYER; if (k >= 1 && ((r_ == 4 && !(L_ & 1)) || (r_ == 3 && (L_ & 1)))) { bf16* ys = (bf16*)((char*)d_ws + WS_END + 128 * MiB) + (size_t)L_ * 64 * NMIX;
            if (rep == 0) hipLaunchKernelGGL(dbg_ysave, dim3(64), dim3(256), 0, stream, (const bf16*)((char*)d_ws + WS_YMIX), ys);
            else { hipLaunchKernelGGL(dbg_ycmp, dim3(64), dim3(256), 0, stream, (const bf16*)((char*)d_ws + WS_YMIX), (const bf16*)ys, (float*)((char*)d_ws + 512 * 1024), L_); if (L_ == 0) hipLaunchKernelGGL(dbg_fetch, dim3(1), dim3(1), 0, stream, (const bf16*)((char*)d_ws + WS_YMIX), (float*)((char*)d_ws + 512 * 1024)); } } }
#endif
    }
#if DBG_PERTURB
    if (rep == 0) { (void)hipMemsetAsync((char*)d_ws + WS_CTL, 0, CTL_ZERO_BYTES, stream); hipLaunchKernelGGL(dbg_save, dim3(2048), dim3(256), 0, stream, (const float*)d_out, (bf16*)((char*)d_ws + WS_END)); }
    else { float* res = (float*)((char*)d_ws + 512 * 1024); hipLaunchKernelGGL(dbg_cmp, dim3(S_), dim3(256), 0, stream, (const float*)d_out, (const bf16*)((char*)d_ws + WS_END), res); hipLaunchKernelGGL(dbg_rep, dim3(2048), dim3(256), 0, stream, (const float*)res, (float*)d_out); }
    }
#endif
#if DBG_CHECK
    hipLaunchKernelGGL(chk_final, dim3(2048), dim3(256), 0, stream, (const float*)((char*)d_ws + 512 * 1024), (float*)d_out, DBG_TOL);
#endif
#else
    p.ph_lo = 0; p.ph_hi = N_PHASES;
    hipLaunchKernelGGL(fwd_kernel, dim3(grid), dim3(NWAVES * 64), LDS_BYTES, stream, p);
#endif
#if DBG_STOP
    hipLaunchKernelGGL(dbg_fold, dim3(2048), dim3(256), 0, stream, (const unsigned*)d_ws, (size_t)(WS_END / 4), (float*)d_out, DBG_STOP > 7 ? 1 : 0);
#endif
#if DBG_TIME
    hipLaunchKernelGGL(dbg_time_rep, dim3(2048), dim3(256), 0, stream, (const unsigned long long*)((char*)d_ws + 768 * 1024), (float*)d_out);
#endif
    const hipError_t le = hipPeekAtLastError();
    if (le != hipSuccess) fprintf(stderr, "kernel_launch: launch failed: %s\n", hipGetErrorName(le));
}
```

```cpp
#ifndef RES_LO
#define RES_LO 0
#endif
#include <hip/hip_runtime.h>
#include <cstdio>
#include <cstdint>
namespace pg8 {
#define PG8_LAS __attribute__((address_space(3)))
typedef unsigned short bf16_t;
typedef short bf16x8 __attribute__((ext_vector_type(8)));
typedef float f32x4 __attribute__((ext_vector_type(4)));
typedef unsigned u32x4 __attribute__((ext_vector_type(4)));
constexpr int BM = 256, BK = 64, HALF = 128, HTB = HALF * BK * 2  , STAGE_BYTES = 8 * HTB, NXCD = 8, WGM = 8;

__host__ __device__ __forceinline__ int lds_byte(int r, int c) { const int st = (r >> 4) * 2 + (c >> 5), rr = r & 15, cc = c & 31, ob = rr * 64 + cc * 2; return st * 1024 + (ob ^ (((ob >> 9) & 1) << 5)); }
__host__ __device__ __forceinline__ void stage_rc(int b, int& R, int& C) { const int st = b / 1024, sb = b % 1024, swz = sb ^ (((sb >> 9) & 1) << 5); R = (st >> 1) * 16 + swz / 64; C = (st & 1) * 32 + (swz % 64) / 2; }
__host__ __device__ __forceinline__ int perm32(int rho) { const int n = rho >> 4, i = rho & 15; return 8 * (i >> 2) + 4 * n + (i & 3); }

struct Unit { int pm, pn, which; };
struct Gemm { const bf16_t* A; const bf16_t* Bt; int M, N, K; long dA, dB; int ld; };

struct StaticOrder {
    int nM, nN, nwg, G, c;
    __host__ __device__ void init(int M, int N, int G_, int c_) { nM = M / BM; nN = N / BM; nwg = nM * nN; G = G_; c = c_; }
    __host__ __device__ bool next(int i, Unit& u) const {
        const long L = (long)i * G + c; if (L >= nwg) return false;
        int wgid = (int)L; { const int q = nwg / NXCD, r = nwg % NXCD, xcd = wgid % NXCD, off = wgid / NXCD; wgid = (xcd < r ? xcd * (q + 1) : r * (q + 1) + (xcd - r) * q) + off; }
        const int nig = WGM * nN, gid = wgid / nig, fm = gid * WGM, gsz = (nM - fm) < WGM ? (nM - fm) : WGM;
        u.pm = fm + ((wgid % nig) % gsz); u.pn = (wgid % nig) / gsz; u.which = 0; return true;
    }
    __device__ __forceinline__ void a_ready(const Unit&) const {}
    __device__ __forceinline__ void done(const Unit&) const {}
};

__device__ __forceinline__ float fq_sum(float v) {
    auto a = __builtin_amdgcn_permlane16_swap(__float_as_uint(v), __float_as_uint(v), false, false); v = __uint_as_float(a[0]) + __uint_as_float(a[1]);
    auto b = __builtin_amdgcn_permlane32_swap(__float_as_uint(v), __float_as_uint(v), false, false); return __uint_as_float(b[0]) + __uint_as_float(b[1]); }
#ifndef USE_F16
#define USE_F16 1
#endif
typedef float f32x2_t __attribute__((ext_vector_type(2))); typedef __bf16 bf16x2_t __attribute__((ext_vector_type(2)));
typedef _Float16 h16x2_t __attribute__((ext_vector_type(2))); typedef _Float16 h16x8_t __attribute__((ext_vector_type(8)));
#if USE_F16
__device__ __forceinline__ unsigned cvt_pk_bf16(float lo, float hi) { f32x2_t v = {lo, hi}; h16x2_t b = __builtin_convertvector(v, h16x2_t); return __builtin_bit_cast(unsigned, b); }
__device__ __forceinline__ float unpk_lo(unsigned w) { return (float)__builtin_bit_cast(h16x2_t, w)[0]; }
__device__ __forceinline__ float unpk_hi(unsigned w) { return (float)__builtin_bit_cast(h16x2_t, w)[1]; }
#define MFMA16(a, b, c) __builtin_amdgcn_mfma_f32_16x16x32_f16(__builtin_bit_cast(pg8::h16x8_t, (a)), __builtin_bit_cast(pg8::h16x8_t, (b)), (c), 0, 0, 0)
#define MFMA32(a, b, c) __builtin_amdgcn_mfma_f32_32x32x16_f16(__builtin_bit_cast(pg8::h16x8_t, (a)), __builtin_bit_cast(pg8::h16x8_t, (b)), (c), 0, 0, 0)
#else
__device__ __forceinline__ unsigned cvt_pk_bf16(float lo, float hi) { f32x2_t v = {lo, hi}; bf16x2_t b = __builtin_convertvector(v, bf16x2_t); return __builtin_bit_cast(unsigned, b); }
__device__ __forceinline__ float unpk_lo(unsigned w) { return __uint_as_float(w << 16); }
__device__ __forceinline__ float unpk_hi(unsigned w) { return __uint_as_float(w & 0xffff0000u); }
#define MFMA16(a, b, c) __builtin_amdgcn_mfma_f32_16x16x32_bf16((a), (b), (c), 0, 0, 0)
#define MFMA32(a, b, c) __builtin_amdgcn_mfma_f32_32x32x16_bf16((a), (b), (c), 0, 0, 0)
#endif

struct EpiProj {
    static constexpr bool PERM = true, AFTER_DRAIN = false;
    bf16_t* O; int ldc; const float* rs; const float* cs; const float* sn; int rope_tiles;
    __device__ __forceinline__ void operator()(const f32x4 (&acc)[2][2][4][2], const Unit& u, int wr, int wc, int fr_in, int fq_in) const {
        int fr = fr_in, fq = fq_in; asm volatile("; EPI_ENTRY" : "+v"(fr), "+v"(fq));
        const int row0 = u.pm * BM + wr * 64 + fr, col0 = u.pn * BM + wc * 32 + 8 * fq;
        const bool rope = u.pn < rope_tiles; const int i0 = (wc * 32 + 8 * fq) >> 1;
#pragma unroll
        for (int ai = 0; ai < 2; ++ai)
#pragma unroll
            for (int m = 0; m < 4; ++m) { const int row = row0 + ai * HALF + m * 16; const float r = rs[row];
                f32x4 c4 = (f32x4){1.f, 1.f, 1.f, 1.f}, s4 = (f32x4){0.f, 0.f, 0.f, 0.f};
                if (rope) { c4 = *(const f32x4*)(cs + (size_t)row * 64 + i0); s4 = *(const f32x4*)(sn + (size_t)row * 64 + i0); }
                bf16_t* rowp = O + (size_t)row * ldc + col0;
#pragma unroll
                for (int bj = 0; bj < 2; ++bj) { const f32x4 v0 = acc[ai][bj][m][0] * r, v1 = acc[ai][bj][m][1] * r;
                    f32x4 o0, o1;
                    o0[0] = v0[0] * c4[0] - v0[1] * s4[0]; o0[1] = v0[1] * c4[0] + v0[0] * s4[0];
                    o0[2] = v0[2] * c4[1] - v0[3] * s4[1]; o0[3] = v0[3] * c4[1] + v0[2] * s4[1];
                    o1[0] = v1[0] * c4[2] - v1[1] * s4[2]; o1[1] = v1[1] * c4[2] + v1[0] * s4[2];
                    o1[2] = v1[2] * c4[3] - v1[3] * s4[3]; o1[3] = v1[3] * c4[3] + v1[2] * s4[3];
                    u32x4 w; w.x = cvt_pk_bf16(o0[0], o0[1]); w.y = cvt_pk_bf16(o0[2], o0[3]); w.z = cvt_pk_bf16(o1[0], o1[1]); w.w = cvt_pk_bf16(o1[2], o1[3]);
                    *(u32x4*)(rowp + bj * HALF) = w; } }
    }
};
struct EpiY {
    static constexpr bool PERM = true, AFTER_DRAIN = false;
    bf16_t* O; int ldc; float* ssp;
    __device__ __forceinline__ void operator()(const f32x4 (&acc)[2][2][4][2], const Unit& u, int wr, int wc, int fr_in, int fq_in) const {
        int fr = fr_in, fq = fq_in; asm volatile("; EPI_ENTRY" : "+v"(fr), "+v"(fq));
        const int row0 = u.pm * BM + wr * 64 + fr, col0 = u.pn * BM + wc * 32 + 8 * fq;
#pragma unroll
        for (int ai = 0; ai < 2; ++ai)
#pragma unroll
            for (int m = 0; m < 4; ++m) { const int row = row0 + ai * HALF + m * 16; bf16_t* rowp = O + (size_t)row * ldc + col0; float s = 0.f;
#pragma unroll
                for (int bj = 0; bj < 2; ++bj) { const f32x4 v0 = acc[ai][bj][m][0], v1 = acc[ai][bj][m][1];
                    s += (v0[0] * v0[0] + v0[1] * v0[1]) + (v0[2] * v0[2] + v0[3] * v0[3]) + (v1[0] * v1[0] + v1[1] * v1[1]) + (v1[2] * v1[2] + v1[3] * v1[3]);
                    u32x4 w; w.x = cvt_pk_bf16(v0[0], v0[1]); w.y = cvt_pk_bf16(v0[2], v0[3]); w.z = cvt_pk_bf16(v1[0], v1[1]); w.w = cvt_pk_bf16(v1[2], v1[3]);
                    *(u32x4*)(rowp + bj * HALF) = w; }
                s = fq_sum(s);
                if (fq == 0) ssp[(size_t)row * 64 + u.pn * 4 + wc] = s; }
    }
};
struct EpiPle {
    static constexpr bool PERM = true, AFTER_DRAIN = false;
    bf16_t* G; bf16_t* HI; bf16_t* LO; float* OUT32; float* ssp;
    __device__ __forceinline__ void operator()(const f32x4 (&acc)[2][2][4][2], const Unit& u, int wr, int wc, int fr_in, int fq_in) const {
        int fr = fr_in, fq = fq_in; asm volatile("; EPI_ENTRY" : "+v"(fr), "+v"(fq));
        const unsigned row0 = (unsigned)(u.pm * BM + wr * 64 + fr), col0 = (unsigned)(u.pn * BM + wc * 32 + 8 * fq);
        char* Gc = (char*)G + (size_t)(u.pm * 16 + u.pn) * 131072u + (unsigned)(wr * 4 + wc) * 16384u; char* HIc = (char*)HI; char* LOc = (char*)LO; char* Oc = (char*)OUT32;
        const unsigned goff = (unsigned)(fq * 16 + fr) * 16u;
        if (u.which == 0) {
#pragma unroll
            for (int ai = 0; ai < 2; ++ai)
#pragma unroll
                for (int m = 0; m < 4; ++m) {
                    u32x4 w;
#pragma unroll
                    for (int bj = 0; bj < 2; ++bj) { f32x4 v0 = acc[ai][bj][m][0], v1 = acc[ai][bj][m][1]; unsigned q0 = 0u, q1 = 0u;
#pragma unroll
                        for (int e = 0; e < 4; ++e) { q0 |= (unsigned)(__builtin_amdgcn_rcpf(1.f + __expf(-v0[e])) * 255.f + 0.5f) << (8 * e); q1 |= (unsigned)(__builtin_amdgcn_rcpf(1.f + __expf(-v1[e])) * 255.f + 0.5f) << (8 * e); }
                        if (bj == 0) { w.x = q0; w.y = q1; } else { w.z = q0; w.w = q1; } }
                    *(u32x4*)(Gc + (unsigned)((ai * 4 + m) * 1024) + goff) = w; }
        } else {
            asm volatile("s_waitcnt vmcnt(0)" ::: "memory");
#pragma unroll
            for (int ai = 0; ai < 2; ++ai)
#pragma unroll
                for (int m = 0; m < 4; ++m) { const unsigned row = row0 + ai * HALF + m * 16, off = row * 4096u + col0; float s = 0.f; const u32x4 gq = *(const u32x4*)(Gc + (unsigned)((ai * 4 + m) * 1024) + goff);
#pragma unroll
                    for (int bj = 0; bj < 2; ++bj) { const unsigned ob = off + bj * HALF; const unsigned qa = bj ? gq.z : gq.x, qb = bj ? gq.w : gq.y;
                        const u32x4 hw = *(const u32x4*)(HIc + (unsigned)(ob * 2u)); u32x4 lw = {0u, 0u, 0u, 0u}; if (RES_LO) lw = *(const u32x4*)(LOc + (unsigned)(ob * 2u));
                        f32x4 g0, g1, h0, h1; g0[0] = (float)(qa & 255u) * (1.f / 255.f); g0[1] = (float)((qa >> 8) & 255u) * (1.f / 255.f); g0[2] = (float)((qa >> 16) & 255u) * (1.f / 255.f); g0[3] = (float)(qa >> 24) * (1.f / 255.f);
                        g1[0] = (float)(qb & 255u) * (1.f / 255.f); g1[1] = (float)((qb >> 8) & 255u) * (1.f / 255.f); g1[2] = (float)((qb >> 16) & 255u) * (1.f / 255.f); g1[3] = (float)(qb >> 24) * (1.f / 255.f);
                        h0[0] = unpk_lo(hw.x) + unpk_lo(lw.x); h0[1] = unpk_hi(hw.x) + unpk_hi(lw.x); h0[2] = unpk_lo(hw.y) + unpk_lo(lw.y); h0[3] = unpk_hi(hw.y) + unpk_hi(lw.y);
                        h1[0] = unpk_lo(hw.z) + unpk_lo(lw.z); h1[1] = unpk_hi(hw.z) + unpk_hi(lw.z); h1[2] = unpk_lo(hw.w) + unpk_lo(lw.w); h1[3] = unpk_hi(hw.w) + unpk_hi(lw.w);
                        const f32x4 v0 = h0 + g0 * acc[ai][bj][m][0], v1 = h1 + g1 * acc[ai][bj][m][1];
                        s += (v0[0] * v0[0] + v0[1] * v0[1]) + (v0[2] * v0[2] + v0[3] * v0[3]) + (v1[0] * v1[0] + v1[1] * v1[1]) + (v1[2] * v1[2] + v1[3] * v1[3]);
                        u32x4 w; w.x = cvt_pk_bf16(v0[0], v0[1]); w.y = cvt_pk_bf16(v0[2], v0[3]); w.z = cvt_pk_bf16(v1[0], v1[1]); w.w = cvt_pk_bf16(v1[2], v1[3]);
                        if (OUT32) { *(f32x4*)(Oc + (unsigned)(ob * 4u)) = v0; *(f32x4*)(Oc + (unsigned)(ob * 4u + 16u)) = v1; }
                        else { u32x4 wl; wl.x = cvt_pk_bf16(v0[0] - unpk_lo(w.x), v0[1] - unpk_hi(w.x)); wl.y = cvt_pk_bf16(v0[2] - unpk_lo(w.y), v0[3] - unpk_hi(w.y));
                            wl.z = cvt_pk_bf16(v1[0] - unpk_lo(w.z), v1[1] - unpk_hi(w.z)); wl.w = cvt_pk_bf16(v1[2] - unpk_lo(w.w), v1[3] - unpk_hi(w.w));
                            *(u32x4*)(HIc + (unsigned)(ob * 2u)) = w; if (RES_LO) *(u32x4*)(LOc + (unsigned)(ob * 2u)) = wl; }
                        asm volatile("" ::: "memory"); }
                    s = fq_sum(s);
                    if (fq == 0) ssp[(size_t)row * 64 + u.pn * 4 + wc] = s;
                    asm volatile("" ::: "memory"); }
        }
    }
};
struct EpiPart {
    static constexpr bool PERM = true, AFTER_DRAIN = false;
    bf16_t* part;
    __device__ __forceinline__ void operator()(const f32x4 (&acc)[2][2][4][2], const Unit& u, int wr, int wc, int fr, int fq) const {
        const int row0 = u.pm * BM + wr * 64 + fr, col0 = wc * 32 + 8 * fq; bf16_t* base = part + (size_t)u.which * 16384 * 256;
#pragma unroll
        for (int ai = 0; ai < 2; ++ai)
#pragma unroll
            for (int m = 0; m < 4; ++m) { bf16_t* rowp = base + (size_t)(row0 + ai * HALF + m * 16) * 256 + col0;
#pragma unroll
                for (int bj = 0; bj < 2; ++bj) { const f32x4 v0 = acc[ai][bj][m][0], v1 = acc[ai][bj][m][1];
                    u32x4 w; w.x = cvt_pk_bf16(v0[0], v0[1]); w.y = cvt_pk_bf16(v0[2], v0[3]); w.z = cvt_pk_bf16(v1[0], v1[1]); w.w = cvt_pk_bf16(v1[2], v1[3]); *(u32x4*)(rowp + bj * HALF) = w; } }
    }
};
struct SplitKOrder {
    int G, c, nunit;
    __device__ __forceinline__ bool next(int i, Unit& u) const { const int L = i * G + c; if (L >= nunit) return false; u.pm = L >> 2; u.pn = 0; u.which = L & 3; return true; }
    __device__ __forceinline__ void a_ready(const Unit&) const {}
    __device__ __forceinline__ void done(const Unit&) const {}
};
struct EpiPleDbg {
    static constexpr bool PERM = true, AFTER_DRAIN = false;
    bf16_t* G; bf16_t* G2;
    __device__ __forceinline__ void operator()(const f32x4 (&acc)[2][2][4][2], const Unit& u, int wr, int wc, int fr, int fq) const {
        const int row0 = u.pm * BM + wr * 64 + fr, col0 = u.pn * BM + wc * 32 + 8 * fq; bf16_t* O = u.which ? G2 : G;
#pragma unroll
        for (int ai = 0; ai < 2; ++ai)
#pragma unroll
            for (int m = 0; m < 4; ++m) { const int row = row0 + ai * HALF + m * 16; bf16_t* rowp = O + (size_t)row * 4096 + col0;
#pragma unroll
                for (int bj = 0; bj < 2; ++bj) { const f32x4 v0 = acc[ai][bj][m][0], v1 = acc[ai][bj][m][1];
                    u32x4 w; w.x = cvt_pk_bf16(v0[0], v0[1]); w.y = cvt_pk_bf16(v0[2], v0[3]); w.z = cvt_pk_bf16(v1[0], v1[1]); w.w = cvt_pk_bf16(v1[2], v1[3]);
                    *(u32x4*)(rowp + bj * HALF) = w; } }
    }
};
struct PleOrder {
    int G, c, ntile;
    __device__ __forceinline__ bool next(int i, Unit& u) const { const int tl = (i >> 1) * G + c; if (tl >= ntile) return false; u.pm = tl >> 4; u.pn = tl & 15; u.which = i & 1; return true; }
    __device__ __forceinline__ void a_ready(const Unit&) const {}
    __device__ __forceinline__ void done(const Unit&) const {}
};
template <class Epi, class Sched, bool ALIGN_EPI = false, bool SP2 = false>
__device__ __forceinline__ void gemm_phase(PG8_LAS unsigned char* lds, const Gemm g, const Sched& S, const Epi& E, int wave_in) {
    int lane_o; asm volatile("v_mbcnt_lo_u32_b32 %0, -1, 0\n\tv_mbcnt_hi_u32_b32 %0, -1, %0 ; LANE_ID" : "=v"(lane_o)); const int wid = wave_in, lane = lane_o, tid = wid * 64 + lane, wr = wid >> 2, wc = wid & 3, fr = lane & 15, fq = lane >> 4;
    const int K = g.ld ? g.ld : g.K, nt = g.K / BK;
    unsigned voffA[2], voffB[2];
#pragma unroll
    for (int i = 0; i < 2; ++i) { int R, C; stage_rc(tid * 16 + i * 8192, R, C); const int Rb = Epi::PERM ? ((R & ~31) + perm32(R & 31)) : R;
        voffA[i] = (unsigned)(R * K + C) * 2u; voffB[i] = (unsigned)(Rb * K + C) * 2u; }
    const size_t kstep = (size_t)(BK * 2);
    const size_t hstep = (size_t)HALF * K * 2;
    const size_t tstep = 2 * hstep;
    const unsigned ldsw = (unsigned)wid * 1024u;
    const int aoff = lds_byte(wr * 64 + fr, fq * 8), boff = lds_byte(wc * 32 + fr, fq * 8);
#define PG8_SA(b, h) (((b) * 2 + (h)) * HTB)
#define PG8_SB(b, h) ((4 + (b) * 2 + (h)) * HTB)
#define PG8_STAGE(bufoff, gbase, voff) do { _Pragma("unroll") for (int _i = 0; _i < 2; ++_i) \
        __builtin_amdgcn_global_load_lds((const unsigned*)((const char*)(gbase) + (voff)[_i]), (PG8_LAS unsigned*)(lds + (bufoff) + ldsw + _i * 8192), 16, 0, 0); } while (0)
#define PG8_LDA(dst, b, h) do { _Pragma("unroll") for (int m = 0; m < 4; ++m) _Pragma("unroll") for (int k = 0; k < 2; ++k) dst[m][k] = *(const PG8_LAS bf16x8*)(lds + PG8_SA(b, h) + aoff + m * 2048 + k * 1024); } while (0)
#define PG8_LDB(dst, b, h) do { _Pragma("unroll") for (int n = 0; n < 2; ++n) _Pragma("unroll") for (int k = 0; k < 2; ++k) dst[n][k] = *(const PG8_LAS bf16x8*)(lds + PG8_SB(b, h) + boff + n * 2048 + k * 1024); } while (0)
#define PG8_MMA(ai, bj, At, Bt) do { __builtin_amdgcn_s_setprio(1); _Pragma("unroll") for (int m = 0; m < 4; ++m) _Pragma("unroll") for (int n = 0; n < 2; ++n) _Pragma("unroll") for (int k = 0; k < 2; ++k) \
        acc[ai][bj][m][n] = MFMA16(Bt[n][k], At[m][k], acc[ai][bj][m][n]); __builtin_amdgcn_s_setprio(0); } while (0)
#define PG8_WAIT_V(n) asm volatile("s_waitcnt vmcnt(" #n ")" ::: "memory")
#define PG8_WAIT_L(n) asm volatile("s_waitcnt lgkmcnt(" #n ")" ::: "memory")
#define PG8_BAR __builtin_amdgcn_s_barrier()
#define PG8_SCHED __builtin_amdgcn_sched_barrier(0)
    Unit cur, nxt; int ui = 0;
    if (!S.next(0, cur)) return;
    f32x4 acc[2][2][4][2];
#pragma unroll
    for (int a = 0; a < 2; ++a)
#pragma unroll
        for (int b = 0; b < 2; ++b)
#pragma unroll
            for (int m = 0; m < 4; ++m)
#pragma unroll
                for (int n = 0; n < 2; ++n) acc[a][b][m][n] = (f32x4){0.f, 0.f, 0.f, 0.f};
    bf16x8 At[4][2], B0[2][2], B1[2][2];
    const char* cA = (const char*)g.A + (size_t)cur.pm * tstep + (size_t)cur.which * (size_t)g.dA; const char* cB = (const char*)g.Bt + (size_t)cur.pn * tstep + (size_t)cur.which * (size_t)g.dB;
    S.a_ready(cur);
    if constexpr (SP2) {
        PG8_STAGE(PG8_SB(0, 0), cB, voffB); PG8_STAGE(PG8_SB(0, 1), cB + hstep, voffB); PG8_STAGE(PG8_SA(0, 0), cA, voffA); PG8_STAGE(PG8_SA(0, 1), cA + hstep, voffA);
        if (wr == 1) PG8_BAR;
        PG8_WAIT_V(2); PG8_BAR;
        PG8_STAGE(PG8_SB(1, 0), cB + kstep, voffB); PG8_STAGE(PG8_SA(1, 0), cA + kstep, voffA); PG8_STAGE(PG8_SB(1, 1), cB + hstep + kstep, voffB);
        PG8_WAIT_V(6); PG8_BAR;
    } else {
        PG8_STAGE(PG8_SB(0, 0), cB, voffB); PG8_STAGE(PG8_SA(0, 0), cA, voffA); PG8_STAGE(PG8_SB(0, 1), cB + hstep, voffB); PG8_STAGE(PG8_SA(0, 1), cA + hstep, voffA);
        if (wr == 1) PG8_BAR;
        PG8_WAIT_V(4); PG8_BAR;
        PG8_STAGE(PG8_SB(1, 0), cB + kstep, voffB); PG8_STAGE(PG8_SA(1, 0), cA + kstep, voffA); PG8_STAGE(PG8_SB(1, 1), cB + hstep + kstep, voffB);
        PG8_WAIT_V(6); PG8_BAR;
    }
    for (;;) {
        const bool has_next = S.next(ui + 1, nxt);
        const char* nA = has_next ? (const char*)g.A + (size_t)nxt.pm * tstep + (size_t)nxt.which * (size_t)g.dA : cA; const char* nB = has_next ? (const char*)g.Bt + (size_t)nxt.pn * tstep + (size_t)nxt.which * (size_t)g.dB : cB;
        for (int t = 0; t < nt; t += 2) {
            const bool last = (t == nt - 2);
            const char* a1 = cA + (size_t)(t + 1) * kstep;
            const char* a2 = last ? nA : cA + (size_t)(t + 2) * kstep; const char* b2 = last ? nB : cB + (size_t)(t + 2) * kstep;
            const char* a3 = a2 + kstep; const char* b3 = b2 + kstep;
            if (last && has_next) S.a_ready(nxt);
            if constexpr (SP2) {
            PG8_LDB(B0, 0, 0); PG8_LDB(B1, 0, 1); PG8_SCHED; PG8_LDA(At, 0, 0); PG8_STAGE(PG8_SA(1, 1), a1 + hstep, voffA);
            PG8_WAIT_V(8); PG8_WAIT_L(0); PG8_BAR; PG8_MMA(0, 0, At, B0); PG8_MMA(0, 1, At, B1); PG8_BAR; PG8_SCHED;
            PG8_LDA(At, 0, 1); PG8_STAGE(PG8_SB(0, 0), b2, voffB); PG8_STAGE(PG8_SB(0, 1), b2 + hstep, voffB); PG8_STAGE(PG8_SA(0, 0), a2, voffA);
            PG8_WAIT_V(8); PG8_WAIT_L(0); PG8_BAR; PG8_MMA(1, 0, At, B0); PG8_MMA(1, 1, At, B1); PG8_BAR; PG8_SCHED;
            PG8_LDB(B0, 1, 0); PG8_LDB(B1, 1, 1); PG8_SCHED; PG8_LDA(At, 1, 0); PG8_STAGE(PG8_SA(0, 1), a2 + hstep, voffA);
            PG8_WAIT_V(8); PG8_WAIT_L(0); PG8_BAR; PG8_MMA(0, 0, At, B0); PG8_MMA(0, 1, At, B1); PG8_BAR; PG8_SCHED;
            PG8_LDA(At, 1, 1); PG8_STAGE(PG8_SB(1, 0), b3, voffB); PG8_STAGE(PG8_SB(1, 1), b3 + hstep, voffB); PG8_STAGE(PG8_SA(1, 0), a3, voffA);
            PG8_WAIT_V(8); PG8_WAIT_L(0); PG8_BAR; PG8_MMA(1, 0, At, B0); PG8_MMA(1, 1, At, B1); PG8_BAR; PG8_SCHED;
            } else {
            PG8_LDB(B0, 0, 0); PG8_SCHED; PG8_LDA(At, 0, 0); PG8_STAGE(PG8_SA(1, 1), a1 + hstep, voffA);
            PG8_WAIT_L(8); PG8_BAR; PG8_WAIT_L(0); PG8_MMA(0, 0, At, B0); PG8_BAR; PG8_SCHED;
            PG8_LDB(B1, 0, 1); PG8_STAGE(PG8_SB(0, 0), b2, voffB);
            PG8_BAR; PG8_WAIT_L(0); PG8_MMA(0, 1, At, B1); PG8_BAR;
            PG8_LDA(At, 0, 1); PG8_STAGE(PG8_SA(0, 0), a2, voffA);
            PG8_BAR; PG8_WAIT_L(0); PG8_MMA(1, 0, At, B0); PG8_BAR; PG8_SCHED;
            PG8_STAGE(PG8_SB(0, 1), b2 + hstep, voffB);
            PG8_WAIT_V(6); PG8_BAR; PG8_MMA(1, 1, At, B1); PG8_BAR;
            PG8_LDB(B0, 1, 0); PG8_SCHED; PG8_LDA(At, 1, 0); PG8_STAGE(PG8_SA(0, 1), a2 + hstep, voffA);
            PG8_WAIT_L(8); PG8_BAR; PG8_WAIT_L(0); PG8_MMA(0, 0, At, B0); PG8_BAR; PG8_SCHED;
            PG8_LDB(B1, 1, 1); PG8_STAGE(PG8_SB(1, 0), b3, voffB);
            PG8_BAR; PG8_WAIT_L(0); PG8_MMA(0, 1, At, B1); PG8_BAR;
            PG8_LDA(At, 1, 1); PG8_STAGE(PG8_SA(1, 0), a3, voffA);
            PG8_BAR; PG8_WAIT_L(0); PG8_MMA(1, 0, At, B0); PG8_BAR; PG8_SCHED;
            PG8_STAGE(PG8_SB(1, 1), b3 + hstep, voffB);
            PG8_WAIT_V(6); PG8_BAR; PG8_MMA(1, 1, At, B1); PG8_BAR;
            }
        }
        if constexpr (ALIGN_EPI) { if (wr == 0) PG8_BAR; }
        if constexpr (!Epi::AFTER_DRAIN) { E(acc, cur, wr, wc, fr, fq); S.done(cur); }
        if (!has_next) break;
#pragma unroll
        for (int a = 0; a < 2; ++a)
#pragma unroll
            for (int b = 0; b < 2; ++b)
#pragma unroll
                for (int m = 0; m < 4; ++m)
#pragma unroll
                    for (int n = 0; n < 2; ++n) acc[a][b][m][n] = (f32x4){0.f, 0.f, 0.f, 0.f};
        cur = nxt; cA = nA; cB = nB; ++ui;
        if constexpr (ALIGN_EPI) { if (wr == 1) PG8_BAR; }
    }
    PG8_WAIT_V(0);
    if constexpr (!ALIGN_EPI) { if (wr == 0) PG8_BAR; }
    PG8_BAR;
    if constexpr (Epi::AFTER_DRAIN) { E.fused(acc, cur, wr, wc, fr, fq, lds, wid, lane); S.done(cur); }
#undef PG8_SA
#undef PG8_SB
#undef PG8_STAGE
#undef PG8_LDA
#undef PG8_LDB
#undef PG8_MMA
#undef PG8_WAIT_V
#undef PG8_WAIT_L
#undef PG8_BAR
#undef PG8_SCHED
}
}

constexpr int S_ = 16384, DM = 4096, NUP = 8192, NIN = 6144, NMIX = 2048, PLED = 256, DEPTH_ = 4, NCH = S_ / 64;
constexpr float EPS_ = 1e-6f;
constexpr int NWAVES = 8;
constexpr size_t MiB = 1u << 20;
constexpr size_t WS_CTL = 0, CTL_ZERO_BYTES = 1 * MiB;
constexpr size_t WS_RIN = 1 * MiB;
constexpr size_t WS_LAM = 1 * MiB + 65536;
constexpr size_t WS_CHS = 1 * MiB + 131072;
constexpr size_t WS_GPRE = 2 * MiB;
constexpr size_t WS_DN = 3 * MiB;
constexpr size_t WS_NH = 3 * MiB + 524288;
constexpr size_t WS_SSP = 4 * MiB;
constexpr size_t WS_COS = 8 * MiB, WS_SIN = 12 * MiB;
constexpr size_t WS_G1 = 16 * MiB;
constexpr size_t WS_PB = 24 * MiB;
constexpr size_t WS_QKC = 56 * MiB;
constexpr size_t WS_HB = 88 * MiB;
constexpr size_t WS_PROJ = 216 * MiB;
constexpr size_t WS_YMIX = 408 * MiB;
constexpr size_t WS_MIXO = 472 * MiB;
constexpr size_t WS_UP = 600 * MiB;
constexpr size_t WS_ACT = 856 * MiB;
constexpr size_t WS_OD = 984 * MiB;
constexpr size_t WS_DC = 1048 * MiB;
constexpr size_t WS_CH = 1176 * MiB;
constexpr size_t WS_WIN = 1240 * MiB;
constexpr size_t WS_WOUT = 1432 * MiB;
constexpr size_t WS_WUP = 1496 * MiB;
constexpr size_t WS_WDN = 1752 * MiB;
constexpr size_t WS_WPD = 1880 * MiB;
constexpr size_t WS_WPU = 1888 * MiB;
constexpr size_t WS_WPP = 1896 * MiB;
constexpr size_t WS_WG = 1904 * MiB;
constexpr size_t WS_LO = 1905 * MiB;
constexpr size_t WS_END = 2033 * MiB;
constexpr int CW_BAR = 4096;
constexpr int CW_Q = 16384;
constexpr int RING_BYTES = 131072;
constexpr int LDSCTL_OFF = RING_BYTES, MISC_OFF = LDSCTL_OFF + 320;
constexpr int LDS_BYTES = 151552;

#define GAS __attribute__((address_space(1)))
#define LAS __attribute__((address_space(3)))
typedef unsigned short bf16;
typedef unsigned v4u __attribute__((ext_vector_type(4)));
typedef unsigned v2u __attribute__((ext_vector_type(2)));
typedef float f32x4 __attribute__((ext_vector_type(4)));
typedef float f32x16 __attribute__((ext_vector_type(16)));
typedef short bf16x8 __attribute__((ext_vector_type(8)));
typedef short s16x4 __attribute__((ext_vector_type(4)));
typedef GAS unsigned gu32;
#define RLX_AGENT __ATOMIC_RELAXED, __HIP_MEMORY_SCOPE_AGENT
#define LDS_WAIT() asm volatile("s_waitcnt lgkmcnt(0)" ::: "memory")
#define VM_WAIT() asm volatile("s_waitcnt vmcnt(0)" ::: "memory")
__device__ __forceinline__ unsigned pk2(float lo, float hi) { return pg8::cvt_pk_bf16(lo, hi); }
__device__ __forceinline__ unsigned f2bf(float f) { return pg8::cvt_pk_bf16(f, 0.f) & 0xffffu; }
__device__ __forceinline__ float bflo(unsigned w) { return pg8::unpk_lo(w); }
__device__ __forceinline__ float bfhi(unsigned w) { return pg8::unpk_hi(w); }
__device__ __forceinline__ float h2f(unsigned short b) { return pg8::unpk_lo((unsigned)b); }
#define dppf(v, ctrl) __builtin_bit_cast(float, __builtin_amdgcn_update_dpp(0, __builtin_bit_cast(int, (float)(v)), (ctrl), 0xf, 0xf, true))
#define DPP_X1 0xB1
#define DPP_X2 0x4E
#define DPP_HM 0x141
#define DPP_RM 0x140
__device__ __forceinline__ float x16_sum(float v) { auto rr = __builtin_amdgcn_permlane16_swap(__float_as_uint(v), __float_as_uint(v), false, false); return __uint_as_float(rr[0]) + __uint_as_float(rr[1]); }
__device__ __forceinline__ float x16_max(float v) { auto rr = __builtin_amdgcn_permlane16_swap(__float_as_uint(v), __float_as_uint(v), false, false); return fmaxf(__uint_as_float(rr[0]), __uint_as_float(rr[1])); }
__device__ __forceinline__ float swap_sum(float v) { auto rr = __builtin_amdgcn_permlane32_swap(__float_as_uint(v), __float_as_uint(v), false, false); return __uint_as_float(rr[0]) + __uint_as_float(rr[1]); }
__device__ __forceinline__ float swap_max(float v) { auto rr = __builtin_amdgcn_permlane32_swap(__float_as_uint(v), __float_as_uint(v), false, false); return fmaxf(__uint_as_float(rr[0]), __uint_as_float(rr[1])); }
__device__ __forceinline__ float wave_sum(float v) { v += dppf(v, DPP_X1); v += dppf(v, DPP_X2); v += dppf(v, DPP_HM); v += dppf(v, DPP_RM); v = x16_sum(v); return swap_sum(v); }
__device__ __forceinline__ float wave_max(float v) { v = fmaxf(v, dppf(v, DPP_X1)); v = fmaxf(v, dppf(v, DPP_X2)); v = fmaxf(v, dppf(v, DPP_HM)); v = fmaxf(v, dppf(v, DPP_RM)); v = x16_max(v); return swap_max(v); }
__device__ __forceinline__ int crow(int r, int hi) { return (r & 3) + 8 * (r >> 2) + 4 * hi; }
#define KSWZ(row, colB) ((row) * 256 + ((colB) ^ (((row) & 15) << 4)))
#define TRRD(dst, base, off) asm volatile("ds_read_b64_tr_b16 %0, %1 offset:%2" : "=&v"(dst) : "v"(base), "i"(off) : "memory")
__device__ __forceinline__ bf16x8 mk8(s16x4 l, s16x4 h) { return (bf16x8){l[0], l[1], l[2], l[3], h[0], h[1], h[2], h[3]}; }
__device__ __forceinline__ bf16x8 pack8f(const float* p) { v4u w; w.x = pk2(p[0], p[1]); w.y = pk2(p[2], p[3]); w.z = pk2(p[4], p[5]); w.w = pk2(p[6], p[7]); return __builtin_bit_cast(bf16x8, w); }

#define XB_TMO      128
#define XB_XCNT(j)  (256  + 64 * (j))
#define XB_XSUB(j)  (1280 + 64 * (j))
#define XB_XGEN(j)  (2304 + 64 * (j))
#define XB_TOP      3328
#define XB_TOPGEN   3392
#define XCD_BAR_WORDS 3456
#define XB_SPIN_CAP (1u << 18)

__device__ __forceinline__ unsigned xb_ld(unsigned* p)              { return __hip_atomic_load(p, __ATOMIC_RELAXED, __HIP_MEMORY_SCOPE_AGENT); }
__device__ __forceinline__ unsigned xb_add(unsigned* p, unsigned v) { return __hip_atomic_fetch_add(p, v, __ATOMIC_RELAXED, __HIP_MEMORY_SCOPE_AGENT); }
__device__ __forceinline__ unsigned xb_xcc_id() { return (unsigned)__builtin_amdgcn_s_getreg((3 << 11) | 20) & 0xFu; }
#define XB_SPIN(cond, bar) do { unsigned _sp = 0; while (cond) { __builtin_amdgcn_s_sleep(1); \
    if ((++_sp & 255u) == 0u) { if (xb_ld(&(bar)[XB_TMO])) break; if (_sp > XB_SPIN_CAP) { atomicAdd(&(bar)[XB_TMO], 1u); break; } } } } while (0)

struct XcdBarrier {
    unsigned* bar; unsigned x;
    volatile LAS unsigned* st;
};

__device__ __forceinline__ XcdBarrier xcd_barrier_post(unsigned* bar, volatile LAS unsigned* st) {
    XcdBarrier b; b.bar = bar; b.x = xb_xcc_id(); b.st = st;
    if (threadIdx.x == 0) (void)xb_add(&bar[XB_XCNT(b.x)], 1u);
    return b;
}
__device__ __forceinline__ void xcd_barrier_complete(unsigned* bar, unsigned x, unsigned& nloc, unsigned& nx) {
    const unsigned G = gridDim.x * gridDim.y * gridDim.z;
    unsigned sum, cnt, mine, sp = 0u;
    for (;;) {
        sum = 0u; cnt = 0u; mine = 0u;
#pragma unroll
        for (unsigned j = 0; j < 16; ++j) { const unsigned c = xb_ld(&bar[XB_XCNT(j)]); sum += c; cnt += (c > 0u) ? 1u : 0u; mine = (j == x) ? c : mine; }
        if (sum == G) break;
        __builtin_amdgcn_s_sleep(1);
        if ((++sp & 255u) == 0u) { if (xb_ld(&bar[XB_TMO])) break; if (sp > XB_SPIN_CAP) { atomicAdd(&bar[XB_TMO], 1u); break; } }
    }
    nloc = mine > 0u ? mine : 1u; nx = cnt > 0u ? cnt : 1u;
}

__device__ __forceinline__ void xcd_barrier(const XcdBarrier& b) {
    asm volatile("s_waitcnt vmcnt(0)" ::: "memory");
    __syncthreads();
    if (threadIdx.x == 0) {
        unsigned* bar = b.bar;
        __builtin_amdgcn_s_waitcnt(0);
        unsigned nloc = b.st[0], nx = b.st[1];
        if (nloc == 0u) { xcd_barrier_complete(bar, b.x, nloc, nx); b.st[0] = nloc; b.st[1] = nx; }
        const unsigned old = xb_add(&bar[XB_XSUB(b.x)], 1u);
        const unsigned gen = old / nloc;
        if (old + 1u == (gen + 1u) * nloc) {
            __builtin_amdgcn_fence(__ATOMIC_RELEASE, "agent");
            asm volatile("s_waitcnt vmcnt(0)" ::: "memory");
            const unsigned og = xb_add(&bar[XB_TOP], 1u);
            const unsigned tg = og / nx;
            if (og + 1u == (tg + 1u) * nx) xb_add(&bar[XB_TOPGEN], 1u);
            else XB_SPIN(xb_ld(&bar[XB_TOPGEN]) == tg, bar);
            __builtin_amdgcn_fence(__ATOMIC_ACQUIRE, "agent");
            xb_add(&bar[XB_XGEN(b.x)], 1u);
            asm volatile("s_waitcnt vmcnt(0)" ::: "memory");
        } else {
            XB_SPIN(xb_ld(&bar[XB_XGEN(b.x)]) == gen, bar);
            __builtin_amdgcn_fence(__ATOMIC_ACQUIRE, "agent");
            asm volatile("s_waitcnt vmcnt(0)" ::: "memory");
        }
    }
    __syncthreads();
}

#ifndef DBG_PERTURB
#define DBG_PERTURB 0
#endif
struct Params { const float* in[26]; float* out; unsigned char* ws; int ph_lo, ph_hi, pert, pad; };
enum { I_X = 0, I_P, I_WINE, I_WOUTE, I_DLAM, I_GDIFF, I_WCQK, I_BCQK, I_BIG, I_BFG, I_GML, I_WINO, I_WOUTO, I_GRET, I_GMPRE, I_GMPOST, I_GFPRE, I_GFPOST, I_WUP, I_WFC, I_BFC, I_WDN, I_GPLE, I_WPD, I_WPU, I_WPP };

typedef const __attribute__((address_space(4))) Params* KParams;
struct Frame {
    LAS unsigned char* lds;
    int tid, lane, wave, G, bid;
};
#define LANE_ID_ASM() ({ int l__; asm volatile("v_mbcnt_lo_u32_b32 %0, -1, 0\n\tv_mbcnt_hi_u32_b32 %0, -1, %0 ; LANE_ID" : "=v"(l__)); l__; })
#define PHASE_ENTRY(F) Frame F = F##_in; { const int l_ = LANE_ID_ASM(); F.lane = l_; F.tid = F.wave * 64 + l_; }

__device__ __forceinline__ void p0_transpose_item(const float* W, int ldw, int K, int N, bf16* WT, const float* gain, int rope_cols, LAS float* scr, int item, int lane) {
    const int nblk = N / 64, kb = item / nblk, nb = item % nblk, k0 = 64 * kb, n0 = 64 * nb;
    const int r4 = lane >> 4, q = lane & 15;
    int lcol, pbase, pstep;
    if (n0 < rope_cols) { const int hb = n0 & ~127, run = q >> 3, i4 = (q & 7) * 4; lcol = hb + run * 64 + ((n0 & 127) >> 1) + i4; pbase = 2 * i4 + run; pstep = 2; }
    else { lcol = n0 + 4 * q; pbase = 4 * q; pstep = 1; }
    f32x4 v[16];
#pragma unroll
    for (int i = 0; i < 16; ++i) v[i] = *(const f32x4*)(W + (size_t)(k0 + 4 * i + r4) * ldw + lcol);
#pragma unroll
    for (int i = 0; i < 16; ++i) { const int kk = 4 * i + r4; const float g = gain ? gain[k0 + kk] : 1.f; LAS float* d = scr + kk * 64;
        d[(pbase + kk) & 63] = v[i][0] * g; d[(pbase + pstep + kk) & 63] = v[i][1] * g; d[(pbase + 2 * pstep + kk) & 63] = v[i][2] * g; d[(pbase + 3 * pstep + kk) & 63] = v[i][3] * g; }
    LDS_WAIT(); asm volatile("" ::: "memory");
    const int c = lane & 7;
#pragma unroll
    for (int jq = 0; jq < 8; ++jq) { const int n = (lane >> 3) + 8 * jq; const LAS float* s = scr + (8 * c) * 64; const int nc = n + 8 * c;
        v4u o; o.x = pk2(s[0 * 64 + ((nc + 0) & 63)], s[1 * 64 + ((nc + 1) & 63)]); o.y = pk2(s[2 * 64 + ((nc + 2) & 63)], s[3 * 64 + ((nc + 3) & 63)]);
        o.z = pk2(s[4 * 64 + ((nc + 4) & 63)], s[5 * 64 + ((nc + 5) & 63)]); o.w = pk2(s[6 * 64 + ((nc + 6) & 63)], s[7 * 64 + ((nc + 7) & 63)]);
        *(GAS v4u*)(WT + (size_t)(n0 + n) * K + k0 + 8 * c) = o; }
    LDS_WAIT(); asm volatile("" ::: "memory");
}
__device__ __forceinline__ void p0_prologue(const Frame& F_in, KParams P) { PHASE_ENTRY(F);
    unsigned char* ws = P->ws;
    LAS float* scr = (LAS float*)(F.lds + F.wave * 16384);
    const int gw = F.bid * NWAVES + F.wave, NGW = F.G * NWAVES;
    constexpr int I_IN = 64 * 96, I_OUT = 32 * 64, I_UP = 64 * 128, I_DN = 64 * 64, I_PD = 64 * 4, I_PU = 4 * 64, I_PP = 4 * 64;
    constexpr int I_LAYER = I_IN + I_OUT + I_UP + I_DN + I_PD + I_PU + I_PP;
    for (int it = gw; it < DEPTH_ * I_LAYER; it += NGW) {
        const int L = it / I_LAYER; int r = it - L * I_LAYER; const int j = L >> 1; const bool ev = (L & 1) == 0;
        if (r < I_IN) { const float* W = ev ? P->in[I_WINE] + (size_t)j * DM * 6152 : P->in[I_WINO] + (size_t)j * DM * 6144;
            p0_transpose_item(W, ev ? 6152 : 6144, DM, NIN, (bf16*)(ws + WS_WIN) + (size_t)L * NIN * DM, P->in[I_GMPRE] + (size_t)L * DM, ev ? 2048 : 1024, scr, r, F.lane); continue; } r -= I_IN;
        if (r < I_OUT) { const float* W = (ev ? P->in[I_WOUTE] : P->in[I_WOUTO]) + (size_t)j * NMIX * DM;
            p0_transpose_item(W, DM, NMIX, DM, (bf16*)(ws + WS_WOUT) + (size_t)L * DM * NMIX, nullptr, 0, scr, r, F.lane); continue; } r -= I_OUT;
        if (r < I_UP) { p0_transpose_item(P->in[I_WUP] + (size_t)L * DM * NUP, NUP, DM, NUP, (bf16*)(ws + WS_WUP) + (size_t)L * NUP * DM, P->in[I_GFPRE] + (size_t)L * DM, 0, scr, r, F.lane); continue; } r -= I_UP;
        if (r < I_DN) { p0_transpose_item(P->in[I_WDN] + (size_t)L * DM * DM, DM, DM, DM, (bf16*)(ws + WS_WDN) + (size_t)L * DM * DM, nullptr, 0, scr, r, F.lane); continue; } r -= I_DN;
        if (r < I_PD) { p0_transpose_item(P->in[I_WPD] + (size_t)L * DM * PLED, PLED, DM, PLED, (bf16*)(ws + WS_WPD) + (size_t)L * PLED * DM, P->in[I_GPLE] + (size_t)L * DM, 0, scr, r, F.lane); continue; } r -= I_PD;
        if (r < I_PU) { p0_transpose_item(P->in[I_WPU] + (size_t)L * PLED * DM, DM, PLED, DM, (bf16*)(ws + WS_WPU) + (size_t)L * DM * PLED, nullptr, 0, scr, r, F.lane); continue; } r -= I_PU;
        p0_transpose_item(P->in[I_WPP] + (size_t)L * PLED * DM, DM, PLED, DM, (bf16*)(ws + WS_WPP) + (size_t)L * DM * PLED, nullptr, 0, scr, r, F.lane);
    }
    { const int l2_ = LANE_ID_ASM(); F.lane = l2_; F.tid = F.wave * 64 + l2_; }
    const int gt = F.bid * (NWAVES * 64) + F.tid, NGT = F.G * NWAVES * 64;
    for (int e = gt; e < 2 * DM; e += NGT) { const int j = e / DM, k = e - j * DM; const float g = P->in[I_GMPRE][(size_t)(2 * j) * DM + k]; const float* w = P->in[I_WINE] + ((size_t)j * DM + k) * 6152 + 6144;
        bf16* o = (bf16*)(ws + WS_WG) + (size_t)j * 8 * DM + k;
#pragma unroll
        for (int c = 0; c < 8; ++c) o[(size_t)c * DM] = (bf16)f2bf(g * w[c]); }
    for (size_t e = gt; e < (size_t)DEPTH_ * S_ * PLED / 8; e += NGT) { const f32x4 a = *(const f32x4*)(P->in[I_P] + e * 8), b = *(const f32x4*)(P->in[I_P] + e * 8 + 4);
        v4u o; o.x = pk2(a[0], a[1]); o.y = pk2(a[2], a[3]); o.z = pk2(b[0], b[1]); o.w = pk2(b[2], b[3]); *(v4u*)((bf16*)(ws + WS_PB) + e * 8) = o; }
    for (int e = gt; e < S_ * 64; e += NGT) { const int t = e >> 6, i = e & 63;
        const float finv = (float)exp2(-(double)i * (13.287712379549449 / 64.0)); const float ang = (float)t * finv; const double ad = (double)ang;
        const double n = rint(ad * 0.63661977236758134308); const double r = (ad - n * 1.57079632679489655800e+00) - n * 6.12323399573676603587e-17; const double r2 = r * r;
        double sn = r * (1.0 + r2 * (-1.0 / 6 + r2 * (1.0 / 120 + r2 * (-1.0 / 5040 + r2 * (1.0 / 362880 + r2 * (-1.0 / 39916800 + r2 * (1.0 / 6227020800.0)))))));
        double cs = 1.0 + r2 * (-0.5 + r2 * (1.0 / 24 + r2 * (-1.0 / 720 + r2 * (1.0 / 40320 + r2 * (-1.0 / 3628800 + r2 * (1.0 / 479001600.0))))));
        const int q = ((int)n) & 3; double c2 = cs, s2 = sn; if (q == 1) { c2 = -sn; s2 = cs; } else if (q == 2) { c2 = -cs; s2 = -sn; } else if (q == 3) { c2 = sn; s2 = -cs; }
        ((float*)(ws + WS_COS))[e] = (float)c2; ((float*)(ws + WS_SIN))[e] = (float)s2; }
    if (F.bid == 0 && F.wave == 0) {
        for (int j = 0; j < 2; ++j) { const float* lp = P->in[I_DLAM] + (size_t)j * 512; const int d = F.lane * 2;
            const float s1 = wave_sum(lp[d] * lp[128 + d] + lp[d + 1] * lp[128 + d + 1]), s2 = wave_sum(lp[256 + d] * lp[384 + d] + lp[256 + d + 1] * lp[384 + d + 1]);
            const float li = 0.8f - 0.6f * expf(-0.3f * (float)(2 * j));
            if (F.lane == 0) { ((float*)(ws + WS_LAM))[2 * j] = expf(s1) - expf(s2) + li; ((float*)(ws + WS_LAM))[2 * j + 1] = li; } }
    }
    for (int row = gw; row < S_; row += NGW) { const float* xr = P->in[I_X] + (size_t)row * DM; bf16* hr = (bf16*)(ws + WS_HB) + (size_t)row * DM; float ss = 0.f;
#pragma unroll
        for (int jj = 0; jj < 8; ++jj) { const int c = (jj * 64 + F.lane) * 8; const f32x4 a = *(const f32x4*)(xr + c), b = *(const f32x4*)(xr + c + 4);
            ss += (a[0] * a[0] + a[1] * a[1]) + (a[2] * a[2] + a[3] * a[3]) + (b[0] * b[0] + b[1] * b[1]) + (b[2] * b[2] + b[3] * b[3]);
            f32x4 a2 = a, b2 = b;
#if DBG_PERTURB
            if (P->pert) { for (int q = 0; q < 4; ++q) { unsigned hx = (unsigned)(row * 4096 + c + q) * 2654435761u; hx ^= hx >> 15; a2[q] *= 1.f + ((float)(hx & 1023u) - 511.5f) * 2e-6f; hx = (unsigned)(row * 4096 + c + 4 + q) * 2654435761u; hx ^= hx >> 15; b2[q] *= 1.f + ((float)(hx & 1023u) - 511.5f) * 2e-6f; } }
#endif
            v4u o; o.x = pk2(a2[0], a2[1]); o.y = pk2(a2[2], a2[3]); o.z = pk2(b2[0], b2[1]); o.w = pk2(b2[2], b2[3]); *(v4u*)(hr + c) = o; }
        const float tot = wave_sum(ss); if (F.lane == 0) ((float*)(ws + WS_RIN))[row] = rsqrtf(tot * (1.f / DM) + EPS_); }
}

__device__ __forceinline__ void gates_pass(const Frame& F_in, const bf16* hb, const bf16* wg, const float* rin, float* gpre) { PHASE_ENTRY(F);
    const int gw = F.bid * NWAVES + F.wave, NGW = F.G * NWAVES;
    for (int rg = gw; rg < S_ / 8; rg += NGW) { const int t0 = rg * 8;
        float acc[8][8];
#pragma unroll
        for (int a = 0; a < 8; ++a)
#pragma unroll
            for (int b = 0; b < 8; ++b) acc[a][b] = 0.f;
        for (int jj = 0; jj < 8; ++jj) { const int k = (jj * 64 + F.lane) * 8;
            v4u w[8];
#pragma unroll
            for (int c = 0; c < 8; ++c) w[c] = *(const v4u*)(wg + (size_t)c * DM + k);
#pragma unroll
            for (int r = 0; r < 8; ++r) { const v4u x = *(const v4u*)(hb + (size_t)(t0 + r) * DM + k);
#pragma unroll
                for (int c = 0; c < 8; ++c) acc[r][c] += (bflo(x.x) * bflo(w[c].x) + bfhi(x.x) * bfhi(w[c].x)) + (bflo(x.y) * bflo(w[c].y) + bfhi(x.y) * bfhi(w[c].y))
                                                        + (bflo(x.z) * bflo(w[c].z) + bfhi(x.z) * bfhi(w[c].z)) + (bflo(x.w) * bflo(w[c].w) + bfhi(x.w) * bfhi(w[c].w)); } }
        float mine = 0.f;
#pragma unroll
        for (int r = 0; r < 8; ++r)
#pragma unroll
            for (int c = 0; c < 8; ++c) { const float s = wave_sum(acc[r][c]); if (F.lane == r * 8 + c) mine = s; }
        gpre[(size_t)t0 * 8 + F.lane] = mine * rin[t0 + (F.lane >> 3)]; }
}
__device__ __forceinline__ void resid_pass(const Frame& F_in, const float* hin32, const bf16* y, const float* ssp, const float* g, bf16* hi, bf16* lo, float* rout) { PHASE_ENTRY(F);
    const int gw = F.bid * NWAVES + F.wave, NGW = F.G * NWAVES;
    for (int row = gw; row < S_; row += NGW) {
        const float ry = rsqrtf(wave_sum(ssp[(size_t)row * 64 + F.lane]) * (1.f / DM) + EPS_);
        const bf16* yr = y + (size_t)row * DM; bf16* hir = hi + (size_t)row * DM; bf16* lor = lo + (size_t)row * DM; float ss = 0.f;
#pragma unroll
        for (int jj = 0; jj < 8; ++jj) { const int c = (jj * 64 + F.lane) * 8; float hv[8];
            if (hin32) { const f32x4 a = *(const f32x4*)(hin32 + (size_t)row * DM + c), b = *(const f32x4*)(hin32 + (size_t)row * DM + c + 4); hv[0] = a[0]; hv[1] = a[1]; hv[2] = a[2]; hv[3] = a[3]; hv[4] = b[0]; hv[5] = b[1]; hv[6] = b[2]; hv[7] = b[3]; }
            else { const v4u h1 = *(const v4u*)(hir + c); v4u l1 = {0u, 0u, 0u, 0u}; if (RES_LO) l1 = *(const v4u*)(lor + c);
                hv[0] = bflo(h1.x) + bflo(l1.x); hv[1] = bfhi(h1.x) + bfhi(l1.x); hv[2] = bflo(h1.y) + bflo(l1.y); hv[3] = bfhi(h1.y) + bfhi(l1.y);
                hv[4] = bflo(h1.z) + bflo(l1.z); hv[5] = bfhi(h1.z) + bfhi(l1.z); hv[6] = bflo(h1.w) + bflo(l1.w); hv[7] = bfhi(h1.w) + bfhi(l1.w); }
            const v4u yv = *(const v4u*)(yr + c); const f32x4 ga = *(const f32x4*)(g + c), gb = *(const f32x4*)(g + c + 4);
            hv[0] += bflo(yv.x) * ry * ga[0]; hv[1] += bfhi(yv.x) * ry * ga[1]; hv[2] += bflo(yv.y) * ry * ga[2]; hv[3] += bfhi(yv.y) * ry * ga[3];
            hv[4] += bflo(yv.z) * ry * gb[0]; hv[5] += bfhi(yv.z) * ry * gb[1]; hv[6] += bflo(yv.w) * ry * gb[2]; hv[7] += bfhi(yv.w) * ry * gb[3];
#pragma unroll
            for (int q = 0; q < 8; ++q) ss += hv[q] * hv[q];
            v4u oh; oh.x = pk2(hv[0], hv[1]); oh.y = pk2(hv[2], hv[3]); oh.z = pk2(hv[4], hv[5]); oh.w = pk2(hv[6], hv[7]);
            v4u ol; ol.x = pk2(hv[0] - bflo(oh.x), hv[1] - bfhi(oh.x)); ol.y = pk2(hv[2] - bflo(oh.y), hv[3] - bfhi(oh.y)); ol.z = pk2(hv[4] - bflo(oh.z), hv[5] - bfhi(oh.z)); ol.w = pk2(hv[6] - bflo(oh.w), hv[7] - bfhi(oh.w));
            *(v4u*)(hir + c) = oh; if (RES_LO) *(v4u*)(lor + c) = ol; }
        const float tot = wave_sum(ss); if (F.lane == 0) rout[row] = rsqrtf(tot * (1.f / DM) + EPS_); }
}
__device__ __forceinline__ void rin_pass(const Frame& F_in, const float* ssp, float* rout) { PHASE_ENTRY(F);
    const int gw = F.bid * NWAVES + F.wave, NGW = F.G * NWAVES;
    for (int row = gw; row < S_; row += NGW) { const float tot = wave_sum(ssp[(size_t)row * 64 + F.lane]); if (F.lane == 0) rout[row] = rsqrtf(tot * (1.f / DM) + EPS_); }
}
__device__ __forceinline__ void pled_combine(const Frame& F_in, const bf16* part, const float* rin, bf16* g1) { PHASE_ENTRY(F);
    const int gt = F.bid * (NWAVES * 64) + F.tid, NGT = F.G * NWAVES * 64;
    for (int it = gt; it < S_ * PLED / 8; it += NGT) { const int row = it >> 5; const size_t o = (size_t)it * 8; const float r = rin[row];
        float a[8] = {0.f, 0.f, 0.f, 0.f, 0.f, 0.f, 0.f, 0.f};
#pragma unroll
        for (int w = 0; w < 4; ++w) { const v4u x = *(const v4u*)(part + (size_t)w * S_ * PLED + o);
            a[0] += bflo(x.x); a[1] += bfhi(x.x); a[2] += bflo(x.y); a[3] += bfhi(x.y); a[4] += bflo(x.z); a[5] += bfhi(x.z); a[6] += bflo(x.w); a[7] += bfhi(x.w); }
        v4u ov; ov.x = pk2(a[0] * r, a[1] * r); ov.y = pk2(a[2] * r, a[3] * r); ov.z = pk2(a[4] * r, a[5] * r); ov.w = pk2(a[6] * r, a[7] * r);
        *(v4u*)(g1 + o) = ov; }
}
__device__ __forceinline__ float gelu_tanh(float x) { const float u = 0.7978845608028654f * (x + 0.044715f * x * x * x); return x * __builtin_amdgcn_rcpf(1.f + __expf(-2.f * u)); }
__device__ __forceinline__ void convffn_pass(const Frame& F_in, const bf16* up, const float* wc, const float* bc, bf16* act) { PHASE_ENTRY(F);
    const int c0 = F.tid * 8;
    float wa[3][8], wb[3][8], ba[8], bb[8];
#pragma unroll
    for (int k = 0; k < 3; ++k)
#pragma unroll
        for (int e = 0; e < 8; ++e) { wa[k][e] = wc[(size_t)k * NUP + c0 + e]; wb[k][e] = wc[(size_t)k * NUP + 4096 + c0 + e]; }
#pragma unroll
    for (int e = 0; e < 8; ++e) { ba[e] = bc[c0 + e]; bb[e] = bc[4096 + c0 + e]; }
    for (int rb = F.bid; rb < S_ / 64; rb += F.G) { const int t0 = rb * 64;
        v4u a2 = (v4u){0u, 0u, 0u, 0u}, a1 = a2, b2 = a2, b1 = a2;
        if (t0 > 0) { a2 = *(const v4u*)(up + (size_t)(t0 - 2) * NUP + c0); b2 = *(const v4u*)(up + (size_t)(t0 - 2) * NUP + 4096 + c0);
                      a1 = *(const v4u*)(up + (size_t)(t0 - 1) * NUP + c0); b1 = *(const v4u*)(up + (size_t)(t0 - 1) * NUP + 4096 + c0); }
        for (int tg = t0; tg < t0 + 64; tg += 4) { v4u an[4], bn[4];
#pragma unroll
          for (int i = 0; i < 4; ++i) { an[i] = *(const v4u*)(up + (size_t)(tg + i) * NUP + c0); bn[i] = *(const v4u*)(up + (size_t)(tg + i) * NUP + 4096 + c0); }
#pragma unroll
          for (int i = 0; i < 4; ++i) { const int t = tg + i; const v4u a0 = an[i], b0 = bn[i];
            float o[8];
            const unsigned A2[4] = {a2.x, a2.y, a2.z, a2.w}, A1[4] = {a1.x, a1.y, a1.z, a1.w}, A0[4] = {a0.x, a0.y, a0.z, a0.w};
            const unsigned B2[4] = {b2.x, b2.y, b2.z, b2.w}, B1[4] = {b1.x, b1.y, b1.z, b1.w}, B0[4] = {b0.x, b0.y, b0.z, b0.w};
#pragma unroll
            for (int e = 0; e < 8; ++e) { const int q = e >> 1; const bool hi = e & 1;
                const float xa2 = hi ? bfhi(A2[q]) : bflo(A2[q]), xa1 = hi ? bfhi(A1[q]) : bflo(A1[q]), xa0 = hi ? bfhi(A0[q]) : bflo(A0[q]);
                const float xb2 = hi ? bfhi(B2[q]) : bflo(B2[q]), xb1 = hi ? bfhi(B1[q]) : bflo(B1[q]), xb0 = hi ? bfhi(B0[q]) : bflo(B0[q]);
                const float ya = ba[e] + wa[0][e] * xa2 + wa[1][e] * xa1 + wa[2][e] * xa0, yb = bb[e] + wb[0][e] * xb2 + wb[1][e] * xb1 + wb[2][e] * xb0;
                o[e] = gelu_tanh(ya) * yb; }
            v4u ov; ov.x = pk2(o[0], o[1]); ov.y = pk2(o[2], o[3]); ov.z = pk2(o[4], o[5]); ov.w = pk2(o[6], o[7]);
            *(v4u*)(act + (size_t)t * DM + c0) = ov;
            a2 = a1; a1 = a0; b2 = b1; b1 = b0; } } }
}
__device__ __forceinline__ void diffcomb_pass(const Frame& F_in, const bf16* od, const float* g, const float* lamv, bf16* ymix) { PHASE_ENTRY(F);
    const int gw = F.bid * NWAVES + F.wave, NGW = F.G * NWAVES; const float lam = lamv[0], sc = 1.f - lamv[1];
    const f32x4 g4 = *(const f32x4*)(g + F.lane * 4);
    for (int it = gw; it < S_ * 4; it += NGW) { const int t = it >> 2, h = it & 3;
        const v2u a = *(const v2u*)(od + ((size_t)t * 8 + 2 * h) * 256 + F.lane * 4), b = *(const v2u*)(od + ((size_t)t * 8 + 2 * h + 1) * 256 + F.lane * 4);
        f32x4 d; d[0] = bflo(a.x) - lam * bflo(b.x); d[1] = bfhi(a.x) - lam * bfhi(b.x); d[2] = bflo(a.y) - lam * bflo(b.y); d[3] = bfhi(a.y) - lam * bfhi(b.y);
        const float r = rsqrtf(wave_sum((d[0] * d[0] + d[1] * d[1]) + (d[2] * d[2] + d[3] * d[3])) * (1.f / 256.f) + EPS_) * sc;
        v2u o; o.x = pk2(d[0] * r * g4[0], d[1] * r * g4[1]); o.y = pk2(d[2] * r * g4[2], d[3] * r * g4[3]);
        *(v2u*)(ymix + (size_t)t * NMIX + h * 256 + F.lane * 4) = o; }
}

constexpr int AT_KT = 16384, AT_NVS = 3;
constexpr float AT_C2 = 0.08838834764831845f * 1.4426950408889634f;
template <int MODE, int NV, int GRP, int ABL = 0>
__device__ __forceinline__ void attn_unit(LAS unsigned char* lds, int wave_in, const bf16* Qp, const bf16* Kp, const bf16* Vp, int ldp, int qb, bf16* Op, int ldo) {
    constexpr bool LAG = GRP != 0, grpB = GRP == 2;
    constexpr bool KSM = (MODE == 0 && NV == 2 && GRP == 1 && ABL == 0);
    constexpr int AT_KB = AT_NVS * (64 * (256 * NV + 64)), AT_KS = (NV == 2) ? 22528 : AT_KT;
    static_assert(NV != 2 || (AT_KB + AT_KT <= LDSCTL_OFF && AT_KB + AT_KS >= LDSCTL_OFF + 2048 && AT_KB + AT_KS + AT_KT <= LDS_BYTES), "LDS map");
    constexpr int AT_VSTR = 256 * NV + 64, AT_VT = 64 * AT_VSTR;
    const int lane_o = LANE_ID_ASM();
    const int wid = wave_in, lane = lane_o, tid = wid * 64 + lane, r32 = lane & 31, hi = lane >> 5;
    const int P0 = qb * 256, qrow = P0 + 32 * wid + r32, jd = (P0 + 32 * wid) >> 6, NT = 4 * qb + 4;
    bf16x8 qr[8];
#pragma unroll
    for (int s = 0; s < 8; ++s) qr[s] = *(const bf16x8*)(Qp + (size_t)qrow * ldp + 16 * s + 8 * hi);
    const unsigned ldsb = (unsigned)(uintptr_t)lds;
    const unsigned vrb = ldsb + (unsigned)((4 * hi + ((lane >> 2) & 3)) * AT_VSTR + (16 * ((lane >> 4) & 1) + 4 * (lane & 3)) * 2);
    constexpr int NPV = AT_VT / 1024, NPW = (NPV + 7) / 8, VCH = AT_VSTR / 16;
    unsigned kof[2], vof[NPW];
#pragma unroll
    for (int i = 0; i < 2; ++i) { const int rr = 4 * i + (lane >> 4); kof[i] = (unsigned)((8 * wid + rr) * ldp + (((lane & 15) ^ ((8 * wid + rr) & 15)) * 8)) * 2u; }
#pragma unroll
    for (int i = 0; i < NPW; ++i) { const int u = (wid + 8 * i) * 64 + lane, row = u / VCH, cc = u - row * VCH; vof[i] = (unsigned)(row * ldp) * 2u + (unsigned)((cc < 16 * NV ? cc : 0) * 16); }
#define AT_DMAK(j, sl) do { const char* g_ = (const char*)(Kp + (size_t)(j) * 64 * ldp); _Pragma("unroll") for (int i_ = 0; i_ < 2; ++i_) \
        __builtin_amdgcn_global_load_lds((const unsigned*)(g_ + kof[i_]), (LAS unsigned*)(lds + AT_KB + (sl) * AT_KS + (2 * wid + i_) * 1024), 16, 0, 0); } while (0)
#define AT_DMAV(j, sl) do { const char* g_ = (const char*)(Vp + (size_t)(j) * 64 * ldp); _Pragma("unroll") for (int i_ = 0; i_ < NPW; ++i_) if (wid + 8 * i_ < NPV) \
        __builtin_amdgcn_global_load_lds((const unsigned*)(g_ + vof[i_]), (LAS unsigned*)(lds + (sl) * AT_VT + (wid + 8 * i_) * 1024), 16, 0, 0); } while (0)
#define AT_JT(t) (MODE == 0 ? (t) : NT - 1 - (t))
    f32x16 o[4 * NV];
#pragma unroll
    for (int d = 0; d < 4 * NV; ++d)
#pragma unroll
        for (int r = 0; r < 16; ++r) o[d][r] = 0.f;
    float m_run = -1e30f, l_run = 0.f, carry = 1.f;
    volatile LAS float* cmx = (volatile LAS float*)(lds + LDSCTL_OFF + 1024);
    __syncthreads();
    AT_DMAK(AT_JT(0), 0); AT_DMAV(AT_JT(0), 0);
    VM_WAIT();
    __syncthreads();
#define AT_KRD(i) asm volatile("ds_read_b128 %0, %1 offset:%2" : "=&v"(kq[i]) : "v"(kb[(i) >> 1]), "i"(((i) & 1) * 32 * 256) : "memory")
#define AT_KWT(i, N) asm volatile("s_waitcnt lgkmcnt(" #N ")" : "+v"(kq[i]) :: "memory")
#define AT_KMM(i) do { if ((i) & 1) p1 = MFMA32(kq[i], qr[(i) >> 1], p1); else p0 = MFMA32(kq[i], qr[(i) >> 1], p0); __builtin_amdgcn_sched_barrier(0); } while (0)
#define AT_QK(bb) do { \
        unsigned kb[8];                             \
        { int rl = lane; asm volatile("" : "+v"(rl)); const int r32b = rl & 31, hib = rl >> 5; \
          _Pragma("unroll") for (int dd = 0; dd < 8; ++dd) kb[dd] = ldsb + (unsigned)(AT_KB + (bb) * AT_KS + KSWZ(r32b, (dd * 16 + hib * 8) * 2)); } \
        bf16x8 kq[16]; \
        AT_KRD(0); AT_KRD(1); AT_KRD(2); AT_KRD(3); AT_KRD(4); AT_KRD(5); \
        AT_KRD(6); AT_KWT(0, 6); AT_KMM(0); AT_KRD(7); AT_KWT(1, 6); AT_KMM(1); AT_KRD(8); AT_KWT(2, 6); AT_KMM(2); AT_KRD(9); AT_KWT(3, 6); AT_KMM(3); \
        AT_KRD(10); AT_KWT(4, 6); AT_KMM(4); AT_KRD(11); AT_KWT(5, 6); AT_KMM(5); AT_KRD(12); AT_KWT(6, 6); AT_KMM(6); AT_KRD(13); AT_KWT(7, 6); AT_KMM(7); \
        AT_KRD(14); AT_KWT(8, 6); AT_KMM(8); AT_KRD(15); AT_KWT(9, 6); AT_KMM(9); AT_KWT(10, 5); AT_KMM(10); AT_KWT(11, 4); AT_KMM(11); \
        AT_KWT(12, 3); AT_KMM(12); AT_KWT(13, 2); AT_KMM(13); AT_KWT(14, 1); AT_KMM(14); AT_KWT(15, 0); AT_KMM(15); } while (0)
#define AT_RD(d0, L0, H0, L1, H1, L2, H2, L3, H3) do { TRRD(L0, vb, 0 * 16 * AT_VSTR + (d0) * 64); TRRD(H0, vb, (0 * 16 + 8) * AT_VSTR + (d0) * 64); TRRD(L1, vb, 1 * 16 * AT_VSTR + (d0) * 64); TRRD(H1, vb, (1 * 16 + 8) * AT_VSTR + (d0) * 64); \
        TRRD(L2, vb, 2 * 16 * AT_VSTR + (d0) * 64); TRRD(H2, vb, (2 * 16 + 8) * AT_VSTR + (d0) * 64); TRRD(L3, vb, 3 * 16 * AT_VSTR + (d0) * 64); TRRD(H3, vb, (3 * 16 + 8) * AT_VSTR + (d0) * 64); } while (0)
#define AT_WT(N, L0, H0, L1, H1, L2, H2, L3, H3) asm volatile("s_waitcnt lgkmcnt(" #N ")" : "+v"(L0), "+v"(H0), "+v"(L1), "+v"(H1), "+v"(L2), "+v"(H2), "+v"(L3), "+v"(H3) :: "memory")
#define AT_MM(d0, L0, H0, L1, H1, L2, H2, L3, H3) do { o[d0] = MFMA32(mk8(L0, H0), pk[0], o[d0]); o[d0] = MFMA32(mk8(L1, H1), pk[1], o[d0]); o[d0] = MFMA32(mk8(L2, H2), pk[2], o[d0]); o[d0] = MFMA32(mk8(L3, H3), pk[3], o[d0]); } while (0)
#define AT_RDA(d0) AT_RD(d0, a0, a1, a2, a3, a4, a5, a6, a7)
#define AT_RDB(d0) AT_RD(d0, b0, b1, b2, b3, b4, b5, b6, b7)
#define AT_WTA(N) AT_WT(N, a0, a1, a2, a3, a4, a5, a6, a7)
#define AT_WTB(N) AT_WT(N, b0, b1, b2, b3, b4, b5, b6, b7)
#define AT_MMA(d0) AT_MM(d0, a0, a1, a2, a3, a4, a5, a6, a7)
#define AT_MMB(d0) AT_MM(d0, b0, b1, b2, b3, b4, b5, b6, b7)
#define AT_PV(slot) do { const unsigned vb = vrb + (unsigned)((slot) * AT_VT); s16x4 a0, a1, a2, a3, a4, a5, a6, a7, b0, b1, b2, b3, b4, b5, b6, b7; \
        if (NV == 2) {                   \
            AT_RDA(0); AT_RDB(1); \
            AT_WTA(8); AT_MMA(0); AT_RDA(2); \
            AT_WTB(8); AT_MMB(1); AT_RDB(3); \
            AT_WTA(8); AT_MMA(2); AT_RDA(4); \
            AT_WTB(8); AT_MMB(3); AT_RDB(5); \
            AT_WTA(8); AT_MMA(4); AT_RDA(6); \
            AT_WTB(8); AT_MMB(5); AT_RDB(4 * NV - 1); \
            AT_WTA(8); AT_MMA(6); \
            AT_WTB(0); AT_MMB(4 * NV - 1); \
        } else { \
            AT_RDA(0); AT_RDB(1); \
            AT_WTA(8); AT_MMA(0); AT_RDA(2); \
            AT_WTB(8); AT_MMB(1); AT_RDB(3); \
            AT_WTA(8); AT_MMA(2); \
            AT_WTB(0); AT_MMB(3); } } while (0)
#define AT_VR(n) do { TRRD(fl[n], vb, ((n) >> 3) * 16 * AT_VSTR + ((n) & 7) * 64); TRRD(fh[n], vb, (((n) >> 3) * 16 + 8) * AT_VSTR + ((n) & 7) * 64); } while (0)
#define AT_VW(n, N) asm volatile("s_waitcnt lgkmcnt(" #N ")" : "+v"(fl[n]), "+v"(fh[n]) :: "memory")
#define AT_VM(n) o[(n) & 7] = MFMA32(mk8(fl[n], fh[n]), pk[(n) >> 3], o[(n) & 7])
#define AT_VE(n) do { p1[n] = __builtin_amdgcn_exp2f(fmaf(p1[n], AT_C2, mb)); ps += p1[n]; } while (0)
#define AT_VPK() do { v4u w_; w_.x = pk2(p1[0], p1[1]); w_.y = pk2(p1[2], p1[3]); w_.z = pk2(p1[4], p1[5]); w_.w = pk2(p1[6], p1[7]); pk[2] = __builtin_bit_cast(bf16x8, w_); \
        w_.x = pk2(p1[8], p1[9]); w_.y = pk2(p1[10], p1[11]); w_.z = pk2(p1[12], p1[13]); w_.w = pk2(p1[14], p1[15]); pk[3] = __builtin_bit_cast(bf16x8, w_); } while (0)
#define AT_PVK(slot) do { const unsigned vb = vrb + (unsigned)((slot) * AT_VT); s16x4 fl[32], fh[32]; AT_VR(0); AT_VR(1); AT_VR(2); AT_VR(3); \
        AT_VR(4); AT_VW(0, 8); AT_VM(0); AT_VE(0); \
        AT_VR(5); AT_VW(1, 8); AT_VM(1); AT_VE(1); \
        AT_VR(6); AT_VW(2, 8); AT_VM(2); AT_VE(2); \
        AT_VR(7); AT_VW(3, 8); AT_VM(3); AT_VE(3); \
        AT_VR(8); AT_VW(4, 8); AT_VM(4); AT_VE(4); \
        AT_VR(9); AT_VW(5, 8); AT_VM(5); AT_VE(5); \
        AT_VR(10); AT_VW(6, 8); AT_VM(6); AT_VE(6); \
        AT_VR(11); AT_VW(7, 8); AT_VM(7); AT_VE(7); \
        AT_VR(12); AT_VW(8, 8); AT_VM(8); AT_VE(8); \
        AT_VR(13); AT_VW(9, 8); AT_VM(9); AT_VE(9); \
        AT_VR(14); AT_VW(10, 8); AT_VM(10); AT_VE(10); \
        AT_VR(15); AT_VW(11, 8); AT_VM(11); AT_VE(11); \
        AT_VR(16); AT_VW(12, 8); AT_VM(12); AT_VE(12); \
        AT_VR(17); AT_VW(13, 8); AT_VM(13); AT_VE(13); \
        AT_VR(18); AT_VW(14, 8); AT_VM(14); AT_VE(14); \
        AT_VR(19); AT_VW(15, 8); AT_VM(15); AT_VE(15); \
        AT_VPK(); \
        AT_VR(20); AT_VW(16, 8); AT_VM(16); \
        AT_VR(21); AT_VW(17, 8); AT_VM(17); \
        AT_VR(22); AT_VW(18, 8); AT_VM(18); \
        AT_VR(23); AT_VW(19, 8); AT_VM(19); \
        AT_VR(24); AT_VW(20, 8); AT_VM(20); \
        AT_VR(25); AT_VW(21, 8); AT_VM(21); \
        AT_VR(26); AT_VW(22, 8); AT_VM(22); \
        AT_VR(27); AT_VW(23, 8); AT_VM(23); \
        AT_VR(28); AT_VW(24, 8); AT_VM(24); \
        AT_VR(29); AT_VW(25, 8); AT_VM(25); \
        AT_VR(30); AT_VW(26, 8); AT_VM(26); \
        AT_VR(31); AT_VW(27, 8); AT_VM(27); \
        AT_VW(28, 6); AT_VM(28); \
        AT_VW(29, 4); AT_VM(29); \
        AT_VW(30, 2); AT_VM(30); \
        AT_VW(31, 0); AT_VM(31); } while (0)
    bf16x8 pk[4]; bool pend = false;
    int vp = 2, vc = 0, vn = 1;
    for (int t = 0; t < NT; ++t) {
        const int j = AT_JT(t), b = t & 1; const bool act = (j <= jd);
        const bool more = t + 1 < NT; const int jn = AT_JT(t + 1);
        if (more && !(ABL & 8)) { AT_DMAK(jn, b ^ 1); AT_DMAV(jn, vn); }
        if (LAG && grpB) { if (pend && !(ABL & 4)) AT_PV(vp); }
        if (act) {
            f32x16 p0, p1;
#pragma unroll
            for (int r = 0; r < 16; ++r) { p0[r] = 0.f; p1[r] = 0.f; }
            if (!(ABL & 1)) AT_QK(b);
            if (ABL & 1) asm volatile("" : "+v"(p0), "+v"(p1));
            if (ABL & 2) { } else if (MODE == 0) {
                float pm = p0[0];
#pragma unroll
                for (int r = 1; r < 16; ++r) pm = fmaxf(pm, p0[r]);
#pragma unroll
                for (int r = 0; r < 16; ++r) pm = fmaxf(pm, p1[r]);
                pm = swap_max(pm);
                if (!__all((pm - m_run) * AT_C2 <= 8.f)) { const float mn = fmaxf(m_run, pm), al = __builtin_amdgcn_exp2f((m_run - mn) * AT_C2); m_run = mn; l_run *= al;
#pragma unroll
                    for (int d = 0; d < 4 * NV; ++d)
#pragma unroll
                        for (int r = 0; r < 16; ++r) o[d][r] *= al; }
                const float mb = -m_run * AT_C2; float ps = 0.f;
                if (KSM) {
#pragma unroll
                    for (int r = 0; r < 16; ++r) { p0[r] = __builtin_amdgcn_exp2f(fmaf(p0[r], AT_C2, mb)); ps += p0[r]; }
                    { v4u w; w.x = pk2(p0[0], p0[1]); w.y = pk2(p0[2], p0[3]); w.z = pk2(p0[4], p0[5]); w.w = pk2(p0[6], p0[7]); pk[0] = __builtin_bit_cast(bf16x8, w);
                      w.x = pk2(p0[8], p0[9]); w.y = pk2(p0[10], p0[11]); w.z = pk2(p0[12], p0[13]); w.w = pk2(p0[14], p0[15]); pk[1] = __builtin_bit_cast(bf16x8, w); }
                    AT_PVK(vc);
                } else {
#pragma unroll
                    for (int r = 0; r < 16; ++r) { p0[r] = __builtin_amdgcn_exp2f(fmaf(p0[r], AT_C2, mb)); p1[r] = __builtin_amdgcn_exp2f(fmaf(p1[r], AT_C2, mb)); ps += p0[r] + p1[r]; }
                }
                l_run += swap_sum(ps);
            } else {
                float up[32];
#pragma unroll
                for (int r = 0; r < 16; ++r) { up[r] = __builtin_amdgcn_exp2f(fminf(p0[r] * AT_C2, 30.f)); up[16 + r] = __builtin_amdgcn_exp2f(fminf(p1[r] * AT_C2, 30.f)); }
                if (j == jd) { const int qrel = qrow - 64 * j;
#pragma unroll
                    for (int r = 0; r < 16; ++r) { if (crow(r, hi) >= qrel) up[r] = 0.f; if (32 + crow(r, hi) >= qrel) up[16 + r] = 0.f; } }
                float all[16], e1[8], e2[8], e3[8];
#pragma unroll
                for (int q = 0; q < 8; ++q) { e1[q] = 1.f + up[4 * q]; e2[q] = e1[q] * (1.f + up[4 * q + 1]); e3[q] = e2[q] * (1.f + up[4 * q + 2]);
                    const float gp = __builtin_amdgcn_rcpf(e3[q] * (1.f + up[4 * q + 3]));
                    auto rr = __builtin_amdgcn_permlane32_swap(__float_as_uint(gp), __float_as_uint(gp), false, false); all[2 * q] = __uint_as_float(rr[0]); all[2 * q + 1] = __uint_as_float(rr[1]); }
                float T[16]; T[15] = carry;
#pragma unroll
                for (int g = 14; g >= 0; --g) T[g] = T[g + 1] * all[g + 1];
                carry = T[0] * all[0];
#pragma unroll
                for (int q = 0; q < 8; ++q) { const float tg = T[2 * q + 1] * (hi ? all[2 * q + 1] : all[2 * q + 1] * all[2 * q]);
                    const float a0 = up[4 * q] * tg, a1 = up[4 * q + 1] * e1[q] * tg, a2 = up[4 * q + 2] * e2[q] * tg, a3 = up[4 * q + 3] * e3[q] * tg;
                    if (q < 4) { p0[4 * q] = a0; p0[4 * q + 1] = a1; p0[4 * q + 2] = a2; p0[4 * q + 3] = a3; } else { p1[4 * q - 16] = a0; p1[4 * q - 15] = a1; p1[4 * q - 14] = a2; p1[4 * q - 13] = a3; } }
            }
            if (!KSM) { v4u w;
              w.x = pk2(p0[0], p0[1]); w.y = pk2(p0[2], p0[3]); w.z = pk2(p0[4], p0[5]); w.w = pk2(p0[6], p0[7]); pk[0] = __builtin_bit_cast(bf16x8, w);
              w.x = pk2(p0[8], p0[9]); w.y = pk2(p0[10], p0[11]); w.z = pk2(p0[12], p0[13]); w.w = pk2(p0[14], p0[15]); pk[1] = __builtin_bit_cast(bf16x8, w);
              w.x = pk2(p1[0], p1[1]); w.y = pk2(p1[2], p1[3]); w.z = pk2(p1[4], p1[5]); w.w = pk2(p1[6], p1[7]); pk[2] = __builtin_bit_cast(bf16x8, w);
              w.x = pk2(p1[8], p1[9]); w.y = pk2(p1[10], p1[11]); w.z = pk2(p1[12], p1[13]); w.w = pk2(p1[14], p1[15]); pk[3] = __builtin_bit_cast(bf16x8, w); }
            if (!KSM && !(LAG && grpB) && !(ABL & 4)) AT_PV(vc);
        }
        if (LAG && grpB) pend = act;
        VM_WAIT();
        if (MODE == 1) { const float cm = wave_max(carry); if (lane == 0) cmx[(t & 1) * 8 + wid] = cm; }
        __syncthreads();
        if (MODE == 1) { float cm = cmx[(t & 1) * 8];
#pragma unroll
            for (int w = 1; w < 8; ++w) cm = fmaxf(cm, cmx[(t & 1) * 8 + w]);
            if (cm < 1.4901161e-8f) break; }
        vp = vc; vc = vn; vn = (vn == AT_NVS - 1) ? 0 : vn + 1;
    }
    if (LAG && grpB && pend && !(ABL & 4)) AT_PV(vp);
#undef AT_PV
#undef AT_PVK
#undef AT_VR
#undef AT_VW
#undef AT_VM
#undef AT_VE
#undef AT_VPK
#undef AT_QK
#undef AT_RDA
#undef AT_RDB
#undef AT_WTA
#undef AT_WTB
#undef AT_MMA
#undef AT_MMB
#undef AT_RD
#undef AT_WT
#undef AT_MM
    const float inv = (MODE == 0) ? __builtin_amdgcn_rcpf(l_run) : 1.f;
    const int lane_e = LANE_ID_ASM(), hi_e = lane_e >> 5;
    bf16* orow = Op + (size_t)(P0 + 32 * wid + (lane_e & 31)) * ldo;
#pragma unroll
    for (int d = 0; d < 4 * NV; ++d)
#pragma unroll
        for (int rg = 0; rg < 4; ++rg) { v2u w; w.x = pk2(o[d][4 * rg] * inv, o[d][4 * rg + 1] * inv); w.y = pk2(o[d][4 * rg + 2] * inv, o[d][4 * rg + 3] * inv);
            *(v2u*)(orow + 32 * d + 8 * rg + 4 * hi_e) = w; }
#undef AT_DMAK
#undef AT_DMAV
#undef AT_KRD
#undef AT_KWT
#undef AT_KMM
#undef AT_JT
}
template <int MODE, int ABL = 0>
__device__ __forceinline__ void attn_phase(const Frame& F_in, gu32* qhead, const bf16* proj, bf16* outp) { PHASE_ENTRY(F);
    volatile LAS unsigned* slot = (volatile LAS unsigned*)(F.lds + MISC_OFF + 64);
    constexpr int NU = 512;
    for (;;) {
        __syncthreads();
        if (F.tid == 0) *slot = __hip_atomic_fetch_add(qhead, 1u, RLX_AGENT);
        __syncthreads();
        const int u = (int)*slot;
        if (u >= NU) break;
        const int qb = 63 - (u >> 3), h = u & 7;
        if (MODE == 0)
            attn_unit<0, 2, 1, ABL>(F.lds, F.wave, proj + h * 128, proj + 1024 + h * 128, proj + 2048 + (h >> 1) * 256, NIN, qb, outp + h * 256, 2048);
        else
            attn_unit<1, 1, 0>(F.lds, F.wave, proj + 3072 + h * 128, proj + 4096 + h * 128, proj + 5120 + h * 128, NIN, qb, outp + 1024 + h * 128, NMIX);
    }
}

constexpr float LIN_SC = 0.08838834764831845f;
constexpr int LK_STR = 320, LV_STR = 576;
struct LinArgs {
    const bf16* proj; bf16* qkc; const float* gpre; const float* b_i; const float* b_f; const float* wconv; const float* bconv; const float* gnorm;
    float* chs; bf16* dC; bf16* CH;
    float* dn; float* nh; bf16* ymix;
};
__device__ __forceinline__ float wave_prefix_sum(float v, int lane, LAS float* scr) { scr[lane] = v; LDS_WAIT(); asm volatile("" ::: "memory"); float b = 0.f;
    for (int s = 0; s < 64; ++s) { const float x = scr[s]; b += (s <= lane) ? x : 0.f; } LDS_WAIT(); asm volatile("" ::: "memory"); return b; }
__device__ __forceinline__ float wave_prefix_max(float v, int lane, LAS float* scr) { scr[lane] = v; LDS_WAIT(); asm volatile("" ::: "memory"); float b = v;
    for (int s = 0; s < 64; ++s) { const float x = scr[s]; b = (s <= lane) ? fmaxf(b, x) : b; } LDS_WAIT(); asm volatile("" ::: "memory"); return b; }
template <bool ML>
__device__ __forceinline__ void lin_gates(const LinArgs& A, int t0, int h, int lane, LAS float* scr, float& li, float& b) {
    if (ML) { const float f = A.gpre[(size_t)(t0 + lane) * 8 + 4 + h] + A.b_f[h]; li = A.gpre[(size_t)(t0 + lane) * 8 + h] + A.b_i[h];
        const float lf = fminf(f, 0.f) - __logf(1.f + __expf(-fabsf(f))); b = wave_prefix_sum(lf, lane, scr);
    } else { const float lg = (h == 0) ? -0.0317486983145803f : (h == 1) ? -0.015748356968139168f : (h == 2) ? -0.007843177461025893f : -0.003913899321136329f;   li = 0.f; b = (float)(lane + 1) * lg; }
}
template <bool ML>
__device__ __forceinline__ void lin_local(const Frame& F_in, const LinArgs& A) { PHASE_ENTRY(F);
    LAS unsigned char* lds = F.lds; const int tid = F.tid, lane = F.lane, wid = F.wave, hi = lane >> 5;
    LAS unsigned char* Kt = lds; LAS unsigned char* Vt = lds + 64 * LK_STR; LAS float* wks = (LAS float*)(lds + 64 * LK_STR + 64 * LV_STR);
    const int sr = tid >> 4, sc = (tid & 15) * 8;
    for (int u = F.bid; u < NCH * 4; u += F.G) { const int c = u >> 2, h = u & 3, t0 = c * 64;
        __syncthreads();
        if (wid == 0) { float li, b; lin_gates<ML>(A, t0, h, lane, wks, li, b); wks[lane] = b; LDS_WAIT(); asm volatile("" ::: "memory"); const float bl = wks[63]; LDS_WAIT(); asm volatile("" ::: "memory"); const float g = bl - b + li; const float a = ML ? wave_max(g) : 0.f;
            wks[lane] = __expf(g - a) * LIN_SC; if (lane == 0) { A.chs[c * 4 + h] = bl; A.chs[NCH * 4 + c * 4 + h] = a; } }
        __syncthreads();
#pragma unroll
        for (int rr = 0; rr < 2; ++rr) { const int s = sr + 32 * rr, t = t0 + s; const float wk = wks[s];
            if (ML) {
#pragma unroll
                for (int X = 0; X < 2; ++X) { const int ch = X * 512 + 128 * h + sc; float y[8];
#pragma unroll
                    for (int e = 0; e < 8; ++e) y[e] = A.bconv[ch + e];
#pragma unroll
                    for (int tap = 0; tap < 4; ++tap) { const int tt = t - 3 + tap; v4u x = (v4u){0u, 0u, 0u, 0u}; if (tt >= 0) x = *(const v4u*)(A.proj + (size_t)tt * NIN + 3072 + ch);
                        const f32x4 w0 = *(const f32x4*)(A.wconv + (size_t)tap * 1024 + ch), w1 = *(const f32x4*)(A.wconv + (size_t)tap * 1024 + ch + 4);
                        y[0] += w0[0] * bflo(x.x); y[1] += w0[1] * bfhi(x.x); y[2] += w0[2] * bflo(x.y); y[3] += w0[3] * bfhi(x.y);
                        y[4] += w1[0] * bflo(x.z); y[5] += w1[1] * bfhi(x.z); y[6] += w1[2] * bflo(x.w); y[7] += w1[3] * bfhi(x.w); }
#pragma unroll
                    for (int e = 0; e < 8; ++e) y[e] = y[e] * __builtin_amdgcn_rcpf(1.f + __expf(-y[e]));
                    v4u o; o.x = pk2(y[0], y[1]); o.y = pk2(y[2], y[3]); o.z = pk2(y[4], y[5]); o.w = pk2(y[6], y[7]);
                    *(v4u*)(A.qkc + (size_t)t * 1024 + ch) = o;
                    if (X == 1) { v4u k; k.x = pk2(y[0] * wk, y[1] * wk); k.y = pk2(y[2] * wk, y[3] * wk); k.z = pk2(y[4] * wk, y[5] * wk); k.w = pk2(y[6] * wk, y[7] * wk);
                        *(LAS v4u*)(Kt + s * LK_STR + sc * 2) = k; } }
            } else { const v4u x = *(const v4u*)(A.proj + (size_t)t * NIN + 512 + 128 * h + sc);
                v4u k; k.x = pk2(bflo(x.x) * wk, bfhi(x.x) * wk); k.y = pk2(bflo(x.y) * wk, bfhi(x.y) * wk); k.z = pk2(bflo(x.z) * wk, bfhi(x.z) * wk); k.w = pk2(bflo(x.w) * wk, bfhi(x.w) * wk);
                *(LAS v4u*)(Kt + s * LK_STR + sc * 2) = k; }
            const bf16* vp = A.proj + (size_t)t * NIN + (ML ? 4096 : 1024) + 256 * h + sc;
            *(LAS v4u*)(Vt + s * LV_STR + sc * 2) = *(const v4u*)vp; *(LAS v4u*)(Vt + s * LV_STR + (128 + sc) * 2) = *(const v4u*)(vp + 128); }
        __syncthreads();
        const unsigned rowb = (unsigned)(8 * hi + ((lane >> 2) & 3)), colb = (unsigned)(16 * ((lane >> 4) & 1) + 4 * (lane & 3));
        const unsigned vb = (unsigned)(uintptr_t)Vt + rowb * LV_STR + (32 * wid + colb) * 2, kbs = (unsigned)(uintptr_t)Kt + rowb * LK_STR + colb * 2;
        bf16x8 av[4];
#define L1_A(ks) do { s16x4 l_, h_; TRRD(l_, vb, (ks) * 16 * LV_STR); TRRD(h_, vb, ((ks) * 16 + 4) * LV_STR); asm volatile("s_waitcnt lgkmcnt(0)" : "+v"(l_), "+v"(h_) :: "memory"); av[ks] = mk8(l_, h_); } while (0)
        L1_A(0); L1_A(1); L1_A(2); L1_A(3);
#undef L1_A
        f32x16 acc[4];
#pragma unroll
        for (int d = 0; d < 4; ++d)
#pragma unroll
            for (int r = 0; r < 16; ++r) acc[d][r] = 0.f;
#define L1_B(d0, ks) do { s16x4 l_, h_; TRRD(l_, kbs, (ks) * 16 * LK_STR + (d0) * 64); TRRD(h_, kbs, ((ks) * 16 + 4) * LK_STR + (d0) * 64); asm volatile("s_waitcnt lgkmcnt(0)" : "+v"(l_), "+v"(h_) :: "memory"); \
            acc[d0] = MFMA32(av[ks], mk8(l_, h_), acc[d0]); } while (0)
#define L1_BD(d0) do { L1_B(d0, 0); L1_B(d0, 1); L1_B(d0, 2); L1_B(d0, 3); } while (0)
        L1_BD(0); L1_BD(1); L1_BD(2); L1_BD(3);
#undef L1_BD
#undef L1_B
        bf16* dcp = A.dC + ((size_t)(c * 4 + h) * 128) * 256;
#pragma unroll
        for (int d0 = 0; d0 < 4; ++d0)
#pragma unroll
            for (int rg = 0; rg < 4; ++rg) { v2u w; w.x = pk2(acc[d0][4 * rg], acc[d0][4 * rg + 1]); w.y = pk2(acc[d0][4 * rg + 2], acc[d0][4 * rg + 3]); *(v2u*)(dcp + (size_t)(32 * d0 + (lane & 31)) * 256 + 32 * wid + 8 * rg + 4 * hi) = w; }
        if (ML && tid < 128) { float s = 0.f;
#pragma unroll 8
            for (int q = 0; q < 64; ++q) s += h2f(*(const LAS unsigned short*)(Kt + q * LK_STR + tid * 2));
            A.dn[(size_t)(c * 4 + h) * 128 + tid] = s; }
    }
}
template <bool ML>
__device__ __forceinline__ void lin_scan(const Frame& F_in, const LinArgs& A) { PHASE_ENTRY(F);
    LAS float* decs = (LAS float*)F.lds; LAS float* inws = decs + NCH; LAS float* mss = decs + 2 * NCH; LAS float* bls = decs + 3 * NCH; LAS float* acs = decs + 4 * NCH;
    for (int blk = F.bid; blk < 256; blk += F.G) { const int h = blk >> 6, idx = (blk & 63) * 512 + F.tid; const bool lead = (blk & 63) == 0;
        __syncthreads();
        if (F.tid < NCH) { bls[F.tid] = A.chs[F.tid * 4 + h]; acs[F.tid] = A.chs[NCH * 4 + F.tid * 4 + h]; }
        __syncthreads();
        if (F.tid == 0) { float m = 0.f;
            for (int c = 0; c < NCH; ++c) { const float bl = bls[c], a = acs[c], mn = fmaxf(bl + m, a); mss[c] = m; decs[c] = __expf(bl + m - mn); inws[c] = __expf(a - mn); m = mn; } }
        __syncthreads();
        if (lead && F.tid < NCH) A.chs[2 * NCH * 4 + F.tid * 4 + h] = mss[F.tid];
        float C = 0.f;
        for (int c0 = 0; c0 < NCH; c0 += 32) { bf16 x[32];
#pragma unroll
            for (int u = 0; u < 32; ++u) x[u] = A.dC[(size_t)((c0 + u) * 4 + h) * 32768 + idx];
#pragma unroll
            for (int u = 0; u < 32; ++u) { const int c = c0 + u; A.CH[(size_t)(c * 4 + h) * 32768 + idx] = (bf16)f2bf(C); C = decs[c] * C + inws[c] * h2f(x[u]); } }
        if (ML && lead && F.tid < 128) { float n = 0.f;
            for (int c0 = 0; c0 < NCH; c0 += 32) { float x[32];
#pragma unroll
                for (int u = 0; u < 32; ++u) x[u] = A.dn[(size_t)((c0 + u) * 4 + h) * 128 + F.tid];
#pragma unroll
                for (int u = 0; u < 32; ++u) { const int c = c0 + u; A.nh[(size_t)(c * 4 + h) * 128 + F.tid] = n; n = decs[c] * n + inws[c] * x[u]; } } }
    }
}
template <bool ML>
__device__ __forceinline__ void lin_out(const Frame& F_in, const LinArgs& A) { PHASE_ENTRY(F);
    LAS unsigned char* lds = F.lds; const int tid = F.tid, lane = F.lane, wid = F.wave, r32 = lane & 31, hi = lane >> 5;
    LAS unsigned char* Kt = lds; LAS unsigned char* Vt = lds + 16384; LAS unsigned char* Ct = lds + 16384 + 64 * LV_STR;
    LAS float* vs = (LAS float*)(lds + 126976); LAS float* Mt = vs + 64; LAS float* Bt = vs + 128; LAS float* nhs = vs + 192; LAS float* ssq = vs + 320;
    const int sr = tid >> 4, sc = (tid & 15) * 8, tb = wid & 1, eq = wid >> 1, tl = 32 * tb + r32;
    for (int u = F.bid; u < NCH * 4; u += F.G) { const int c = u >> 2, h = u & 3, t0 = c * 64;
        const float mc = ML ? A.chs[2 * NCH * 4 + c * 4 + h] : 0.f;
        __syncthreads();
        const bf16* kp = ML ? A.qkc + (size_t)t0 * 1024 + 512 + 128 * h : A.proj + (size_t)t0 * NIN + 512 + 128 * h; const int kld = ML ? 1024 : NIN;
        v4u tk[2], tv[2][2], tc[8];
#pragma unroll
        for (int rr = 0; rr < 2; ++rr) { const int s = sr + 32 * rr;
            tk[rr] = *(const v4u*)(kp + (size_t)s * kld + sc);
            const bf16* vp = A.proj + (size_t)(t0 + s) * NIN + (ML ? 4096 : 1024) + 256 * h + sc;
            tv[rr][0] = *(const v4u*)vp; tv[rr][1] = *(const v4u*)(vp + 128); }
        const bf16* chp = A.CH + (size_t)(c * 4 + h) * 32768;
#pragma unroll
        for (int i = 0; i < 8; ++i) { const int ck = tid + 512 * i, d = ck >> 5, e0 = (ck & 31) * 8; tc[i] = *(const v4u*)(chp + (size_t)d * 256 + e0); }
        const bf16* qp = (ML ? A.qkc + (size_t)(t0 + tl) * 1024 + 128 * h : A.proj + (size_t)(t0 + tl) * NIN + 128 * h) + 8 * hi;
        bf16x8 qr[8];
#pragma unroll
        for (int s = 0; s < 8; ++s) qr[s] = *(const bf16x8*)(qp + 16 * s);
        asm volatile("" ::: "memory");
        if (wid == 0) { float li, b; lin_gates<ML>(A, t0, h, lane, ssq, li, b); const float v = li - b, uu = wave_prefix_max(v, lane, ssq); vs[lane] = v; Mt[lane] = fmaxf(mc, uu); Bt[lane] = b; }
        if (ML && wid >= 2 && wid < 4) nhs[tid - 128] = A.nh[(size_t)(c * 4 + h) * 128 + tid - 128];
#pragma unroll
        for (int rr = 0; rr < 2; ++rr) { const int s = sr + 32 * rr;
            *(LAS v4u*)(Kt + KSWZ(s, sc * 2)) = tk[rr];
            *(LAS v4u*)(Vt + s * LV_STR + sc * 2) = tv[rr][0]; *(LAS v4u*)(Vt + s * LV_STR + (128 + sc) * 2) = tv[rr][1]; }
#pragma unroll
        for (int i = 0; i < 8; ++i) { const int ck = tid + 512 * i, d = ck >> 5, e0 = (ck & 31) * 8; *(LAS v4u*)(Ct + d * LV_STR + e0 * 2) = tc[i]; }
        __syncthreads();
        const float Mme = Mt[tl], bme = Bt[tl], wint = __expf(mc - Mme);
        f32x16 p[2]; float nq = 0.f;
#pragma unroll
        for (int sb = 0; sb < 2; ++sb) {
#pragma unroll
            for (int r = 0; r < 16; ++r) p[sb][r] = 0.f;
            if (sb <= tb) {
#pragma unroll
                for (int d0 = 0; d0 < 8; ++d0) { const bf16x8 kf = *(const LAS bf16x8*)(Kt + KSWZ(32 * sb + r32, (16 * d0 + 8 * hi) * 2)); p[sb] = MFMA32(kf, qr[d0], p[sb]); }
#pragma unroll
                for (int r = 0; r < 16; ++r) { const int s = 32 * sb + crow(r, hi); const float w = (s <= tl) ? __expf(vs[s] - Mme) * LIN_SC : 0.f; p[sb][r] *= w; nq += p[sb][r]; }
            }
        }
        bf16x8 pk[4];
        { v4u w;
          w.x = pk2(p[0][0], p[0][1]); w.y = pk2(p[0][2], p[0][3]); w.z = pk2(p[0][4], p[0][5]); w.w = pk2(p[0][6], p[0][7]); pk[0] = __builtin_bit_cast(bf16x8, w);
          w.x = pk2(p[0][8], p[0][9]); w.y = pk2(p[0][10], p[0][11]); w.z = pk2(p[0][12], p[0][13]); w.w = pk2(p[0][14], p[0][15]); pk[1] = __builtin_bit_cast(bf16x8, w);
          w.x = pk2(p[1][0], p[1][1]); w.y = pk2(p[1][2], p[1][3]); w.z = pk2(p[1][4], p[1][5]); w.w = pk2(p[1][6], p[1][7]); pk[2] = __builtin_bit_cast(bf16x8, w);
          w.x = pk2(p[1][8], p[1][9]); w.y = pk2(p[1][10], p[1][11]); w.z = pk2(p[1][12], p[1][13]); w.w = pk2(p[1][14], p[1][15]); pk[3] = __builtin_bit_cast(bf16x8, w); }
        bf16x8 qw[8]; float qn = 0.f;
#pragma unroll
        for (int s = 0; s < 8; ++s) { const v4u x = __builtin_bit_cast(v4u, qr[s]); float f[8] = {bflo(x.x), bfhi(x.x), bflo(x.y), bfhi(x.y), bflo(x.z), bfhi(x.z), bflo(x.w), bfhi(x.w)};
            if (ML) {
#pragma unroll
                for (int e = 0; e < 8; ++e) qn += f[e] * nhs[16 * s + 8 * hi + e]; }
#pragma unroll
            for (int e = 0; e < 8; ++e) f[e] *= wint;
            qw[s] = pack8f(f); }
        nq = swap_sum(nq) + wint * swap_sum(qn);
        const unsigned q4 = (unsigned)((lane >> 2) & 3), colb = (unsigned)(16 * ((lane >> 4) & 1) + 4 * (lane & 3));
        const unsigned vb = (unsigned)(uintptr_t)Vt + (4 * hi + q4) * LV_STR + (64 * eq + colb) * 2;
        const unsigned cb0 = (unsigned)(uintptr_t)Ct + (8 * hi + q4) * LV_STR + (64 * eq + colb) * 2, cb1 = cb0 + 64 * LV_STR;
        f32x16 acc[2];
#pragma unroll
        for (int eb = 0; eb < 2; ++eb)
#pragma unroll
            for (int r = 0; r < 16; ++r) acc[eb][r] = 0.f;
        const bf16* gp = A.proj + (size_t)(t0 + tl) * NIN + (ML ? 5120 : 2048) + 256 * h;
        v2u gwv[2][4];
#pragma unroll
        for (int eb = 0; eb < 2; ++eb)
#pragma unroll
            for (int rg = 0; rg < 4; ++rg) { const int e = 64 * eq + 32 * eb + 8 * rg + 4 * hi; gwv[eb][rg] = *(const v2u*)(gp + e); }
#define L3_RV(i, eb, ks) do { TRRD(fl_[i], vb, (ks) * 16 * LV_STR + (eb) * 64); TRRD(fh_[i], vb, ((ks) * 16 + 8) * LV_STR + (eb) * 64); } while (0)
#define L3_RC(i, eb, base, so) do { TRRD(fl_[i], base, (so) * 16 * LV_STR + (eb) * 64); TRRD(fh_[i], base, ((so) * 16 + 4) * LV_STR + (eb) * 64); } while (0)
#define L3_W4() asm volatile("s_waitcnt lgkmcnt(0)" : "+v"(fl_[0]), "+v"(fh_[0]), "+v"(fl_[1]), "+v"(fh_[1]), "+v"(fl_[2]), "+v"(fh_[2]), "+v"(fl_[3]), "+v"(fh_[3]) :: "memory")
#define L3_W2() asm volatile("s_waitcnt lgkmcnt(0)" : "+v"(fl_[0]), "+v"(fh_[0]), "+v"(fl_[1]), "+v"(fh_[1]) :: "memory")
#define L3_E(eb) do { s16x4 fl_[4], fh_[4]; \
            if (tb) { L3_RV(0, eb, 0); L3_RV(1, eb, 1); L3_RV(2, eb, 2); L3_RV(3, eb, 3); L3_W4(); \
                acc[eb] = MFMA32(mk8(fl_[0], fh_[0]), pk[0], acc[eb]); acc[eb] = MFMA32(mk8(fl_[1], fh_[1]), pk[1], acc[eb]); acc[eb] = MFMA32(mk8(fl_[2], fh_[2]), pk[2], acc[eb]); acc[eb] = MFMA32(mk8(fl_[3], fh_[3]), pk[3], acc[eb]); } \
            else { L3_RV(0, eb, 0); L3_RV(1, eb, 1); L3_W2(); acc[eb] = MFMA32(mk8(fl_[0], fh_[0]), pk[0], acc[eb]); acc[eb] = MFMA32(mk8(fl_[1], fh_[1]), pk[1], acc[eb]); } \
            L3_RC(0, eb, cb0, 0); L3_RC(1, eb, cb0, 1); L3_RC(2, eb, cb0, 2); L3_RC(3, eb, cb0, 3); L3_W4(); \
            acc[eb] = MFMA32(mk8(fl_[0], fh_[0]), qw[0], acc[eb]); acc[eb] = MFMA32(mk8(fl_[1], fh_[1]), qw[1], acc[eb]); acc[eb] = MFMA32(mk8(fl_[2], fh_[2]), qw[2], acc[eb]); acc[eb] = MFMA32(mk8(fl_[3], fh_[3]), qw[3], acc[eb]); \
            L3_RC(0, eb, cb1, 0); L3_RC(1, eb, cb1, 1); L3_RC(2, eb, cb1, 2); L3_RC(3, eb, cb1, 3); L3_W4(); \
            acc[eb] = MFMA32(mk8(fl_[0], fh_[0]), qw[4], acc[eb]); acc[eb] = MFMA32(mk8(fl_[1], fh_[1]), qw[5], acc[eb]); acc[eb] = MFMA32(mk8(fl_[2], fh_[2]), qw[6], acc[eb]); acc[eb] = MFMA32(mk8(fl_[3], fh_[3]), qw[7], acc[eb]); } while (0)
        L3_E(0); L3_E(1);
#undef L3_RV
#undef L3_RC
#undef L3_W4
#undef L3_W2
#undef L3_E
        float dinv = 1.f;
        if (ML) dinv = __builtin_amdgcn_rcpf(fmaxf(fabsf(nq), __expf(-(bme + Mme))));
        float ss = 0.f;
#pragma unroll
        for (int eb = 0; eb < 2; ++eb)
#pragma unroll
            for (int r = 0; r < 16; ++r) { acc[eb][r] *= dinv; ss += acc[eb][r] * acc[eb][r]; }
        ss = swap_sum(ss);
        if (hi == 0) ssq[eq * 64 + tl] = ss;
        __syncthreads();
        const float rn = rsqrtf(((ssq[tl] + ssq[64 + tl]) + (ssq[128 + tl] + ssq[192 + tl])) * (1.f / 256.f) + EPS_);
        bf16* yp = A.ymix + (size_t)(t0 + tl) * NMIX + (ML ? 1024 : 0) + 256 * h;
#pragma unroll
        for (int eb = 0; eb < 2; ++eb)
#pragma unroll
            for (int rg = 0; rg < 4; ++rg) { const int e = 64 * eq + 32 * eb + 8 * rg + 4 * hi; const v2u gw = gwv[eb][rg]; const f32x4 gn = *(const f32x4*)(A.gnorm + e);
                float gt[4] = {bflo(gw.x), bfhi(gw.x), bflo(gw.y), bfhi(gw.y)}, o[4];
#pragma unroll
                for (int k = 0; k < 4; ++k) { const float sg = __builtin_amdgcn_rcpf(1.f + __expf(-gt[k])); const float gate = ML ? sg : gt[k] * sg; o[k] = acc[eb][4 * rg + k] * rn * gn[k] * gate; }
                v2u w; w.x = pk2(o[0], o[1]); w.y = pk2(o[2], o[3]); *(v2u*)(yp + e) = w; }
    }
}

#ifndef MK_SPLIT
#define MK_SPLIT 0
#endif
constexpr int PH_PER_LAYER = 16, N_PHASES = 1 + PH_PER_LAYER * DEPTH_;
__global__ void __launch_bounds__(NWAVES * 64, 2) fwd_kernel(Params P) {
    extern __shared__ __attribute__((aligned(16))) unsigned char lds_raw[];
    Frame F0; F0.lds = (LAS unsigned char*)lds_raw; F0.tid = threadIdx.x; F0.lane = F0.tid & 63; F0.wave = __builtin_amdgcn_readfirstlane(F0.tid >> 6); F0.G = gridDim.x; F0.bid = blockIdx.x;
    volatile LAS unsigned* MISC = (volatile LAS unsigned*)(F0.lds + MISC_OFF);
    for (int u = F0.tid; u < (LDS_BYTES - LDSCTL_OFF) / 4; u += NWAVES * 64) ((LAS unsigned*)(F0.lds + LDSCTL_OFF))[u] = 0u;
    __syncthreads();
    gu32* ctl = (gu32*)(P.ws + WS_CTL);
    XcdBarrier bar; bar.bar = (unsigned*)ctl + CW_BAR; bar.x = 0; bar.st = nullptr;
    if (!MK_SPLIT) bar = xcd_barrier_post((unsigned*)ctl + CW_BAR, MISC + 8);
    const int lo = P.ph_lo, hi = P.ph_hi;
#ifndef PHMASK
#define PHMASK 0xffffffffu
#endif
#ifndef DUPMASK
#define DUPMASK (0u)
#endif
#define DUPN(n) for (int rep_ = 0; rep_ < (((DUPMASK >> (n)) & 1u) ? 2 : 1); ++rep_)
#define IN(k) (lo <= (k) && (k) < hi)
#define INM(k, n) (((PHMASK >> (n)) & 1u) && IN(k))
#ifndef DBG_TIME
#define DBG_TIME 0
#endif
#if DBG_TIME
#define SEAM(k) do { if (!MK_SPLIT && lo <= (k) && (k) + 1 < hi) xcd_barrier(bar); if (F0.bid == 0 && F0.tid == 0) ((unsigned long long*)(P.ws + 768 * 1024))[(k) + 1] = wall_clock64(); } while (0)
#else
#define SEAM(k) do { if (!MK_SPLIT && lo <= (k) && (k) + 1 < hi) xcd_barrier(bar); } while (0)
#endif
#define PHASE_PTRS() KParams Pk = (KParams)__builtin_amdgcn_kernarg_segment_ptr(); Frame F = F0; asm volatile("; PHASE_PTRS" : "+s"(Pk), "+s"(F.G), "+s"(F.bid), "+s"(F.wave)); unsigned char* ws = Pk->ws; float* out = Pk->out; \
    bf16* hb = (bf16*)(ws + WS_HB); bf16* proj = (bf16*)(ws + WS_PROJ); bf16* ymix = (bf16*)(ws + WS_YMIX); bf16* mixo = (bf16*)(ws + WS_MIXO); bf16* upb = (bf16*)(ws + WS_UP); \
    bf16* act = (bf16*)(ws + WS_ACT); bf16* od = (bf16*)(ws + WS_OD); bf16* g1 = (bf16*)(ws + WS_G1); bf16* qkc = (bf16*)(ws + WS_QKC); \
    float* rin = (float*)(ws + WS_RIN); float* ssp = (float*)(ws + WS_SSP); float* gpre = (float*)(ws + WS_GPRE); \
    const float* cst = (const float*)(ws + WS_COS); const float* snt = (const float*)(ws + WS_SIN); \
    (void)out; (void)hb; (void)proj; (void)ymix; (void)mixo; (void)upb; (void)act; (void)od; (void)g1; (void)qkc; (void)rin; (void)ssp; (void)gpre; (void)cst; (void)snt
#define LIN_ARGS() LinArgs LA; LA.proj = proj; LA.qkc = qkc; LA.gpre = gpre; LA.b_i = Pk->in[I_BIG] + j * 4; LA.b_f = Pk->in[I_BFG] + j * 4; LA.wconv = Pk->in[I_WCQK] + (size_t)j * 4096; LA.bconv = Pk->in[I_BCQK] + (size_t)j * 1024; \
    LA.gnorm = ev ? Pk->in[I_GML] + j * 256 : Pk->in[I_GRET] + j * 256; LA.chs = (float*)(ws + WS_CHS); LA.dC = (bf16*)(ws + WS_DC); LA.CH = (bf16*)(ws + WS_CH); LA.dn = (float*)(ws + WS_DN); LA.nh = (float*)(ws + WS_NH); LA.ymix = ymix

#if DBG_TIME
    if (F0.bid == 0 && F0.tid == 0) ((unsigned long long*)(P.ws + 768 * 1024))[0] = wall_clock64();
#endif
    if (INM(0, 31)) DUPN(31) { PHASE_PTRS(); p0_prologue(F, Pk); }
    SEAM(0);
#pragma unroll 1
    for (int L = 0; L < DEPTH_; ++L) {
        const int pbase = 1 + PH_PER_LAYER * L, j = L >> 1; const bool ev = (L & 1) == 0;
        if (INM(pbase + 0, 0)) DUPN(0) { PHASE_PTRS();
            if (ev) gates_pass(F, hb, (const bf16*)(ws + WS_WG) + (size_t)j * 8 * DM, rin, gpre);
            pg8::Gemm g{hb, (const bf16*)(ws + WS_WIN) + (size_t)L * NIN * DM, S_, NIN, DM, 0, 0}; pg8::StaticOrder S; S.init(S_, NIN, F.G, F.bid);
            pg8::EpiProj E{proj, NIN, rin, cst, snt, ev ? 8 : 4};
            pg8::gemm_phase<pg8::EpiProj, pg8::StaticOrder, true, true>(F.lds, g, S, E, F.wave);
        }
        SEAM(pbase + 0);
        if (INM(pbase + 1, 1)) DUPN(1) { PHASE_PTRS(); LIN_ARGS(); if (ev) lin_local<true>(F, LA); else lin_local<false>(F, LA); }
        SEAM(pbase + 1);
        if (INM(pbase + 2, 2)) DUPN(2) { PHASE_PTRS(); LIN_ARGS(); if (ev) lin_scan<true>(F, LA); else lin_scan<false>(F, LA); }
        SEAM(pbase + 2);
        if (INM(pbase + 3, 3)) DUPN(3) { PHASE_PTRS(); LIN_ARGS();
#ifndef P3MASK
#define P3MASK 15
#endif
#ifndef P3ABL
#define P3ABL 0
#endif
#ifndef P3DUP
#define P3DUP 15
#endif
            const int p3m = rep_ ? (P3MASK & P3DUP) : P3MASK;
            if (ev) { if (p3m & 1) lin_out<true>(F, LA); if (p3m & 2) { if (rep_) attn_phase<0, P3ABL>(F, ctl + CW_Q + 64 * (L + 4 * rep_), proj, (bf16*)(ws + WS_UP)); else attn_phase<0>(F, ctl + CW_Q + 64 * (L + 4 * rep_), proj, od); } }
            else { if (p3m & 4) lin_out<false>(F, LA); if (p3m & 8) attn_phase<1>(F, ctl + CW_Q + 64 * (L + 4 * rep_), proj, ymix); }
        }
        SEAM(pbase + 3);
        if (ev) { if (INM(pbase + 4, 4)) DUPN(4) { PHASE_PTRS(); diffcomb_pass(F, od, Pk->in[I_GDIFF] + j * 256, (const float*)(ws + WS_LAM) + 2 * j, ymix); } SEAM(pbase + 4); }
        if (INM(pbase + 5, 5)) DUPN(5) { PHASE_PTRS();
            pg8::Gemm g{ymix, (const bf16*)(ws + WS_WOUT) + (size_t)L * DM * NMIX, S_, DM, NMIX, 0, 0}; pg8::StaticOrder S; S.init(S_, DM, F.G, F.bid);
            pg8::EpiY E{mixo, DM, ssp};
            pg8::gemm_phase<pg8::EpiY, pg8::StaticOrder, true, true>(F.lds, g, S, E, F.wave);
        }
        SEAM(pbase + 5);
        if (INM(pbase + 6, 6)) DUPN(6) { PHASE_PTRS(); resid_pass(F, (RES_LO && L == 0) ? Pk->in[I_X] : (const float*)nullptr, mixo, ssp, Pk->in[I_GMPOST] + (size_t)L * DM, hb, (bf16*)(ws + WS_LO), rin); }
        SEAM(pbase + 6);
        if (INM(pbase + 7, 7)) DUPN(7) { PHASE_PTRS();
            pg8::Gemm g{hb, (const bf16*)(ws + WS_WUP) + (size_t)L * NUP * DM, S_, NUP, DM, 0, 0}; pg8::StaticOrder S; S.init(S_, NUP, F.G, F.bid);
            pg8::EpiProj E{upb, NUP, rin, cst, snt, 0};
            pg8::gemm_phase<pg8::EpiProj, pg8::StaticOrder, true, true>(F.lds, g, S, E, F.wave);
        }
        SEAM(pbase + 7);
        if (INM(pbase + 8, 8)) DUPN(8) { PHASE_PTRS(); convffn_pass(F, upb, Pk->in[I_WFC] + (size_t)L * 3 * NUP, Pk->in[I_BFC] + (size_t)L * NUP, act); }
        SEAM(pbase + 8);
        if (INM(pbase + 9, 9)) DUPN(9) { PHASE_PTRS();
            pg8::Gemm g{act, (const bf16*)(ws + WS_WDN) + (size_t)L * DM * DM, S_, DM, DM, 0, 0}; pg8::StaticOrder S; S.init(S_, DM, F.G, F.bid);
            pg8::EpiY E{mixo, DM, ssp};
            pg8::gemm_phase<pg8::EpiY, pg8::StaticOrder, true, true>(F.lds, g, S, E, F.wave);
        }
        SEAM(pbase + 9);
        if (INM(pbase + 10, 10)) DUPN(10) { PHASE_PTRS(); resid_pass(F, (const float*)nullptr, mixo, ssp, Pk->in[I_GFPOST] + (size_t)L * DM, hb, (bf16*)(ws + WS_LO), rin); }
        SEAM(pbase + 10);
        if (INM(pbase + 11, 11)) DUPN(11) { PHASE_PTRS();
            pg8::Gemm g{hb, (const bf16*)(ws + WS_WPD) + (size_t)L * PLED * DM, S_, PLED, DM / 4, (long)(DM / 4) * 2, (long)(DM / 4) * 2, DM}; pg8::SplitKOrder S{F.G, F.bid, (S_ / 256) * 4};
            pg8::EpiPart E{(bf16*)(ws + WS_UP)};
            pg8::gemm_phase<pg8::EpiPart, pg8::SplitKOrder, true, true>(F.lds, g, S, E, F.wave);
        }
        SEAM(pbase + 11);
        if (INM(pbase + 12, 12)) DUPN(12) { PHASE_PTRS(); pled_combine(F, (const bf16*)(ws + WS_UP), rin, g1); }
        SEAM(pbase + 12);
        if (INM(pbase + 13, 13)) DUPN(13) { PHASE_PTRS();
            int Kp = PLED; asm volatile("; opaque K (keeps the K-loop rolled)" : "+s"(Kp));
            pg8::Gemm g{g1, (const bf16*)(ws + WS_WPU) + (size_t)L * DM * PLED, S_, DM, Kp, (long)(WS_PB - WS_G1) + (long)L * S_ * PLED * 2, (long)(WS_WPP - WS_WPU)};
#ifndef DBG_PLE_PLAIN
#define DBG_PLE_PLAIN 0
#endif
#if DBG_PLE_PLAIN == 1
            pg8::StaticOrder S; S.init(S_, DM, F.G, F.bid); pg8::EpiY E{mixo, DM, ssp};
            pg8::gemm_phase<pg8::EpiY, pg8::StaticOrder, true, true>(F.lds, g, S, E, F.wave);
#elif DBG_PLE_PLAIN == 2
            pg8::PleOrder S{F.G, F.bid, (S_ / 256) * (DM / 256)}; pg8::EpiPleDbg E{mixo, act};
            pg8::gemm_phase<pg8::EpiPleDbg, pg8::PleOrder, true, true>(F.lds, g, S, E, F.wave);
#else
            pg8::PleOrder S{F.G, F.bid, (S_ / 256) * (DM / 256)};
            pg8::EpiPle E{mixo, hb, (bf16*)(ws + WS_LO), L == DEPTH_ - 1 ? out : (float*)nullptr, ssp};
            pg8::gemm_phase<pg8::EpiPle, pg8::PleOrder, true, true>(F.lds, g, S, E, F.wave);
#endif
        }
        SEAM(pbase + 13);
        if (L + 1 < DEPTH_) { if (INM(pbase + 14, 14)) DUPN(14) { PHASE_PTRS(); rin_pass(F, ssp, rin); } SEAM(pbase + 14); }
    }
#undef IN
#undef INM
#undef SEAM
}

#ifndef DBG_STOP
#define DBG_STOP 0
#endif
#if DBG_STOP
__global__ void dbg_fold(const unsigned* ws, size_t nwords, float* out, int keep_out) {
    for (size_t i = (size_t)blockIdx.x * blockDim.x + threadIdx.x; i < (size_t)S_ * DM; i += (size_t)gridDim.x * blockDim.x) { float acc = keep_out ? out[i] : 0.f;
        for (size_t w = (1u << 18) + i; w < nwords; w += (size_t)S_ * DM) { const unsigned x = ws[w]; acc += (float)(x & 0xffffu) * (1.f / 65536.f) + (float)(x >> 16) * (1.f / 65536.f); }
        out[i] = acc; }
}
#endif
#ifndef DBG_CHECK
#define DBG_CHECK 0
#endif
#ifndef DBG_LAYER
#define DBG_LAYER 0
#endif

#if DBG_CHECK
__global__ void chk_rin(const float* h, const float* rin, float* errs, int code) { __shared__ float sh[8]; const int row = hsh(2020 + blockIdx.x) % S_; float ss = 0.f;
    for (int k = threadIdx.x; k < DM; k += blockDim.x) { const float a = h[(size_t)row * DM + k]; ss += a * a; } ss = blk_sum(ss, sh); if (threadIdx.x == 0) rep_err(errs, code, rin[row], rsqrtf(ss / DM + EPS_), 1e-3f); }
static void dbg_checks(int k, int before, void* const* d_in, void* d_out, void* d_ws, hipStream_t st) {
    const int r = (k - 1) % PH_PER_LAYER, L = (k - 1) / PH_PER_LAYER, j = L >> 1; const bool ev = (L & 1) == 0;
    if (k < 1 || L != DBG_LAYER) return;
    unsigned char* ws = (unsigned char*)d_ws; float* errs = (float*)(ws + 512 * 1024); float* out = (float*)d_out; float* tmp = (float*)(ws + WS_UP);
    const float* const* in = (const float* const*)d_in;
    bf16* proj = (bf16*)(ws + WS_PROJ); bf16* ymix = (bf16*)(ws + WS_YMIX); bf16* mixo = (bf16*)(ws + WS_MIXO); bf16* hb = (bf16*)(ws + WS_HB); bf16* upb = (bf16*)(ws + WS_UP); bf16* act = (bf16*)(ws + WS_ACT);
    bf16* od = (bf16*)(ws + WS_OD); bf16* g1 = (bf16*)(ws + WS_G1); float* rin = (float*)(ws + WS_RIN); float* ssp = (float*)(ws + WS_SSP); float* gpre = (float*)(ws + WS_GPRE);
    const float* cst = (const float*)(ws + WS_COS); const float* snt = (const float*)(ws + WS_SIN);
    const float* hin0 = (L == 0) ? in[I_X] : (const float*)out;
    if (before) { if ((DBG_CHECK == 1 && r == 6 && L > 0) || (DBG_CHECK == 2 && (r == 10 || r == 12))) (void)hipMemcpyAsync(tmp, out, (size_t)S_ * DM * 4, hipMemcpyDeviceToDevice, st); return; }
    if (DBG_CHECK == 1) {
        if (r == 0) { const float* W = ev ? in[I_WINE] + (size_t)j * DM * 6152 : in[I_WINO] + (size_t)j * DM * 6144;
            hipLaunchKernelGGL(chk_gemm, dim3(16384), dim3(256), 0, st, hin0, (const bf16*)nullptr, DM, in[I_GMPRE] + (size_t)L * DM, (const float*)nullptr, 1, W, ev ? 6152 : 6144, NIN, ev ? 2048 : 1024, cst, snt, (const bf16*)proj, NIN, errs, 1, 11u);
            if (ev) hipLaunchKernelGGL(chk_gates, dim3(4096), dim3(256), 0, st, hin0, in[I_GMPRE] + (size_t)L * DM, in[I_WINE] + (size_t)j * DM * 6152, (const float*)gpre, errs, 2); }
        if (r == 3) { float* hn = (float*)(ws + WS_UP); float* scr = (float*)(ws + WS_UP + 128 * MiB);
            if (ev) { hipLaunchKernelGGL(chk_diffattn, dim3(1024), dim3(256), 0, st, (const bf16*)proj, (const bf16*)od, scr, errs, 3);
                hipLaunchKernelGGL(chk_lin_naive, dim3(256, 4), dim3(128), 0, st, (const bf16*)proj, (const float*)gpre, in[I_BIG] + j * 4, in[I_BFG] + j * 4, in[I_WCQK] + (size_t)j * 4096, in[I_BCQK] + (size_t)j * 1024, 1, hn);
                hipLaunchKernelGGL(chk_lin_cmp, dim3(8192), dim3(256), 0, st, (const float*)hn, (const bf16*)proj, in[I_GML] + j * 256, 1, (const bf16*)ymix, errs, 4);
            } else { hipLaunchKernelGGL(chk_stick, dim3(1024), dim3(128), 0, st, (const bf16*)proj, (const bf16*)ymix, errs, 3);
                hipLaunchKernelGGL(chk_lin_naive, dim3(256, 4), dim3(128), 0, st, (const bf16*)proj, (const float*)gpre, in[I_BIG], in[I_BFG], in[I_WCQK], in[I_BCQK], 0, hn);
                hipLaunchKernelGGL(chk_lin_cmp, dim3(8192), dim3(256), 0, st, (const float*)hn, (const bf16*)proj, in[I_GRET] + j * 256, 0, (const bf16*)ymix, errs, 4); } }
        if (r == 4 && ev) hipLaunchKernelGGL(chk_diffcomb, dim3(8192), dim3(256), 0, st, (const bf16*)od, in[I_DLAM] + (size_t)j * 512, in[I_GDIFF] + j * 256, 0.8f - 0.6f * expf(-0.3f * (float)L), (const bf16*)ymix, errs, 5);
        if (r == 5) { const float* W = (ev ? in[I_WOUTE] : in[I_WOUTO]) + (size_t)j * NMIX * DM;
            hipLaunchKernelGGL(chk_gemm, dim3(16384), dim3(256), 0, st, (const float*)nullptr, (const bf16*)ymix, NMIX, (const float*)nullptr, (const float*)nullptr, 0, W, DM, DM, 0, cst, snt, (const bf16*)mixo, DM, errs, 6, 22u);
            hipLaunchKernelGGL(chk_ssp, dim3(4096), dim3(256), 0, st, (const bf16*)mixo, (const float*)ssp, errs, 6); }
        if (r == 6) hipLaunchKernelGGL(chk_resid, dim3(4096), dim3(256), 0, st, L == 0 ? in[I_X] : (const float*)tmp, (const bf16*)mixo, in[I_GMPOST] + (size_t)L * DM, (const float*)out, (const float*)rin, errs, 7);
        if (r == 7) hipLaunchKernelGGL(chk_gemm, dim3(16384), dim3(256), 0, st, (const float*)nullptr, (const bf16*)hb, DM, in[I_GFPRE] + (size_t)L * DM, (const float*)rin, 0, in[I_WUP] + (size_t)L * DM * NUP, NUP, NUP, 0, cst, snt, (const bf16*)upb, NUP, errs, 8, 33u);
        if (r == 8) hipLaunchKernelGGL(chk_conv, dim3(4096), dim3(256), 0, st, (const bf16*)upb, in[I_WFC] + (size_t)L * 3 * NUP, in[I_BFC] + (size_t)L * NUP, (const bf16*)act, errs, 9);
    } else {
        if (r == 9) { hipLaunchKernelGGL(chk_gemm, dim3(16384), dim3(256), 0, st, (const float*)nullptr, (const bf16*)act, DM, (const float*)nullptr, (const float*)nullptr, 0, in[I_WDN] + (size_t)L * DM * DM, DM, DM, 0, cst, snt, (const bf16*)mixo, DM, errs, 1, 44u);
            hipLaunchKernelGGL(chk_ssp, dim3(4096), dim3(256), 0, st, (const bf16*)mixo, (const float*)ssp, errs, 1); }
        if (r == 10) hipLaunchKernelGGL(chk_resid, dim3(4096), dim3(256), 0, st, (const float*)tmp, (const bf16*)mixo, in[I_GFPOST] + (size_t)L * DM, (const float*)out, (const float*)rin, errs, 2);
        if (r == 11) hipLaunchKernelGGL(chk_gemm, dim3(16384), dim3(256), 0, st, (const float*)nullptr, (const bf16*)hb, DM, in[I_GPLE] + (size_t)L * DM, (const float*)rin, 0, in[I_WPD] + (size_t)L * DM * PLED, PLED, PLED, 0, cst, snt, (const bf16*)g1, PLED, errs, 3, 55u);
        if (r == 12 && DBG_PLE_PLAIN == 2) hipLaunchKernelGGL(chk_gemm, dim3(16384), dim3(256), 0, st, (const float*)nullptr, (const bf16*)(ws + WS_PB) + (size_t)L * S_ * PLED, PLED, (const float*)nullptr, (const float*)nullptr, 0, in[I_WPP] + (size_t)L * PLED * DM, DM, DM, 0, cst, snt, (const bf16*)act, DM, errs, 5, 77u);
        if (r == 12 && DBG_PLE_PLAIN) hipLaunchKernelGGL(chk_gemm, dim3(16384), dim3(256), 0, st, (const float*)nullptr, (const bf16*)g1, PLED, (const float*)nullptr, (const float*)nullptr, 0, in[I_WPU] + (size_t)L * PLED * DM, DM, DM, 0, cst, snt, (const bf16*)mixo, DM, errs, 4, 66u);
        if (r == 12 && !DBG_PLE_PLAIN) { hipLaunchKernelGGL(chk_ple2, dim3(16384), dim3(256), 0, st, (const float*)tmp, (const bf16*)g1, in[I_WPU] + (size_t)L * PLED * DM, in[I_P] + (size_t)L * S_ * PLED, in[I_WPP] + (size_t)L * PLED * DM, (const float*)out, (const bf16*)mixo, errs, 4);
            hipLaunchKernelGGL(chk_ple, dim3(16384), dim3(256), 0, st, (const float*)tmp, (const bf16*)g1, in[I_WPU] + (size_t)L * PLED * DM, in[I_P] + (size_t)L * S_ * PLED, in[I_WPP] + (size_t)L * PLED * DM, (const float*)out, errs, 5); }
        if (r == 13) hipLaunchKernelGGL(chk_rin, dim3(4096), dim3(256), 0, st, (const float*)out, (const float*)rin, errs, 7);
    }
}
#endif
#ifndef DBG_NOPERT
#define DBG_NOPERT 0
#endif
#if DBG_PERTURB
__global__ void dbg_save(const float* out, bf16* sav) { for (size_t i = (size_t)blockIdx.x * blockDim.x + threadIdx.x; i < (size_t)S_ * DM; i += (size_t)gridDim.x * blockDim.x) sav[i] = (bf16)f2bf(out[i]); }
__global__ void dbg_cmp(const float* out, const bf16* sav, float* res) {
    __shared__ float sh[8]; const int row = blockIdx.x; float m = 0.f;
    for (int k = threadIdx.x; k < DM; k += blockDim.x) m = fmaxf(m, fabsf(out[(size_t)row * DM + k] - h2f(sav[(size_t)row * DM + k])));
    m = wave_max(m); __syncthreads(); if ((threadIdx.x & 63) == 0) sh[threadIdx.x >> 6] = m; __syncthreads();
    if (threadIdx.x == 0) { m = fmaxf(fmaxf(sh[0], sh[1]), fmaxf(sh[2], sh[3])); res[16 + row] = m; atomicMax((int*)res, __float_as_int(m)); }
}
__global__ void dbg_ysave(const bf16* ymix, bf16* sav) { for (int i = blockIdx.x * blockDim.x + threadIdx.x; i < 64 * NMIX; i += gridDim.x * blockDim.x) sav[i] = ymix[i]; }
__global__ void dbg_ycmp(const bf16* ymix, const bf16* sav, float* res, int L) {
    for (int i = blockIdx.x * blockDim.x + threadIdx.x; i < 64 * NMIX; i += gridDim.x * blockDim.x) { const float d = fabsf(h2f(ymix[i]) - h2f(sav[i]));
        atomicMax((int*)res + 1 + L, __float_as_int(d)); if (L == 0) atomicMax((unsigned long long*)(res + 1000), ((unsigned long long)__float_as_uint(d) << 32) | (unsigned)i); atomicMax((int*)res + 100 + L * 8 + ((i % NMIX) >> 8), __float_as_int(d)); atomicMax((int*)res + 200 + L * 64 + i / NMIX, __float_as_int(d)); }
}
__global__ void dbg_fetch(const bf16* ymix, float* res) { const unsigned i = ((const unsigned*)res)[1000]; res[1002] = h2f(ymix[i]); }
__global__ void dbg_rep(const float* res, float* out) {
    __shared__ float cc; if (threadIdx.x == 0) { const float mx = res[0]; int rw = 0; for (int r = 0; r < S_; ++r) if (res[16 + r] == mx) { rw = r; break; }
        int cnt = 0; for (int r = 0; r < S_; ++r) if (res[16 + r] > 0.5f * mx) ++cnt;
        if (DBG_PERTURB >= 5) { int Lf = 9, cb = 0, rw2 = 0; float md = 0.f; for (int L = 0; L < 4; ++L) if (res[1 + L] > 0.1f) { Lf = L; break; }
            if (Lf < 4) { for (int b = 0; b < 8; ++b) if (res[100 + Lf * 8 + b] > md) { md = res[100 + Lf * 8 + b]; cb = b; } md = 0.f; for (int r = 0; r < 64; ++r) if (res[200 + Lf * 64 + r] > md) { md = res[200 + Lf * 64 + r]; rw2 = r; } }
            cc = (DBG_PERTURB == 5) ? 1000.f * (Lf + 1) + 100.f * cb : (DBG_PERTURB == 6) ? 1000.f * (Lf + 1) + 100.f * fminf(9.f, (float)rw2) : (DBG_PERTURB == 11) ? 1000.f + 100.f * (float)rw2 : (DBG_PERTURB == 12) ? 1000.f + 30.f * (float)(((const unsigned*)res)[1000] % NMIX & 255) : (DBG_PERTURB == 13) ? 1000.f + 1000.f * fabsf(res[1002]) : 1000.f + 1000.f * res[1 + (DBG_PERTURB - 7)]; }
        else cc = (DBG_PERTURB == 1) ? 1000.f + mx * 1000.f : (DBG_PERTURB == 2) ? 1000.f + (float)rw * (9000.f / 16384.f) : (DBG_PERTURB == 3) ? 1000.f + (float)(rw & 1023) * (9000.f / 1024.f) : 1000.f + (float)cnt * 10.f; }
    __syncthreads(); const float c = cc;
    for (size_t i = (size_t)blockIdx.x * blockDim.x + threadIdx.x; i < (size_t)S_ * DM; i += (size_t)gridDim.x * blockDim.x) out[i] = c;
}
#endif
#if DBG_TIME
__global__ void dbg_time_rep(const unsigned long long* st, float* out) {
    __shared__ float cc; if (threadIdx.x == 0) { double us = 0.0; const int kind = DBG_TIME - 1;
        if (kind == 0) us = (double)(st[1] - st[0]) * 0.01; else if (kind == 20) us = (double)(st[1 + PH_PER_LAYER * (DEPTH_ - 1) + 13] - st[0]) * 0.01;
        else if (kind >= 30) { const int L = kind - 30; us = (double)(st[1 + 1 + PH_PER_LAYER * L + 3] - st[1 + PH_PER_LAYER * L + 3]) * 0.01; }
        else { const int r = kind - 1; for (int L = 0; L < DEPTH_; ++L) { const int k = 1 + PH_PER_LAYER * L + r; if ((r == 4 && (L & 1)) || (r == 13 && L == DEPTH_ - 1)) continue; unsigned long long prev = st[k]; int kp = k; while (prev == 0ull && kp > 0) prev = st[--kp]; us += (double)(st[k + 1] - prev) * 0.01; } }
        cc = (float)(us * 100.0); }
    __syncthreads(); const float c = cc;
    for (size_t i = (size_t)blockIdx.x * blockDim.x + threadIdx.x; i < (size_t)S_ * DM; i += (size_t)gridDim.x * blockDim.x) out[i] = c;
}
#endif
extern "C" void kernel_launch(void* const* d_in, const int* in_sizes, int n_in, void* d_out, int out_size, void* d_ws, size_t ws_size, hipStream_t stream) {
    static int grid = 0;
    if (grid == 0) {
        if (n_in != 26 || out_size != S_ * DM || ws_size < WS_END) { fprintf(stderr, "kernel_launch: unexpected shapes (n_in %d, out %d, ws %zu < %zu); nothing launched\n", n_in, out_size, ws_size, (size_t)WS_END); grid = -1; return; }
        int dev = 0, cus = 0, per_cu = 0;
        if (hipGetDevice(&dev) != hipSuccess || hipDeviceGetAttribute(&cus, hipDeviceAttributeMultiprocessorCount, dev) != hipSuccess) { grid = -1; return; }
        if (hipFuncSetAttribute((const void*)fwd_kernel, hipFuncAttributeMaxDynamicSharedMemorySize, LDS_BYTES) != hipSuccess) { fprintf(stderr, "kernel_launch: hipFuncSetAttribute failed\n"); grid = -1; return; }
        if (hipOccupancyMaxActiveBlocksPerMultiprocessor(&per_cu, (const void*)fwd_kernel, NWAVES * 64, LDS_BYTES) != hipSuccess || per_cu < 1) { fprintf(stderr, "kernel_launch: occupancy query says %d blocks per CU\n", per_cu); (void)hipGetLastError(); }
        grid = cus;
    }
    if (grid < 0) return;
    (void)hipMemsetAsync((char*)d_ws + WS_CTL, 0, CTL_ZERO_BYTES, stream);
    Params p{};
    for (int i = 0; i < 26; ++i) p.in[i] = (const float*)d_in[i];
    p.out = (float*)d_out; p.ws = (unsigned char*)d_ws;
#if MK_SPLIT
#if DBG_PERTURB
    for (int rep = 0; rep < 2; ++rep) { p.pert = DBG_NOPERT ? 0 : rep;
#endif
    for (int k = 0; k < N_PHASES; ++k) { const int r = (k - 1) % PH_PER_LAYER, L = (k - 1) / PH_PER_LAYER;
        if (k > 0 && (r > 14 || (r == 4 && (L & 1)) || (r == 14 && L == DEPTH_ - 1))) continue;
        if (DBG_STOP && k >= DBG_STOP) break;
#if DBG_CHECK
        dbg_checks(k, 1, d_in, d_out, d_ws, stream);
#endif
        p.ph_lo = k; p.ph_hi = k + 1; hipLaunchKernelGGL(fwd_kernel, dim3(grid), dim3(NWAVES * 64), LDS_BYTES, stream, p);
#if DBG_CHECK
        dbg_checks(k, 0, d_in, d_out, d_ws, stream);
#endif
#if DBG_PERTURB
        { const int r_ = (k - 1) % PH_PER_LAYER, L_ = (k - 1) / PH_PER_LAYER; if (k >= 1 && ((r_ == 4 && !(L_ & 1)) || (r_ == 3 && (L_ & 1)))) { bf16* ys = (bf16*)((char*)d_ws + WS_END + 128 * MiB) + (size_t)L_ * 64 * NMIX;
            if (rep == 0) hipLaunchKernelGGL(dbg_ysave, dim3(64), dim3(256), 0, stream, (const bf16*)((char*)d_ws + WS_YMIX), ys);
            else { hipLaunchKernelGGL(dbg_ycmp, dim3(64), dim3(256), 0, stream, (const bf16*)((char*)d_ws + WS_YMIX), (const bf16*)ys, (float*)((char*)d_ws + 512 * 1024), L_); if (L_ == 0) hipLaunchKernelGGL(dbg_fetch, dim3(1), dim3(1), 0, stream, (const bf16*)((char*)d_ws + WS_YMIX), (float*)((char*)d_ws + 512 * 1024)); } } }
#endif
    }
#if DBG_PERTURB
    if (rep == 0) { (void)hipMemsetAsync((char*)d_ws + WS_CTL, 0, CTL_ZERO_BYTES, stream); hipLaunchKernelGGL(dbg_save, dim3(2048), dim3(256), 0, stream, (const float*)d_out, (bf16*)((char*)d_ws + WS_END)); }
    else { float* res = (float*)((char*)d_ws + 512 * 1024); hipLaunchKernelGGL(dbg_cmp, dim3(S_), dim3(256), 0, stream, (const float*)d_out, (const bf16*)((char*)d_ws + WS_END), res); hipLaunchKernelGGL(dbg_rep, dim3(2048), dim3(256), 0, stream, (const float*)res, (float*)d_out); }
    }
#endif
#if DBG_CHECK
    hipLaunchKernelGGL(chk_final, dim3(2048), dim3(256), 0, stream, (const float*)((char*)d_ws + 512 * 1024), (float*)d_out, DBG_TOL);
#endif
#else
    p.ph_lo = 0; p.ph_hi = N_PHASES;
    hipLaunchKernelGGL(fwd_kernel, dim3(grid), dim3(NWAVES * 64), LDS_BYTES, stream, p);
#endif
#if DBG_STOP
    hipLaunchKernelGGL(dbg_fold, dim3(2048), dim3(256), 0, stream, (const unsigned*)d_ws, (size_t)(WS_END / 4), (float*)d_out, DBG_STOP > 7 ? 1 : 0);
#endif
#if DBG_TIME
    hipLaunchKernelGGL(dbg_time_rep, dim3(2048), dim3(256), 0, stream, (const unsigned long long*)((char*)d_ws + 768 * 1024), (float*)d_out);
#endif
    const hipError_t le = hipPeekAtLastError();
    if (le != hipSuccess) fprintf(stderr, "kernel_launch: launch failed: %s\n", hipGetErrorName(le));
}
```

```cpp
#ifndef RES_LO
#define RES_LO 0
#endif
#include <hip/hip_runtime.h>
#include <cstdio>
#include <cstdint>
namespace pg8 {
#define PG8_LAS __attribute__((address_space(3)))
typedef unsigned short bf16_t;
typedef short bf16x8 __attribute__((ext_vector_type(8)));
typedef float f32x4 __attribute__((ext_vector_type(4)));
typedef unsigned u32x4 __attribute__((ext_vector_type(4)));
constexpr int BM = 256, BK = 64, HALF = 128, HTB = HALF * BK * 2  , STAGE_BYTES = 8 * HTB, NXCD = 8, WGM = 8;

__host__ __device__ __forceinline__ int lds_byte(int r, int c) { const int st = (r >> 4) * 2 + (c >> 5), rr = r & 15, cc = c & 31, ob = rr * 64 + cc * 2; return st * 1024 + (ob ^ (((ob >> 9) & 1) << 5)); }
__host__ __device__ __forceinline__ void stage_rc(int b, int& R, int& C) { const int st = b / 1024, sb = b % 1024, swz = sb ^ (((sb >> 9) & 1) << 5); R = (st >> 1) * 16 + swz / 64; C = (st & 1) * 32 + (swz % 64) / 2; }
__host__ __device__ __forceinline__ int perm32(int rho) { const int n = rho >> 4, i = rho & 15; return 8 * (i >> 2) + 4 * n + (i & 3); }

struct Unit { int pm, pn, which; };
struct Gemm { const bf16_t* A; const bf16_t* Bt; int M, N, K; long dA, dB; int ld; };

struct StaticOrder {
    int nM, nN, nwg, G, c;
    __host__ __device__ void init(int M, int N, int G_, int c_) { nM = M / BM; nN = N / BM; nwg = nM * nN; G = G_; c = c_; }
    __host__ __device__ bool next(int i, Unit& u) const {
        const long L = (long)i * G + c; if (L >= nwg) return false;
        int wgid = (int)L; { const int q = nwg / NXCD, r = nwg % NXCD, xcd = wgid % NXCD, off = wgid / NXCD; wgid = (xcd < r ? xcd * (q + 1) : r * (q + 1) + (xcd - r) * q) + off; }
        const int nig = WGM * nN, gid = wgid / nig, fm = gid * WGM, gsz = (nM - fm) < WGM ? (nM - fm) : WGM;
        u.pm = fm + ((wgid % nig) % gsz); u.pn = (wgid % nig) / gsz; u.which = 0; return true;
    }
    __device__ __forceinline__ void a_ready(const Unit&) const {}
    __device__ __forceinline__ void done(const Unit&) const {}
};

__device__ __forceinline__ float fq_sum(float v) {
    auto a = __builtin_amdgcn_permlane16_swap(__float_as_uint(v), __float_as_uint(v), false, false); v = __uint_as_float(a[0]) + __uint_as_float(a[1]);
    auto b = __builtin_amdgcn_permlane32_swap(__float_as_uint(v), __float_as_uint(v), false, false); return __uint_as_float(b[0]) + __uint_as_float(b[1]); }
#ifndef USE_F16
#define USE_F16 1
#endif
typedef float f32x2_t __attribute__((ext_vector_type(2))); typedef __bf16 bf16x2_t __attribute__((ext_vector_type(2)));
typedef _Float16 h16x2_t __attribute__((ext_vector_type(2))); typedef _Float16 h16x8_t __attribute__((ext_vector_type(8)));
#if USE_F16
__device__ __forceinline__ unsigned cvt_pk_bf16(float lo, float hi) { f32x2_t v = {lo, hi}; h16x2_t b = __builtin_convertvector(v, h16x2_t); return __builtin_bit_cast(unsigned, b); }
__device__ __forceinline__ float unpk_lo(unsigned w) { return (float)__builtin_bit_cast(h16x2_t, w)[0]; }
__device__ __forceinline__ float unpk_hi(unsigned w) { return (float)__builtin_bit_cast(h16x2_t, w)[1]; }
#define MFMA16(a, b, c) __builtin_amdgcn_mfma_f32_16x16x32_f16(__builtin_bit_cast(pg8::h16x8_t, (a)), __builtin_bit_cast(pg8::h16x8_t, (b)), (c), 0, 0, 0)
#define MFMA32(a, b, c) __builtin_amdgcn_mfma_f32_32x32x16_f16(__builtin_bit_cast(pg8::h16x8_t, (a)), __builtin_bit_cast(pg8::h16x8_t, (b)), (c), 0, 0, 0)
#else
__device__ __forceinline__ unsigned cvt_pk_bf16(float lo, float hi) { f32x2_t v = {lo, hi}; bf16x2_t b = __builtin_convertvector(v, bf16x2_t); return __builtin_bit_cast(unsigned, b); }
__device__ __forceinline__ float unpk_lo(unsigned w) { return __uint_as_float(w << 16); }
__device__ __forceinline__ float unpk_hi(unsigned w) { return __uint_as_float(w & 0xffff0000u); }
#define MFMA16(a, b, c) __builtin_amdgcn_mfma_f32_16x16x32_bf16((a), (b), (c), 0, 0, 0)
#define MFMA32(a, b, c) __builtin_amdgcn_mfma_f32_32x32x16_bf16((a), (b), (c), 0, 0, 0)
#endif

struct EpiProj {
    static constexpr bool PERM = true, AFTER_DRAIN = false;
    bf16_t* O; int ldc; const float* rs; const float* cs; const float* sn; int rope_tiles;
    __device__ __forceinline__ void operator()(const f32x4 (&acc)[2][2][4][2], const Unit& u, int wr, int wc, int fr_in, int fq_in) const {
        int fr = fr_in, fq = fq_in; asm volatile("; EPI_ENTRY" : "+v"(fr), "+v"(fq));
        const int row0 = u.pm * BM + wr * 64 + fr, col0 = u.pn * BM + wc * 32 + 8 * fq;
        const bool rope = u.pn < rope_tiles; const int i0 = (wc * 32 + 8 * fq) >> 1;
#pragma unroll
        for (int ai = 0; ai < 2; ++ai)
#pragma unroll
            for (int m = 0; m < 4; ++m) { const int row = row0 + ai * HALF + m * 16; const float r = rs[row];
                f32x4 c4 = (f32x4){1.f, 1.f, 1.f, 1.f}, s4 = (f32x4){0.f, 0.f, 0.f, 0.f};
                if (rope) { c4 = *(const f32x4*)(cs + (size_t)row * 64 + i0); s4 = *(const f32x4*)(sn + (size_t)row * 64 + i0); }
                bf16_t* rowp = O + (size_t)row * ldc + col0;
#pragma unroll
                for (int bj = 0; bj < 2; ++bj) { const f32x4 v0 = acc[ai][bj][m][0] * r, v1 = acc[ai][bj][m][1] * r;
                    f32x4 o0, o1;
                    o0[0] = v0[0] * c4[0] - v0[1] * s4[0]; o0[1] = v0[1] * c4[0] + v0[0] * s4[0];
                    o0[2] = v0[2] * c4[1] - v0[3] * s4[1]; o0[3] = v0[3] * c4[1] + v0[2] * s4[1];
                    o1[0] = v1[0] * c4[2] - v1[1] * s4[2]; o1[1] = v1[1] * c4[2] + v1[0] * s4[2];
                    o1[2] = v1[2] * c4[3] - v1[3] * s4[3]; o1[3] = v1[3] * c4[3] + v1[2] * s4[3];
                    u32x4 w; w.x = cvt_pk_bf16(o0[0], o0[1]); w.y = cvt_pk_bf16(o0[2], o0[3]); w.z = cvt_pk_bf16(o1[0], o1[1]); w.w = cvt_pk_bf16(o1[2], o1[3]);
                    *(u32x4*)(rowp + bj * HALF) = w; } }
    }
};
struct EpiY {
    static constexpr bool PERM = true, AFTER_DRAIN = false;
    bf16_t* O; int ldc; float* ssp;
    __device__ __forceinline__ void operator()(const f32x4 (&acc)[2][2][4][2], const Unit& u, int wr, int wc, int fr_in, int fq_in) const {
        int fr = fr_in, fq = fq_in; asm volatile("; EPI_ENTRY" : "+v"(fr), "+v"(fq));
        const int row0 = u.pm * BM + wr * 64 + fr, col0 = u.pn * BM + wc * 32 + 8 * fq;
#pragma unroll
        for (int ai = 0; ai < 2; ++ai)
#pragma unroll
            for (int m = 0; m < 4; ++m) { const int row = row0 + ai * HALF + m * 16; bf16_t* rowp = O + (size_t)row * ldc + col0; float s = 0.f;
#pragma unroll
                for (int bj = 0; bj < 2; ++bj) { const f32x4 v0 = acc[ai][bj][m][0], v1 = acc[ai][bj][m][1];
                    s += (v0[0] * v0[0] + v0[1] * v0[1]) + (v0[2] * v0[2] + v0[3] * v0[3]) + (v1[0] * v1[0] + v1[1] * v1[1]) + (v1[2] * v1[2] + v1[3] * v1[3]);
                    u32x4 w; w.x = cvt_pk_bf16(v0[0], v0[1]); w.y = cvt_pk_bf16(v0[2], v0[3]); w.z = cvt_pk_bf16(v1[0], v1[1]); w.w = cvt_pk_bf16(v1[2], v1[3]);
                    *(u32x4*)(rowp + bj * HALF) = w; }
                s = fq_sum(s);
                if (fq == 0) ssp[(size_t)row * 64 + u.pn * 4 + wc] = s; }
    }
};
struct EpiPle {
    static constexpr bool PERM = true, AFTER_DRAIN = false;
    bf16_t* G; bf16_t* HI; bf16_t* LO; float* OUT32; float* ssp;
    __device__ __forceinline__ void operator()(const f32x4 (&acc)[2][2][4][2], const Unit& u, int wr, int wc, int fr_in, int fq_in) const {
        int fr = fr_in, fq = fq_in; asm volatile("; EPI_ENTRY" : "+v"(fr), "+v"(fq));
        const unsigned row0 = (unsigned)(u.pm * BM + wr * 64 + fr), col0 = (unsigned)(u.pn * BM + wc * 32 + 8 * fq);
        char* Gc = (char*)G + (size_t)(u.pm * 16 + u.pn) * 131072u + (unsigned)(wr * 4 + wc) * 16384u; char* HIc = (char*)HI; char* LOc = (char*)LO; char* Oc = (char*)OUT32;
        const unsigned goff = (unsigned)(fq * 16 + fr) * 16u;
        if (u.which == 0) {
#pragma unroll
            for (int ai = 0; ai < 2; ++ai)
#pragma unroll
                for (int m = 0; m < 4; ++m) {
                    u32x4 w;
#pragma unroll
                    for (int bj = 0; bj < 2; ++bj) { f32x4 v0 = acc[ai][bj][m][0], v1 = acc[ai][bj][m][1]; unsigned q0 = 0u, q1 = 0u;
#pragma unroll
                        for (int e = 0; e < 4; ++e) { q0 |= (unsigned)(__builtin_amdgcn_rcpf(1.f + __expf(-v0[e])) * 255.f + 0.5f) << (8 * e); q1 |= (unsigned)(__builtin_amdgcn_rcpf(1.f + __expf(-v1[e])) * 255.f + 0.5f) << (8 * e); }
                        if (bj == 0) { w.x = q0; w.y = q1; } else { w.z = q0; w.w = q1; } }
                    *(u32x4*)(Gc + (unsigned)((ai * 4 + m) * 1024) + goff) = w; }
        } else {
            asm volatile("s_waitcnt vmcnt(0)" ::: "memory");
#pragma unroll
            for (int ai = 0; ai < 2; ++ai)
#pragma unroll
                for (int m = 0; m < 4; ++m) { const unsigned row = row0 + ai * HALF + m * 16, off = row * 4096u + col0; float s = 0.f; const u32x4 gq = *(const u32x4*)(Gc + (unsigned)((ai * 4 + m) * 1024) + goff);
#pragma unroll
                    for (int bj = 0; bj < 2; ++bj) { const unsigned ob = off + bj * HALF; const unsigned qa = bj ? gq.z : gq.x, qb = bj ? gq.w : gq.y;
                        const u32x4 hw = *(const u32x4*)(HIc + (unsigned)(ob * 2u)); u32x4 lw = {0u, 0u, 0u, 0u}; if (RES_LO) lw = *(const u32x4*)(LOc + (unsigned)(ob * 2u));
                        f32x4 g0, g1, h0, h1; g0[0] = (float)(qa & 255u) * (1.f / 255.f); g0[1] = (float)((qa >> 8) & 255u) * (1.f / 255.f); g0[2] = (float)((qa >> 16) & 255u) * (1.f / 255.f); g0[3] = (float)(qa >> 24) * (1.f / 255.f);
                        g1[0] = (float)(qb & 255u) * (1.f / 255.f); g1[1] = (float)((qb >> 8) & 255u) * (1.f / 255.f); g1[2] = (float)((qb >> 16) & 255u) * (1.f / 255.f); g1[3] = (float)(qb >> 24) * (1.f / 255.f);
                        h0[0] = unpk_lo(hw.x) + unpk_lo(lw.x); h0[1] = unpk_hi(hw.x) + unpk_hi(lw.x); h0[2] = unpk_lo(hw.y) + unpk_lo(lw.y); h0[3] = unpk_hi(hw.y) + unpk_hi(lw.y);
                        h1[0] = unpk_lo(hw.z) + unpk_lo(lw.z); h1[1] = unpk_hi(hw.z) + unpk_hi(lw.z); h1[2] = unpk_lo(hw.w) + unpk_lo(lw.w); h1[3] = unpk_hi(hw.w) + unpk_hi(lw.w);
                        const f32x4 v0 = h0 + g0 * acc[ai][bj][m][0], v1 = h1 + g1 * acc[ai][bj][m][1];
                        s += (v0[0] * v0[0] + v0[1] * v0[1]) + (v0[2] * v0[2] + v0[3] * v0[3]) + (v1[0] * v1[0] + v1[1] * v1[1]) + (v1[2] * v1[2] + v1[3] * v1[3]);
                        u32x4 w; w.x = cvt_pk_bf16(v0[0], v0[1]); w.y = cvt_pk_bf16(v0[2], v0[3]); w.z = cvt_pk_bf16(v1[0], v1[1]); w.w = cvt_pk_bf16(v1[2], v1[3]);
                        if (OUT32) { *(f32x4*)(Oc + (unsigned)(ob * 4u)) = v0; *(f32x4*)(Oc + (unsigned)(ob * 4u + 16u)) = v1; }
                        else { u32x4 wl; wl.x = cvt_pk_bf16(v0[0] - unpk_lo(w.x), v0[1] - unpk_hi(w.x)); wl.y = cvt_pk_bf16(v0[2] - unpk_lo(w.y), v0[3] - unpk_hi(w.y));
                            wl.z = cvt_pk_bf16(v1[0] - unpk_lo(w.z), v1[1] - unpk_hi(w.z)); wl.w = cvt_pk_bf16(v1[2] - unpk_lo(w.w), v1[3] - unpk_hi(w.w));
                            *(u32x4*)(HIc + (unsigned)(ob * 2u)) = w; if (RES_LO) *(u32x4*)(LOc + (unsigned)(ob * 2u)) = wl; }
                        asm volatile("" ::: "memory"); }
                    s = fq_sum(s);
                    if (fq == 0) ssp[(size_t)row * 64 + u.pn * 4 + wc] = s;
                    asm volatile("" ::: "memory"); }
        }
    }
};
struct EpiPart {
    static constexpr bool PERM = true, AFTER_DRAIN = false;
    bf16_t* part;
    __device__ __forceinline__ void operator()(const f32x4 (&acc)[2][2][4][2], const Unit& u, int wr, int wc, int fr, int fq) const {
        const int row0 = u.pm * BM + wr * 64 + fr, col0 = wc * 32 + 8 * fq; bf16_t* base = part + (size_t)u.which * 16384 * 256;
#pragma unroll
        for (int ai = 0; ai < 2; ++ai)
#pragma unroll
            for (int m = 0; m < 4; ++m) { bf16_t* rowp = base + (size_t)(row0 + ai * HALF + m * 16) * 256 + col0;
#pragma unroll
                for (int bj = 0; bj < 2; ++bj) { const f32x4 v0 = acc[ai][bj][m][0], v1 = acc[ai][bj][m][1];
                    u32x4 w; w.x = cvt_pk_bf16(v0[0], v0[1]); w.y = cvt_pk_bf16(v0[2], v0[3]); w.z = cvt_pk_bf16(v1[0], v1[1]); w.w = cvt_pk_bf16(v1[2], v1[3]); *(u32x4*)(rowp + bj * HALF) = w; } }
    }
};
struct SplitKOrder {
    int G, c, nunit;
    __device__ __forceinline__ bool next(int i, Unit& u) const { const int L = i * G + c; if (L >= nunit) return false; u.pm = L >> 2; u.pn = 0; u.which = L & 3; return true; }
    __device__ __forceinline__ void a_ready(const Unit&) const {}
    __device__ __forceinline__ void done(const Unit&) const {}
};
struct EpiPleDbg {
    static constexpr bool PERM = true, AFTER_DRAIN = false;
    bf16_t* G; bf16_t* G2;
    __device__ __forceinline__ void operator()(const f32x4 (&acc)[2][2][4][2], const Unit& u, int wr, int wc, int fr, int fq) const {
        const int row0 = u.pm * BM + wr * 64 + fr, col0 = u.pn * BM + wc * 32 + 8 * fq; bf16_t* O = u.which ? G2 : G;
#pragma unroll
        for (int ai = 0; ai < 2; ++ai)
#pragma unroll
            for (int m = 0; m < 4; ++m) { const int row = row0 + ai * HALF + m * 16; bf16_t* rowp = O + (size_t)row * 4096 + col0;
#pragma unroll
                for (int bj = 0; bj < 2; ++bj) { const f32x4 v0 = acc[ai][bj][m][0], v1 = acc[ai][bj][m][1];
                    u32x4 w; w.x = cvt_pk_bf16(v0[0], v0[1]); w.y = cvt_pk_bf16(v0[2], v0[3]); w.z = cvt_pk_bf16(v1[0], v1[1]); w.w = cvt_pk_bf16(v1[2], v1[3]);
                    *(u32x4*)(rowp + bj * HALF) = w; } }
    }
};
struct PleOrder {
    int G, c, ntile;
    __device__ __forceinline__ bool next(int i, Unit& u) const { const int tl = (i >> 1) * G + c; if (tl >= ntile) return false; u.pm = tl >> 4; u.pn = tl & 15; u.which = i & 1; return true; }
    __device__ __forceinline__ void a_ready(const Unit&) const {}
    __device__ __forceinline__ void done(const Unit&) const {}
};
template <class Epi, class Sched, bool ALIGN_EPI = false, bool SP2 = false>
__device__ __forceinline__ void gemm_phase(PG8_LAS unsigned char* lds, const Gemm g, const Sched& S, const Epi& E, int wave_in) {
    int lane_o; asm volatile("v_mbcnt_lo_u32_b32 %0, -1, 0\n\tv_mbcnt_hi_u32_b32 %0, -1, %0 ; LANE_ID" : "=v"(lane_o)); const int wid = wave_in, lane = lane_o, tid = wid * 64 + lane, wr = wid >> 2, wc = wid & 3, fr = lane & 15, fq = lane >> 4;
    const int K = g.ld ? g.ld : g.K, nt = g.K / BK;
    unsigned voffA[2], voffB[2];
#pragma unroll
    for (int i = 0; i < 2; ++i) { int R, C; stage_rc(tid * 16 + i * 8192, R, C); const int Rb = Epi::PERM ? ((R & ~31) + perm32(R & 31)) : R;
        voffA[i] = (unsigned)(R * K + C) * 2u; voffB[i] = (unsigned)(Rb * K + C) * 2u; }
    const size_t kstep = (size_t)(BK * 2);
    const size_t hstep = (size_t)HALF * K * 2;
    const size_t tstep = 2 * hstep;
    const unsigned ldsw = (unsigned)wid * 1024u;
    const int aoff = lds_byte(wr * 64 + fr, fq * 8), boff = lds_byte(wc * 32 + fr, fq * 8);
#define PG8_SA(b, h) (((b) * 2 + (h)) * HTB)
#define PG8_SB(b, h) ((4 + (b) * 2 + (h)) * HTB)
#define PG8_STAGE(bufoff, gbase, voff) do { _Pragma("unroll") for (int _i = 0; _i < 2; ++_i) \
        __builtin_amdgcn_global_load_lds((const unsigned*)((const char*)(gbase) + (voff)[_i]), (PG8_LAS unsigned*)(lds + (bufoff) + ldsw + _i * 8192), 16, 0, 0); } while (0)
#define PG8_LDA(dst, b, h) do { _Pragma("unroll") for (int m = 0; m < 4; ++m) _Pragma("unroll") for (int k = 0; k < 2; ++k) dst[m][k] = *(const PG8_LAS bf16x8*)(lds + PG8_SA(b, h) + aoff + m * 2048 + k * 1024); } while (0)
#define PG8_LDB(dst, b, h) do { _Pragma("unroll") for (int n = 0; n < 2; ++n) _Pragma("unroll") for (int k = 0; k < 2; ++k) dst[n][k] = *(const PG8_LAS bf16x8*)(lds + PG8_SB(b, h) + boff + n * 2048 + k * 1024); } while (0)
#define PG8_MMA(ai, bj, At, Bt) do { __builtin_amdgcn_s_setprio(1); _Pragma("unroll") for (int m = 0; m < 4; ++m) _Pragma("unroll") for (int n = 0; n < 2; ++n) _Pragma("unroll") for (int k = 0; k < 2; ++k) \
        acc[ai][bj][m][n] = MFMA16(Bt[n][k], At[m][k], acc[ai][bj][m][n]); __builtin_amdgcn_s_setprio(0); } while (0)
#define PG8_WAIT_V(n) asm volatile("s_waitcnt vmcnt(" #n ")" ::: "memory")
#define PG8_WAIT_L(n) asm volatile("s_waitcnt lgkmcnt(" #n ")" ::: "memory")
#define PG8_BAR __builtin_amdgcn_s_barrier()
#define PG8_SCHED __builtin_amdgcn_sched_barrier(0)
    Unit cur, nxt; int ui = 0;
    if (!S.next(0, cur)) return;
    f32x4 acc[2][2][4][2];
#pragma unroll
    for (int a = 0; a < 2; ++a)
#pragma unroll
        for (int b = 0; b < 2; ++b)
#pragma unroll
            for (int m = 0; m < 4; ++m)
#pragma unroll
                for (int n = 0; n < 2; ++n) acc[a][b][m][n] = (f32x4){0.f, 0.f, 0.f, 0.f};
    bf16x8 At[4][2], B0[2][2], B1[2][2];
    const char* cA = (const char*)g.A + (size_t)cur.pm * tstep + (size_t)cur.which * (size_t)g.dA; const char* cB = (const char*)g.Bt + (size_t)cur.pn * tstep + (size_t)cur.which * (size_t)g.dB;
    S.a_ready(cur);
    if constexpr (SP2) {
        PG8_STAGE(PG8_SB(0, 0), cB, voffB); PG8_STAGE(PG8_SB(0, 1), cB + hstep, voffB); PG8_STAGE(PG8_SA(0, 0), cA, voffA); PG8_STAGE(PG8_SA(0, 1), cA + hstep, voffA);
        if (wr == 1) PG8_BAR;
        PG8_WAIT_V(2); PG8_BAR;
        PG8_STAGE(PG8_SB(1, 0), cB + kstep, voffB); PG8_STAGE(PG8_SA(1, 0), cA + kstep, voffA); PG8_STAGE(PG8_SB(1, 1), cB + hstep + kstep, voffB);
        PG8_WAIT_V(6); PG8_BAR;
    } else {
        PG8_STAGE(PG8_SB(0, 0), cB, voffB); PG8_STAGE(PG8_SA(0, 0), cA, voffA); PG8_STAGE(PG8_SB(0, 1), cB + hstep, voffB); PG8_STAGE(PG8_SA(0, 1), cA + hstep, voffA);
        if (wr == 1) PG8_BAR;
        PG8_WAIT_V(4); PG8_BAR;
        PG8_STAGE(PG8_SB(1, 0), cB + kstep, voffB); PG8_STAGE(PG8_SA(1, 0), cA + kstep, voffA); PG8_STAGE(PG8_SB(1, 1), cB + hstep + kstep, voffB);
        PG8_WAIT_V(6); PG8_BAR;
    }
    for (;;) {
        const bool has_next = S.next(ui + 1, nxt);
        const char* nA = has_next ? (const char*)g.A + (size_t)nxt.pm * tstep + (size_t)nxt.which * (size_t)g.dA : cA; const char* nB = has_next ? (const char*)g.Bt + (size_t)nxt.pn * tstep + (size_t)nxt.which * (size_t)g.dB : cB;
        for (int t = 0; t < nt; t += 2) {
            const bool last = (t == nt - 2);
            const char* a1 = cA + (size_t)(t + 1) * kstep;
            const char* a2 = last ? nA : cA + (size_t)(t + 2) * kstep; const char* b2 = last ? nB : cB + (size_t)(t + 2) * kstep;
            const char* a3 = a2 + kstep; const char* b3 = b2 + kstep;
            if (last && has_next) S.a_ready(nxt);
            if constexpr (SP2) {
            PG8_LDB(B0, 0, 0); PG8_LDB(B1, 0, 1); PG8_SCHED; PG8_LDA(At, 0, 0); PG8_STAGE(PG8_SA(1, 1), a1 + hstep, voffA);
            PG8_WAIT_V(8); PG8_WAIT_L(0); PG8_BAR; PG8_MMA(0, 0, At, B0); PG8_MMA(0, 1, At, B1); PG8_BAR; PG8_SCHED;
            PG8_LDA(At, 0, 1); PG8_STAGE(PG8_SB(0, 0), b2, voffB); PG8_STAGE(PG8_SB(0, 1), b2 + hstep, voffB); PG8_STAGE(PG8_SA(0, 0), a2, voffA);
            PG8_WAIT_V(8); PG8_WAIT_L(0); PG8_BAR; PG8_MMA(1, 0, At, B0); PG8_MMA(1, 1, At, B1); PG8_BAR; PG8_SCHED;
            PG8_LDB(B0, 1, 0); PG8_LDB(B1, 1, 1); PG8_SCHED; PG8_LDA(At, 1, 0); PG8_STAGE(PG8_SA(0, 1), a2 + hstep, voffA);
            PG8_WAIT_V(8); PG8_WAIT_L(0); PG8_BAR; PG8_MMA(0, 0, At, B0); PG8_MMA(0, 1, At, B1); PG8_BAR; PG8_SCHED;
            PG8_LDA(At, 1, 1); PG8_STAGE(PG8_SB(1, 0), b3, voffB); PG8_STAGE(PG8_SB(1, 1), b3 + hstep, voffB); PG8_STAGE(PG8_SA(1, 0), a3, voffA);
            PG8_WAIT_V(8); PG8_WAIT_L(0); PG8_BAR; PG8_MMA(1, 0, At, B0); PG8_MMA(1, 1, At, B1); PG8_BAR; PG8_SCHED;
            } else {
            PG8_LDB(B0, 0, 0); PG8_SCHED; PG8_LDA(At, 0, 0); PG8_STAGE(PG8_SA(1, 1), a1 + hstep, voffA);
            PG8_WAIT_L(8); PG8_BAR; PG8_WAIT_L(0); PG8_MMA(0, 0, At, B0); PG8_BAR; PG8_SCHED;
            PG8_LDB(B1, 0, 1); PG8_STAGE(PG8_SB(0, 0), b2, voffB);
            PG8_BAR; PG8_WAIT_L(0); PG8_MMA(0, 1, At, B1); PG8_BAR;
            PG8_LDA(At, 0, 1); PG8_STAGE(PG8_SA(0, 0), a2, voffA);
            PG8_BAR; PG8_WAIT_L(0); PG8_MMA(1, 0, At, B0); PG8_BAR; PG8_SCHED;
            PG8_STAGE(PG8_SB(0, 1), b2 + hstep, voffB);
            PG8_WAIT_V(6); PG8_BAR; PG8_MMA(1, 1, At, B1); PG8_BAR;
            PG8_LDB(B0, 1, 0); PG8_SCHED; PG8_LDA(At, 1, 0); PG8_STAGE(PG8_SA(0, 1), a2 + hstep, voffA);
            PG8_WAIT_L(8); PG8_BAR; PG8_WAIT_L(0); PG8_MMA(0, 0, At, B0); PG8_BAR; PG8_SCHED;
            PG8_LDB(B1, 1, 1); PG8_STAGE(PG8_SB(1, 0), b3, voffB);
            PG8_BAR; PG8_WAIT_L(0); PG8_MMA(0, 1, At, B1); PG8_BAR;
            PG8_LDA(At, 1, 1); PG8_STAGE(PG8_SA(1, 0), a3, voffA);
            PG8_BAR; PG8_WAIT_L(0); PG8_MMA(1, 0, At, B0); PG8_BAR; PG8_SCHED;
            PG8_STAGE(PG8_SB(1, 1), b3 + hstep, voffB);
            PG8_WAIT_V(6); PG8_BAR; PG8_MMA(1, 1, At, B1); PG8_BAR;
            }
        }
        if constexpr (ALIGN_EPI) { if (wr == 0) PG8_BAR; }
        if constexpr (!Epi::AFTER_DRAIN) { E(acc, cur, wr, wc, fr, fq); S.done(cur); }
        if (!has_next) break;
#pragma unroll
        for (int a = 0; a < 2; ++a)
#pragma unroll
            for (int b = 0; b < 2; ++b)
#pragma unroll
                for (int m = 0; m < 4; ++m)
#pragma unroll
                    for (int n = 0; n < 2; ++n) acc[a][b][m][n] = (f32x4){0.f, 0.f, 0.f, 0.f};
        cur = nxt; cA = nA; cB = nB; ++ui;
        if constexpr (ALIGN_EPI) { if (wr == 1) PG8_BAR; }
    }
    PG8_WAIT_V(0);
    if constexpr (!ALIGN_EPI) { if (wr == 0) PG8_BAR; }
    PG8_BAR;
    if constexpr (Epi::AFTER_DRAIN) { E.fused(acc, cur, wr, wc, fr, fq, lds, wid, lane); S.done(cur); }
#undef PG8_SA
#undef PG8_SB
#undef PG8_STAGE
#undef PG8_LDA
#undef PG8_LDB
#undef PG8_MMA
#undef PG8_WAIT_V
#undef PG8_WAIT_L
#undef PG8_BAR
#undef PG8_SCHED
}
}

constexpr int S_ = 16384, DM = 4096, NUP = 8192, NIN = 6144, NMIX = 2048, PLED = 256, DEPTH_ = 4, NCH = S_ / 64;
constexpr float EPS_ = 1e-6f;
constexpr int NWAVES = 8;
constexpr size_t MiB = 1u << 20;
constexpr size_t WS_CTL = 0, CTL_ZERO_BYTES = 1 * MiB;
constexpr size_t WS_RIN = 1 * MiB;
constexpr size_t WS_LAM = 1 * MiB + 65536;
constexpr size_t WS_CHS = 1 * MiB + 131072;
constexpr size_t WS_GPRE = 2 * MiB;
constexpr size_t WS_DN = 3 * MiB;
constexpr size_t WS_NH = 3 * MiB + 524288;
constexpr size_t WS_SSP = 4 * MiB;
constexpr size_t WS_COS = 8 * MiB, WS_SIN = 12 * MiB;
constexpr size_t WS_G1 = 16 * MiB;
constexpr size_t WS_PB = 24 * MiB;
constexpr size_t WS_QKC = 56 * MiB;
constexpr size_t WS_HB = 88 * MiB;
constexpr size_t WS_PROJ = 216 * MiB;
constexpr size_t WS_YMIX = 408 * MiB;
constexpr size_t WS_MIXO = 472 * MiB;
constexpr size_t WS_UP = 600 * MiB;
constexpr size_t WS_ACT = 856 * MiB;
constexpr size_t WS_OD = 984 * MiB;
constexpr size_t WS_DC = 1048 * MiB;
constexpr size_t WS_CH = 1176 * MiB;
constexpr size_t WS_WIN = 1240 * MiB;
constexpr size_t WS_WOUT = 1432 * MiB;
constexpr size_t WS_WUP = 1496 * MiB;
constexpr size_t WS_WDN = 1752 * MiB;
constexpr size_t WS_WPD = 1880 * MiB;
constexpr size_t WS_WPU = 1888 * MiB;
constexpr size_t WS_WPP = 1896 * MiB;
constexpr size_t WS_WG = 1904 * MiB;
constexpr size_t WS_LO = 1905 * MiB;
constexpr size_t WS_END = 2033 * MiB;
constexpr int CW_BAR = 4096;
constexpr int CW_Q = 16384;
constexpr int RING_BYTES = 131072;
constexpr int LDSCTL_OFF = RING_BYTES, MISC_OFF = LDSCTL_OFF + 320;
constexpr int LDS_BYTES = 151552;

#define GAS __attribute__((address_space(1)))
#define LAS __attribute__((address_space(3)))
typedef unsigned short bf16;
typedef unsigned v4u __attribute__((ext_vector_type(4)));
typedef unsigned v2u __attribute__((ext_vector_type(2)));
typedef float f32x4 __attribute__((ext_vector_type(4)));
typedef float f32x16 __attribute__((ext_vector_type(16)));
typedef short bf16x8 __attribute__((ext_vector_type(8)));
typedef short s16x4 __attribute__((ext_vector_type(4)));
typedef GAS unsigned gu32;
#define RLX_AGENT __ATOMIC_RELAXED, __HIP_MEMORY_SCOPE_AGENT
#define LDS_WAIT() asm volatile("s_waitcnt lgkmcnt(0)" ::: "memory")
#define VM_WAIT() asm volatile("s_waitcnt vmcnt(0)" ::: "memory")
__device__ __forceinline__ unsigned pk2(float lo, float hi) { return pg8::cvt_pk_bf16(lo, hi); }
__device__ __forceinline__ unsigned f2bf(float f) { return pg8::cvt_pk_bf16(f, 0.f) & 0xffffu; }
__device__ __forceinline__ float bflo(unsigned w) { return pg8::unpk_lo(w); }
__device__ __forceinline__ float bfhi(unsigned w) { return pg8::unpk_hi(w); }
__device__ __forceinline__ float h2f(unsigned short b) { return pg8::unpk_lo((unsigned)b); }
#define dppf(v, ctrl) __builtin_bit_cast(float, __builtin_amdgcn_update_dpp(0, __builtin_bit_cast(int, (float)(v)), (ctrl), 0xf, 0xf, true))
#define DPP_X1 0xB1
#define DPP_X2 0x4E
#define DPP_HM 0x141
#define DPP_RM 0x140
__device__ __forceinline__ float x16_sum(float v) { auto rr = __builtin_amdgcn_permlane16_swap(__float_as_uint(v), __float_as_uint(v), false, false); return __uint_as_float(rr[0]) + __uint_as_float(rr[1]); }
__device__ __forceinline__ float x16_max(float v) { auto rr = __builtin_amdgcn_permlane16_swap(__float_as_uint(v), __float_as_uint(v), false, false); return fmaxf(__uint_as_float(rr[0]), __uint_as_float(rr[1])); }
__device__ __forceinline__ float swap_sum(float v) { auto rr = __builtin_amdgcn_permlane32_swap(__float_as_uint(v), __float_as_uint(v), false, false); return __uint_as_float(rr[0]) + __uint_as_float(rr[1]); }
__device__ __forceinline__ float swap_max(float v) { auto rr = __builtin_amdgcn_permlane32_swap(__float_as_uint(v), __float_as_uint(v), false, false); return fmaxf(__uint_as_float(rr[0]), __uint_as_float(rr[1])); }
__device__ __forceinline__ float wave_sum(float v) { v += dppf(v, DPP_X1); v += dppf(v, DPP_X2); v += dppf(v, DPP_HM); v += dppf(v, DPP_RM); v = x16_sum(v); return swap_sum(v); }
__device__ __forceinline__ float wave_max(float v) { v = fmaxf(v, dppf(v, DPP_X1)); v = fmaxf(v, dppf(v, DPP_X2)); v = fmaxf(v, dppf(v, DPP_HM)); v = fmaxf(v, dppf(v, DPP_RM)); v = x16_max(v); return swap_max(v); }
__device__ __forceinline__ int crow(int r, int hi) { return (r & 3) + 8 * (r >> 2) + 4 * hi; }
#define KSWZ(row, colB) ((row) * 256 + ((colB) ^ (((row) & 15) << 4)))
#define TRRD(dst, base, off) asm volatile("ds_read_b64_tr_b16 %0, %1 offset:%2" : "=&v"(dst) : "v"(base), "i"(off) : "memory")
__device__ __forceinline__ bf16x8 mk8(s16x4 l, s16x4 h) { return (bf16x8){l[0], l[1], l[2], l[3], h[0], h[1], h[2], h[3]}; }
__device__ __forceinline__ bf16x8 pack8f(const float* p) { v4u w; w.x = pk2(p[0], p[1]); w.y = pk2(p[2], p[3]); w.z = pk2(p[4], p[5]); w.w = pk2(p[6], p[7]); return __builtin_bit_cast(bf16x8, w); }

#define XB_TMO      128
#define XB_XCNT(j)  (256  + 64 * (j))
#define XB_XSUB(j)  (1280 + 64 * (j))
#define XB_XGEN(j)  (2304 + 64 * (j))
#define XB_TOP      3328
#define XB_TOPGEN   3392
#define XCD_BAR_WORDS 3456
#define XB_SPIN_CAP (1u << 18)

__device__ __forceinline__ unsigned xb_ld(unsigned* p)              { return __hip_atomic_load(p, __ATOMIC_RELAXED, __HIP_MEMORY_SCOPE_AGENT); }
__device__ __forceinline__ unsigned xb_add(unsigned* p, unsigned v) { return __hip_atomic_fetch_add(p, v, __ATOMIC_RELAXED, __HIP_MEMORY_SCOPE_AGENT); }
__device__ __forceinline__ unsigned xb_xcc_id() { return (unsigned)__builtin_amdgcn_s_getreg((3 << 11) | 20) & 0xFu; }
#define XB_SPIN(cond, bar) do { unsigned _sp = 0; while (cond) { __builtin_amdgcn_s_sleep(1); \
    if ((++_sp & 255u) == 0u) { if (xb_ld(&(bar)[XB_TMO])) break; if (_sp > XB_SPIN_CAP) { atomicAdd(&(bar)[XB_TMO], 1u); break; } } } } while (0)

struct XcdBarrier {
    unsigned* bar; unsigned x;
    volatile LAS unsigned* st;
};

__device__ __forceinline__ XcdBarrier xcd_barrier_post(unsigned* bar, volatile LAS unsigned* st) {
    XcdBarrier b; b.bar = bar; b.x = xb_xcc_id(); b.st = st;
    if (threadIdx.x == 0) (void)xb_add(&bar[XB_XCNT(b.x)], 1u);
    return b;
}
__device__ __forceinline__ void xcd_barrier_complete(unsigned* bar, unsigned x, unsigned& nloc, unsigned& nx) {
    const unsigned G = gridDim.x * gridDim.y * gridDim.z;
    unsigned sum, cnt, mine, sp = 0u;
    for (;;) {
        sum = 0u; cnt = 0u; mine = 0u;
#pragma unroll
        for (unsigned j = 0; j < 16; ++j) { const unsigned c = xb_ld(&bar[XB_XCNT(j)]); sum += c; cnt += (c > 0u) ? 1u : 0u; mine = (j == x) ? c : mine; }
        if (sum == G) break;
        __builtin_amdgcn_s_sleep(1);
        if ((++sp & 255u) == 0u) { if (xb_ld(&bar[XB_TMO])) break; if (sp > XB_SPIN_CAP) { atomicAdd(&bar[XB_TMO], 1u); break; } }
    }
    nloc = mine > 0u ? mine : 1u; nx = cnt > 0u ? cnt : 1u;
}

__device__ __forceinline__ void xcd_barrier(const XcdBarrier& b) {
    asm volatile("s_waitcnt vmcnt(0)" ::: "memory");
    __syncthreads();
    if (threadIdx.x == 0) {
        unsigned* bar = b.bar;
        __builtin_amdgcn_s_waitcnt(0);
        unsigned nloc = b.st[0], nx = b.st[1];
        if (nloc == 0u) { xcd_barrier_complete(bar, b.x, nloc, nx); b.st[0] = nloc; b.st[1] = nx; }
        const unsigned old = xb_add(&bar[XB_XSUB(b.x)], 1u);
        const unsigned gen = old / nloc;
        if (old + 1u == (gen + 1u) * nloc) {
            __builtin_amdgcn_fence(__ATOMIC_RELEASE, "agent");
            asm volatile("s_waitcnt vmcnt(0)" ::: "memory");
            const unsigned og = xb_add(&bar[XB_TOP], 1u);
            const unsigned tg = og / nx;
            if (og + 1u == (tg + 1u) * nx) xb_add(&bar[XB_TOPGEN], 1u);
            else XB_SPIN(xb_ld(&bar[XB_TOPGEN]) == tg, bar);
            __builtin_amdgcn_fence(__ATOMIC_ACQUIRE, "agent");
            xb_add(&bar[XB_XGEN(b.x)], 1u);
            asm volatile("s_waitcnt vmcnt(0)" ::: "memory");
        } else {
            XB_SPIN(xb_ld(&bar[XB_XGEN(b.x)]) == gen, bar);
            __builtin_amdgcn_fence(__ATOMIC_ACQUIRE, "agent");
            asm volatile("s_waitcnt vmcnt(0)" ::: "memory");
        }
    }
    __syncthreads();
}

#ifndef DBG_PERTURB
#define DBG_PERTURB 0
#endif
struct Params { const float* in[26]; float* out; unsigned char* ws; int ph_lo, ph_hi, pert, pad; };
enum { I_X = 0, I_P, I_WINE, I_WOUTE, I_DLAM, I_GDIFF, I_WCQK, I_BCQK, I_BIG, I_BFG, I_GML, I_WINO, I_WOUTO, I_GRET, I_GMPRE, I_GMPOST, I_GFPRE, I_GFPOST, I_WUP, I_WFC, I_BFC, I_WDN, I_GPLE, I_WPD, I_WPU, I_WPP };

typedef const __attribute__((address_space(4))) Params* KParams;
struct Frame {
    LAS unsigned char* lds;
    int tid, lane, wave, G, bid;
};
#define LANE_ID_ASM() ({ int l__; asm volatile("v_mbcnt_lo_u32_b32 %0, -1, 0\n\tv_mbcnt_hi_u32_b32 %0, -1, %0 ; LANE_ID" : "=v"(l__)); l__; })
#define PHASE_ENTRY(F) Frame F = F##_in; { const int l_ = LANE_ID_ASM(); F.lane = l_; F.tid = F.wave * 64 + l_; }

__device__ __forceinline__ void p0_transpose_item(const float* W, int ldw, int K, int N, bf16* WT, const float* gain, int rope_cols, LAS float* scr, int item, int lane) {
    const int nblk = N / 64, kb = item / nblk, nb = item % nblk, k0 = 64 * kb, n0 = 64 * nb;
    const int r4 = lane >> 4, q = lane & 15;
    int lcol, pbase, pstep;
    if (n0 < rope_cols) { const int hb = n0 & ~127, run = q >> 3, i4 = (q & 7) * 4; lcol = hb + run * 64 + ((n0 & 127) >> 1) + i4; pbase = 2 * i4 + run; pstep = 2; }
    else { lcol = n0 + 4 * q; pbase = 4 * q; pstep = 1; }
    f32x4 v[16];
#pragma unroll
    for (int i = 0; i < 16; ++i) v[i] = *(const f32x4*)(W + (size_t)(k0 + 4 * i + r4) * ldw + lcol);
#pragma unroll
    for (int i = 0; i < 16; ++i) { const int kk = 4 * i + r4; const float g = gain ? gain[k0 + kk] : 1.f; LAS float* d = scr + kk * 64;
        d[(pbase + kk) & 63] = v[i][0] * g; d[(pbase + pstep + kk) & 63] = v[i][1] * g; d[(pbase + 2 * pstep + kk) & 63] = v[i][2] * g; d[(pbase + 3 * pstep + kk) & 63] = v[i][3] * g; }
    LDS_WAIT(); asm volatile("" ::: "memory");
    const int c = lane & 7;
#pragma unroll
    for (int jq = 0; jq < 8; ++jq) { const int n = (lane >> 3) + 8 * jq; const LAS float* s = scr + (8 * c) * 64; const int nc = n + 8 * c;
        v4u o; o.x = pk2(s[0 * 64 + ((nc + 0) & 63)], s[1 * 64 + ((nc + 1) & 63)]); o.y = pk2(s[2 * 64 + ((nc + 2) & 63)], s[3 * 64 + ((nc + 3) & 63)]);
        o.z = pk2(s[4 * 64 + ((nc + 4) & 63)], s[5 * 64 + ((nc + 5) & 63)]); o.w = pk2(s[6 * 64 + ((nc + 6) & 63)], s[7 * 64 + ((nc + 7) & 63)]);
        *(GAS v4u*)(WT + (size_t)(n0 + n) * K + k0 + 8 * c) = o; }
    LDS_WAIT(); asm volatile("" ::: "memory");
}
__device__ __forceinline__ void p0_prologue(const Frame& F_in, KParams P) { PHASE_ENTRY(F);
    unsigned char* ws = P->ws;
    LAS float* scr = (LAS float*)(F.lds + F.wave * 16384);
    const int gw = F.bid * NWAVES + F.wave, NGW = F.G * NWAVES;
    constexpr int I_IN = 64 * 96, I_OUT = 32 * 64, I_UP = 64 * 128, I_DN = 64 * 64, I_PD = 64 * 4, I_PU = 4 * 64, I_PP = 4 * 64;
    constexpr int I_LAYER = I_IN + I_OUT + I_UP + I_DN + I_PD + I_PU + I_PP;
    for (int it = gw; it < DEPTH_ * I_LAYER; it += NGW) {
        const int L = it / I_LAYER; int r = it - L * I_LAYER; const int j = L >> 1; const bool ev = (L & 1) == 0;
        if (r < I_IN) { const float* W = ev ? P->in[I_WINE] + (size_t)j * DM * 6152 : P->in[I_WINO] + (size_t)j * DM * 6144;
            p0_transpose_item(W, ev ? 6152 : 6144, DM, NIN, (bf16*)(ws + WS_WIN) + (size_t)L * NIN * DM, P->in[I_GMPRE] + (size_t)L * DM, ev ? 2048 : 1024, scr, r, F.lane); continue; } r -= I_IN;
        if (r < I_OUT) { const float* W = (ev ? P->in[I_WOUTE] : P->in[I_WOUTO]) + (size_t)j * NMIX * DM;
            p0_transpose_item(W, DM, NMIX, DM, (bf16*)(ws + WS_WOUT) + (size_t)L * DM * NMIX, nullptr, 0, scr, r, F.lane); continue; } r -= I_OUT;
        if (r < I_UP) { p0_transpose_item(P->in[I_WUP] + (size_t)L * DM * NUP, NUP, DM, NUP, (bf16*)(ws + WS_WUP) + (size_t)L * NUP * DM, P->in[I_GFPRE] + (size_t)L * DM, 0, scr, r, F.lane); continue; } r -= I_UP;
        if (r < I_DN) { p0_transpose_item(P->in[I_WDN] + (size_t)L * DM * DM, DM, DM, DM, (bf16*)(ws + WS_WDN) + (size_t)L * DM * DM, nullptr, 0, scr, r, F.lane); continue; } r -= I_DN;
        if (r < I_PD) { p0_transpose_item(P->in[I_WPD] + (size_t)L * DM * PLED, PLED, DM, PLED, (bf16*)(ws + WS_WPD) + (size_t)L * PLED * DM, P->in[I_GPLE] + (size_t)L * DM, 0, scr, r, F.lane); continue; } r -= I_PD;
        if (r < I_PU) { p0_transpose_item(P->in[I_WPU] + (size_t)L * PLED * DM, DM, PLED, DM, (bf16*)(ws + WS_WPU) + (size_t)L * DM * PLED, nullptr, 0, scr, r, F.lane); continue; } r -= I_PU;
        p0_transpose_item(P->in[I_WPP] + (size_t)L * PLED * DM, DM, PLED, DM, (bf16*)(ws + WS_WPP) + (size_t)L * DM * PLED, nullptr, 0, scr, r, F.lane);
    }
    { const int l2_ = LANE_ID_ASM(); F.lane = l2_; F.tid = F.wave * 64 + l2_; }
    const int gt = F.bid * (NWAVES * 64) + F.tid, NGT = F.G * NWAVES * 64;
    for (int e = gt; e < 2 * DM; e += NGT) { const int j = e / DM, k = e - j * DM; const float g = P->in[I_GMPRE][(size_t)(2 * j) * DM + k]; const float* w = P->in[I_WINE] + ((size_t)j * DM + k) * 6152 + 6144;
        bf16* o = (bf16*)(ws + WS_WG) + (size_t)j * 8 * DM + k;
#pragma unroll
        for (int c = 0; c < 8; ++c) o[(size_t)c * DM] = (bf16)f2bf(g * w[c]); }
    for (size_t e = gt; e < (size_t)DEPTH_ * S_ * PLED / 8; e += NGT) { const f32x4 a = *(const f32x4*)(P->in[I_P] + e * 8), b = *(const f32x4*)(P->in[I_P] + e * 8 + 4);
        v4u o; o.x = pk2(a[0], a[1]); o.y = pk2(a[2], a[3]); o.z = pk2(b[0], b[1]); o.w = pk2(b[2], b[3]); *(v4u*)((bf16*)(ws + WS_PB) + e * 8) = o; }
    for (int e = gt; e < S_ * 64; e += NGT) { const int t = e >> 6, i = e & 63;
        const float finv = (float)exp2(-(double)i * (13.287712379549449 / 64.0)); const float ang = (float)t * finv; const double ad = (double)ang;
        const double n = rint(ad * 0.63661977236758134308); const double r = (ad - n * 1.57079632679489655800e+00) - n * 6.12323399573676603587e-17; const double r2 = r * r;
        double sn = r * (1.0 + r2 * (-1.0 / 6 + r2 * (1.0 / 120 + r2 * (-1.0 / 5040 + r2 * (1.0 / 362880 + r2 * (-1.0 / 39916800 + r2 * (1.0 / 6227020800.0)))))));
        double cs = 1.0 + r2 * (-0.5 + r2 * (1.0 / 24 + r2 * (-1.0 / 720 + r2 * (1.0 / 40320 + r2 * (-1.0 / 3628800 + r2 * (1.0 / 479001600.0))))));
        const int q = ((int)n) & 3; double c2 = cs, s2 = sn; if (q == 1) { c2 = -sn; s2 = cs; } else if (q == 2) { c2 = -cs; s2 = -sn; } else if (q == 3) { c2 = sn; s2 = -cs; }
        ((float*)(ws + WS_COS))[e] = (float)c2; ((float*)(ws + WS_SIN))[e] = (float)s2; }
    if (F.bid == 0 && F.wave == 0) {
        for (int j = 0; j < 2; ++j) { const float* lp = P->in[I_DLAM] + (size_t)j * 512; const int d = F.lane * 2;
            const float s1 = wave_sum(lp[d] * lp[128 + d] + lp[d + 1] * lp[128 + d + 1]), s2 = wave_sum(lp[256 + d] * lp[384 + d] + lp[256 + d + 1] * lp[384 + d + 1]);
            const float li = 0.8f - 0.6f * expf(-0.3f * (float)(2 * j));
            if (F.lane == 0) { ((float*)(ws + WS_LAM))[2 * j] = expf(s1) - expf(s2) + li; ((float*)(ws + WS_LAM))[2 * j + 1] = li; } }
    }
    for (int row = gw; row < S_; row += NGW) { const float* xr = P->in[I_X] + (size_t)row * DM; bf16* hr = (bf16*)(ws + WS_HB) + (size_t)row * DM; float ss = 0.f;
#pragma unroll
        for (int jj = 0; jj < 8; ++jj) { const int c = (jj * 64 + F.lane) * 8; const f32x4 a = *(const f32x4*)(xr + c), b = *(const f32x4*)(xr + c + 4);
            ss += (a[0] * a[0] + a[1] * a[1]) + (a[2] * a[2] + a[3] * a[3]) + (b[0] * b[0] + b[1] * b[1]) + (b[2] * b[2] + b[3] * b[3]);
            f32x4 a2 = a, b2 = b;
#if DBG_PERTURB
            if (P->pert) { for (int q = 0; q < 4; ++q) { unsigned hx = (unsigned)(row * 4096 + c + q) * 2654435761u; hx ^= hx >> 15; a2[q] *= 1.f + ((float)(hx & 1023u) - 511.5f) * 2e-6f; hx = (unsigned)(row * 4096 + c + 4 + q) * 2654435761u; hx ^= hx >> 15; b2[q] *= 1.f + ((float)(hx & 1023u) - 511.5f) * 2e-6f; } }
#endif
            v4u o; o.x = pk2(a2[0], a2[1]); o.y = pk2(a2[2], a2[3]); o.z = pk2(b2[0], b2[1]); o.w = pk2(b2[2], b2[3]); *(v4u*)(hr + c) = o; }
        const float tot = wave_sum(ss); if (F.lane == 0) ((float*)(ws + WS_RIN))[row] = rsqrtf(tot * (1.f / DM) + EPS_); }
}

__device__ __forceinline__ void gates_pass(const Frame& F_in, const bf16* hb, const bf16* wg, const float* rin, float* gpre) { PHASE_ENTRY(F);
    const int gw = F.bid * NWAVES + F.wave, NGW = F.G * NWAVES;
    for (int rg = gw; rg < S_ / 8; rg += NGW) { const int t0 = rg * 8;
        float acc[8][8];
#pragma unroll
        for (int a = 0; a < 8; ++a)
#pragma unroll
            for (int b = 0; b < 8; ++b) acc[a][b] = 0.f;
        for (int jj = 0; jj < 8; ++jj) { const int k = (jj * 64 + F.lane) * 8;
            v4u w[8];
#pragma unroll
            for (int c = 0; c < 8; ++c) w[c] = *(const v4u*)(wg + (size_t)c * DM + k);
#pragma unroll
            for (int r = 0; r < 8; ++r) { const v4u x = *(const v4u*)(hb + (size_t)(t0 + r) * DM + k);
#pragma unroll
                for (int c = 0; c < 8; ++c) acc[r][c] += (bflo(x.x) * bflo(w[c].x) + bfhi(x.x) * bfhi(w[c].x)) + (bflo(x.y) * bflo(w[c].y) + bfhi(x.y) * bfhi(w[c].y))
                                                        + (bflo(x.z) * bflo(w[c].z) + bfhi(x.z) * bfhi(w[c].z)) + (bflo(x.w) * bflo(w[c].w) + bfhi(x.w) * bfhi(w[c].w)); } }
        float mine = 0.f;
#pragma unroll
        for (int r = 0; r < 8; ++r)
#pragma unroll
            for (int c = 0; c < 8; ++c) { const float s = wave_sum(acc[r][c]); if (F.lane == r * 8 + c) mine = s; }
        gpre[(size_t)t0 * 8 + F.lane] = mine * rin[t0 + (F.lane >> 3)]; }
}
__device__ __forceinline__ void resid_pass(const Frame& F_in, const float* hin32, const bf16* y, const float* ssp, const float* g, bf16* hi, bf16* lo, float* rout) { PHASE_ENTRY(F);
    const int gw = F.bid * NWAVES + F.wave, NGW = F.G * NWAVES;
    for (int row = gw; row < S_; row += NGW) {
        const float ry = rsqrtf(wave_sum(ssp[(size_t)row * 64 + F.lane]) * (1.f / DM) + EPS_);
        const bf16* yr = y + (size_t)row * DM; bf16* hir = hi + (size_t)row * DM; bf16* lor = lo + (size_t)row * DM; float ss = 0.f;
#pragma unroll
        for (int jj = 0; jj < 8; ++jj) { const int c = (jj * 64 + F.lane) * 8; float hv[8];
            if (hin32) { const f32x4 a = *(const f32x4*)(hin32 + (size_t)row * DM + c), b = *(const f32x4*)(hin32 + (size_t)row * DM + c + 4); hv[0] = a[0]; hv[1] = a[1]; hv[2] = a[2]; hv[3] = a[3]; hv[4] = b[0]; hv[5] = b[1]; hv[6] = b[2]; hv[7] = b[3]; }
            else { const v4u h1 = *(const v4u*)(hir + c); v4u l1 = {0u, 0u, 0u, 0u}; if (RES_LO) l1 = *(const v4u*)(lor + c);
                hv[0] = bflo(h1.x) + bflo(l1.x); hv[1] = bfhi(h1.x) + bfhi(l1.x); hv[2] = bflo(h1.y) + bflo(l1.y); hv[3] = bfhi(h1.y) + bfhi(l1.y);
                hv[4] = bflo(h1.z) + bflo(l1.z); hv[5] = bfhi(h1.z) + bfhi(l1.z); hv[6] = bflo(h1.w) + bflo(l1.w); hv[7] = bfhi(h1.w) + bfhi(l1.w); }
            const v4u yv = *(const v4u*)(yr + c); const f32x4 ga = *(const f32x4*)(g + c), gb = *(const f32x4*)(g + c + 4);
            hv[0] += bflo(yv.x) * ry * ga[0]; hv[1] += bfhi(yv.x) * ry * ga[1]; hv[2] += bflo(yv.y) * ry * ga[2]; hv[3] += bfhi(yv.y) * ry * ga[3];
            hv[4] += bflo(yv.z) * ry * gb[0]; hv[5] += bfhi(yv.z) * ry * gb[1]; hv[6] += bflo(yv.w) * ry * gb[2]; hv[7] += bfhi(yv.w) * ry * gb[3];
#pragma unroll
            for (int q = 0; q < 8; ++q) ss += hv[q] * hv[q];
            v4u oh; oh.x = pk2(hv[0], hv[1]); oh.y = pk2(hv[2], hv[3]); oh.z = pk2(hv[4], hv[5]); oh.w = pk2(hv[6], hv[7]);
            v4u ol; ol.x = pk2(hv[0] - bflo(oh.x), hv[1] - bfhi(oh.x)); ol.y = pk2(hv[2] - bflo(oh.y), hv[3] - bfhi(oh.y)); ol.z = pk2(hv[4] - bflo(oh.z), hv[5] - bfhi(oh.z)); ol.w = pk2(hv[6] - bflo(oh.w), hv[7] - bfhi(oh.w));
            *(v4u*)(hir + c) = oh; if (RES_LO) *(v4u*)(lor + c) = ol; }
        const float tot = wave_sum(ss); if (F.lane == 0) rout[row] = rsqrtf(tot * (1.f / DM) + EPS_); }
}
__device__ __forceinline__ void rin_pass(const Frame& F_in, const float* ssp, float* rout) { PHASE_ENTRY(F);
    const int gw = F.bid * NWAVES + F.wave, NGW = F.G * NWAVES;
    for (int row = gw; row < S_; row += NGW) { const float tot = wave_sum(ssp[(size_t)row * 64 + F.lane]); if (F.lane == 0) rout[row] = rsqrtf(tot * (1.f / DM) + EPS_); }
}
__device__ __forceinline__ void pled_combine(const Frame& F_in, const bf16* part, const float* rin, bf16* g1) { PHASE_ENTRY(F);
    const int gt = F.bid * (NWAVES * 64) + F.tid, NGT = F.G * NWAVES * 64;
    for (int it = gt; it < S_ * PLED / 8; it += NGT) { const int row = it >> 5; const size_t o = (size_t)it * 8; const float r = rin[row];
        float a[8] = {0.f, 0.f, 0.f, 0.f, 0.f, 0.f, 0.f, 0.f};
#pragma unroll
        for (int w = 0; w < 4; ++w) { const v4u x = *(const v4u*)(part + (size_t)w * S_ * PLED + o);
            a[0] += bflo(x.x); a[1] += bfhi(x.x); a[2] += bflo(x.y); a[3] += bfhi(x.y); a[4] += bflo(x.z); a[5] += bfhi(x.z); a[6] += bflo(x.w); a[7] += bfhi(x.w); }
        v4u ov; ov.x = pk2(a[0] * r, a[1] * r); ov.y = pk2(a[2] * r, a[3] * r); ov.z = pk2(a[4] * r, a[5] * r); ov.w = pk2(a[6] * r, a[7] * r);
        *(v4u*)(g1 + o) = ov; }
}
__device__ __forceinline__ float gelu_tanh(float x) { const float u = 0.7978845608028654f * (x + 0.044715f * x * x * x); return x * __builtin_amdgcn_rcpf(1.f + __expf(-2.f * u)); }
__device__ __forceinline__ void convffn_pass(const Frame& F_in, const bf16* up, const float* wc, const float* bc, bf16* act) { PHASE_ENTRY(F);
    const int c0 = F.tid * 8;
    float wa[3][8], wb[3][8], ba[8], bb[8];
#pragma unroll
    for (int k = 0; k < 3; ++k)
#pragma unroll
        for (int e = 0; e < 8; ++e) { wa[k][e] = wc[(size_t)k * NUP + c0 + e]; wb[k][e] = wc[(size_t)k * NUP + 4096 + c0 + e]; }
#pragma unroll
    for (int e = 0; e < 8; ++e) { ba[e] = bc[c0 + e]; bb[e] = bc[4096 + c0 + e]; }
    for (int rb = F.bid; rb < S_ / 64; rb += F.G) { const int t0 = rb * 64;
        v4u a2 = (v4u){0u, 0u, 0u, 0u}, a1 = a2, b2 = a2, b1 = a2;
        if (t0 > 0) { a2 = *(const v4u*)(up + (size_t)(t0 - 2) * NUP + c0); b2 = *(const v4u*)(up + (size_t)(t0 - 2) * NUP + 4096 + c0);
                      a1 = *(const v4u*)(up + (size_t)(t0 - 1) * NUP + c0); b1 = *(const v4u*)(up + (size_t)(t0 - 1) * NUP + 4096 + c0); }
        for (int tg = t0; tg < t0 + 64; tg += 8) { v4u an[8], bn[8];
#pragma unroll
          for (int i = 0; i < 8; ++i) { an[i] = *(const v4u*)(up + (size_t)(tg + i) * NUP + c0); bn[i] = *(const v4u*)(up + (size_t)(tg + i) * NUP + 4096 + c0); }
#pragma unroll
          for (int i = 0; i < 8; ++i) { const int t = tg + i; const v4u a0 = an[i], b0 = bn[i];
            float o[8];
            const unsigned A2[4] = {a2.x, a2.y, a2.z, a2.w}, A1[4] = {a1.x, a1.y, a1.z, a1.w}, A0[4] = {a0.x, a0.y, a0.z, a0.w};
            const unsigned B2[4] = {b2.x, b2.y, b2.z, b2.w}, B1[4] = {b1.x, b1.y, b1.z, b1.w}, B0[4] = {b0.x, b0.y, b0.z, b0.w};
#pragma unroll
            for (int e = 0; e < 8; ++e) { const int q = e >> 1; const bool hi = e & 1;
                const float xa2 = hi ? bfhi(A2[q]) : bflo(A2[q]), xa1 = hi ? bfhi(A1[q]) : bflo(A1[q]), xa0 = hi ? bfhi(A0[q]) : bflo(A0[q]);
                const float xb2 = hi ? bfhi(B2[q]) : bflo(B2[q]), xb1 = hi ? bfhi(B1[q]) : bflo(B1[q]), xb0 = hi ? bfhi(B0[q]) : bflo(B0[q]);
                const float ya = ba[e] + wa[0][e] * xa2 + wa[1][e] * xa1 + wa[2][e] * xa0, yb = bb[e] + wb[0][e] * xb2 + wb[1][e] * xb1 + wb[2][e] * xb0;
                o[e] = gelu_tanh(ya) * yb; }
            v4u ov; ov.x = pk2(o[0], o[1]); ov.y = pk2(o[2], o[3]); ov.z = pk2(o[4], o[5]); ov.w = pk2(o[6], o[7]);
            *(v4u*)(act + (size_t)t * DM + c0) = ov;
            a2 = a1; a1 = a0; b2 = b1; b1 = b0; } } }
}
__device__ __forceinline__ void diffcomb_pass(const Frame& F_in, const bf16* od, const float* g, const float* lamv, bf16* ymix) { PHASE_ENTRY(F);
    const int gw = F.bid * NWAVES + F.wave, NGW = F.G * NWAVES; const float lam = lamv[0], sc = 1.f - lamv[1];
    const f32x4 g4 = *(const f32x4*)(g + F.lane * 4);
    for (int it = gw; it < S_ * 4; it += NGW) { const int t = it >> 2, h = it & 3;
        const v2u a = *(const v2u*)(od + ((size_t)t * 8 + 2 * h) * 256 + F.lane * 4), b = *(const v2u*)(od + ((size_t)t * 8 + 2 * h + 1) * 256 + F.lane * 4);
        f32x4 d; d[0] = bflo(a.x) - lam * bflo(b.x); d[1] = bfhi(a.x) - lam * bfhi(b.x); d[2] = bflo(a.y) - lam * bflo(b.y); d[3] = bfhi(a.y) - lam * bfhi(b.y);
        const float r = rsqrtf(wave_sum((d[0] * d[0] + d[1] * d[1]) + (d[2] * d[2] + d[3] * d[3])) * (1.f / 256.f) + EPS_) * sc;
        v2u o; o.x = pk2(d[0] * r * g4[0], d[1] * r * g4[1]); o.y = pk2(d[2] * r * g4[2], d[3] * r * g4[3]);
        *(v2u*)(ymix + (size_t)t * NMIX + h * 256 + F.lane * 4) = o; }
}

constexpr int AT_KT = 16384, AT_NVS = 3;
constexpr float AT_C2 = 0.08838834764831845f * 1.4426950408889634f;
template <int MODE, int NV, int GRP, int ABL = 0>
__device__ __forceinline__ void attn_unit(LAS unsigned char* lds, int wave_in, const bf16* Qp, const bf16* Kp, const bf16* Vp, int ldp, int qb, bf16* Op, int ldo) {
    constexpr bool LAG = GRP != 0, grpB = GRP == 2;
    constexpr bool KSM = (MODE == 0 && NV == 2 && GRP == 1 && ABL == 0);
    constexpr int AT_KB = AT_NVS * (64 * (256 * NV + 64)), AT_KS = (NV == 2) ? 22528 : AT_KT;
    static_assert(NV != 2 || (AT_KB + AT_KT <= LDSCTL_OFF && AT_KB + AT_KS >= LDSCTL_OFF + 2048 && AT_KB + AT_KS + AT_KT <= LDS_BYTES), "LDS map");
    constexpr int AT_VSTR = 256 * NV + 64, AT_VT = 64 * AT_VSTR;
    const int lane_o = LANE_ID_ASM();
    const int wid = wave_in, lane = lane_o, tid = wid * 64 + lane, r32 = lane & 31, hi = lane >> 5;
    const int P0 = qb * 256, qrow = P0 + 32 * wid + r32, jd = (P0 + 32 * wid) >> 6, NT = 4 * qb + 4;
    bf16x8 qr[8];
#pragma unroll
    for (int s = 0; s < 8; ++s) qr[s] = *(const bf16x8*)(Qp + (size_t)qrow * ldp + 16 * s + 8 * hi);
    const unsigned ldsb = (unsigned)(uintptr_t)lds;
    const unsigned vrb = ldsb + (unsigned)((4 * hi + ((lane >> 2) & 3)) * AT_VSTR + (16 * ((lane >> 4) & 1) + 4 * (lane & 3)) * 2);
    constexpr int NPV = AT_VT / 1024, NPW = (NPV + 7) / 8, VCH = AT_VSTR / 16;
    unsigned kof[2], vof[NPW];
#pragma unroll
    for (int i = 0; i < 2; ++i) { const int rr = 4 * i + (lane >> 4); kof[i] = (unsigned)((8 * wid + rr) * ldp + (((lane & 15) ^ ((8 * wid + rr) & 15)) * 8)) * 2u; }
#pragma unroll
    for (int i = 0; i < NPW; ++i) { const int u = (wid + 8 * i) * 64 + lane, row = u / VCH, cc = u - row * VCH; vof[i] = (unsigned)(row * ldp) * 2u + (unsigned)((cc < 16 * NV ? cc : 0) * 16); }
#define AT_DMAK(j, sl) do { const char* g_ = (const char*)(Kp + (size_t)(j) * 64 * ldp); _Pragma("unroll") for (int i_ = 0; i_ < 2; ++i_) \
        __builtin_amdgcn_global_load_lds((const unsigned*)(g_ + kof[i_]), (LAS unsigned*)(lds + AT_KB + (sl) * AT_KS + (2 * wid + i_) * 1024), 16, 0, 0); } while (0)
#define AT_DMAV(j, sl) do { const char* g_ = (const char*)(Vp + (size_t)(j) * 64 * ldp); _Pragma("unroll") for (int i_ = 0; i_ < NPW; ++i_) if (wid + 8 * i_ < NPV) \
        __builtin_amdgcn_global_load_lds((const unsigned*)(g_ + vof[i_]), (LAS unsigned*)(lds + (sl) * AT_VT + (wid + 8 * i_) * 1024), 16, 0, 0); } while (0)
#define AT_JT(t) (MODE == 0 ? (t) : NT - 1 - (t))
    f32x16 o[4 * NV];
#pragma unroll
    for (int d = 0; d < 4 * NV; ++d)
#pragma unroll
        for (int r = 0; r < 16; ++r) o[d][r] = 0.f;
    float m_run = -1e30f, l_run = 0.f, carry = 1.f;
    volatile LAS float* cmx = (volatile LAS float*)(lds + LDSCTL_OFF + 1024);
    __syncthreads();
    AT_DMAK(AT_JT(0), 0); AT_DMAV(AT_JT(0), 0);
    VM_WAIT();
    __syncthreads();
#define AT_KRD(i) asm volatile("ds_read_b128 %0, %1 offset:%2" : "=&v"(kq[i]) : "v"(kb[(i) >> 1]), "i"(((i) & 1) * 32 * 256) : "memory")
#define AT_KWT(i, N) asm volatile("s_waitcnt lgkmcnt(" #N ")" : "+v"(kq[i]) :: "memory")
#define AT_KMM(i) do { if ((i) & 1) p1 = MFMA32(kq[i], qr[(i) >> 1], p1); else p0 = MFMA32(kq[i], qr[(i) >> 1], p0); __builtin_amdgcn_sched_barrier(0); } while (0)
#define AT_QK(bb) do { \
        unsigned kb[8];                             \
        { int rl = lane; asm volatile("" : "+v"(rl)); const int r32b = rl & 31, hib = rl >> 5; \
          _Pragma("unroll") for (int dd = 0; dd < 8; ++dd) kb[dd] = ldsb + (unsigned)(AT_KB + (bb) * AT_KS + KSWZ(r32b, (dd * 16 + hib * 8) * 2)); } \
        bf16x8 kq[16]; \
        AT_KRD(0); AT_KRD(1); AT_KRD(2); AT_KRD(3); AT_KRD(4); AT_KRD(5); \
        AT_KRD(6); AT_KWT(0, 6); AT_KMM(0); AT_KRD(7); AT_KWT(1, 6); AT_KMM(1); AT_KRD(8); AT_KWT(2, 6); AT_KMM(2); AT_KRD(9); AT_KWT(3, 6); AT_KMM(3); \
        AT_KRD(10); AT_KWT(4, 6); AT_KMM(4); AT_KRD(11); AT_KWT(5, 6); AT_KMM(5); AT_KRD(12); AT_KWT(6, 6); AT_KMM(6); AT_KRD(13); AT_KWT(7, 6); AT_KMM(7); \
        AT_KRD(14); AT_KWT(8, 6); AT_KMM(8); AT_KRD(15); AT_KWT(9, 6); AT_KMM(9); AT_KWT(10, 5); AT_KMM(10); AT_KWT(11, 4); AT_KMM(11); \
        AT_KWT(12, 3); AT_KMM(12); AT_KWT(13, 2); AT_KMM(13); AT_KWT(14, 1); AT_KMM(14); AT_KWT(15, 0); AT_KMM(15); } while (0)
#define AT_RD(d0, L0, H0, L1, H1, L2, H2, L3, H3) do { TRRD(L0, vb, 0 * 16 * AT_VSTR + (d0) * 64); TRRD(H0, vb, (0 * 16 + 8) * AT_VSTR + (d0) * 64); TRRD(L1, vb, 1 * 16 * AT_VSTR + (d0) * 64); TRRD(H1, vb, (1 * 16 + 8) * AT_VSTR + (d0) * 64); \
        TRRD(L2, vb, 2 * 16 * AT_VSTR + (d0) * 64); TRRD(H2, vb, (2 * 16 + 8) * AT_VSTR + (d0) * 64); TRRD(L3, vb, 3 * 16 * AT_VSTR + (d0) * 64); TRRD(H3, vb, (3 * 16 + 8) * AT_VSTR + (d0) * 64); } while (0)
#define AT_WT(N, L0, H0, L1, H1, L2, H2, L3, H3) asm volatile("s_waitcnt lgkmcnt(" #N ")" : "+v"(L0), "+v"(H0), "+v"(L1), "+v"(H1), "+v"(L2), "+v"(H2), "+v"(L3), "+v"(H3) :: "memory")
#define AT_MM(d0, L0, H0, L1, H1, L2, H2, L3, H3) do { o[d0] = MFMA32(mk8(L0, H0), pk[0], o[d0]); o[d0] = MFMA32(mk8(L1, H1), pk[1], o[d0]); o[d0] = MFMA32(mk8(L2, H2), pk[2], o[d0]); o[d0] = MFMA32(mk8(L3, H3), pk[3], o[d0]); } while (0)
#define AT_RDA(d0) AT_RD(d0, a0, a1, a2, a3, a4, a5, a6, a7)
#define AT_RDB(d0) AT_RD(d0, b0, b1, b2, b3, b4, b5, b6, b7)
#define AT_WTA(N) AT_WT(N, a0, a1, a2, a3, a4, a5, a6, a7)
#define AT_WTB(N) AT_WT(N, b0, b1, b2, b3, b4, b5, b6, b7)
#define AT_MMA(d0) AT_MM(d0, a0, a1, a2, a3, a4, a5, a6, a7)
#define AT_MMB(d0) AT_MM(d0, b0, b1, b2, b3, b4, b5, b6, b7)
#define AT_PV(slot) do { const unsigned vb = vrb + (unsigned)((slot) * AT_VT); s16x4 a0, a1, a2, a3, a4, a5, a6, a7, b0, b1, b2, b3, b4, b5, b6, b7; \
        if (NV == 2) {                   \
            AT_RDA(0); AT_RDB(1); \
            AT_WTA(8); AT_MMA(0); AT_RDA(2); \
            AT_WTB(8); AT_MMB(1); AT_RDB(3); \
            AT_WTA(8); AT_MMA(2); AT_RDA(4); \
            AT_WTB(8); AT_MMB(3); AT_RDB(5); \
            AT_WTA(8); AT_MMA(4); AT_RDA(6); \
            AT_WTB(8); AT_MMB(5); AT_RDB(4 * NV - 1); \
            AT_WTA(8); AT_MMA(6); \
            AT_WTB(0); AT_MMB(4 * NV - 1); \
        } else { \
            AT_RDA(0); AT_RDB(1); \
            AT_WTA(8); AT_MMA(0); AT_RDA(2); \
            AT_WTB(8); AT_MMB(1); AT_RDB(3); \
            AT_WTA(8); AT_MMA(2); \
            AT_WTB(0); AT_MMB(3); } } while (0)
#define AT_VR(n) do { TRRD(fl[n], vb, ((n) >> 3) * 16 * AT_VSTR + ((n) & 7) * 64); TRRD(fh[n], vb, (((n) >> 3) * 16 + 8) * AT_VSTR + ((n) & 7) * 64); } while (0)
#define AT_VW(n, N) asm volatile("s_waitcnt lgkmcnt(" #N ")" : "+v"(fl[n]), "+v"(fh[n]) :: "memory")
#define AT_VM(n) o[(n) & 7] = MFMA32(mk8(fl[n], fh[n]), pk[(n) >> 3], o[(n) & 7])
#define AT_VE(n) do { p1[n] = __builtin_amdgcn_exp2f(fmaf(p1[n], AT_C2, mb)); ps += p1[n]; } while (0)
#define AT_VPK() do { v4u w_; w_.x = pk2(p1[0], p1[1]); w_.y = pk2(p1[2], p1[3]); w_.z = pk2(p1[4], p1[5]); w_.w = pk2(p1[6], p1[7]); pk[2] = __builtin_bit_cast(bf16x8, w_); \
        w_.x = pk2(p1[8], p1[9]); w_.y = pk2(p1[10], p1[11]); w_.z = pk2(p1[12], p1[13]); w_.w = pk2(p1[14], p1[15]); pk[3] = __builtin_bit_cast(bf16x8, w_); } while (0)
#define AT_PVK(slot) do { const unsigned vb = vrb + (unsigned)((slot) * AT_VT); s16x4 fl[32], fh[32]; AT_VR(0); AT_VR(1); AT_VR(2); AT_VR(3); \
        AT_VR(4); AT_VW(0, 8); AT_VM(0); AT_VE(0); \
        AT_VR(5); AT_VW(1, 8); AT_VM(1); AT_VE(1); \
        AT_VR(6); AT_VW(2, 8); AT_VM(2); AT_VE(2); \
        AT_VR(7); AT_VW(3, 8); AT_VM(3); AT_VE(3); \
        AT_VR(8); AT_VW(4, 8); AT_VM(4); AT_VE(4); \
        AT_VR(9); AT_VW(5, 8); AT_VM(5); AT_VE(5); \
        AT_VR(10); AT_VW(6, 8); AT_VM(6); AT_VE(6); \
        AT_VR(11); AT_VW(7, 8); AT_VM(7); AT_VE(7); \
        AT_VR(12); AT_VW(8, 8); AT_VM(8); AT_VE(8); \
        AT_VR(13); AT_VW(9, 8); AT_VM(9); AT_VE(9); \
        AT_VR(14); AT_VW(10, 8); AT_VM(10); AT_VE(10); \
        AT_VR(15); AT_VW(11, 8); AT_VM(11); AT_VE(11); \
        AT_VR(16); AT_VW(12, 8); AT_VM(12); AT_VE(12); \
        AT_VR(17); AT_VW(13, 8); AT_VM(13); AT_VE(13); \
        AT_VR(18); AT_VW(14, 8); AT_VM(14); AT_VE(14); \
        AT_VR(19); AT_VW(15, 8); AT_VM(15); AT_VE(15); \
        AT_VPK(); \
        AT_VR(20); AT_VW(16, 8); AT_VM(16); \
        AT_VR(21); AT_VW(17, 8); AT_VM(17); \
        AT_VR(22); AT_VW(18, 8); AT_VM(18); \
        AT_VR(23); AT_VW(19, 8); AT_VM(19); \
        AT_VR(24); AT_VW(20, 8); AT_VM(20); \
        AT_VR(25); AT_VW(21, 8); AT_VM(21); \
        AT_VR(26); AT_VW(22, 8); AT_VM(22); \
        AT_VR(27); AT_VW(23, 8); AT_VM(23); \
        AT_VR(28); AT_VW(24, 8); AT_VM(24); \
        AT_VR(29); AT_VW(25, 8); AT_VM(25); \
        AT_VR(30); AT_VW(26, 8); AT_VM(26); \
        AT_VR(31); AT_VW(27, 8); AT_VM(27); \
        AT_VW(28, 6); AT_VM(28); \
        AT_VW(29, 4); AT_VM(29); \
        AT_VW(30, 2); AT_VM(30); \
        AT_VW(31, 0); AT_VM(31); } while (0)
    bf16x8 pk[4]; bool pend = false;
    int vp = 2, vc = 0, vn = 1;
    for (int t = 0; t < NT; ++t) {
        const int j = AT_JT(t), b = t & 1; const bool act = (j <= jd);
        const bool more = t + 1 < NT; const int jn = AT_JT(t + 1);
        if (more && !(ABL & 8)) { AT_DMAK(jn, b ^ 1); AT_DMAV(jn, vn); }
        if (LAG && grpB) { if (pend && !(ABL & 4)) AT_PV(vp); }
        if (act) {
            f32x16 p0, p1;
#pragma unroll
            for (int r = 0; r < 16; ++r) { p0[r] = 0.f; p1[r] = 0.f; }
            if (!(ABL & 1)) AT_QK(b);
            if (ABL & 1) asm volatile("" : "+v"(p0), "+v"(p1));
            if (ABL & 2) { } else if (MODE == 0) {
                float pm = p0[0];
#pragma unroll
                for (int r = 1; r < 16; ++r) pm = fmaxf(pm, p0[r]);
#pragma unroll
                for (int r = 0; r < 16; ++r) pm = fmaxf(pm, p1[r]);
                pm = swap_max(pm);
                if (!__all((pm - m_run) * AT_C2 <= 8.f)) { const float mn = fmaxf(m_run, pm), al = __builtin_amdgcn_exp2f((m_run - mn) * AT_C2); m_run = mn; l_run *= al;
#pragma unroll
                    for (int d = 0; d < 4 * NV; ++d)
#pragma unroll
                        for (int r = 0; r < 16; ++r) o[d][r] *= al; }
                const float mb = -m_run * AT_C2; float ps = 0.f;
                if (KSM) {
#pragma unroll
                    for (int r = 0; r < 16; ++r) { p0[r] = __builtin_amdgcn_exp2f(fmaf(p0[r], AT_C2, mb)); ps += p0[r]; }
                    { v4u w; w.x = pk2(p0[0], p0[1]); w.y = pk2(p0[2], p0[3]); w.z = pk2(p0[4], p0[5]); w.w = pk2(p0[6], p0[7]); pk[0] = __builtin_bit_cast(bf16x8, w);
                      w.x = pk2(p0[8], p0[9]); w.y = pk2(p0[10], p0[11]); w.z = pk2(p0[12], p0[13]); w.w = pk2(p0[14], p0[15]); pk[1] = __builtin_bit_cast(bf16x8, w); }
                    AT_PVK(vc);
                } else {
#pragma unroll
                    for (int r = 0; r < 16; ++r) { p0[r] = __builtin_amdgcn_exp2f(fmaf(p0[r], AT_C2, mb)); p1[r] = __builtin_amdgcn_exp2f(fmaf(p1[r], AT_C2, mb)); ps += p0[r] + p1[r]; }
                }
                l_run += swap_sum(ps);
            } else {
                float up[32];
#pragma unroll
                for (int r = 0; r < 16; ++r) { up[r] = __builtin_amdgcn_exp2f(fminf(p0[r] * AT_C2, 30.f)); up[16 + r] = __builtin_amdgcn_exp2f(fminf(p1[r] * AT_C2, 30.f)); }
                if (j == jd) { const int qrel = qrow - 64 * j;
#pragma unroll
                    for (int r = 0; r < 16; ++r) { if (crow(r, hi) >= qrel) up[r] = 0.f; if (32 + crow(r, hi) >= qrel) up[16 + r] = 0.f; } }
                float all[16], e1[8], e2[8], e3[8];
#pragma unroll
                for (int q = 0; q < 8; ++q) { e1[q] = 1.f + up[4 * q]; e2[q] = e1[q] * (1.f + up[4 * q + 1]); e3[q] = e2[q] * (1.f + up[4 * q + 2]);
                    const float gp = __builtin_amdgcn_rcpf(e3[q] * (1.f + up[4 * q + 3]));
                    auto rr = __builtin_amdgcn_permlane32_swap(__float_as_uint(gp), __float_as_uint(gp), false, false); all[2 * q] = __uint_as_float(rr[0]); all[2 * q + 1] = __uint_as_float(rr[1]); }
                float T[16]; T[15] = carry;
#pragma unroll
                for (int g = 14; g >= 0; --g) T[g] = T[g + 1] * all[g + 1];
                carry = T[0] * all[0];
#pragma unroll
                for (int q = 0; q < 8; ++q) { const float tg = T[2 * q + 1] * (hi ? all[2 * q + 1] : all[2 * q + 1] * all[2 * q]);
                    const float a0 = up[4 * q] * tg, a1 = up[4 * q + 1] * e1[q] * tg, a2 = up[4 * q + 2] * e2[q] * tg, a3 = up[4 * q + 3] * e3[q] * tg;
                    if (q < 4) { p0[4 * q] = a0; p0[4 * q + 1] = a1; p0[4 * q + 2] = a2; p0[4 * q + 3] = a3; } else { p1[4 * q - 16] = a0; p1[4 * q - 15] = a1; p1[4 * q - 14] = a2; p1[4 * q - 13] = a3; } }
            }
            if (!KSM) { v4u w;
              w.x = pk2(p0[0], p0[1]); w.y = pk2(p0[2], p0[3]); w.z = pk2(p0[4], p0[5]); w.w = pk2(p0[6], p0[7]); pk[0] = __builtin_bit_cast(bf16x8, w);
              w.x = pk2(p0[8], p0[9]); w.y = pk2(p0[10], p0[11]); w.z = pk2(p0[12], p0[13]); w.w = pk2(p0[14], p0[15]); pk[1] = __builtin_bit_cast(bf16x8, w);
              w.x = pk2(p1[0], p1[1]); w.y = pk2(p1[2], p1[3]); w.z = pk2(p1[4], p1[5]); w.w = pk2(p1[6], p1[7]); pk[2] = __builtin_bit_cast(bf16x8, w);
              w.x = pk2(p1[8], p1[9]); w.y = pk2(p1[10], p1[11]); w.z = pk2(p1[12], p1[13]); w.w = pk2(p1[14], p1[15]); pk[3] = __builtin_bit_cast(bf16x8, w); }
            if (!KSM && !(LAG && grpB) && !(ABL & 4)) AT_PV(vc);
        }
        if (LAG && grpB) pend = act;
        VM_WAIT();
        if (MODE == 1) { const float cm = wave_max(carry); if (lane == 0) cmx[(t & 1) * 8 + wid] = cm; }
        __syncthreads();
        if (MODE == 1) { float cm = cmx[(t & 1) * 8];
#pragma unroll
            for (int w = 1; w < 8; ++w) cm = fmaxf(cm, cmx[(t & 1) * 8 + w]);
            if (cm < 1.4901161e-8f) break; }
        vp = vc; vc = vn; vn = (vn == AT_NVS - 1) ? 0 : vn + 1;
    }
    if (LAG && grpB && pend && !(ABL & 4)) AT_PV(vp);
#undef AT_PV
#undef AT_PVK
#undef AT_VR
#undef AT_VW
#undef AT_VM
#undef AT_VE
#undef AT_VPK
#undef AT_QK
#undef AT_RDA
#undef AT_RDB
#undef AT_WTA
#undef AT_WTB
#undef AT_MMA
#undef AT_MMB
#undef AT_RD
#undef AT_WT
#undef AT_MM
    const float inv = (MODE == 0) ? __builtin_amdgcn_rcpf(l_run) : 1.f;
    const int lane_e = LANE_ID_ASM(), hi_e = lane_e >> 5;
    bf16* orow = Op + (size_t)(P0 + 32 * wid + (lane_e & 31)) * ldo;
#pragma unroll
    for (int d = 0; d < 4 * NV; ++d)
#pragma unroll
        for (int rg = 0; rg < 4; ++rg) { v2u w; w.x = pk2(o[d][4 * rg] * inv, o[d][4 * rg + 1] * inv); w.y = pk2(o[d][4 * rg + 2] * inv, o[d][4 * rg + 3] * inv);
            *(v2u*)(orow + 32 * d + 8 * rg + 4 * hi_e) = w; }
#undef AT_DMAK
#undef AT_DMAV
#undef AT_KRD
#undef AT_KWT
#undef AT_KMM
#undef AT_JT
}
template <int MODE, int ABL = 0>
__device__ __forceinline__ void attn_phase(const Frame& F_in, gu32* qhead, const bf16* proj, bf16* outp) { PHASE_ENTRY(F);
    volatile LAS unsigned* slot = (volatile LAS unsigned*)(F.lds + MISC_OFF + 64);
    constexpr int NU = 512;
    for (;;) {
        __syncthreads();
        if (F.tid == 0) *slot = __hip_atomic_fetch_add(qhead, 1u, RLX_AGENT);
        __syncthreads();
        const int u = (int)*slot;
        if (u >= NU) break;
        const int qb = 63 - (u >> 3), h = u & 7;
        if (MODE == 0)
            attn_unit<0, 2, 1, ABL>(F.lds, F.wave, proj + h * 128, proj + 1024 + h * 128, proj + 2048 + (h >> 1) * 256, NIN, qb, outp + h * 256, 2048);
        else
            attn_unit<1, 1, 0>(F.lds, F.wave, proj + 3072 + h * 128, proj + 4096 + h * 128, proj + 5120 + h * 128, NIN, qb, outp + 1024 + h * 128, NMIX);
    }
}

constexpr float LIN_SC = 0.08838834764831845f;
constexpr int LK_STR = 320, LV_STR = 576;
struct LinArgs {
    const bf16* proj; bf16* qkc; const float* gpre; const float* b_i; const float* b_f; const float* wconv; const float* bconv; const float* gnorm;
    float* chs; bf16* dC; bf16* CH;
    float* dn; float* nh; bf16* ymix;
};
__device__ __forceinline__ float wave_prefix_sum(float v, int lane, LAS float* scr) { scr[lane] = v; LDS_WAIT(); asm volatile("" ::: "memory"); float b = 0.f;
    for (int s = 0; s < 64; ++s) { const float x = scr[s]; b += (s <= lane) ? x : 0.f; } LDS_WAIT(); asm volatile("" ::: "memory"); return b; }
__device__ __forceinline__ float wave_prefix_max(float v, int lane, LAS float* scr) { scr[lane] = v; LDS_WAIT(); asm volatile("" ::: "memory"); float b = v;
    for (int s = 0; s < 64; ++s) { const float x = scr[s]; b = (s <= lane) ? fmaxf(b, x) : b; } LDS_WAIT(); asm volatile("" ::: "memory"); return b; }
template <bool ML>
__device__ __forceinline__ void lin_gates(const LinArgs& A, int t0, int h, int lane, LAS float* scr, float& li, float& b) {
    if (ML) { const float f = A.gpre[(size_t)(t0 + lane) * 8 + 4 + h] + A.b_f[h]; li = A.gpre[(size_t)(t0 + lane) * 8 + h] + A.b_i[h];
        const float lf = fminf(f, 0.f) - __logf(1.f + __expf(-fabsf(f))); b = wave_prefix_sum(lf, lane, scr);
    } else { const float lg = (h == 0) ? -0.0317486983145803f : (h == 1) ? -0.015748356968139168f : (h == 2) ? -0.007843177461025893f : -0.003913899321136329f;   li = 0.f; b = (float)(lane + 1) * lg; }
}
template <bool ML>
__device__ __forceinline__ void lin_local(const Frame& F_in, const LinArgs& A) { PHASE_ENTRY(F);
    LAS unsigned char* lds = F.lds; const int tid = F.tid, lane = F.lane, wid = F.wave, hi = lane >> 5;
    LAS unsigned char* Kt = lds; LAS unsigned char* Vt = lds + 64 * LK_STR; LAS float* wks = (LAS float*)(lds + 64 * LK_STR + 64 * LV_STR);
    const int sr = tid >> 4, sc = (tid & 15) * 8;
    for (int u = F.bid; u < NCH * 4; u += F.G) { const int c = u >> 2, h = u & 3, t0 = c * 64;
        __syncthreads();
        if (wid == 0) { float li, b; lin_gates<ML>(A, t0, h, lane, wks, li, b); wks[lane] = b; LDS_WAIT(); asm volatile("" ::: "memory"); const float bl = wks[63]; LDS_WAIT(); asm volatile("" ::: "memory"); const float g = bl - b + li; const float a = ML ? wave_max(g) : 0.f;
            wks[lane] = __expf(g - a) * LIN_SC; if (lane == 0) { A.chs[c * 4 + h] = bl; A.chs[NCH * 4 + c * 4 + h] = a; } }
        __syncthreads();
#pragma unroll
        for (int rr = 0; rr < 2; ++rr) { const int s = sr + 32 * rr, t = t0 + s; const float wk = wks[s];
            if (ML) {
#pragma unroll
                for (int X = 0; X < 2; ++X) { const int ch = X * 512 + 128 * h + sc; float y[8];
#pragma unroll
                    for (int e = 0; e < 8; ++e) y[e] = A.bconv[ch + e];
#pragma unroll
                    for (int tap = 0; tap < 4; ++tap) { const int tt = t - 3 + tap; v4u x = (v4u){0u, 0u, 0u, 0u}; if (tt >= 0) x = *(const v4u*)(A.proj + (size_t)tt * NIN + 3072 + ch);
                        const f32x4 w0 = *(const f32x4*)(A.wconv + (size_t)tap * 1024 + ch), w1 = *(const f32x4*)(A.wconv + (size_t)tap * 1024 + ch + 4);
                        y[0] += w0[0] * bflo(x.x); y[1] += w0[1] * bfhi(x.x); y[2] += w0[2] * bflo(x.y); y[3] += w0[3] * bfhi(x.y);
                        y[4] += w1[0] * bflo(x.z); y[5] += w1[1] * bfhi(x.z); y[6] += w1[2] * bflo(x.w); y[7] += w1[3] * bfhi(x.w); }
#pragma unroll
                    for (int e = 0; e < 8; ++e) y[e] = y[e] * __builtin_amdgcn_rcpf(1.f + __expf(-y[e]));
                    v4u o; o.x = pk2(y[0], y[1]); o.y = pk2(y[2], y[3]); o.z = pk2(y[4], y[5]); o.w = pk2(y[6], y[7]);
                    *(v4u*)(A.qkc + (size_t)t * 1024 + ch) = o;
                    if (X == 1) { v4u k; k.x = pk2(y[0] * wk, y[1] * wk); k.y = pk2(y[2] * wk, y[3] * wk); k.z = pk2(y[4] * wk, y[5] * wk); k.w = pk2(y[6] * wk, y[7] * wk);
                        *(LAS v4u*)(Kt + s * LK_STR + sc * 2) = k; } }
            } else { const v4u x = *(const v4u*)(A.proj + (size_t)t * NIN + 512 + 128 * h + sc);
                v4u k; k.x = pk2(bflo(x.x) * wk, bfhi(x.x) * wk); k.y = pk2(bflo(x.y) * wk, bfhi(x.y) * wk); k.z = pk2(bflo(x.z) * wk, bfhi(x.z) * wk); k.w = pk2(bflo(x.w) * wk, bfhi(x.w) * wk);
                *(LAS v4u*)(Kt + s * LK_STR + sc * 2) = k; }
            const bf16* vp = A.proj + (size_t)t * NIN + (ML ? 4096 : 1024) + 256 * h + sc;
            *(LAS v4u*)(Vt + s * LV_STR + sc * 2) = *(const v4u*)vp; *(LAS v4u*)(Vt + s * LV_STR + (128 + sc) * 2) = *(const v4u*)(vp + 128); }
        __syncthreads();
        const unsigned rowb = (unsigned)(8 * hi + ((lane >> 2) & 3)), colb = (unsigned)(16 * ((lane >> 4) & 1) + 4 * (lane & 3));
        const unsigned vb = (unsigned)(uintptr_t)Vt + rowb * LV_STR + (32 * wid + colb) * 2, kbs = (unsigned)(uintptr_t)Kt + rowb * LK_STR + colb * 2;
        bf16x8 av[4];
#define L1_A(ks) do { s16x4 l_, h_; TRRD(l_, vb, (ks) * 16 * LV_STR); TRRD(h_, vb, ((ks) * 16 + 4) * LV_STR); asm volatile("s_waitcnt lgkmcnt(0)" : "+v"(l_), "+v"(h_) :: "memory"); av[ks] = mk8(l_, h_); } while (0)
        L1_A(0); L1_A(1); L1_A(2); L1_A(3);
#undef L1_A
        f32x16 acc[4];
#pragma unroll
        for (int d = 0; d < 4; ++d)
#pragma unroll
            for (int r = 0; r < 16; ++r) acc[d][r] = 0.f;
#define L1_B(d0, ks) do { s16x4 l_, h_; TRRD(l_, kbs, (ks) * 16 * LK_STR + (d0) * 64); TRRD(h_, kbs, ((ks) * 16 + 4) * LK_STR + (d0) * 64); asm volatile("s_waitcnt lgkmcnt(0)" : "+v"(l_), "+v"(h_) :: "memory"); \
            acc[d0] = MFMA32(av[ks], mk8(l_, h_), acc[d0]); } while (0)
#define L1_BD(d0) do { L1_B(d0, 0); L1_B(d0, 1); L1_B(d0, 2); L1_B(d0, 3); } while (0)
        L1_BD(0); L1_BD(1); L1_BD(2); L1_BD(3);
#undef L1_BD
#undef L1_B
        bf16* dcp = A.dC + ((size_t)(c * 4 + h) * 128) * 256;
#pragma unroll
        for (int d0 = 0; d0 < 4; ++d0)
#pragma unroll
            for (int rg = 0; rg < 4; ++rg) { v2u w; w.x = pk2(acc[d0][4 * rg], acc[d0][4 * rg + 1]); w.y = pk2(acc[d0][4 * rg + 2], acc[d0][4 * rg + 3]); *(v2u*)(dcp + (size_t)(32 * d0 + (lane & 31)) * 256 + 32 * wid + 8 * rg + 4 * hi) = w; }
        if (ML && tid < 128) { float s = 0.f;
#pragma unroll 8
            for (int q = 0; q < 64; ++q) s += h2f(*(const LAS unsigned short*)(Kt + q * LK_STR + tid * 2));
            A.dn[(size_t)(c * 4 + h) * 128 + tid] = s; }
    }
}
template <bool ML>
__device__ __forceinline__ void lin_scan(const Frame& F_in, const LinArgs& A) { PHASE_ENTRY(F);
    LAS float* decs = (LAS float*)F.lds; LAS float* inws = decs + NCH; LAS float* bls = decs + 2 * NCH; LAS float* acs = decs + 3 * NCH; LAS float* mss = decs + 4 * NCH;
    for (int blk = F.bid; blk < 256; blk += F.G) { const int h = blk >> 6, idx = (blk & 63) * 512 + F.tid; const bool lead = (blk & 63) == 0;
        __syncthreads();
        if (F.tid < NCH) { bls[F.tid] = A.chs[F.tid * 4 + h]; acs[F.tid] = A.chs[NCH * 4 + F.tid * 4 + h]; }
        __syncthreads();
        if (F.tid == 0) { float m = 0.f;
            for (int c0 = 0; c0 < NCH; c0 += 8) { float bl[8], aa[8];
#pragma unroll
                for (int i = 0; i < 8; ++i) { bl[i] = bls[c0 + i]; aa[i] = acs[c0 + i]; }
#pragma unroll
                for (int i = 0; i < 8; ++i) { mss[c0 + i] = m; m = fmaxf(bl[i] + m, aa[i]); } }
            mss[NCH] = m; }
        __syncthreads();
        if (F.tid < NCH) { const float m = mss[F.tid], mn = mss[F.tid + 1], bl = bls[F.tid], a = acs[F.tid]; decs[F.tid] = __expf(bl + m - mn); inws[F.tid] = __expf(a - mn); }
        __syncthreads();
        if (lead && F.tid < NCH) A.chs[2 * NCH * 4 + F.tid * 4 + h] = mss[F.tid];
        float C = 0.f;
        for (int c0 = 0; c0 < NCH; c0 += 32) { bf16 x[32];
#pragma unroll
            for (int u = 0; u < 32; ++u) x[u] = A.dC[(size_t)((c0 + u) * 4 + h) * 32768 + idx];
#pragma unroll
            for (int u = 0; u < 32; ++u) { const int c = c0 + u; A.CH[(size_t)(c * 4 + h) * 32768 + idx] = (bf16)f2bf(C); C = decs[c] * C + inws[c] * h2f(x[u]); } }
        if (ML && lead && F.tid < 128) { float n = 0.f;
            for (int c0 = 0; c0 < NCH; c0 += 32) { float x[32];
#pragma unroll
                for (int u = 0; u < 32; ++u) x[u] = A.dn[(size_t)((c0 + u) * 4 + h) * 128 + F.tid];
#pragma unroll
                for (int u = 0; u < 32; ++u) { const int c = c0 + u; A.nh[(size_t)(c * 4 + h) * 128 + F.tid] = n; n = decs[c] * n + inws[c] * x[u]; } } }
    }
}
template <bool ML>
__device__ __forceinline__ void lin_out(const Frame& F_in, const LinArgs& A) { PHASE_ENTRY(F);
    LAS unsigned char* lds = F.lds; const int tid = F.tid, lane = F.lane, wid = F.wave, r32 = lane & 31, hi = lane >> 5;
    LAS unsigned char* Kt = lds; LAS unsigned char* Vt = lds + 16384; LAS unsigned char* Ct = lds + 16384 + 64 * LV_STR;
    LAS float* vs = (LAS float*)(lds + 126976); LAS float* Mt = vs + 64; LAS float* Bt = vs + 128; LAS float* nhs = vs + 192; LAS float* ssq = vs + 320;
    const int sr = tid >> 4, sc = (tid & 15) * 8, tb = wid & 1, eq = wid >> 1, tl = 32 * tb + r32;
    for (int u = F.bid; u < NCH * 4; u += F.G) { const int c = u >> 2, h = u & 3, t0 = c * 64;
        const float mc = ML ? A.chs[2 * NCH * 4 + c * 4 + h] : 0.f;
        __syncthreads();
        const bf16* kp = ML ? A.qkc + (size_t)t0 * 1024 + 512 + 128 * h : A.proj + (size_t)t0 * NIN + 512 + 128 * h; const int kld = ML ? 1024 : NIN;
        v4u tk[2], tv[2][2], tc[8];
#pragma unroll
        for (int rr = 0; rr < 2; ++rr) { const int s = sr + 32 * rr;
            tk[rr] = *(const v4u*)(kp + (size_t)s * kld + sc);
            const bf16* vp = A.proj + (size_t)(t0 + s) * NIN + (ML ? 4096 : 1024) + 256 * h + sc;
            tv[rr][0] = *(const v4u*)vp; tv[rr][1] = *(const v4u*)(vp + 128); }
        const bf16* chp = A.CH + (size_t)(c * 4 + h) * 32768;
#pragma unroll
        for (int i = 0; i < 8; ++i) { const int ck = tid + 512 * i, d = ck >> 5, e0 = (ck & 31) * 8; tc[i] = *(const v4u*)(chp + (size_t)d * 256 + e0); }
        const bf16* qp = (ML ? A.qkc + (size_t)(t0 + tl) * 1024 + 128 * h : A.proj + (size_t)(t0 + tl) * NIN + 128 * h) + 8 * hi;
        bf16x8 qr[8];
#pragma unroll
        for (int s = 0; s < 8; ++s) qr[s] = *(const bf16x8*)(qp + 16 * s);
        asm volatile("" ::: "memory");
        if (wid == 0) { float li, b; lin_gates<ML>(A, t0, h, lane, ssq, li, b); const float v = li - b, uu = wave_prefix_max(v, lane, ssq); vs[lane] = v; Mt[lane] = fmaxf(mc, uu); Bt[lane] = b; }
        if (ML && wid >= 2 && wid < 4) nhs[tid - 128] = A.nh[(size_t)(c * 4 + h) * 128 + tid - 128];
#pragma unroll
        for (int rr = 0; rr < 2; ++rr) { const int s = sr + 32 * rr;
            *(LAS v4u*)(Kt + KSWZ(s, sc * 2)) = tk[rr];
            *(LAS v4u*)(Vt + s * LV_STR + sc * 2) = tv[rr][0]; *(LAS v4u*)(Vt + s * LV_STR + (128 + sc) * 2) = tv[rr][1]; }
#pragma unroll
        for (int i = 0; i < 8; ++i) { const int ck = tid + 512 * i, d = ck >> 5, e0 = (ck & 31) * 8; *(LAS v4u*)(Ct + d * LV_STR + e0 * 2) = tc[i]; }
        __syncthreads();
        const float Mme = Mt[tl], bme = Bt[tl], wint = __expf(mc - Mme);
        f32x16 p[2]; float nq = 0.f;
#pragma unroll
        for (int sb = 0; sb < 2; ++sb) {
#pragma unroll
            for (int r = 0; r < 16; ++r) p[sb][r] = 0.f;
            if (sb <= tb) {
#pragma unroll
                for (int d0 = 0; d0 < 8; ++d0) { const bf16x8 kf = *(const LAS bf16x8*)(Kt + KSWZ(32 * sb + r32, (16 * d0 + 8 * hi) * 2)); p[sb] = MFMA32(kf, qr[d0], p[sb]); }
#pragma unroll
                for (int r = 0; r < 16; ++r) { const int s = 32 * sb + crow(r, hi); const float w = (s <= tl) ? __expf(vs[s] - Mme) * LIN_SC : 0.f; p[sb][r] *= w; nq += p[sb][r]; }
            }
        }
        bf16x8 pk[4];
        { v4u w;
          w.x = pk2(p[0][0], p[0][1]); w.y = pk2(p[0][2], p[0][3]); w.z = pk2(p[0][4], p[0][5]); w.w = pk2(p[0][6], p[0][7]); pk[0] = __builtin_bit_cast(bf16x8, w);
          w.x = pk2(p[0][8], p[0][9]); w.y = pk2(p[0][10], p[0][11]); w.z = pk2(p[0][12], p[0][13]); w.w = pk2(p[0][14], p[0][15]); pk[1] = __builtin_bit_cast(bf16x8, w);
          w.x = pk2(p[1][0], p[1][1]); w.y = pk2(p[1][2], p[1][3]); w.z = pk2(p[1][4], p[1][5]); w.w = pk2(p[1][6], p[1][7]); pk[2] = __builtin_bit_cast(bf16x8, w);
          w.x = pk2(p[1][8], p[1][9]); w.y = pk2(p[1][10], p[1][11]); w.z = pk2(p[1][12], p[1][13]); w.w = pk2(p[1][14], p[1][15]); pk[3] = __builtin_bit_cast(bf16x8, w); }
        bf16x8 qw[8]; float qn = 0.f;
#pragma unroll
        for (int s = 0; s < 8; ++s) { const v4u x = __builtin_bit_cast(v4u, qr[s]); float f[8] = {bflo(x.x), bfhi(x.x), bflo(x.y), bfhi(x.y), bflo(x.z), bfhi(x.z), bflo(x.w), bfhi(x.w)};
            if (ML) {
#pragma unroll
                for (int e = 0; e < 8; ++e) qn += f[e] * nhs[16 * s + 8 * hi + e]; }
#pragma unroll
            for (int e = 0; e < 8; ++e) f[e] *= wint;
            qw[s] = pack8f(f); }
        nq = swap_sum(nq) + wint * swap_sum(qn);
        const unsigned q4 = (unsigned)((lane >> 2) & 3), colb = (unsigned)(16 * ((lane >> 4) & 1) + 4 * (lane & 3));
        const unsigned vb = (unsigned)(uintptr_t)Vt + (4 * hi + q4) * LV_STR + (64 * eq + colb) * 2;
        const unsigned cb0 = (unsigned)(uintptr_t)Ct + (8 * hi + q4) * LV_STR + (64 * eq + colb) * 2, cb1 = cb0 + 64 * LV_STR;
        f32x16 acc[2];
#pragma unroll
        for (int eb = 0; eb < 2; ++eb)
#pragma unroll
            for (int r = 0; r < 16; ++r) acc[eb][r] = 0.f;
        const bf16* gp = A.proj + (size_t)(t0 + tl) * NIN + (ML ? 5120 : 2048) + 256 * h;
        v2u gwv[2][4];
#pragma unroll
        for (int eb = 0; eb < 2; ++eb)
#pragma unroll
            for (int rg = 0; rg < 4; ++rg) { const int e = 64 * eq + 32 * eb + 8 * rg + 4 * hi; gwv[eb][rg] = *(const v2u*)(gp + e); }
#define L3_RV(i, eb, ks) do { TRRD(fl_[i], vb, (ks) * 16 * LV_STR + (eb) * 64); TRRD(fh_[i], vb, ((ks) * 16 + 8) * LV_STR + (eb) * 64); } while (0)
#define L3_RC(i, eb, base, so) do { TRRD(fl_[i], base, (so) * 16 * LV_STR + (eb) * 64); TRRD(fh_[i], base, ((so) * 16 + 4) * LV_STR + (eb) * 64); } while (0)
#define L3_W4() asm volatile("s_waitcnt lgkmcnt(0)" : "+v"(fl_[0]), "+v"(fh_[0]), "+v"(fl_[1]), "+v"(fh_[1]), "+v"(fl_[2]), "+v"(fh_[2]), "+v"(fl_[3]), "+v"(fh_[3]) :: "memory")
#define L3_W2() asm volatile("s_waitcnt lgkmcnt(0)" : "+v"(fl_[0]), "+v"(fh_[0]), "+v"(fl_[1]), "+v"(fh_[1]) :: "memory")
#define L3_E(eb) do { s16x4 fl_[4], fh_[4]; \
            if (tb) { L3_RV(0, eb, 0); L3_RV(1, eb, 1); L3_RV(2, eb, 2); L3_RV(3, eb, 3); L3_W4(); \
                acc[eb] = MFMA32(mk8(fl_[0], fh_[0]), pk[0], acc[eb]); acc[eb] = MFMA32(mk8(fl_[1], fh_[1]), pk[1], acc[eb]); acc[eb] = MFMA32(mk8(fl_[2], fh_[2]), pk[2], acc[eb]); acc[eb] = MFMA32(mk8(fl_[3], fh_[3]), pk[3], acc[eb]); } \
            else { L3_RV(0, eb, 0); L3_RV(1, eb, 1); L3_W2(); acc[eb] = MFMA32(mk8(fl_[0], fh_[0]), pk[0], acc[eb]); acc[eb] = MFMA32(mk8(fl_[1], fh_[1]), pk[1], acc[eb]); } \
            L3_RC(0, eb, cb0, 0); L3_RC(1, eb, cb0, 1); L3_RC(2, eb, cb0, 2); L3_RC(3, eb, cb0, 3); L3_W4(); \
            acc[eb] = MFMA32(mk8(fl_[0], fh_[0]), qw[0], acc[eb]); acc[eb] = MFMA32(mk8(fl_[1], fh_[1]), qw[1], acc[eb]); acc[eb] = MFMA32(mk8(fl_[2], fh_[2]), qw[2], acc[eb]); acc[eb] = MFMA32(mk8(fl_[3], fh_[3]), qw[3], acc[eb]); \
            L3_RC(0, eb, cb1, 0); L3_RC(1, eb, cb1, 1); L3_RC(2, eb, cb1, 2); L3_RC(3, eb, cb1, 3); L3_W4(); \
            acc[eb] = MFMA32(mk8(fl_[0], fh_[0]), qw[4], acc[eb]); acc[eb] = MFMA32(mk8(fl_[1], fh_[1]), qw[5], acc[eb]); acc[eb] = MFMA32(mk8(fl_[2], fh_[2]), qw[6], acc[eb]); acc[eb] = MFMA32(mk8(fl_[3], fh_[3]), qw[7], acc[eb]); } while (0)
        L3_E(0); L3_E(1);
#undef L3_RV
#undef L3_RC
#undef L3_W4
#undef L3_W2
#undef L3_E
        float dinv = 1.f;
        if (ML) dinv = __builtin_amdgcn_rcpf(fmaxf(fabsf(nq), __expf(-(bme + Mme))));
        float ss = 0.f;
#pragma unroll
        for (int eb = 0; eb < 2; ++eb)
#pragma unroll
            for (int r = 0; r < 16; ++r) { acc[eb][r] *= dinv; ss += acc[eb][r] * acc[eb][r]; }
        ss = swap_sum(ss);
        if (hi == 0) ssq[eq * 64 + tl] = ss;
        __syncthreads();
        const float rn = rsqrtf(((ssq[tl] + ssq[64 + tl]) + (ssq[128 + tl] + ssq[192 + tl])) * (1.f / 256.f) + EPS_);
        bf16* yp = A.ymix + (size_t)(t0 + tl) * NMIX + (ML ? 1024 : 0) + 256 * h;
#pragma unroll
        for (int eb = 0; eb < 2; ++eb)
#pragma unroll
            for (int rg = 0; rg < 4; ++rg) { const int e = 64 * eq + 32 * eb + 8 * rg + 4 * hi; const v2u gw = gwv[eb][rg]; const f32x4 gn = *(const f32x4*)(A.gnorm + e);
                float gt[4] = {bflo(gw.x), bfhi(gw.x), bflo(gw.y), bfhi(gw.y)}, o[4];
#pragma unroll
                for (int k = 0; k < 4; ++k) { const float sg = __builtin_amdgcn_rcpf(1.f + __expf(-gt[k])); const float gate = ML ? sg : gt[k] * sg; o[k] = acc[eb][4 * rg + k] * rn * gn[k] * gate; }
                v2u w; w.x = pk2(o[0], o[1]); w.y = pk2(o[2], o[3]); *(v2u*)(yp + e) = w; }
    }
}

#ifndef MK_SPLIT
#define MK_SPLIT 0
#endif
constexpr int PH_PER_LAYER = 16, N_PHASES = 1 + PH_PER_LAYER * DEPTH_;
__global__ void __launch_bounds__(NWAVES * 64, 2) fwd_kernel(Params P) {
    extern __shared__ __attribute__((aligned(16))) unsigned char lds_raw[];
    Frame F0; F0.lds = (LAS unsigned char*)lds_raw; F0.tid = threadIdx.x; F0.lane = F0.tid & 63; F0.wave = __builtin_amdgcn_readfirstlane(F0.tid >> 6); F0.G = gridDim.x; F0.bid = blockIdx.x;
    volatile LAS unsigned* MISC = (volatile LAS unsigned*)(F0.lds + MISC_OFF);
    for (int u = F0.tid; u < (LDS_BYTES - LDSCTL_OFF) / 4; u += NWAVES * 64) ((LAS unsigned*)(F0.lds + LDSCTL_OFF))[u] = 0u;
    __syncthreads();
    gu32* ctl = (gu32*)(P.ws + WS_CTL);
    XcdBarrier bar; bar.bar = (unsigned*)ctl + CW_BAR; bar.x = 0; bar.st = nullptr;
    if (!MK_SPLIT) bar = xcd_barrier_post((unsigned*)ctl + CW_BAR, MISC + 8);
    const int lo = P.ph_lo, hi = P.ph_hi;
#ifndef PHMASK
#define PHMASK 0xffffffffu
#endif
#ifndef DUPMASK
#define DUPMASK (0u)
#endif
#define DUPN(n) for (int rep_ = 0; rep_ < (((DUPMASK >> (n)) & 1u) ? 2 : 1); ++rep_)
#define IN(k) (lo <= (k) && (k) < hi)
#define INM(k, n) (((PHMASK >> (n)) & 1u) && IN(k))
#ifndef DBG_TIME
#define DBG_TIME 0
#endif
#if DBG_TIME
#define SEAM(k) do { if (!MK_SPLIT && lo <= (k) && (k) + 1 < hi) xcd_barrier(bar); if (F0.bid == 0 && F0.tid == 0) ((unsigned long long*)(P.ws + 768 * 1024))[(k) + 1] = wall_clock64(); } while (0)
#else
#define SEAM(k) do { if (!MK_SPLIT && lo <= (k) && (k) + 1 < hi) xcd_barrier(bar); } while (0)
#endif
#define PHASE_PTRS() KParams Pk = (KParams)__builtin_amdgcn_kernarg_segment_ptr(); Frame F = F0; asm volatile("; PHASE_PTRS" : "+s"(Pk), "+s"(F.G), "+s"(F.bid), "+s"(F.wave)); unsigned char* ws = Pk->ws; float* out = Pk->out; \
    bf16* hb = (bf16*)(ws + WS_HB); bf16* proj = (bf16*)(ws + WS_PROJ); bf16* ymix = (bf16*)(ws + WS_YMIX); bf16* mixo = (bf16*)(ws + WS_MIXO); bf16* upb = (bf16*)(ws + WS_UP); \
    bf16* act = (bf16*)(ws + WS_ACT); bf16* od = (bf16*)(ws + WS_OD); bf16* g1 = (bf16*)(ws + WS_G1); bf16* qkc = (bf16*)(ws + WS_QKC); \
    float* rin = (float*)(ws + WS_RIN); float* ssp = (float*)(ws + WS_SSP); float* gpre = (float*)(ws + WS_GPRE); \
    const float* cst = (const float*)(ws + WS_COS); const float* snt = (const float*)(ws + WS_SIN); \
    (void)out; (void)hb; (void)proj; (void)ymix; (void)mixo; (void)upb; (void)act; (void)od; (void)g1; (void)qkc; (void)rin; (void)ssp; (void)gpre; (void)cst; (void)snt
#define LIN_ARGS() LinArgs LA; LA.proj = proj; LA.qkc = qkc; LA.gpre = gpre; LA.b_i = Pk->in[I_BIG] + j * 4; LA.b_f = Pk->in[I_BFG] + j * 4; LA.wconv = Pk->in[I_WCQK] + (size_t)j * 4096; LA.bconv = Pk->in[I_BCQK] + (size_t)j * 1024; \
    LA.gnorm = ev ? Pk->in[I_GML] + j * 256 : Pk->in[I_GRET] + j * 256; LA.chs = (float*)(ws + WS_CHS); LA.dC = (bf16*)(ws + WS_DC); LA.CH = (bf16*)(ws + WS_CH); LA.dn = (float*)(ws + WS_DN); LA.nh = (float*)(ws + WS_NH); LA.ymix = ymix

#if DBG_TIME
    if (F0.bid == 0 && F0.tid == 0) ((unsigned long long*)(P.ws + 768 * 1024))[0] = wall_clock64();
#endif
    if (INM(0, 31)) DUPN(31) { PHASE_PTRS(); p0_prologue(F, Pk); }
    SEAM(0);
#pragma unroll 1
    for (int L = 0; L < DEPTH_; ++L) {
        const int pbase = 1 + PH_PER_LAYER * L, j = L >> 1; const bool ev = (L & 1) == 0;
        if (INM(pbase + 0, 0)) DUPN(0) { PHASE_PTRS();
            if (ev) gates_pass(F, hb, (const bf16*)(ws + WS_WG) + (size_t)j * 8 * DM, rin, gpre);
            pg8::Gemm g{hb, (const bf16*)(ws + WS_WIN) + (size_t)L * NIN * DM, S_, NIN, DM, 0, 0}; pg8::StaticOrder S; S.init(S_, NIN, F.G, F.bid);
            pg8::EpiProj E{proj, NIN, rin, cst, snt, ev ? 8 : 4};
            pg8::gemm_phase<pg8::EpiProj, pg8::StaticOrder, true, true>(F.lds, g, S, E, F.wave);
        }
        SEAM(pbase + 0);
        if (INM(pbase + 1, 1)) DUPN(1) { PHASE_PTRS(); LIN_ARGS(); if (ev) lin_local<true>(F, LA); else lin_local<false>(F, LA); }
        SEAM(pbase + 1);
        if (INM(pbase + 2, 2)) DUPN(2) { PHASE_PTRS(); LIN_ARGS(); if (ev) lin_scan<true>(F, LA); else lin_scan<false>(F, LA); }
        SEAM(pbase + 2);
        if (INM(pbase + 3, 3)) DUPN(3) { PHASE_PTRS(); LIN_ARGS();
#ifndef P3MASK
#define P3MASK 15
#endif
#ifndef P3ABL
#define P3ABL 0
#endif
#ifndef P3DUP
#define P3DUP 15
#endif
            const int p3m = rep_ ? (P3MASK & P3DUP) : P3MASK;
            if (ev) { if (p3m & 1) lin_out<true>(F, LA); if (p3m & 2) { if (rep_) attn_phase<0, P3ABL>(F, ctl + CW_Q + 64 * (L + 4 * rep_), proj, (bf16*)(ws + WS_UP)); else attn_phase<0>(F, ctl + CW_Q + 64 * (L + 4 * rep_), proj, od); } }
            else { if (p3m & 4) lin_out<false>(F, LA); if (p3m & 8) attn_phase<1>(F, ctl + CW_Q + 64 * (L + 4 * rep_), proj, ymix); }
        }
        SEAM(pbase + 3);
        if (ev) { if (INM(pbase + 4, 4)) DUPN(4) { PHASE_PTRS(); diffcomb_pass(F, od, Pk->in[I_GDIFF] + j * 256, (const float*)(ws + WS_LAM) + 2 * j, ymix); } SEAM(pbase + 4); }
        if (INM(pbase + 5, 5)) DUPN(5) { PHASE_PTRS();
            pg8::Gemm g{ymix, (const bf16*)(ws + WS_WOUT) + (size_t)L * DM * NMIX, S_, DM, NMIX, 0, 0}; pg8::StaticOrder S; S.init(S_, DM, F.G, F.bid);
            pg8::EpiY E{mixo, DM, ssp};
            pg8::gemm_phase<pg8::EpiY, pg8::StaticOrder, true, true>(F.lds, g, S, E, F.wave);
        }
        SEAM(pbase + 5);
        if (INM(pbase + 6, 6)) DUPN(6) { PHASE_PTRS(); resid_pass(F, (RES_LO && L == 0) ? Pk->in[I_X] : (const float*)nullptr, mixo, ssp, Pk->in[I_GMPOST] + (size_t)L * DM, hb, (bf16*)(ws + WS_LO), rin); }
        SEAM(pbase + 6);
        if (INM(pbase + 7, 7)) DUPN(7) { PHASE_PTRS();
            pg8::Gemm g{hb, (const bf16*)(ws + WS_WUP) + (size_t)L * NUP * DM, S_, NUP, DM, 0, 0}; pg8::StaticOrder S; S.init(S_, NUP, F.G, F.bid);
            pg8::EpiProj E{upb, NUP, rin, cst, snt, 0};
            pg8::gemm_phase<pg8::EpiProj, pg8::StaticOrder, true, true>(F.lds, g, S, E, F.wave);
        }
        SEAM(pbase + 7);
        if (INM(pbase + 8, 8)) DUPN(8) { PHASE_PTRS(); convffn_pass(F, upb, Pk->in[I_WFC] + (size_t)L * 3 * NUP, Pk->in[I_BFC] + (size_t)L * NUP, act); }
        SEAM(pbase + 8);
        if (INM(pbase + 9, 9)) DUPN(9) { PHASE_PTRS();
            pg8::Gemm g{act, (const bf16*)(ws + WS_WDN) + (size_t)L * DM * DM, S_, DM, DM, 0, 0}; pg8::StaticOrder S; S.init(S_, DM, F.G, F.bid);
            pg8::EpiY E{mixo, DM, ssp};
            pg8::gemm_phase<pg8::EpiY, pg8::StaticOrder, true, true>(F.lds, g, S, E, F.wave);
        }
        SEAM(pbase + 9);
        if (INM(pbase + 10, 10)) DUPN(10) { PHASE_PTRS(); resid_pass(F, (const float*)nullptr, mixo, ssp, Pk->in[I_GFPOST] + (size_t)L * DM, hb, (bf16*)(ws + WS_LO), rin); }
        SEAM(pbase + 10);
        if (INM(pbase + 11, 11)) DUPN(11) { PHASE_PTRS();
            pg8::Gemm g{hb, (const bf16*)(ws + WS_WPD) + (size_t)L * PLED * DM, S_, PLED, DM / 4, (long)(DM / 4) * 2, (long)(DM / 4) * 2, DM}; pg8::SplitKOrder S{F.G, F.bid, (S_ / 256) * 4};
            pg8::EpiPart E{(bf16*)(ws + WS_UP)};
            pg8::gemm_phase<pg8::EpiPart, pg8::SplitKOrder, true, true>(F.lds, g, S, E, F.wave);
        }
        SEAM(pbase + 11);
        if (INM(pbase + 12, 12)) DUPN(12) { PHASE_PTRS(); pled_combine(F, (const bf16*)(ws + WS_UP), rin, g1); }
        SEAM(pbase + 12);
        if (INM(pbase + 13, 13)) DUPN(13) { PHASE_PTRS();
            int Kp = PLED; asm volatile("; opaque K (keeps the K-loop rolled)" : "+s"(Kp));
            pg8::Gemm g{g1, (const bf16*)(ws + WS_WPU) + (size_t)L * DM * PLED, S_, DM, Kp, (long)(WS_PB - WS_G1) + (long)L * S_ * PLED * 2, (long)(WS_WPP - WS_WPU)};
#ifndef DBG_PLE_PLAIN
#define DBG_PLE_PLAIN 0
#endif
#if DBG_PLE_PLAIN == 1
            pg8::StaticOrder S; S.init(S_, DM, F.G, F.bid); pg8::EpiY E{mixo, DM, ssp};
            pg8::gemm_phase<pg8::EpiY, pg8::StaticOrder, true, true>(F.lds, g, S, E, F.wave);
#elif DBG_PLE_PLAIN == 2
            pg8::PleOrder S{F.G, F.bid, (S_ / 256) * (DM / 256)}; pg8::EpiPleDbg E{mixo, act};
            pg8::gemm_phase<pg8::EpiPleDbg, pg8::PleOrder, true, true>(F.lds, g, S, E, F.wave);
#else
            pg8::PleOrder S{F.G, F.bid, (S_ / 256) * (DM / 256)};
            pg8::EpiPle E{mixo, hb, (bf16*)(ws + WS_LO), L == DEPTH_ - 1 ? out : (float*)nullptr, ssp};
            pg8::gemm_phase<pg8::EpiPle, pg8::PleOrder, true, true>(F.lds, g, S, E, F.wave);
#endif
        }
        SEAM(pbase + 13);
        if (L + 1 < DEPTH_) { if (INM(pbase + 14, 14)) DUPN(14) { PHASE_PTRS(); rin_pass(F, ssp, rin); } SEAM(pbase + 14); }
    }
#undef IN
#undef INM
#undef SEAM
}

#ifndef DBG_STOP
#define DBG_STOP 0
#endif
#if DBG_STOP
__global__ void dbg_fold(const unsigned* ws, size_t nwords, float* out, int keep_out) {
    for (size_t i = (size_t)blockIdx.x * blockDim.x + threadIdx.x; i < (size_t)S_ * DM; i += (size_t)gridDim.x * blockDim.x) { float acc = keep_out ? out[i] : 0.f;
        for (size_t w = (1u << 18) + i; w < nwords; w += (size_t)S_ * DM) { const unsigned x = ws[w]; acc += (float)(x & 0xffffu) * (1.f / 65536.f) + (float)(x >> 16) * (1.f / 65536.f); }
        out[i] = acc; }
}
#endif
#ifndef DBG_CHECK
#define DBG_CHECK 0
#endif
#ifndef DBG_LAYER
#define DBG_LAYER 0
#endif

#if DBG_CHECK
__global__ void chk_rin(const float* h, const float* rin, float* errs, int code) { __shared__ float sh[8]; const int row = hsh(2020 + blockIdx.x) % S_; float ss = 0.f;
    for (int k = threadIdx.x; k < DM; k += blockDim.x) { const float a = h[(size_t)row * DM + k]; ss += a * a; } ss = blk_sum(ss, sh); if (threadIdx.x == 0) rep_err(errs, code, rin[row], rsqrtf(ss / DM + EPS_), 1e-3f); }
static void dbg_checks(int k, int before, void* const* d_in, void* d_out, void* d_ws, hipStream_t st) {
    const int r = (k - 1) % PH_PER_LAYER, L = (k - 1) / PH_PER_LAYER, j = L >> 1; const bool ev = (L & 1) == 0;
    if (k < 1 || L != DBG_LAYER) return;
    unsigned char* ws = (unsigned char*)d_ws; float* errs = (float*)(ws + 512 * 1024); float* out = (float*)d_out; float* tmp = (float*)(ws + WS_UP);
    const float* const* in = (const float* const*)d_in;
    bf16* proj = (bf16*)(ws + WS_PROJ); bf16* ymix = (bf16*)(ws + WS_YMIX); bf16* mixo = (bf16*)(ws + WS_MIXO); bf16* hb = (bf16*)(ws + WS_HB); bf16* upb = (bf16*)(ws + WS_UP); bf16* act = (bf16*)(ws + WS_ACT);
    bf16* od = (bf16*)(ws + WS_OD); bf16* g1 = (bf16*)(ws + WS_G1); float* rin = (float*)(ws + WS_RIN); float* ssp = (float*)(ws + WS_SSP); float* gpre = (float*)(ws + WS_GPRE);
    const float* cst = (const float*)(ws + WS_COS); const float* snt = (const float*)(ws + WS_SIN);
    const float* hin0 = (L == 0) ? in[I_X] : (const float*)out;
    if (before) { if ((DBG_CHECK == 1 && r == 6 && L > 0) || (DBG_CHECK == 2 && (r == 10 || r == 12))) (void)hipMemcpyAsync(tmp, out, (size_t)S_ * DM * 4, hipMemcpyDeviceToDevice, st); return; }
    if (DBG_CHECK == 1) {
        if (r == 0) { const float* W = ev ? in[I_WINE] + (size_t)j * DM * 6152 : in[I_WINO] + (size_t)j * DM * 6144;
            hipLaunchKernelGGL(chk_gemm, dim3(16384), dim3(256), 0, st, hin0, (const bf16*)nullptr, DM, in[I_GMPRE] + (size_t)L * DM, (const float*)nullptr, 1, W, ev ? 6152 : 6144, NIN, ev ? 2048 : 1024, cst, snt, (const bf16*)proj, NIN, errs, 1, 11u);
            if (ev) hipLaunchKernelGGL(chk_gates, dim3(4096), dim3(256), 0, st, hin0, in[I_GMPRE] + (size_t)L * DM, in[I_WINE] + (size_t)j * DM * 6152, (const float*)gpre, errs, 2); }
        if (r == 3) { float* hn = (float*)(ws + WS_UP); float* scr = (float*)(ws + WS_UP + 128 * MiB);
            if (ev) { hipLaunchKernelGGL(chk_diffattn, dim3(1024), dim3(256), 0, st, (const bf16*)proj, (const bf16*)od, scr, errs, 3);
                hipLaunchKernelGGL(chk_lin_naive, dim3(256, 4), dim3(128), 0, st, (const bf16*)proj, (const float*)gpre, in[I_BIG] + j * 4, in[I_BFG] + j * 4, in[I_WCQK] + (size_t)j * 4096, in[I_BCQK] + (size_t)j * 1024, 1, hn);
                hipLaunchKernelGGL(chk_lin_cmp, dim3(8192), dim3(256), 0, st, (const float*)hn, (const bf16*)proj, in[I_GML] + j * 256, 1, (const bf16*)ymix, errs, 4);
            } else { hipLaunchKernelGGL(chk_stick, dim3(1024), dim3(128), 0, st, (const bf16*)proj, (const bf16*)ymix, errs, 3);
                hipLaunchKernelGGL(chk_lin_naive, dim3(256, 4), dim3(128), 0, st, (const bf16*)proj, (const float*)gpre, in[I_BIG], in[I_BFG], in[I_WCQK], in[I_BCQK], 0, hn);
                hipLaunchKernelGGL(chk_lin_cmp, dim3(8192), dim3(256), 0, st, (const float*)hn, (const bf16*)proj, in[I_GRET] + j * 256, 0, (const bf16*)ymix, errs, 4); } }
        if (r == 4 && ev) hipLaunchKernelGGL(chk_diffcomb, dim3(8192), dim3(256), 0, st, (const bf16*)od, in[I_DLAM] + (size_t)j * 512, in[I_GDIFF] + j * 256, 0.8f - 0.6f * expf(-0.3f * (float)L), (const bf16*)ymix, errs, 5);
        if (r == 5) { const float* W = (ev ? in[I_WOUTE] : in[I_WOUTO]) + (size_t)j * NMIX * DM;
            hipLaunchKernelGGL(chk_gemm, dim3(16384), dim3(256), 0, st, (const float*)nullptr, (const bf16*)ymix, NMIX, (const float*)nullptr, (const float*)nullptr, 0, W, DM, DM, 0, cst, snt, (const bf16*)mixo, DM, errs, 6, 22u);
            hipLaunchKernelGGL(chk_ssp, dim3(4096), dim3(256), 0, st, (const bf16*)mixo, (const float*)ssp, errs, 6); }
        if (r == 6) hipLaunchKernelGGL(chk_resid, dim3(4096), dim3(256), 0, st, L == 0 ? in[I_X] : (const float*)tmp, (const bf16*)mixo, in[I_GMPOST] + (size_t)L * DM, (const float*)out, (const float*)rin, errs, 7);
        if (r == 7) hipLaunchKernelGGL(chk_gemm, dim3(16384), dim3(256), 0, st, (const float*)nullptr, (const bf16*)hb, DM, in[I_GFPRE] + (size_t)L * DM, (const float*)rin, 0, in[I_WUP] + (size_t)L * DM * NUP, NUP, NUP, 0, cst, snt, (const bf16*)upb, NUP, errs, 8, 33u);
        if (r == 8) hipLaunchKernelGGL(chk_conv, dim3(4096), dim3(256), 0, st, (const bf16*)upb, in[I_WFC] + (size_t)L * 3 * NUP, in[I_BFC] + (size_t)L * NUP, (const bf16*)act, errs, 9);
    } else {
        if (r == 9) { hipLaunchKernelGGL(chk_gemm, dim3(16384), dim3(256), 0, st, (const float*)nullptr, (const bf16*)act, DM, (const float*)nullptr, (const float*)nullptr, 0, in[I_WDN] + (size_t)L * DM * DM, DM, DM, 0, cst, snt, (const bf16*)mixo, DM, errs, 1, 44u);
            hipLaunchKernelGGL(chk_ssp, dim3(4096), dim3(256), 0, st, (const bf16*)mixo, (const float*)ssp, errs, 1); }
        if (r == 10) hipLaunchKernelGGL(chk_resid, dim3(4096), dim3(256), 0, st, (const float*)tmp, (const bf16*)mixo, in[I_GFPOST] + (size_t)L * DM, (const float*)out, (const float*)rin, errs, 2);
        if (r == 11) hipLaunchKernelGGL(chk_gemm, dim3(16384), dim3(256), 0, st, (const float*)nullptr, (const bf16*)hb, DM, in[I_GPLE] + (size_t)L * DM, (const float*)rin, 0, in[I_WPD] + (size_t)L * DM * PLED, PLED, PLED, 0, cst, snt, (const bf16*)g1, PLED, errs, 3, 55u);
        if (r == 12 && DBG_PLE_PLAIN == 2) hipLaunchKernelGGL(chk_gemm, dim3(16384), dim3(256), 0, st, (const float*)nullptr, (const bf16*)(ws + WS_PB) + (size_t)L * S_ * PLED, PLED, (const float*)nullptr, (const float*)nullptr, 0, in[I_WPP] + (size_t)L * PLED * DM, DM, DM, 0, cst, snt, (const bf16*)act, DM, errs, 5, 77u);
        if (r == 12 && DBG_PLE_PLAIN) hipLaunchKernelGGL(chk_gemm, dim3(16384), dim3(256), 0, st, (const float*)nullptr, (const bf16*)g1, PLED, (const float*)nullptr, (const float*)nullptr, 0, in[I_WPU] + (size_t)L * PLED * DM, DM, DM, 0, cst, snt, (const bf16*)mixo, DM, errs, 4, 66u);
        if (r == 12 && !DBG_PLE_PLAIN) { hipLaunchKernelGGL(chk_ple2, dim3(16384), dim3(256), 0, st, (const float*)tmp, (const bf16*)g1, in[I_WPU] + (size_t)L * PLED * DM, in[I_P] + (size_t)L * S_ * PLED, in[I_WPP] + (size_t)L * PLED * DM, (const float*)out, (const bf16*)mixo, errs, 4);
            hipLaunchKernelGGL(chk_ple, dim3(16384), dim3(256), 0, st, (const float*)tmp, (const bf16*)g1, in[I_WPU] + (size_t)L * PLED * DM, in[I_P] + (size_t)L * S_ * PLED, in[I_WPP] + (size_t)L * PLED * DM, (const float*)out, errs, 5); }
        if (r == 13) hipLaunchKernelGGL(chk_rin, dim3(4096), dim3(256), 0, st, (const float*)out, (const float*)rin, errs, 7);
    }
}
#endif
#ifndef DBG_NOPERT
#define DBG_NOPERT 0
#endif
#if DBG_PERTURB
__global__ void dbg_save(const float* out, bf16* sav) { for (size_t i = (size_t)blockIdx.x * blockDim.x + threadIdx.x; i < (size_t)S_ * DM; i += (size_t)gridDim.x * blockDim.x) sav[i] = (bf16)f2bf(out[i]); }
__global__ void dbg_cmp(const float* out, const bf16* sav, float* res) {
    __shared__ float sh[8]; const int row = blockIdx.x; float m = 0.f;
    for (int k = threadIdx.x; k < DM; k += blockDim.x) m = fmaxf(m, fabsf(out[(size_t)row * DM + k] - h2f(sav[(size_t)row * DM + k])));
    m = wave_max(m); __syncthreads(); if ((threadIdx.x & 63) == 0) sh[threadIdx.x >> 6] = m; __syncthreads();
    if (threadIdx.x == 0) { m = fmaxf(fmaxf(sh[0], sh[1]), fmaxf(sh[2], sh[3])); res[16 + row] = m; atomicMax((int*)res, __float_as_int(m)); }
}
__global__ void dbg_ysave(const bf16* ymix, bf16* sav) { for (int i = blockIdx.x * blockDim.x + threadIdx.x; i < 64 * NMIX; i += gridDim.x * blockDim.x) sav[i] = ymix[i]; }
__global__ void dbg_ycmp(const bf16* ymix, const bf16* sav, float* res, int L) {
    for (int i = blockIdx.x * blockDim.x + threadIdx.x; i < 64 * NMIX; i += gridDim.x * blockDim.x) { const float d = fabsf(h2f(ymix[i]) - h2f(sav[i]));
        atomicMax((int*)res + 1 + L, __float_as_int(d)); if (L == 0) atomicMax((unsigned long long*)(res + 1000), ((unsigned long long)__float_as_uint(d) << 32) | (unsigned)i); atomicMax((int*)res + 100 + L * 8 + ((i % NMIX) >> 8), __float_as_int(d)); atomicMax((int*)res + 200 + L * 64 + i / NMIX, __float_as_int(d)); }
}
__global__ void dbg_fetch(const bf16* ymix, float* res) { const unsigned i = ((const unsigned*)res)[1000]; res[1002] = h2f(ymix[i]); }
__global__ void dbg_rep(const float* res, float* out) {
    __shared__ float cc; if (threadIdx.x == 0) { const float mx = res[0]; int rw = 0; for (int r = 0; r < S_; ++r) if (res[16 + r] == mx) { rw = r; break; }
        int cnt = 0; for (int r = 0; r < S_; ++r) if (res[16 + r] > 0.5f * mx) ++cnt;
        if (DBG_PERTURB >= 5) { int Lf = 9, cb = 0, rw2 = 0; float md = 0.f; for (int L = 0; L < 4; ++L) if (res[1 + L] > 0.1f) { Lf = L; break; }
            if (Lf < 4) { for (int b = 0; b < 8; ++b) if (res[100 + Lf * 8 + b] > md) { md = res[100 + Lf * 8 + b]; cb = b; } md = 0.f; for (int r = 0; r < 64; ++r) if (res[200 + Lf * 64 + r] > md) { md = res[200 + Lf * 64 + r]; rw2 = r; } }
            cc = (DBG_PERTURB == 5) ? 1000.f * (Lf + 1) + 100.f * cb : (DBG_PERTURB == 6) ? 1000.f * (Lf + 1) + 100.f * fminf(9.f, (float)rw2) : (DBG_PERTURB == 11) ? 1000.f + 100.f * (float)rw2 : (DBG_PERTURB == 12) ? 1000.f + 30.f * (float)(((const unsigned*)res)[1000] % NMIX & 255) : (DBG_PERTURB == 13) ? 1000.f + 1000.f * fabsf(res[1002]) : 1000.f + 1000.f * res[1 + (DBG_PERTURB - 7)]; }
        else cc = (DBG_PERTURB == 1) ? 1000.f + mx * 1000.f : (DBG_PERTURB == 2) ? 1000.f + (float)rw * (9000.f / 16384.f) : (DBG_PERTURB == 3) ? 1000.f + (float)(rw & 1023) * (9000.f / 1024.f) : 1000.f + (float)cnt * 10.f; }
    __syncthreads(); const float c = cc;
    for (size_t i = (size_t)blockIdx.x * blockDim.x + threadIdx.x; i < (size_t)S_ * DM; i += (size_t)gridDim.x * blockDim.x) out[i] = c;
}
#endif
#if DBG_TIME
__global__ void dbg_time_rep(const unsigned long long* st, float* out) {
    __shared__ float cc; if (threadIdx.x == 0) { double us = 0.0; const int kind = DBG_TIME - 1;
        if (kind == 0) us = (double)(st[1] - st[0]) * 0.01; else if (kind == 20) us = (double)(st[1 + PH_PER_LAYER * (DEPTH_ - 1) + 13] - st[0]) * 0.01;
        else if (kind >= 30) { const int L = kind - 30; us = (double)(st[1 + 1 + PH_PER_LAYER * L + 3] - st[1 + PH_PER_LAYER * L + 3]) * 0.01; }
        else { const int r = kind - 1; for (int L = 0; L < DEPTH_; ++L) { const int k = 1 + PH_PER_LAYER * L + r; if ((r == 4 && (L & 1)) || (r == 13 && L == DEPTH_ - 1)) continue; unsigned long long prev = st[k]; int kp = k; while (prev == 0ull && kp > 0) prev = st[--kp]; us += (double)(st[k + 1] - prev) * 0.01; } }
        cc = (float)(us * 100.0); }
    __syncthreads(); const float c = cc;
    for (size_t i = (size_t)blockIdx.x * blockDim.x + threadIdx.x; i < (size_t)S_ * DM; i += (size_t)gridDim.x * blockDim.x) out[i] = c;
}
#endif
extern "C" void kernel_launch(void* const* d_in, const int* in_sizes, int n_in, void* d_out, int out_size, void* d_ws, size_t ws_size, hipStream_t stream) {
    static int grid = 0;
    if (grid == 0) {
        if (n_in != 26 || out_size != S_ * DM || ws_size < WS_END) { fprintf(stderr, "kernel_launch: unexpected shapes (n_in %d, out %d, ws %zu < %zu); nothing launched\n", n_in, out_size, ws_size, (size_t)WS_END); grid = -1; return; }
        int dev = 0, cus = 0, per_cu = 0;
        if (hipGetDevice(&dev) != hipSuccess || hipDeviceGetAttribute(&cus, hipDeviceAttributeMultiprocessorCount, dev) != hipSuccess) { grid = -1; return; }
        if (hipFuncSetAttribute((const void*)fwd_kernel, hipFuncAttributeMaxDynamicSharedMemorySize, LDS_BYTES) != hipSuccess) { fprintf(stderr, "kernel_launch: hipFuncSetAttribute failed\n"); grid = -1; return; }
        if (hipOccupancyMaxActiveBlocksPerMultiprocessor(&per_cu, (const void*)fwd_kernel, NWAVES * 64, LDS_BYTES) != hipSuccess || per_cu < 1) { fprintf(stderr, "kernel_launch: occupancy query says %d blocks per CU\n", per_cu); (void)hipGetLastError(); }
        grid = cus;
    }
    if (grid < 0) return;
    (void)hipMemsetAsync((char*)d_ws + WS_CTL, 0, CTL_ZERO_BYTES, stream);
    Params p{};
    for (int i = 0; i < 26; ++i) p.in[i] = (const float*)d_in[i];
    p.out = (float*)d_out; p.ws = (unsigned char*)d_ws;
#if MK_SPLIT
#if DBG_PERTURB
    for (int rep = 0; rep < 2; ++rep) { p.pert = DBG_NOPERT ? 0 : rep;
#endif
    for (int k = 0; k < N_PHASES; ++k) { const int r = (k - 1) % PH_PER_LAYER, L = (k - 1) / PH_PER_LAYER;
        if (k > 0 && (r > 14 || (r == 4 && (L & 1)) || (r == 14 && L == DEPTH_ - 1))) continue;
        if (DBG_STOP && k >= DBG_STOP) break;
#if DBG_CHECK
        dbg_checks(k, 1, d_in, d_out, d_ws, stream);
#endif
        p.ph_lo = k; p.ph_hi = k + 1; hipLaunchKernelGGL(fwd_kernel, dim3(grid), dim3(NWAVES * 64), LDS_BYTES, stream, p);
#if DBG_CHECK
        dbg_checks(k, 0, d_in, d_out, d_ws, stream);
#endif
#if DBG_PERTURB
        { const int r_ = (k - 1) % PH_PER_LAYER, L_ = (k - 1) / PH_PER_LAYER; if (k >= 1 && ((r_ == 4 && !(L_ & 1)) || (r_ == 3 && (L_ & 1)))) { bf16* ys = (bf16*)((char*)d_ws + WS_END + 128 * MiB) + (size_t)L_ * 64 * NMIX;
            if (rep == 0) hipLaunchKernelGGL(dbg_ysave, dim3(64), dim3(256), 0, stream, (const bf16*)((char*)d_ws + WS_YMIX), ys);
            else { hipLaunchKernelGGL(dbg_ycmp, dim3(64), dim3(256), 0, stream, (const bf16*)((char*)d_ws + WS_YMIX), (const bf16*)ys, (float*)((char*)d_ws + 512 * 1024), L_); if (L_ == 0) hipLaunchKernelGGL(dbg_fetch, dim3(1), dim3(1), 0, stream, (const bf16*)((char*)d_ws + WS_YMIX), (float*)((char*)d_ws + 512 * 1024)); } } }
#endif
    }
#if DBG_PERTURB
    if (rep == 0) { (void)hipMemsetAsync((char*)d_ws + WS_CTL, 0, CTL_ZERO_BYTES, stream); hipLaunchKernelGGL(dbg_save, dim3(2048), dim3(256), 0, stream, (const float*)d_out, (bf16*)((char*)d_ws + WS_END)); }
    else { float* res = (float*)((char*)d_ws + 512 * 1024); hipLaunchKernelGGL(dbg_cmp, dim3(S_), dim3(256), 0, stream, (const float*)d_out, (const bf16*)((char*)d_ws + WS_END), res); hipLaunchKernelGGL(dbg_rep, dim3(2048), dim3(256), 0, stream, (const float*)res, (float*)d_out); }
    }
#endif
#if DBG_CHECK
    hipLaunchKernelGGL(chk_final, dim3(2048), dim3(256), 0, stream, (const float*)((char*)d_ws + 512 * 1024), (float*)d_out, DBG_TOL);
#endif
#else
    p.ph_lo = 0; p.ph_hi = N_PHASES;
    hipLaunchKernelGGL(fwd_kernel, dim3(grid), dim3(NWAVES * 64), LDS_BYTES, stream, p);
#endif
#if DBG_STOP
    hipLaunchKernelGGL(dbg_fold, dim3(2048), dim3(256), 0, stream, (const unsigned*)d_ws, (size_t)(WS_END / 4), (float*)d_out, DBG_STOP > 7 ? 1 : 0);
#endif
#if DBG_TIME
    hipLaunchKernelGGL(dbg_time_rep, dim3(2048), dim3(256), 0, stream, (const unsigned long long*)((char*)d_ws + 768 * 1024), (float*)d_out);
#endif
    const hipError_t le = hipPeekAtLastError();
    if (le != hipSuccess) fprintf(stderr, "kernel_launch: launch failed: %s\n", hipGetErrorName(le));
}
```

```cpp
#ifndef RES_LO
#define RES_LO 0
#endif
#include <hip/hip_runtime.h>
#include <cstdio>
#include <cstdint>
namespace pg8 {
#define PG8_LAS __attribute__((address_space(3)))
typedef unsigned short bf16_t;
typedef short bf16x8 __attribute__((ext_vector_type(8)));
typedef float f32x4 __attribute__((ext_vector_type(4)));
typedef unsigned u32x4 __attribute__((ext_vector_type(4)));
constexpr int BM = 256, BK = 64, HALF = 128, HTB = HALF * BK * 2  , STAGE_BYTES = 8 * HTB, NXCD = 8, WGM = 8;

__host__ __device__ __forceinline__ int lds_byte(int r, int c) { const int st = (r >> 4) * 2 + (c >> 5), rr = r & 15, cc = c & 31, ob = rr * 64 + cc * 2; return st * 1024 + (ob ^ (((ob >> 9) & 1) << 5)); }
__host__ __device__ __forceinline__ void stage_rc(int b, int& R, int& C) { const int st = b / 1024, sb = b % 1024, swz = sb ^ (((sb >> 9) & 1) << 5); R = (st >> 1) * 16 + swz / 64; C = (st & 1) * 32 + (swz % 64) / 2; }
__host__ __device__ __forceinline__ int perm32(int rho) { const int n = rho >> 4, i = rho & 15; return 8 * (i >> 2) + 4 * n + (i & 3); }

struct Unit { int pm, pn, which; };
struct Gemm { const bf16_t* A; const bf16_t* Bt; int M, N, K; long dA, dB; int ld; };

struct StaticOrder {
    int nM, nN, nwg, G, c;
    __host__ __device__ void init(int M, int N, int G_, int c_) { nM = M / BM; nN = N / BM; nwg = nM * nN; G = G_; c = c_; }
    __host__ __device__ bool next(int i, Unit& u) const {
        const long L = (long)i * G + c; if (L >= nwg) return false;
        int wgid = (int)L; { const int q = nwg / NXCD, r = nwg % NXCD, xcd = wgid % NXCD, off = wgid / NXCD; wgid = (xcd < r ? xcd * (q + 1) : r * (q + 1) + (xcd - r) * q) + off; }
        const int nig = WGM * nN, gid = wgid / nig, fm = gid * WGM, gsz = (nM - fm) < WGM ? (nM - fm) : WGM;
        u.pm = fm + ((wgid % nig) % gsz); u.pn = (wgid % nig) / gsz; u.which = 0; return true;
    }
    __device__ __forceinline__ void a_ready(const Unit&) const {}
    __device__ __forceinline__ void done(const Unit&) const {}
};

__device__ __forceinline__ float fq_sum(float v) {
    auto a = __builtin_amdgcn_permlane16_swap(__float_as_uint(v), __float_as_uint(v), false, false); v = __uint_as_float(a[0]) + __uint_as_float(a[1]);
    auto b = __builtin_amdgcn_permlane32_swap(__float_as_uint(v), __float_as_uint(v), false, false); return __uint_as_float(b[0]) + __uint_as_float(b[1]); }
#ifndef USE_F16
#define USE_F16 1
#endif
typedef float f32x2_t __attribute__((ext_vector_type(2))); typedef __bf16 bf16x2_t __attribute__((ext_vector_type(2)));
typedef _Float16 h16x2_t __attribute__((ext_vector_type(2))); typedef _Float16 h16x8_t __attribute__((ext_vector_type(8)));
#if USE_F16
__device__ __forceinline__ unsigned cvt_pk_bf16(float lo, float hi) { f32x2_t v = {lo, hi}; h16x2_t b = __builtin_convertvector(v, h16x2_t); return __builtin_bit_cast(unsigned, b); }
__device__ __forceinline__ float unpk_lo(unsigned w) { return (float)__builtin_bit_cast(h16x2_t, w)[0]; }
__device__ __forceinline__ float unpk_hi(unsigned w) { return (float)__builtin_bit_cast(h16x2_t, w)[1]; }
#define MFMA16(a, b, c) __builtin_amdgcn_mfma_f32_16x16x32_f16(__builtin_bit_cast(pg8::h16x8_t, (a)), __builtin_bit_cast(pg8::h16x8_t, (b)), (c), 0, 0, 0)
#define MFMA32(a, b, c) __builtin_amdgcn_mfma_f32_32x32x16_f16(__builtin_bit_cast(pg8::h16x8_t, (a)), __builtin_bit_cast(pg8::h16x8_t, (b)), (c), 0, 0, 0)
#else
__device__ __forceinline__ unsigned cvt_pk_bf16(float lo, float hi) { f32x2_t v = {lo, hi}; bf16x2_t b = __builtin_convertvector(v, bf16x2_t); return __builtin_bit_cast(unsigned, b); }
__device__ __forceinline__ float unpk_lo(unsigned w) { return __uint_as_float(w << 16); }
__device__ __forceinline__ float unpk_hi(unsigned w) { return __uint_as_float(w & 0xffff0000u); }
#define MFMA16(a, b, c) __builtin_amdgcn_mfma_f32_16x16x32_bf16((a), (b), (c), 0, 0, 0)
#define MFMA32(a, b, c) __builtin_amdgcn_mfma_f32_32x32x16_bf16((a), (b), (c), 0, 0, 0)
#endif

struct EpiProj {
    static constexpr bool PERM = true, AFTER_DRAIN = false;
    bf16_t* O; int ldc; const float* rs; const float* cs; const float* sn; int rope_tiles;
    __device__ __forceinline__ void operator()(const f32x4 (&acc)[2][2][4][2], const Unit& u, int wr, int wc, int fr_in, int fq_in) const {
        int fr = fr_in, fq = fq_in; asm volatile("; EPI_ENTRY" : "+v"(fr), "+v"(fq));
        const int row0 = u.pm * BM + wr * 64 + fr, col0 = u.pn * BM + wc * 32 + 8 * fq;
        const bool rope = u.pn < rope_tiles; const int i0 = (wc * 32 + 8 * fq) >> 1;
#pragma unroll
        for (int ai = 0; ai < 2; ++ai)
#pragma unroll
            for (int m = 0; m < 4; ++m) { const int row = row0 + ai * HALF + m * 16; const float r = rs[row];
                f32x4 c4 = (f32x4){1.f, 1.f, 1.f, 1.f}, s4 = (f32x4){0.f, 0.f, 0.f, 0.f};
                if (rope) { c4 = *(const f32x4*)(cs + (size_t)row * 64 + i0); s4 = *(const f32x4*)(sn + (size_t)row * 64 + i0); }
                bf16_t* rowp = O + (size_t)row * ldc + col0;
#pragma unroll
                for (int bj = 0; bj < 2; ++bj) { const f32x4 v0 = acc[ai][bj][m][0] * r, v1 = acc[ai][bj][m][1] * r;
                    f32x4 o0, o1;
                    o0[0] = v0[0] * c4[0] - v0[1] * s4[0]; o0[1] = v0[1] * c4[0] + v0[0] * s4[0];
                    o0[2] = v0[2] * c4[1] - v0[3] * s4[1]; o0[3] = v0[3] * c4[1] + v0[2] * s4[1];
                    o1[0] = v1[0] * c4[2] - v1[1] * s4[2]; o1[1] = v1[1] * c4[2] + v1[0] * s4[2];
                    o1[2] = v1[2] * c4[3] - v1[3] * s4[3]; o1[3] = v1[3] * c4[3] + v1[2] * s4[3];
                    u32x4 w; w.x = cvt_pk_bf16(o0[0], o0[1]); w.y = cvt_pk_bf16(o0[2], o0[3]); w.z = cvt_pk_bf16(o1[0], o1[1]); w.w = cvt_pk_bf16(o1[2], o1[3]);
                    *(u32x4*)(rowp + bj * HALF) = w; } }
    }
};
struct EpiY {
    static constexpr bool PERM = true, AFTER_DRAIN = false;
    bf16_t* O; int ldc; float* ssp;
    __device__ __forceinline__ void operator()(const f32x4 (&acc)[2][2][4][2], const Unit& u, int wr, int wc, int fr_in, int fq_in) const {
        int fr = fr_in, fq = fq_in; asm volatile("; EPI_ENTRY" : "+v"(fr), "+v"(fq));
        const int row0 = u.pm * BM + wr * 64 + fr, col0 = u.pn * BM + wc * 32 + 8 * fq;
#pragma unroll
        for (int ai = 0; ai < 2; ++ai)
#pragma unroll
            for (int m = 0; m < 4; ++m) { const int row = row0 + ai * HALF + m * 16; bf16_t* rowp = O + (size_t)row * ldc + col0; float s = 0.f;
#pragma unroll
                for (int bj = 0; bj < 2; ++bj) { const f32x4 v0 = acc[ai][bj][m][0], v1 = acc[ai][bj][m][1];
                    s += (v0[0] * v0[0] + v0[1] * v0[1]) + (v0[2] * v0[2] + v0[3] * v0[3]) + (v1[0] * v1[0] + v1[1] * v1[1]) + (v1[2] * v1[2] + v1[3] * v1[3]);
                    u32x4 w; w.x = cvt_pk_bf16(v0[0], v0[1]); w.y = cvt_pk_bf16(v0[2], v0[3]); w.z = cvt_pk_bf16(v1[0], v1[1]); w.w = cvt_pk_bf16(v1[2], v1[3]);
                    *(u32x4*)(rowp + bj * HALF) = w; }
                s = fq_sum(s);
                if (fq == 0) ssp[(size_t)row * 64 + u.pn * 4 + wc] = s; }
    }
};
struct EpiPle {
    static constexpr bool PERM = true, AFTER_DRAIN = false;
    bf16_t* G; bf16_t* HI; bf16_t* LO; float* OUT32; float* ssp;
    __device__ __forceinline__ void operator()(const f32x4 (&acc)[2][2][4][2], const Unit& u, int wr, int wc, int fr_in, int fq_in) const {
        int fr = fr_in, fq = fq_in; asm volatile("; EPI_ENTRY" : "+v"(fr), "+v"(fq));
        const unsigned row0 = (unsigned)(u.pm * BM + wr * 64 + fr), col0 = (unsigned)(u.pn * BM + wc * 32 + 8 * fq);
        char* Gc = (char*)G + (size_t)(u.pm * 16 + u.pn) * 131072u + (unsigned)(wr * 4 + wc) * 16384u; char* HIc = (char*)HI; char* LOc = (char*)LO; char* Oc = (char*)OUT32;
        const unsigned goff = (unsigned)(fq * 16 + fr) * 16u;
        if (u.which == 0) {
#pragma unroll
            for (int ai = 0; ai < 2; ++ai)
#pragma unroll
                for (int m = 0; m < 4; ++m) {
                    u32x4 w;
#pragma unroll
                    for (int bj = 0; bj < 2; ++bj) { f32x4 v0 = acc[ai][bj][m][0], v1 = acc[ai][bj][m][1]; unsigned q0 = 0u, q1 = 0u;
#pragma unroll
                        for (int e = 0; e < 4; ++e) { q0 |= (unsigned)(__builtin_amdgcn_rcpf(1.f + __expf(-v0[e])) * 255.f + 0.5f) << (8 * e); q1 |= (unsigned)(__builtin_amdgcn_rcpf(1.f + __expf(-v1[e])) * 255.f + 0.5f) << (8 * e); }
                        if (bj == 0) { w.x = q0; w.y = q1; } else { w.z = q0; w.w = q1; } }
                    *(u32x4*)(Gc + (unsigned)((ai * 4 + m) * 1024) + goff) = w; }
        } else {
            asm volatile("s_waitcnt vmcnt(0)" ::: "memory");
#pragma unroll
            for (int ai = 0; ai < 2; ++ai)
#pragma unroll
                for (int m = 0; m < 4; ++m) { const unsigned row = row0 + ai * HALF + m * 16, off = row * 4096u + col0; float s = 0.f; const u32x4 gq = *(const u32x4*)(Gc + (unsigned)((ai * 4 + m) * 1024) + goff);
#pragma unroll
                    for (int bj = 0; bj < 2; ++bj) { const unsigned ob = off + bj * HALF; const unsigned qa = bj ? gq.z : gq.x, qb = bj ? gq.w : gq.y;
                        const u32x4 hw = *(const u32x4*)(HIc + (unsigned)(ob * 2u)); u32x4 lw = {0u, 0u, 0u, 0u}; if (RES_LO) lw = *(const u32x4*)(LOc + (unsigned)(ob * 2u));
                        f32x4 g0, g1, h0, h1; g0[0] = (float)(qa & 255u) * (1.f / 255.f); g0[1] = (float)((qa >> 8) & 255u) * (1.f / 255.f); g0[2] = (float)((qa >> 16) & 255u) * (1.f / 255.f); g0[3] = (float)(qa >> 24) * (1.f / 255.f);
                        g1[0] = (float)(qb & 255u) * (1.f / 255.f); g1[1] = (float)((qb >> 8) & 255u) * (1.f / 255.f); g1[2] = (float)((qb >> 16) & 255u) * (1.f / 255.f); g1[3] = (float)(qb >> 24) * (1.f / 255.f);
                        h0[0] = unpk_lo(hw.x) + unpk_lo(lw.x); h0[1] = unpk_hi(hw.x) + unpk_hi(lw.x); h0[2] = unpk_lo(hw.y) + unpk_lo(lw.y); h0[3] = unpk_hi(hw.y) + unpk_hi(lw.y);
                        h1[0] = unpk_lo(hw.z) + unpk_lo(lw.z); h1[1] = unpk_hi(hw.z) + unpk_hi(lw.z); h1[2] = unpk_lo(hw.w) + unpk_lo(lw.w); h1[3] = unpk_hi(hw.w) + unpk_hi(lw.w);
                        const f32x4 v0 = h0 + g0 * acc[ai][bj][m][0], v1 = h1 + g1 * acc[ai][bj][m][1];
                        s += (v0[0] * v0[0] + v0[1] * v0[1]) + (v0[2] * v0[2] + v0[3] * v0[3]) + (v1[0] * v1[0] + v1[1] * v1[1]) + (v1[2] * v1[2] + v1[3] * v1[3]);
                        u32x4 w; w.x = cvt_pk_bf16(v0[0], v0[1]); w.y = cvt_pk_bf16(v0[2], v0[3]); w.z = cvt_pk_bf16(v1[0], v1[1]); w.w = cvt_pk_bf16(v1[2], v1[3]);
                        if (OUT32) { *(f32x4*)(Oc + (unsigned)(ob * 4u)) = v0; *(f32x4*)(Oc + (unsigned)(ob * 4u + 16u)) = v1; }
                        else { u32x4 wl; wl.x = cvt_pk_bf16(v0[0] - unpk_lo(w.x), v0[1] - unpk_hi(w.x)); wl.y = cvt_pk_bf16(v0[2] - unpk_lo(w.y), v0[3] - unpk_hi(w.y));
                            wl.z = cvt_pk_bf16(v1[0] - unpk_lo(w.z), v1[1] - unpk_hi(w.z)); wl.w = cvt_pk_bf16(v1[2] - unpk_lo(w.w), v1[3] - unpk_hi(w.w));
                            *(u32x4*)(HIc + (unsigned)(ob * 2u)) = w; if (RES_LO) *(u32x4*)(LOc + (unsigned)(ob * 2u)) = wl; }
                        asm volatile("" ::: "memory"); }
                    s = fq_sum(s);
                    if (fq == 0) ssp[(size_t)row * 64 + u.pn * 4 + wc] = s;
                    asm volatile("" ::: "memory"); }
        }
    }
};
struct EpiPart {
    static constexpr bool PERM = true, AFTER_DRAIN = false;
    bf16_t* part;
    __device__ __forceinline__ void operator()(const f32x4 (&acc)[2][2][4][2], const Unit& u, int wr, int wc, int fr, int fq) const {
        const int row0 = u.pm * BM + wr * 64 + fr, col0 = wc * 32 + 8 * fq; bf16_t* base = part + (size_t)u.which * 16384 * 256;
#pragma unroll
        for (int ai = 0; ai < 2; ++ai)
#pragma unroll
            for (int m = 0; m < 4; ++m) { bf16_t* rowp = base + (size_t)(row0 + ai * HALF + m * 16) * 256 + col0;
#pragma unroll
                for (int bj = 0; bj < 2; ++bj) { const f32x4 v0 = acc[ai][bj][m][0], v1 = acc[ai][bj][m][1];
                    u32x4 w; w.x = cvt_pk_bf16(v0[0], v0[1]); w.y = cvt_pk_bf16(v0[2], v0[3]); w.z = cvt_pk_bf16(v1[0], v1[1]); w.w = cvt_pk_bf16(v1[2], v1[3]); *(u32x4*)(rowp + bj * HALF) = w; } }
    }
};
struct SplitKOrder {
    int G, c, nunit;
    __device__ __forceinline__ bool next(int i, Unit& u) const { const int L = i * G + c; if (L >= nunit) return false; u.pm = L >> 2; u.pn = 0; u.which = L & 3; return true; }
    __device__ __forceinline__ void a_ready(const Unit&) const {}
    __device__ __forceinline__ void done(const Unit&) const {}
};
struct EpiPleDbg {
    static constexpr bool PERM = true, AFTER_DRAIN = false;
    bf16_t* G; bf16_t* G2;
    __device__ __forceinline__ void operator()(const f32x4 (&acc)[2][2][4][2], const Unit& u, int wr, int wc, int fr, int fq) const {
        const int row0 = u.pm * BM + wr * 64 + fr, col0 = u.pn * BM + wc * 32 + 8 * fq; bf16_t* O = u.which ? G2 : G;
#pragma unroll
        for (int ai = 0; ai < 2; ++ai)
#pragma unroll
            for (int m = 0; m < 4; ++m) { const int row = row0 + ai * HALF + m * 16; bf16_t* rowp = O + (size_t)row * 4096 + col0;
#pragma unroll
                for (int bj = 0; bj < 2; ++bj) { const f32x4 v0 = acc[ai][bj][m][0], v1 = acc[ai][bj][m][1];
                    u32x4 w; w.x = cvt_pk_bf16(v0[0], v0[1]); w.y = cvt_pk_bf16(v0[2], v0[3]); w.z = cvt_pk_bf16(v1[0], v1[1]); w.w = cvt_pk_bf16(v1[2], v1[3]);
                    *(u32x4*)(rowp + bj * HALF) = w; } }
    }
};
struct PleOrder {
    int G, c, ntile;
    __device__ __forceinline__ bool next(int i, Unit& u) const { const int tl = (i >> 1) * G + c; if (tl >= ntile) return false; u.pm = tl >> 4; u.pn = tl & 15; u.which = i & 1; return true; }
    __device__ __forceinline__ void a_ready(const Unit&) const {}
    __device__ __forceinline__ void done(const Unit&) const {}
};
template <class Epi, class Sched, bool ALIGN_EPI = false, bool SP2 = false>
__device__ __forceinline__ void gemm_phase(PG8_LAS unsigned char* lds, const Gemm g, const Sched& S, const Epi& E, int wave_in) {
    int lane_o; asm volatile("v_mbcnt_lo_u32_b32 %0, -1, 0\n\tv_mbcnt_hi_u32_b32 %0, -1, %0 ; LANE_ID" : "=v"(lane_o)); const int wid = wave_in, lane = lane_o, tid = wid * 64 + lane, wr = wid >> 2, wc = wid & 3, fr = lane & 15, fq = lane >> 4;
    const int K = g.ld ? g.ld : g.K, nt = g.K / BK;
    unsigned voffA[2], voffB[2];
#pragma unroll
    for (int i = 0; i < 2; ++i) { int R, C; stage_rc(tid * 16 + i * 8192, R, C); const int Rb = Epi::PERM ? ((R & ~31) + perm32(R & 31)) : R;
        voffA[i] = (unsigned)(R * K + C) * 2u; voffB[i] = (unsigned)(Rb * K + C) * 2u; }
    const size_t kstep = (size_t)(BK * 2);
    const size_t hstep = (size_t)HALF * K * 2;
    const size_t tstep = 2 * hstep;
    const unsigned ldsw = (unsigned)wid * 1024u;
    const int aoff = lds_byte(wr * 64 + fr, fq * 8), boff = lds_byte(wc * 32 + fr, fq * 8);
#define PG8_SA(b, h) (((b) * 2 + (h)) * HTB)
#define PG8_SB(b, h) ((4 + (b) * 2 + (h)) * HTB)
#define PG8_STAGE(bufoff, gbase, voff) do { _Pragma("unroll") for (int _i = 0; _i < 2; ++_i) \
        __builtin_amdgcn_global_load_lds((const unsigned*)((const char*)(gbase) + (voff)[_i]), (PG8_LAS unsigned*)(lds + (bufoff) + ldsw + _i * 8192), 16, 0, 0); } while (0)
#define PG8_LDA(dst, b, h) do { _Pragma("unroll") for (int m = 0; m < 4; ++m) _Pragma("unroll") for (int k = 0; k < 2; ++k) dst[m][k] = *(const PG8_LAS bf16x8*)(lds + PG8_SA(b, h) + aoff + m * 2048 + k * 1024); } while (0)
#define PG8_LDB(dst, b, h) do { _Pragma("unroll") for (int n = 0; n < 2; ++n) _Pragma("unroll") for (int k = 0; k < 2; ++k) dst[n][k] = *(const PG8_LAS bf16x8*)(lds + PG8_SB(b, h) + boff + n * 2048 + k * 1024); } while (0)
#define PG8_MMA(ai, bj, At, Bt) do { __builtin_amdgcn_s_setprio(1); _Pragma("unroll") for (int m = 0; m < 4; ++m) _Pragma("unroll") for (int n = 0; n < 2; ++n) _Pragma("unroll") for (int k = 0; k < 2; ++k) \
        acc[ai][bj][m][n] = MFMA16(Bt[n][k], At[m][k], acc[ai][bj][m][n]); __builtin_amdgcn_s_setprio(0); } while (0)
#define PG8_WAIT_V(n) asm volatile("s_waitcnt vmcnt(" #n ")" ::: "memory")
#define PG8_WAIT_L(n) asm volatile("s_waitcnt lgkmcnt(" #n ")" ::: "memory")
#define PG8_BAR __builtin_amdgcn_s_barrier()
#define PG8_SCHED __builtin_amdgcn_sched_barrier(0)
    Unit cur, nxt; int ui = 0;
    if (!S.next(0, cur)) return;
    f32x4 acc[2][2][4][2];
#pragma unroll
    for (int a = 0; a < 2; ++a)
#pragma unroll
        for (int b = 0; b < 2; ++b)
#pragma unroll
            for (int m = 0; m < 4; ++m)
#pragma unroll
                for (int n = 0; n < 2; ++n) acc[a][b][m][n] = (f32x4){0.f, 0.f, 0.f, 0.f};
    bf16x8 At[4][2], B0[2][2], B1[2][2];
    const char* cA = (const char*)g.A + (size_t)cur.pm * tstep + (size_t)cur.which * (size_t)g.dA; const char* cB = (const char*)g.Bt + (size_t)cur.pn * tstep + (size_t)cur.which * (size_t)g.dB;
    S.a_ready(cur);
    if constexpr (SP2) {
        PG8_STAGE(PG8_SB(0, 0), cB, voffB); PG8_STAGE(PG8_SB(0, 1), cB + hstep, voffB); PG8_STAGE(PG8_SA(0, 0), cA, voffA); PG8_STAGE(PG8_SA(0, 1), cA + hstep, voffA);
        if (wr == 1) PG8_BAR;
        PG8_WAIT_V(2); PG8_BAR;
        PG8_STAGE(PG8_SB(1, 0), cB + kstep, voffB); PG8_STAGE(PG8_SA(1, 0), cA + kstep, voffA); PG8_STAGE(PG8_SB(1, 1), cB + hstep + kstep, voffB);
        PG8_WAIT_V(6); PG8_BAR;
    } else {
        PG8_STAGE(PG8_SB(0, 0), cB, voffB); PG8_STAGE(PG8_SA(0, 0), cA, voffA); PG8_STAGE(PG8_SB(0, 1), cB + hstep, voffB); PG8_STAGE(PG8_SA(0, 1), cA + hstep, voffA);
        if (wr == 1) PG8_BAR;
        PG8_WAIT_V(4); PG8_BAR;
        PG8_STAGE(PG8_SB(1, 0), cB + kstep, voffB); PG8_STAGE(PG8_SA(1, 0), cA + kstep, voffA); PG8_STAGE(PG8_SB(1, 1), cB + hstep + kstep, voffB);
        PG8_WAIT_V(6); PG8_BAR;
    }
    for (;;) {
        const bool has_next = S.next(ui + 1, nxt);
        const char* nA = has_next ? (const char*)g.A + (size_t)nxt.pm * tstep + (size_t)nxt.which * (size_t)g.dA : cA; const char* nB = has_next ? (const char*)g.Bt + (size_t)nxt.pn * tstep + (size_t)nxt.which * (size_t)g.dB : cB;
        for (int t = 0; t < nt; t += 2) {
            const bool last = (t == nt - 2);
            const char* a1 = cA + (size_t)(t + 1) * kstep;
            const char* a2 = last ? nA : cA + (size_t)(t + 2) * kstep; const char* b2 = last ? nB : cB + (size_t)(t + 2) * kstep;
            const char* a3 = a2 + kstep; const char* b3 = b2 + kstep;
            if (last && has_next) S.a_ready(nxt);
            if constexpr (SP2) {
            PG8_LDB(B0, 0, 0); PG8_LDB(B1, 0, 1); PG8_SCHED; PG8_LDA(At, 0, 0); PG8_STAGE(PG8_SA(1, 1), a1 + hstep, voffA);
            PG8_WAIT_V(8); PG8_WAIT_L(0); PG8_BAR; PG8_MMA(0, 0, At, B0); PG8_MMA(0, 1, At, B1); PG8_BAR; PG8_SCHED;
            PG8_LDA(At, 0, 1); PG8_STAGE(PG8_SB(0, 0), b2, voffB); PG8_STAGE(PG8_SB(0, 1), b2 + hstep, voffB); PG8_STAGE(PG8_SA(0, 0), a2, voffA);
            PG8_WAIT_V(8); PG8_WAIT_L(0); PG8_BAR; PG8_MMA(1, 0, At, B0); PG8_MMA(1, 1, At, B1); PG8_BAR; PG8_SCHED;
            PG8_LDB(B0, 1, 0); PG8_LDB(B1, 1, 1); PG8_SCHED; PG8_LDA(At, 1, 0); PG8_STAGE(PG8_SA(0, 1), a2 + hstep, voffA);
            PG8_WAIT_V(8); PG8_WAIT_L(0); PG8_BAR; PG8_MMA(0, 0, At, B0); PG8_MMA(0, 1, At, B1); PG8_BAR; PG8_SCHED;
            PG8_LDA(At, 1, 1); PG8_STAGE(PG8_SB(1, 0), b3, voffB); PG8_STAGE(PG8_SB(1, 1), b3 + hstep, voffB); PG8_STAGE(PG8_SA(1, 0), a3, voffA);
            PG8_WAIT_V(8); PG8_WAIT_L(0); PG8_BAR; PG8_MMA(1, 0, At, B0); PG8_MMA(1, 1, At, B1); PG8_BAR; PG8_SCHED;
            } else {
            PG8_LDB(B0, 0, 0); PG8_SCHED; PG8_LDA(At, 0, 0); PG8_STAGE(PG8_SA(1, 1), a1 + hstep, voffA);
            PG8_WAIT_L(8); PG8_BAR; PG8_WAIT_L(0); PG8_MMA(0, 0, At, B0); PG8_BAR; PG8_SCHED;
            PG8_LDB(B1, 0, 1); PG8_STAGE(PG8_SB(0, 0), b2, voffB);
            PG8_BAR; PG8_WAIT_L(0); PG8_MMA(0, 1, At, B1); PG8_BAR;
            PG8_LDA(At, 0, 1); PG8_STAGE(PG8_SA(0, 0), a2, voffA);
            PG8_BAR; PG8_WAIT_L(0); PG8_MMA(1, 0, At, B0); PG8_BAR; PG8_SCHED;
            PG8_STAGE(PG8_SB(0, 1), b2 + hstep, voffB);
            PG8_WAIT_V(6); PG8_BAR; PG8_MMA(1, 1, At, B1); PG8_BAR;
            PG8_LDB(B0, 1, 0); PG8_SCHED; PG8_LDA(At, 1, 0); PG8_STAGE(PG8_SA(0, 1), a2 + hstep, voffA);
            PG8_WAIT_L(8); PG8_BAR; PG8_WAIT_L(0); PG8_MMA(0, 0, At, B0); PG8_BAR; PG8_SCHED;
            PG8_LDB(B1, 1, 1); PG8_STAGE(PG8_SB(1, 0), b3, voffB);
            PG8_BAR; PG8_WAIT_L(0); PG8_MMA(0, 1, At, B1); PG8_BAR;
            PG8_LDA(At, 1, 1); PG8_STAGE(PG8_SA(1, 0), a3, voffA);
            PG8_BAR; PG8_WAIT_L(0); PG8_MMA(1, 0, At, B0); PG8_BAR; PG8_SCHED;
            PG8_STAGE(PG8_SB(1, 1), b3 + hstep, voffB);
            PG8_WAIT_V(6); PG8_BAR; PG8_MMA(1, 1, At, B1); PG8_BAR;
            }
        }
        if constexpr (ALIGN_EPI) { if (wr == 0) PG8_BAR; }
        if constexpr (!Epi::AFTER_DRAIN) { E(acc, cur, wr, wc, fr, fq); S.done(cur); }
        if (!has_next) break;
#pragma unroll
        for (int a = 0; a < 2; ++a)
#pragma unroll
            for (int b = 0; b < 2; ++b)
#pragma unroll
                for (int m = 0; m < 4; ++m)
#pragma unroll
                    for (int n = 0; n < 2; ++n) acc[a][b][m][n] = (f32x4){0.f, 0.f, 0.f, 0.f};
        cur = nxt; cA = nA; cB = nB; ++ui;
        if constexpr (ALIGN_EPI) { if (wr == 1) PG8_BAR; }
    }
    PG8_WAIT_V(0);
    if constexpr (!ALIGN_EPI) { if (wr == 0) PG8_BAR; }
    PG8_BAR;
    if constexpr (Epi::AFTER_DRAIN) { E.fused(acc, cur, wr, wc, fr, fq, lds, wid, lane); S.done(cur); }
#undef PG8_SA
#undef PG8_SB
#undef PG8_STAGE
#undef PG8_LDA
#undef PG8_LDB
#undef PG8_MMA
#undef PG8_WAIT_V
#undef PG8_WAIT_L
#undef PG8_BAR
#undef PG8_SCHED
}
}

constexpr int S_ = 16384, DM = 4096, NUP = 8192, NIN = 6144, NMIX = 2048, PLED = 256, DEPTH_ = 4, NCH = S_ / 64;
constexpr float EPS_ = 1e-6f;
constexpr int NWAVES = 8;
constexpr size_t MiB = 1u << 20;
constexpr size_t WS_CTL = 0, CTL_ZERO_BYTES = 1 * MiB;
constexpr size_t WS_RIN = 1 * MiB;
constexpr size_t WS_LAM = 1 * MiB + 65536;
constexpr size_t WS_CHS = 1 * MiB + 131072;
constexpr size_t WS_GPRE = 2 * MiB;
constexpr size_t WS_DN = 3 * MiB;
constexpr size_t WS_NH = 3 * MiB + 524288;
constexpr size_t WS_SSP = 4 * MiB;
constexpr size_t WS_COS = 8 * MiB, WS_SIN = 12 * MiB;
constexpr size_t WS_G1 = 16 * MiB;
constexpr size_t WS_PB = 24 * MiB;
constexpr size_t WS_QKC = 56 * MiB;
constexpr size_t WS_HB = 88 * MiB;
constexpr size_t WS_PROJ = 216 * MiB;
constexpr size_t WS_YMIX = 408 * MiB;
constexpr size_t WS_MIXO = 472 * MiB;
constexpr size_t WS_UP = 600 * MiB;
constexpr size_t WS_ACT = 856 * MiB;
constexpr size_t WS_OD = 984 * MiB;
constexpr size_t WS_DC = 1048 * MiB;
constexpr size_t WS_CH = 1176 * MiB;
constexpr size_t WS_WIN = 1240 * MiB;
constexpr size_t WS_WOUT = 1432 * MiB;
constexpr size_t WS_WUP = 1496 * MiB;
constexpr size_t WS_WDN = 1752 * MiB;
constexpr size_t WS_WPD = 1880 * MiB;
constexpr size_t WS_WPU = 1888 * MiB;
constexpr size_t WS_WPP = 1896 * MiB;
constexpr size_t WS_WG = 1904 * MiB;
constexpr size_t WS_LO = 1905 * MiB;
constexpr size_t WS_END = 2033 * MiB;
constexpr int CW_BAR = 4096;
constexpr int CW_Q = 16384;
constexpr int RING_BYTES = 131072;
constexpr int LDSCTL_OFF = RING_BYTES, MISC_OFF = LDSCTL_OFF + 320;
constexpr int LDS_BYTES = 151552;

#define GAS __attribute__((address_space(1)))
#define LAS __attribute__((address_space(3)))
typedef unsigned short bf16;
typedef unsigned v4u __attribute__((ext_vector_type(4)));
typedef unsigned v2u __attribute__((ext_vector_type(2)));
typedef float f32x4 __attribute__((ext_vector_type(4)));
typedef float f32x16 __attribute__((ext_vector_type(16)));
typedef short bf16x8 __attribute__((ext_vector_type(8)));
typedef short s16x4 __attribute__((ext_vector_type(4)));
typedef GAS unsigned gu32;
#define RLX_AGENT __ATOMIC_RELAXED, __HIP_MEMORY_SCOPE_AGENT
#define LDS_WAIT() asm volatile("s_waitcnt lgkmcnt(0)" ::: "memory")
#define VM_WAIT() asm volatile("s_waitcnt vmcnt(0)" ::: "memory")
__device__ __forceinline__ unsigned pk2(float lo, float hi) { return pg8::cvt_pk_bf16(lo, hi); }
__device__ __forceinline__ unsigned f2bf(float f) { return pg8::cvt_pk_bf16(f, 0.f) & 0xffffu; }
__device__ __forceinline__ float bflo(unsigned w) { return pg8::unpk_lo(w); }
__device__ __forceinline__ float bfhi(unsigned w) { return pg8::unpk_hi(w); }
__device__ __forceinline__ float h2f(unsigned short b) { return pg8::unpk_lo((unsigned)b); }
#define dppf(v, ctrl) __builtin_bit_cast(float, __builtin_amdgcn_update_dpp(0, __builtin_bit_cast(int, (float)(v)), (ctrl), 0xf, 0xf, true))
#define DPP_X1 0xB1
#define DPP_X2 0x4E
#define DPP_HM 0x141
#define DPP_RM 0x140
__device__ __forceinline__ float x16_sum(float v) { auto rr = __builtin_amdgcn_permlane16_swap(__float_as_uint(v), __float_as_uint(v), false, false); return __uint_as_float(rr[0]) + __uint_as_float(rr[1]); }
__device__ __forceinline__ float x16_max(float v) { auto rr = __builtin_amdgcn_permlane16_swap(__float_as_uint(v), __float_as_uint(v), false, false); return fmaxf(__uint_as_float(rr[0]), __uint_as_float(rr[1])); }
__device__ __forceinline__ float swap_sum(float v) { auto rr = __builtin_amdgcn_permlane32_swap(__float_as_uint(v), __float_as_uint(v), false, false); return __uint_as_float(rr[0]) + __uint_as_float(rr[1]); }
__device__ __forceinline__ float swap_max(float v) { auto rr = __builtin_amdgcn_permlane32_swap(__float_as_uint(v), __float_as_uint(v), false, false); return fmaxf(__uint_as_float(rr[0]), __uint_as_float(rr[1])); }
__device__ __forceinline__ float wave_sum(float v) { v += dppf(v, DPP_X1); v += dppf(v, DPP_X2); v += dppf(v, DPP_HM); v += dppf(v, DPP_RM); v = x16_sum(v); return swap_sum(v); }
__device__ __forceinline__ float wave_max(float v) { v = fmaxf(v, dppf(v, DPP_X1)); v = fmaxf(v, dppf(v, DPP_X2)); v = fmaxf(v, dppf(v, DPP_HM)); v = fmaxf(v, dppf(v, DPP_RM)); v = x16_max(v); return swap_max(v); }
__device__ __forceinline__ int crow(int r, int hi) { return (r & 3) + 8 * (r >> 2) + 4 * hi; }
#define KSWZ(row, colB) ((row) * 256 + ((colB) ^ (((row) & 15) << 4)))
#define TRRD(dst, base, off) asm volatile("ds_read_b64_tr_b16 %0, %1 offset:%2" : "=&v"(dst) : "v"(base), "i"(off) : "memory")
__device__ __forceinline__ bf16x8 mk8(s16x4 l, s16x4 h) { return (bf16x8){l[0], l[1], l[2], l[3], h[0], h[1], h[2], h[3]}; }
__device__ __forceinline__ bf16x8 pack8f(const float* p) { v4u w; w.x = pk2(p[0], p[1]); w.y = pk2(p[2], p[3]); w.z = pk2(p[4], p[5]); w.w = pk2(p[6], p[7]); return __builtin_bit_cast(bf16x8, w); }

#define XB_TMO      128
#define XB_XCNT(j)  (256  + 64 * (j))
#define XB_XSUB(j)  (1280 + 64 * (j))
#define XB_XGEN(j)  (2304 + 64 * (j))
#define XB_TOP      3328
#define XB_TOPGEN   3392
#define XCD_BAR_WORDS 3456
#define XB_SPIN_CAP (1u << 18)

__device__ __forceinline__ unsigned xb_ld(unsigned* p)              { return __hip_atomic_load(p, __ATOMIC_RELAXED, __HIP_MEMORY_SCOPE_AGENT); }
__device__ __forceinline__ unsigned xb_add(unsigned* p, unsigned v) { return __hip_atomic_fetch_add(p, v, __ATOMIC_RELAXED, __HIP_MEMORY_SCOPE_AGENT); }
__device__ __forceinline__ unsigned xb_xcc_id() { return (unsigned)__builtin_amdgcn_s_getreg((3 << 11) | 20) & 0xFu; }
#define XB_SPIN(cond, bar) do { unsigned _sp = 0; while (cond) { __builtin_amdgcn_s_sleep(1); \
    if ((++_sp & 255u) == 0u) { if (xb_ld(&(bar)[XB_TMO])) break; if (_sp > XB_SPIN_CAP) { atomicAdd(&(bar)[XB_TMO], 1u); break; } } } } while (0)

struct XcdBarrier {
    unsigned* bar; unsigned x;
    volatile LAS unsigned* st;
};

__device__ __forceinline__ XcdBarrier xcd_barrier_post(unsigned* bar, volatile LAS unsigned* st) {
    XcdBarrier b; b.bar = bar; b.x = xb_xcc_id(); b.st = st;
    if (threadIdx.x == 0) (void)xb_add(&bar[XB_XCNT(b.x)], 1u);
    return b;
}
__device__ __forceinline__ void xcd_barrier_complete(unsigned* bar, unsigned x, unsigned& nloc, unsigned& nx) {
    const unsigned G = gridDim.x * gridDim.y * gridDim.z;
    unsigned sum, cnt, mine, sp = 0u;
    for (;;) {
        sum = 0u; cnt = 0u; mine = 0u;
#pragma unroll
        for (unsigned j = 0; j < 16; ++j) { const unsigned c = xb_ld(&bar[XB_XCNT(j)]); sum += c; cnt += (c > 0u) ? 1u : 0u; mine = (j == x) ? c : mine; }
        if (sum == G) break;
        __builtin_amdgcn_s_sleep(1);
        if ((++sp & 255u) == 0u) { if (xb_ld(&bar[XB_TMO])) break; if (sp > XB_SPIN_CAP) { atomicAdd(&bar[XB_TMO], 1u); break; } }
    }
    nloc = mine > 0u ? mine : 1u; nx = cnt > 0u ? cnt : 1u;
}

__device__ __forceinline__ void xcd_barrier(const XcdBarrier& b) {
    asm volatile("s_waitcnt vmcnt(0)" ::: "memory");
    __syncthreads();
    if (threadIdx.x == 0) {
        unsigned* bar = b.bar;
        __builtin_amdgcn_s_waitcnt(0);
        unsigned nloc = b.st[0], nx = b.st[1];
        if (nloc == 0u) { xcd_barrier_complete(bar, b.x, nloc, nx); b.st[0] = nloc; b.st[1] = nx; }
        const unsigned old = xb_add(&bar[XB_XSUB(b.x)], 1u);
        const unsigned gen = old / nloc;
        if (old + 1u == (gen + 1u) * nloc) {
            __builtin_amdgcn_fence(__ATOMIC_RELEASE, "agent");
            asm volatile("s_waitcnt vmcnt(0)" ::: "memory");
            const unsigned og = xb_add(&bar[XB_TOP], 1u);
            const unsigned tg = og / nx;
            if (og + 1u == (tg + 1u) * nx) xb_add(&bar[XB_TOPGEN], 1u);
            else XB_SPIN(xb_ld(&bar[XB_TOPGEN]) == tg, bar);
            __builtin_amdgcn_fence(__ATOMIC_ACQUIRE, "agent");
            xb_add(&bar[XB_XGEN(b.x)], 1u);
            asm volatile("s_waitcnt vmcnt(0)" ::: "memory");
        } else {
            XB_SPIN(xb_ld(&bar[XB_XGEN(b.x)]) == gen, bar);
            __builtin_amdgcn_fence(__ATOMIC_ACQUIRE, "agent");
            asm volatile("s_waitcnt vmcnt(0)" ::: "memory");
        }
    }
    __syncthreads();
}

#ifndef DBG_PERTURB
#define DBG_PERTURB 0
#endif
struct Params { const float* in[26]; float* out; unsigned char* ws; int ph_lo, ph_hi, pert, pad; };
enum { I_X = 0, I_P, I_WINE, I_WOUTE, I_DLAM, I_GDIFF, I_WCQK, I_BCQK, I_BIG, I_BFG, I_GML, I_WINO, I_WOUTO, I_GRET, I_GMPRE, I_GMPOST, I_GFPRE, I_GFPOST, I_WUP, I_WFC, I_BFC, I_WDN, I_GPLE, I_WPD, I_WPU, I_WPP };

typedef const __attribute__((address_space(4))) Params* KParams;
struct Frame {
    LAS unsigned char* lds;
    int tid, lane, wave, G, bid;
};
#define LANE_ID_ASM() ({ int l__; asm volatile("v_mbcnt_lo_u32_b32 %0, -1, 0\n\tv_mbcnt_hi_u32_b32 %0, -1, %0 ; LANE_ID" : "=v"(l__)); l__; })
#define PHASE_ENTRY(F) Frame F = F##_in; { const int l_ = LANE_ID_ASM(); F.lane = l_; F.tid = F.wave * 64 + l_; }

__device__ __forceinline__ void p0_transpose_item(const float* W, int ldw, int K, int N, bf16* WT, const float* gain, int rope_cols, LAS float* scr, int item, int lane) {
    const int nblk = N / 64, kb = item / nblk, nb = item % nblk, k0 = 64 * kb, n0 = 64 * nb;
    const int r4 = lane >> 4, q = lane & 15;
    int lcol, pbase, pstep;
    if (n0 < rope_cols) { const int hb = n0 & ~127, run = q >> 3, i4 = (q & 7) * 4; lcol = hb + run * 64 + ((n0 & 127) >> 1) + i4; pbase = 2 * i4 + run; pstep = 2; }
    else { lcol = n0 + 4 * q; pbase = 4 * q; pstep = 1; }
    f32x4 v[16];
#pragma unroll
    for (int i = 0; i < 16; ++i) v[i] = *(const f32x4*)(W + (size_t)(k0 + 4 * i + r4) * ldw + lcol);
#pragma unroll
    for (int i = 0; i < 16; ++i) { const int kk = 4 * i + r4; const float g = gain ? gain[k0 + kk] : 1.f; LAS float* d = scr + kk * 64;
        d[(pbase + kk) & 63] = v[i][0] * g; d[(pbase + pstep + kk) & 63] = v[i][1] * g; d[(pbase + 2 * pstep + kk) & 63] = v[i][2] * g; d[(pbase + 3 * pstep + kk) & 63] = v[i][3] * g; }
    LDS_WAIT(); asm volatile("" ::: "memory");
    const int c = lane & 7;
#pragma unroll
    for (int jq = 0; jq < 8; ++jq) { const int n = (lane >> 3) + 8 * jq; const LAS float* s = scr + (8 * c) * 64; const int nc = n + 8 * c;
        v4u o; o.x = pk2(s[0 * 64 + ((nc + 0) & 63)], s[1 * 64 + ((nc + 1) & 63)]); o.y = pk2(s[2 * 64 + ((nc + 2) & 63)], s[3 * 64 + ((nc + 3) & 63)]);
        o.z = pk2(s[4 * 64 + ((nc + 4) & 63)], s[5 * 64 + ((nc + 5) & 63)]); o.w = pk2(s[6 * 64 + ((nc + 6) & 63)], s[7 * 64 + ((nc + 7) & 63)]);
        *(GAS v4u*)(WT + (size_t)(n0 + n) * K + k0 + 8 * c) = o; }
    LDS_WAIT(); asm volatile("" ::: "memory");
}
__device__ __forceinline__ void p0_prologue(const Frame& F_in, KParams P) { PHASE_ENTRY(F);
    unsigned char* ws = P->ws;
    LAS float* scr = (LAS float*)(F.lds + F.wave * 16384);
    const int gw = F.bid * NWAVES + F.wave, NGW = F.G * NWAVES;
    constexpr int I_IN = 64 * 96, I_OUT = 32 * 64, I_UP = 64 * 128, I_DN = 64 * 64, I_PD = 64 * 4, I_PU = 4 * 64, I_PP = 4 * 64;
    constexpr int I_LAYER = I_IN + I_OUT + I_UP + I_DN + I_PD + I_PU + I_PP;
    for (int it = gw; it < DEPTH_ * I_LAYER; it += NGW) {
        const int L = it / I_LAYER; int r = it - L * I_LAYER; const int j = L >> 1; const bool ev = (L & 1) == 0;
        if (r < I_IN) { const float* W = ev ? P->in[I_WINE] + (size_t)j * DM * 6152 : P->in[I_WINO] + (size_t)j * DM * 6144;
            p0_transpose_item(W, ev ? 6152 : 6144, DM, NIN, (bf16*)(ws + WS_WIN) + (size_t)L * NIN * DM, P->in[I_GMPRE] + (size_t)L * DM, ev ? 2048 : 1024, scr, r, F.lane); continue; } r -= I_IN;
        if (r < I_OUT) { const float* W = (ev ? P->in[I_WOUTE] : P->in[I_WOUTO]) + (size_t)j * NMIX * DM;
            p0_transpose_item(W, DM, NMIX, DM, (bf16*)(ws + WS_WOUT) + (size_t)L * DM * NMIX, nullptr, 0, scr, r, F.lane); continue; } r -= I_OUT;
        if (r < I_UP) { p0_transpose_item(P->in[I_WUP] + (size_t)L * DM * NUP, NUP, DM, NUP, (bf16*)(ws + WS_WUP) + (size_t)L * NUP * DM, P->in[I_GFPRE] + (size_t)L * DM, 0, scr, r, F.lane); continue; } r -= I_UP;
        if (r < I_DN) { p0_transpose_item(P->in[I_WDN] + (size_t)L * DM * DM, DM, DM, DM, (bf16*)(ws + WS_WDN) + (size_t)L * DM * DM, nullptr, 0, scr, r, F.lane); continue; } r -= I_DN;
        if (r < I_PD) { p0_transpose_item(P->in[I_WPD] + (size_t)L * DM * PLED, PLED, DM, PLED, (bf16*)(ws + WS_WPD) + (size_t)L * PLED * DM, P->in[I_GPLE] + (size_t)L * DM, 0, scr, r, F.lane); continue; } r -= I_PD;
        if (r < I_PU) { p0_transpose_item(P->in[I_WPU] + (size_t)L * PLED * DM, DM, PLED, DM, (bf16*)(ws + WS_WPU) + (size_t)L * DM * PLED, nullptr, 0, scr, r, F.lane); continue; } r -= I_PU;
        p0_transpose_item(P->in[I_WPP] + (size_t)L * PLED * DM, DM, PLED, DM, (bf16*)(ws + WS_WPP) + (size_t)L * DM * PLED, nullptr, 0, scr, r, F.lane);
    }
    { const int l2_ = LANE_ID_ASM(); F.lane = l2_; F.tid = F.wave * 64 + l2_; }
    const int gt = F.bid * (NWAVES * 64) + F.tid, NGT = F.G * NWAVES * 64;
    for (int e = gt; e < 2 * DM; e += NGT) { const int j = e / DM, k = e - j * DM; const float g = P->in[I_GMPRE][(size_t)(2 * j) * DM + k]; const float* w = P->in[I_WINE] + ((size_t)j * DM + k) * 6152 + 6144;
        bf16* o = (bf16*)(ws + WS_WG) + (size_t)j * 8 * DM + k;
#pragma unroll
        for (int c = 0; c < 8; ++c) o[(size_t)c * DM] = (bf16)f2bf(g * w[c]); }
    for (size_t e = gt; e < (size_t)DEPTH_ * S_ * PLED / 8; e += NGT) { const f32x4 a = *(const f32x4*)(P->in[I_P] + e * 8), b = *(const f32x4*)(P->in[I_P] + e * 8 + 4);
        v4u o; o.x = pk2(a[0], a[1]); o.y = pk2(a[2], a[3]); o.z = pk2(b[0], b[1]); o.w = pk2(b[2], b[3]); *(v4u*)((bf16*)(ws + WS_PB) + e * 8) = o; }
    for (int e = gt; e < S_ * 64; e += NGT) { const int t = e >> 6, i = e & 63;
        const float finv = (float)exp2(-(double)i * (13.287712379549449 / 64.0)); const float ang = (float)t * finv; const double ad = (double)ang;
        const double n = rint(ad * 0.63661977236758134308); const double r = (ad - n * 1.57079632679489655800e+00) - n * 6.12323399573676603587e-17; const double r2 = r * r;
        double sn = r * (1.0 + r2 * (-1.0 / 6 + r2 * (1.0 / 120 + r2 * (-1.0 / 5040 + r2 * (1.0 / 362880 + r2 * (-1.0 / 39916800 + r2 * (1.0 / 6227020800.0)))))));
        double cs = 1.0 + r2 * (-0.5 + r2 * (1.0 / 24 + r2 * (-1.0 / 720 + r2 * (1.0 / 40320 + r2 * (-1.0 / 3628800 + r2 * (1.0 / 479001600.0))))));
        const int q = ((int)n) & 3; double c2 = cs, s2 = sn; if (q == 1) { c2 = -sn; s2 = cs; } else if (q == 2) { c2 = -cs; s2 = -sn; } else if (q == 3) { c2 = sn; s2 = -cs; }
        ((float*)(ws + WS_COS))[e] = (float)c2; ((float*)(ws + WS_SIN))[e] = (float)s2; }
    if (F.bid == 0 && F.wave == 0) {
        for (int j = 0; j < 2; ++j) { const float* lp = P->in[I_DLAM] + (size_t)j * 512; const int d = F.lane * 2;
            const float s1 = wave_sum(lp[d] * lp[128 + d] + lp[d + 1] * lp[128 + d + 1]), s2 = wave_sum(lp[256 + d] * lp[384 + d] + lp[256 + d + 1] * lp[384 + d + 1]);
            const float li = 0.8f - 0.6f * expf(-0.3f * (float)(2 * j));
            if (F.lane == 0) { ((float*)(ws + WS_LAM))[2 * j] = expf(s1) - expf(s2) + li; ((float*)(ws + WS_LAM))[2 * j + 1] = li; } }
    }
    for (int row = gw; row < S_; row += NGW) { const float* xr = P->in[I_X] + (size_t)row * DM; bf16* hr = (bf16*)(ws + WS_HB) + (size_t)row * DM; float ss = 0.f;
#pragma unroll
        for (int jj = 0; jj < 8; ++jj) { const int c = (jj * 64 + F.lane) * 8; const f32x4 a = *(const f32x4*)(xr + c), b = *(const f32x4*)(xr + c + 4);
            ss += (a[0] * a[0] + a[1] * a[1]) + (a[2] * a[2] + a[3] * a[3]) + (b[0] * b[0] + b[1] * b[1]) + (b[2] * b[2] + b[3] * b[3]);
            f32x4 a2 = a, b2 = b;
#if DBG_PERTURB
            if (P->pert) { for (int q = 0; q < 4; ++q) { unsigned hx = (unsigned)(row * 4096 + c + q) * 2654435761u; hx ^= hx >> 15; a2[q] *= 1.f + ((float)(hx & 1023u) - 511.5f) * 2e-6f; hx = (unsigned)(row * 4096 + c + 4 + q) * 2654435761u; hx ^= hx >> 15; b2[q] *= 1.f + ((float)(hx & 1023u) - 511.5f) * 2e-6f; } }
#endif
            v4u o; o.x = pk2(a2[0], a2[1]); o.y = pk2(a2[2], a2[3]); o.z = pk2(b2[0], b2[1]); o.w = pk2(b2[2], b2[3]); *(v4u*)(hr + c) = o; }
        const float tot = wave_sum(ss); if (F.lane == 0) ((float*)(ws + WS_RIN))[row] = rsqrtf(tot * (1.f / DM) + EPS_); }
}

__device__ __forceinline__ void gates_pass(const Frame& F_in, const bf16* hb, const bf16* wg, const float* rin, float* gpre) { PHASE_ENTRY(F);
    const int gw = F.bid * NWAVES + F.wave, NGW = F.G * NWAVES;
    for (int rg = gw; rg < S_ / 8; rg += NGW) { const int t0 = rg * 8;
        float acc[8][8];
#pragma unroll
        for (int a = 0; a < 8; ++a)
#pragma unroll
            for (int b = 0; b < 8; ++b) acc[a][b] = 0.f;
        for (int jj = 0; jj < 8; ++jj) { const int k = (jj * 64 + F.lane) * 8;
            v4u w[8];
#pragma unroll
            for (int c = 0; c < 8; ++c) w[c] = *(const v4u*)(wg + (size_t)c * DM + k);
#pragma unroll
            for (int r = 0; r < 8; ++r) { const v4u x = *(const v4u*)(hb + (size_t)(t0 + r) * DM + k);
#pragma unroll
                for (int c = 0; c < 8; ++c) acc[r][c] += (bflo(x.x) * bflo(w[c].x) + bfhi(x.x) * bfhi(w[c].x)) + (bflo(x.y) * bflo(w[c].y) + bfhi(x.y) * bfhi(w[c].y))
                                                        + (bflo(x.z) * bflo(w[c].z) + bfhi(x.z) * bfhi(w[c].z)) + (bflo(x.w) * bflo(w[c].w) + bfhi(x.w) * bfhi(w[c].w)); } }
        float mine = 0.f;
#pragma unroll
        for (int r = 0; r < 8; ++r)
#pragma unroll
            for (int c = 0; c < 8; ++c) { const float s = wave_sum(acc[r][c]); if (F.lane == r * 8 + c) mine = s; }
        gpre[(size_t)t0 * 8 + F.lane] = mine * rin[t0 + (F.lane >> 3)]; }
}
__device__ __forceinline__ void resid_pass(const Frame& F_in, const float* hin32, const bf16* y, const float* ssp, const float* g, bf16* hi, bf16* lo, float* rout) { PHASE_ENTRY(F);
    const int gw = F.bid * NWAVES + F.wave, NGW = F.G * NWAVES;
    for (int row = gw; row < S_; row += NGW) {
        const float ry = rsqrtf(wave_sum(ssp[(size_t)row * 64 + F.lane]) * (1.f / DM) + EPS_);
        const bf16* yr = y + (size_t)row * DM; bf16* hir = hi + (size_t)row * DM; bf16* lor = lo + (size_t)row * DM; float ss = 0.f;
#pragma unroll
        for (int jj = 0; jj < 8; ++jj) { const int c = (jj * 64 + F.lane) * 8; float hv[8];
            if (hin32) { const f32x4 a = *(const f32x4*)(hin32 + (size_t)row * DM + c), b = *(const f32x4*)(hin32 + (size_t)row * DM + c + 4); hv[0] = a[0]; hv[1] = a[1]; hv[2] = a[2]; hv[3] = a[3]; hv[4] = b[0]; hv[5] = b[1]; hv[6] = b[2]; hv[7] = b[3]; }
            else { const v4u h1 = *(const v4u*)(hir + c); v4u l1 = {0u, 0u, 0u, 0u}; if (RES_LO) l1 = *(const v4u*)(lor + c);
                hv[0] = bflo(h1.x) + bflo(l1.x); hv[1] = bfhi(h1.x) + bfhi(l1.x); hv[2] = bflo(h1.y) + bflo(l1.y); hv[3] = bfhi(h1.y) + bfhi(l1.y);
                hv[4] = bflo(h1.z) + bflo(l1.z); hv[5] = bfhi(h1.z) + bfhi(l1.z); hv[6] = bflo(h1.w) + bflo(l1.w); hv[7] = bfhi(h1.w) + bfhi(l1.w); }
            const v4u yv = *(const v4u*)(yr + c); const f32x4 ga = *(const f32x4*)(g + c), gb = *(const f32x4*)(g + c + 4);
            hv[0] += bflo(yv.x) * ry * ga[0]; hv[1] += bfhi(yv.x) * ry * ga[1]; hv[2] += bflo(yv.y) * ry * ga[2]; hv[3] += bfhi(yv.y) * ry * ga[3];
            hv[4] += bflo(yv.z) * ry * gb[0]; hv[5] += bfhi(yv.z) * ry * gb[1]; hv[6] += bflo(yv.w) * ry * gb[2]; hv[7] += bfhi(yv.w) * ry * gb[3];
#pragma unroll
            for (int q = 0; q < 8; ++q) ss += hv[q] * hv[q];
            v4u oh; oh.x = pk2(hv[0], hv[1]); oh.y = pk2(hv[2], hv[3]); oh.z = pk2(hv[4], hv[5]); oh.w = pk2(hv[6], hv[7]);
            v4u ol; ol.x = pk2(hv[0] - bflo(oh.x), hv[1] - bfhi(oh.x)); ol.y = pk2(hv[2] - bflo(oh.y), hv[3] - bfhi(oh.y)); ol.z = pk2(hv[4] - bflo(oh.z), hv[5] - bfhi(oh.z)); ol.w = pk2(hv[6] - bflo(oh.w), hv[7] - bfhi(oh.w));
            *(v4u*)(hir + c) = oh; if (RES_LO) *(v4u*)(lor + c) = ol; }
        const float tot = wave_sum(ss); if (F.lane == 0) rout[row] = rsqrtf(tot * (1.f / DM) + EPS_); }
}
__device__ __forceinline__ void rin_pass(const Frame& F_in, const float* ssp, float* rout) { PHASE_ENTRY(F);
    const int gw = F.bid * NWAVES + F.wave, NGW = F.G * NWAVES;
    for (int row = gw; row < S_; row += 4 * NGW) { float v[4];
#pragma unroll
        for (int i = 0; i < 4; ++i) { const int r = row + i * NGW; v[i] = (r < S_) ? ssp[(size_t)r * 64 + F.lane] : 0.f; }
#pragma unroll
        for (int i = 0; i < 4; ++i) { const int r = row + i * NGW; const float tot = wave_sum(v[i]); if (F.lane == 0 && r < S_) rout[r] = rsqrtf(tot * (1.f / DM) + EPS_); } }
}
__device__ __forceinline__ void pled_combine(const Frame& F_in, const bf16* part, const float* rin, bf16* g1) { PHASE_ENTRY(F);
    const int gt = F.bid * (NWAVES * 64) + F.tid, NGT = F.G * NWAVES * 64;
    for (int it = gt; it < S_ * PLED / 8; it += NGT) { const int row = it >> 5; const size_t o = (size_t)it * 8; const float r = rin[row];
        float a[8] = {0.f, 0.f, 0.f, 0.f, 0.f, 0.f, 0.f, 0.f};
#pragma unroll
        for (int w = 0; w < 4; ++w) { const v4u x = *(const v4u*)(part + (size_t)w * S_ * PLED + o);
            a[0] += bflo(x.x); a[1] += bfhi(x.x); a[2] += bflo(x.y); a[3] += bfhi(x.y); a[4] += bflo(x.z); a[5] += bfhi(x.z); a[6] += bflo(x.w); a[7] += bfhi(x.w); }
        v4u ov; ov.x = pk2(a[0] * r, a[1] * r); ov.y = pk2(a[2] * r, a[3] * r); ov.z = pk2(a[4] * r, a[5] * r); ov.w = pk2(a[6] * r, a[7] * r);
        *(v4u*)(g1 + o) = ov; }
}
__device__ __forceinline__ float gelu_tanh(float x) { const float u = 0.7978845608028654f * (x + 0.044715f * x * x * x); return x * __builtin_amdgcn_rcpf(1.f + __expf(-2.f * u)); }
__device__ __forceinline__ void convffn_pass(const Frame& F_in, const bf16* up, const float* wc, const float* bc, bf16* act) { PHASE_ENTRY(F);
    const int c0 = F.tid * 8;
    float wa[3][8], wb[3][8], ba[8], bb[8];
#pragma unroll
    for (int k = 0; k < 3; ++k)
#pragma unroll
        for (int e = 0; e < 8; ++e) { wa[k][e] = wc[(size_t)k * NUP + c0 + e]; wb[k][e] = wc[(size_t)k * NUP + 4096 + c0 + e]; }
#pragma unroll
    for (int e = 0; e < 8; ++e) { ba[e] = bc[c0 + e]; bb[e] = bc[4096 + c0 + e]; }
    for (int rb = F.bid; rb < S_ / 64; rb += F.G) { const int t0 = rb * 64;
        v4u a2 = (v4u){0u, 0u, 0u, 0u}, a1 = a2, b2 = a2, b1 = a2;
        if (t0 > 0) { a2 = *(const v4u*)(up + (size_t)(t0 - 2) * NUP + c0); b2 = *(const v4u*)(up + (size_t)(t0 - 2) * NUP + 4096 + c0);
                      a1 = *(const v4u*)(up + (size_t)(t0 - 1) * NUP + c0); b1 = *(const v4u*)(up + (size_t)(t0 - 1) * NUP + 4096 + c0); }
        for (int tg = t0; tg < t0 + 64; tg += 8) { v4u an[8], bn[8];
#pragma unroll
          for (int i = 0; i < 8; ++i) { an[i] = *(const v4u*)(up + (size_t)(tg + i) * NUP + c0); bn[i] = *(const v4u*)(up + (size_t)(tg + i) * NUP + 4096 + c0); }
#pragma unroll
          for (int i = 0; i < 8; ++i) { const int t = tg + i; const v4u a0 = an[i], b0 = bn[i];
            float o[8];
            const unsigned A2[4] = {a2.x, a2.y, a2.z, a2.w}, A1[4] = {a1.x, a1.y, a1.z, a1.w}, A0[4] = {a0.x, a0.y, a0.z, a0.w};
            const unsigned B2[4] = {b2.x, b2.y, b2.z, b2.w}, B1[4] = {b1.x, b1.y, b1.z, b1.w}, B0[4] = {b0.x, b0.y, b0.z, b0.w};
#pragma unroll
            for (int e = 0; e < 8; ++e) { const int q = e >> 1; const bool hi = e & 1;
                const float xa2 = hi ? bfhi(A2[q]) : bflo(A2[q]), xa1 = hi ? bfhi(A1[q]) : bflo(A1[q]), xa0 = hi ? bfhi(A0[q]) : bflo(A0[q]);
                const float xb2 = hi ? bfhi(B2[q]) : bflo(B2[q]), xb1 = hi ? bfhi(B1[q]) : bflo(B1[q]), xb0 = hi ? bfhi(B0[q]) : bflo(B0[q]);
                const float ya = ba[e] + wa[0][e] * xa2 + wa[1][e] * xa1 + wa[2][e] * xa0, yb = bb[e] + wb[0][e] * xb2 + wb[1][e] * xb1 + wb[2][e] * xb0;
                o[e] = gelu_tanh(ya) * yb; }
            v4u ov; ov.x = pk2(o[0], o[1]); ov.y = pk2(o[2], o[3]); ov.z = pk2(o[4], o[5]); ov.w = pk2(o[6], o[7]);
            *(v4u*)(act + (size_t)t * DM + c0) = ov;
            a2 = a1; a1 = a0; b2 = b1; b1 = b0; } } }
}
__device__ __forceinline__ void diffcomb_pass(const Frame& F_in, const bf16* od, const float* g, const float* lamv, bf16* ymix) { PHASE_ENTRY(F);
    const int gw = F.bid * NWAVES + F.wave, NGW = F.G * NWAVES; const float lam = lamv[0], sc = 1.f - lamv[1];
    const f32x4 g4 = *(const f32x4*)(g + F.lane * 4);
    for (int it0 = gw; it0 < S_ * 4; it0 += 4 * NGW) { v2u av[4], bv[4];
#pragma unroll
        for (int i = 0; i < 4; ++i) { const int it = it0 + i * NGW, t = it >> 2, h = it & 3; av[i] = (v2u){0u, 0u}; bv[i] = (v2u){0u, 0u};
            if (it < S_ * 4) { av[i] = *(const v2u*)(od + ((size_t)t * 8 + 2 * h) * 256 + F.lane * 4); bv[i] = *(const v2u*)(od + ((size_t)t * 8 + 2 * h + 1) * 256 + F.lane * 4); } }
#pragma unroll
        for (int i = 0; i < 4; ++i) { const int it = it0 + i * NGW, t = it >> 2, h = it & 3; const v2u a = av[i], b = bv[i];
            f32x4 d; d[0] = bflo(a.x) - lam * bflo(b.x); d[1] = bfhi(a.x) - lam * bfhi(b.x); d[2] = bflo(a.y) - lam * bflo(b.y); d[3] = bfhi(a.y) - lam * bfhi(b.y);
            const float r = rsqrtf(wave_sum((d[0] * d[0] + d[1] * d[1]) + (d[2] * d[2] + d[3] * d[3])) * (1.f / 256.f) + EPS_) * sc;
            v2u o; o.x = pk2(d[0] * r * g4[0], d[1] * r * g4[1]); o.y = pk2(d[2] * r * g4[2], d[3] * r * g4[3]);
            if (it < S_ * 4) *(v2u*)(ymix + (size_t)t * NMIX + h * 256 + F.lane * 4) = o; } }
}

constexpr int AT_KT = 16384, AT_NVS = 3;
constexpr float AT_C2 = 0.08838834764831845f * 1.4426950408889634f;
template <int MODE, int NV, int GRP, int ABL = 0>
__device__ __forceinline__ void attn_unit(LAS unsigned char* lds, int wave_in, const bf16* Qp, const bf16* Kp, const bf16* Vp, int ldp, int qb, bf16* Op, int ldo) {
    constexpr bool LAG = GRP != 0, grpB = GRP == 2;
    constexpr bool KSM = (MODE == 0 && NV == 2 && GRP == 1 && ABL == 0);
    constexpr int AT_KB = AT_NVS * (64 * (256 * NV + 64)), AT_KS = (NV == 2) ? 22528 : AT_KT;
    static_assert(NV != 2 || (AT_KB + AT_KT <= LDSCTL_OFF && AT_KB + AT_KS >= LDSCTL_OFF + 2048 && AT_KB + AT_KS + AT_KT <= LDS_BYTES), "LDS map");
    constexpr int AT_VSTR = 256 * NV + 64, AT_VT = 64 * AT_VSTR;
    const int lane_o = LANE_ID_ASM();
    const int wid = wave_in, lane = lane_o, tid = wid * 64 + lane, r32 = lane & 31, hi = lane >> 5;
    const int P0 = qb * 256, qrow = P0 + 32 * wid + r32, jd = (P0 + 32 * wid) >> 6, NT = 4 * qb + 4;
    bf16x8 qr[8];
#pragma unroll
    for (int s = 0; s < 8; ++s) qr[s] = *(const bf16x8*)(Qp + (size_t)qrow * ldp + 16 * s + 8 * hi);
    const unsigned ldsb = (unsigned)(uintptr_t)lds;
    const unsigned vrb = ldsb + (unsigned)((4 * hi + ((lane >> 2) & 3)) * AT_VSTR + (16 * ((lane >> 4) & 1) + 4 * (lane & 3)) * 2);
    constexpr int NPV = AT_VT / 1024, NPW = (NPV + 7) / 8, VCH = AT_VSTR / 16;
    unsigned kof[2], vof[NPW];
#pragma unroll
    for (int i = 0; i < 2; ++i) { const int rr = 4 * i + (lane >> 4); kof[i] = (unsigned)((8 * wid + rr) * ldp + (((lane & 15) ^ ((8 * wid + rr) & 15)) * 8)) * 2u; }
#pragma unroll
    for (int i = 0; i < NPW; ++i) { const int u = (wid + 8 * i) * 64 + lane, row = u / VCH, cc = u - row * VCH; vof[i] = (unsigned)(row * ldp) * 2u + (unsigned)((cc < 16 * NV ? cc : 0) * 16); }
#define AT_DMAK(j, sl) do { const char* g_ = (const char*)(Kp + (size_t)(j) * 64 * ldp); _Pragma("unroll") for (int i_ = 0; i_ < 2; ++i_) \
        __builtin_amdgcn_global_load_lds((const unsigned*)(g_ + kof[i_]), (LAS unsigned*)(lds + AT_KB + (sl) * AT_KS + (2 * wid + i_) * 1024), 16, 0, 0); } while (0)
#define AT_DMAV(j, sl) do { const char* g_ = (const char*)(Vp + (size_t)(j) * 64 * ldp); _Pragma("unroll") for (int i_ = 0; i_ < NPW; ++i_) if (wid + 8 * i_ < NPV) \
        __builtin_amdgcn_global_load_lds((const unsigned*)(g_ + vof[i_]), (LAS unsigned*)(lds + (sl) * AT_VT + (wid + 8 * i_) * 1024), 16, 0, 0); } while (0)
#define AT_JT(t) (MODE == 0 ? (t) : NT - 1 - (t))
    f32x16 o[4 * NV];
#pragma unroll
    for (int d = 0; d < 4 * NV; ++d)
#pragma unroll
        for (int r = 0; r < 16; ++r) o[d][r] = 0.f;
    float m_run = -1e30f, l_run = 0.f, carry = 1.f;
    volatile LAS float* cmx = (volatile LAS float*)(lds + LDSCTL_OFF + 1024);
    __syncthreads();
    AT_DMAK(AT_JT(0), 0); AT_DMAV(AT_JT(0), 0);
    VM_WAIT();
    __syncthreads();
#define AT_KRD(i) asm volatile("ds_read_b128 %0, %1 offset:%2" : "=&v"(kq[i]) : "v"(kb[(i) >> 1]), "i"(((i) & 1) * 32 * 256) : "memory")
#define AT_KWT(i, N) asm volatile("s_waitcnt lgkmcnt(" #N ")" : "+v"(kq[i]) :: "memory")
#define AT_KMM(i) do { if ((i) & 1) p1 = MFMA32(kq[i], qr[(i) >> 1], p1); else p0 = MFMA32(kq[i], qr[(i) >> 1], p0); __builtin_amdgcn_sched_barrier(0); } while (0)
#define AT_QK(bb) do { \
        unsigned kb[8];                             \
        { int rl = lane; asm volatile("" : "+v"(rl)); const int r32b = rl & 31, hib = rl >> 5; \
          _Pragma("unroll") for (int dd = 0; dd < 8; ++dd) kb[dd] = ldsb + (unsigned)(AT_KB + (bb) * AT_KS + KSWZ(r32b, (dd * 16 + hib * 8) * 2)); } \
        bf16x8 kq[16]; \
        AT_KRD(0); AT_KRD(1); AT_KRD(2); AT_KRD(3); AT_KRD(4); AT_KRD(5); \
        AT_KRD(6); AT_KWT(0, 6); AT_KMM(0); AT_KRD(7); AT_KWT(1, 6); AT_KMM(1); AT_KRD(8); AT_KWT(2, 6); AT_KMM(2); AT_KRD(9); AT_KWT(3, 6); AT_KMM(3); \
        AT_KRD(10); AT_KWT(4, 6); AT_KMM(4); AT_KRD(11); AT_KWT(5, 6); AT_KMM(5); AT_KRD(12); AT_KWT(6, 6); AT_KMM(6); AT_KRD(13); AT_KWT(7, 6); AT_KMM(7); \
        AT_KRD(14); AT_KWT(8, 6); AT_KMM(8); AT_KRD(15); AT_KWT(9, 6); AT_KMM(9); AT_KWT(10, 5); AT_KMM(10); AT_KWT(11, 4); AT_KMM(11); \
        AT_KWT(12, 3); AT_KMM(12); AT_KWT(13, 2); AT_KMM(13); AT_KWT(14, 1); AT_KMM(14); AT_KWT(15, 0); AT_KMM(15); } while (0)
#define AT_RD(d0, L0, H0, L1, H1, L2, H2, L3, H3) do { TRRD(L0, vb, 0 * 16 * AT_VSTR + (d0) * 64); TRRD(H0, vb, (0 * 16 + 8) * AT_VSTR + (d0) * 64); TRRD(L1, vb, 1 * 16 * AT_VSTR + (d0) * 64); TRRD(H1, vb, (1 * 16 + 8) * AT_VSTR + (d0) * 64); \
        TRRD(L2, vb, 2 * 16 * AT_VSTR + (d0) * 64); TRRD(H2, vb, (2 * 16 + 8) * AT_VSTR + (d0) * 64); TRRD(L3, vb, 3 * 16 * AT_VSTR + (d0) * 64); TRRD(H3, vb, (3 * 16 + 8) * AT_VSTR + (d0) * 64); } while (0)
#define AT_WT(N, L0, H0, L1, H1, L2, H2, L3, H3) asm volatile("s_waitcnt lgkmcnt(" #N ")" : "+v"(L0), "+v"(H0), "+v"(L1), "+v"(H1), "+v"(L2), "+v"(H2), "+v"(L3), "+v"(H3) :: "memory")
#define AT_MM(d0, L0, H0, L1, H1, L2, H2, L3, H3) do { o[d0] = MFMA32(mk8(L0, H0), pk[0], o[d0]); o[d0] = MFMA32(mk8(L1, H1), pk[1], o[d0]); o[d0] = MFMA32(mk8(L2, H2), pk[2], o[d0]); o[d0] = MFMA32(mk8(L3, H3), pk[3], o[d0]); } while (0)
#define AT_RDA(d0) AT_RD(d0, a0, a1, a2, a3, a4, a5, a6, a7)
#define AT_RDB(d0) AT_RD(d0, b0, b1, b2, b3, b4, b5, b6, b7)
#define AT_WTA(N) AT_WT(N, a0, a1, a2, a3, a4, a5, a6, a7)
#define AT_WTB(N) AT_WT(N, b0, b1, b2, b3, b4, b5, b6, b7)
#define AT_MMA(d0) AT_MM(d0, a0, a1, a2, a3, a4, a5, a6, a7)
#define AT_MMB(d0) AT_MM(d0, b0, b1, b2, b3, b4, b5, b6, b7)
#define AT_PV(slot) do { const unsigned vb = vrb + (unsigned)((slot) * AT_VT); s16x4 a0, a1, a2, a3, a4, a5, a6, a7, b0, b1, b2, b3, b4, b5, b6, b7; \
        if (NV == 2) {                   \
            AT_RDA(0); AT_RDB(1); \
            AT_WTA(8); AT_MMA(0); AT_RDA(2); \
            AT_WTB(8); AT_MMB(1); AT_RDB(3); \
            AT_WTA(8); AT_MMA(2); AT_RDA(4); \
            AT_WTB(8); AT_MMB(3); AT_RDB(5); \
            AT_WTA(8); AT_MMA(4); AT_RDA(6); \
            AT_WTB(8); AT_MMB(5); AT_RDB(4 * NV - 1); \
            AT_WTA(8); AT_MMA(6); \
            AT_WTB(0); AT_MMB(4 * NV - 1); \
        } else { \
            AT_RDA(0); AT_RDB(1); \
            AT_WTA(8); AT_MMA(0); AT_RDA(2); \
            AT_WTB(8); AT_MMB(1); AT_RDB(3); \
            AT_WTA(8); AT_MMA(2); \
            AT_WTB(0); AT_MMB(3); } } while (0)
#define AT_VR(n) do { TRRD(fl[n], vb, ((n) >> 3) * 16 * AT_VSTR + ((n) & 7) * 64); TRRD(fh[n], vb, (((n) >> 3) * 16 + 8) * AT_VSTR + ((n) & 7) * 64); } while (0)
#define AT_VW(n, N) asm volatile("s_waitcnt lgkmcnt(" #N ")" : "+v"(fl[n]), "+v"(fh[n]) :: "memory")
#define AT_VM(n) o[(n) & 7] = MFMA32(mk8(fl[n], fh[n]), pk[(n) >> 3], o[(n) & 7])
#define AT_VE(n) do { p1[n] = __builtin_amdgcn_exp2f(fmaf(p1[n], AT_C2, mb)); ps += p1[n]; } while (0)
#define AT_VPK() do { v4u w_; w_.x = pk2(p1[0], p1[1]); w_.y = pk2(p1[2], p1[3]); w_.z = pk2(p1[4], p1[5]); w_.w = pk2(p1[6], p1[7]); pk[2] = __builtin_bit_cast(bf16x8, w_); \
        w_.x = pk2(p1[8], p1[9]); w_.y = pk2(p1[10], p1[11]); w_.z = pk2(p1[12], p1[13]); w_.w = pk2(p1[14], p1[15]); pk[3] = __builtin_bit_cast(bf16x8, w_); } while (0)
#define AT_PVK(slot) do { const unsigned vb = vrb + (unsigned)((slot) * AT_VT); s16x4 fl[32], fh[32]; AT_VR(0); AT_VR(1); AT_VR(2); AT_VR(3); \
        AT_VR(4); AT_VW(0, 8); AT_VM(0); AT_VE(0); \
        AT_VR(5); AT_VW(1, 8); AT_VM(1); AT_VE(1); \
        AT_VR(6); AT_VW(2, 8); AT_VM(2); AT_VE(2); \
        AT_VR(7); AT_VW(3, 8); AT_VM(3); AT_VE(3); \
        AT_VR(8); AT_VW(4, 8); AT_VM(4); AT_VE(4); \
        AT_VR(9); AT_VW(5, 8); AT_VM(5); AT_VE(5); \
        AT_VR(10); AT_VW(6, 8); AT_VM(6); AT_VE(6); \
        AT_VR(11); AT_VW(7, 8); AT_VM(7); AT_VE(7); \
        AT_VR(12); AT_VW(8, 8); AT_VM(8); AT_VE(8); \
        AT_VR(13); AT_VW(9, 8); AT_VM(9); AT_VE(9); \
        AT_VR(14); AT_VW(10, 8); AT_VM(10); AT_VE(10); \
        AT_VR(15); AT_VW(11, 8); AT_VM(11); AT_VE(11); \
        AT_VR(16); AT_VW(12, 8); AT_VM(12); AT_VE(12); \
        AT_VR(17); AT_VW(13, 8); AT_VM(13); AT_VE(13); \
        AT_VR(18); AT_VW(14, 8); AT_VM(14); AT_VE(14); \
        AT_VR(19); AT_VW(15, 8); AT_VM(15); AT_VE(15); \
        AT_VPK(); \
        AT_VR(20); AT_VW(16, 8); AT_VM(16); \
        AT_VR(21); AT_VW(17, 8); AT_VM(17); \
        AT_VR(22); AT_VW(18, 8); AT_VM(18); \
        AT_VR(23); AT_VW(19, 8); AT_VM(19); \
        AT_VR(24); AT_VW(20, 8); AT_VM(20); \
        AT_VR(25); AT_VW(21, 8); AT_VM(21); \
        AT_VR(26); AT_VW(22, 8); AT_VM(22); \
        AT_VR(27); AT_VW(23, 8); AT_VM(23); \
        AT_VR(28); AT_VW(24, 8); AT_VM(24); \
        AT_VR(29); AT_VW(25, 8); AT_VM(25); \
        AT_VR(30); AT_VW(26, 8); AT_VM(26); \
        AT_VR(31); AT_VW(27, 8); AT_VM(27); \
        AT_VW(28, 6); AT_VM(28); \
        AT_VW(29, 4); AT_VM(29); \
        AT_VW(30, 2); AT_VM(30); \
        AT_VW(31, 0); AT_VM(31); } while (0)
    bf16x8 pk[4]; bool pend = false;
    int vp = 2, vc = 0, vn = 1;
    for (int t = 0; t < NT; ++t) {
        const int j = AT_JT(t), b = t & 1; const bool act = (j <= jd);
        const bool more = t + 1 < NT; const int jn = AT_JT(t + 1);
        if (more && !(ABL & 8)) { AT_DMAK(jn, b ^ 1); AT_DMAV(jn, vn); }
        if (LAG && grpB) { if (pend && !(ABL & 4)) AT_PV(vp); }
        if (act) {
            f32x16 p0, p1;
#pragma unroll
            for (int r = 0; r < 16; ++r) { p0[r] = 0.f; p1[r] = 0.f; }
            if (!(ABL & 1)) AT_QK(b);
            if (ABL & 1) asm volatile("" : "+v"(p0), "+v"(p1));
            if (ABL & 2) { } else if (MODE == 0) {
                float pm = p0[0];
#pragma unroll
                for (int r = 1; r < 16; ++r) pm = fmaxf(pm, p0[r]);
#pragma unroll
                for (int r = 0; r < 16; ++r) pm = fmaxf(pm, p1[r]);
                pm = swap_max(pm);
                if (!__all((pm - m_run) * AT_C2 <= 8.f)) { const float mn = fmaxf(m_run, pm), al = __builtin_amdgcn_exp2f((m_run - mn) * AT_C2); m_run = mn; l_run *= al;
#pragma unroll
                    for (int d = 0; d < 4 * NV; ++d)
#pragma unroll
                        for (int r = 0; r < 16; ++r) o[d][r] *= al; }
                const float mb = -m_run * AT_C2; float ps = 0.f;
                if (KSM) {
#pragma unroll
                    for (int r = 0; r < 16; ++r) { p0[r] = __builtin_amdgcn_exp2f(fmaf(p0[r], AT_C2, mb)); ps += p0[r]; }
                    { v4u w; w.x = pk2(p0[0], p0[1]); w.y = pk2(p0[2], p0[3]); w.z = pk2(p0[4], p0[5]); w.w = pk2(p0[6], p0[7]); pk[0] = __builtin_bit_cast(bf16x8, w);
                      w.x = pk2(p0[8], p0[9]); w.y = pk2(p0[10], p0[11]); w.z = pk2(p0[12], p0[13]); w.w = pk2(p0[14], p0[15]); pk[1] = __builtin_bit_cast(bf16x8, w); }
                    AT_PVK(vc);
                } else {
#pragma unroll
                    for (int r = 0; r < 16; ++r) { p0[r] = __builtin_amdgcn_exp2f(fmaf(p0[r], AT_C2, mb)); p1[r] = __builtin_amdgcn_exp2f(fmaf(p1[r], AT_C2, mb)); ps += p0[r] + p1[r]; }
                }
                l_run += swap_sum(ps);
            } else {
                float up[32];
#pragma unroll
                for (int r = 0; r < 16; ++r) { up[r] = __builtin_amdgcn_exp2f(fminf(p0[r] * AT_C2, 30.f)); up[16 + r] = __builtin_amdgcn_exp2f(fminf(p1[r] * AT_C2, 30.f)); }
                if (j == jd) { const int qrel = qrow - 64 * j;
#pragma unroll
                    for (int r = 0; r < 16; ++r) { if (crow(r, hi) >= qrel) up[r] = 0.f; if (32 + crow(r, hi) >= qrel) up[16 + r] = 0.f; } }
                float all[16], e1[8], e2[8], e3[8];
#pragma unroll
                for (int q = 0; q < 8; ++q) { e1[q] = 1.f + up[4 * q]; e2[q] = e1[q] * (1.f + up[4 * q + 1]); e3[q] = e2[q] * (1.f + up[4 * q + 2]);
                    const float gp = __builtin_amdgcn_rcpf(e3[q] * (1.f + up[4 * q + 3]));
                    auto rr = __builtin_amdgcn_permlane32_swap(__float_as_uint(gp), __float_as_uint(gp), false, false); all[2 * q] = __uint_as_float(rr[0]); all[2 * q + 1] = __uint_as_float(rr[1]); }
                float T[16]; T[15] = carry;
#pragma unroll
                for (int g = 14; g >= 0; --g) T[g] = T[g + 1] * all[g + 1];
                carry = T[0] * all[0];
#pragma unroll
                for (int q = 0; q < 8; ++q) { const float tg = T[2 * q + 1] * (hi ? all[2 * q + 1] : all[2 * q + 1] * all[2 * q]);
                    const float a0 = up[4 * q] * tg, a1 = up[4 * q + 1] * e1[q] * tg, a2 = up[4 * q + 2] * e2[q] * tg, a3 = up[4 * q + 3] * e3[q] * tg;
                    if (q < 4) { p0[4 * q] = a0; p0[4 * q + 1] = a1; p0[4 * q + 2] = a2; p0[4 * q + 3] = a3; } else { p1[4 * q - 16] = a0; p1[4 * q - 15] = a1; p1[4 * q - 14] = a2; p1[4 * q - 13] = a3; } }
            }
            if (!KSM) { v4u w;
              w.x = pk2(p0[0], p0[1]); w.y = pk2(p0[2], p0[3]); w.z = pk2(p0[4], p0[5]); w.w = pk2(p0[6], p0[7]); pk[0] = __builtin_bit_cast(bf16x8, w);
              w.x = pk2(p0[8], p0[9]); w.y = pk2(p0[10], p0[11]); w.z = pk2(p0[12], p0[13]); w.w = pk2(p0[14], p0[15]); pk[1] = __builtin_bit_cast(bf16x8, w);
              w.x = pk2(p1[0], p1[1]); w.y = pk2(p1[2], p1[3]); w.z = pk2(p1[4], p1[5]); w.w = pk2(p1[6], p1[7]); pk[2] = __builtin_bit_cast(bf16x8, w);
              w.x = pk2(p1[8], p1[9]); w.y = pk2(p1[10], p1[11]); w.z = pk2(p1[12], p1[13]); w.w = pk2(p1[14], p1[15]); pk[3] = __builtin_bit_cast(bf16x8, w); }
            if (!KSM && !(LAG && grpB) && !(ABL & 4)) AT_PV(vc);
        }
        if (LAG && grpB) pend = act;
        VM_WAIT();
        if (MODE == 1) { const float cm = wave_max(carry); if (lane == 0) cmx[(t & 1) * 8 + wid] = cm; }
        __syncthreads();
        if (MODE == 1) { float cm = cmx[(t & 1) * 8];
#pragma unroll
            for (int w = 1; w < 8; ++w) cm = fmaxf(cm, cmx[(t & 1) * 8 + w]);
            if (cm < 1.4901161e-8f) break; }
        vp = vc; vc = vn; vn = (vn == AT_NVS - 1) ? 0 : vn + 1;
    }
    if (LAG && grpB && pend && !(ABL & 4)) AT_PV(vp);
#undef AT_PV
#undef AT_PVK
#undef AT_VR
#undef AT_VW
#undef AT_VM
#undef AT_VE
#undef AT_VPK
#undef AT_QK
#undef AT_RDA
#undef AT_RDB
#undef AT_WTA
#undef AT_WTB
#undef AT_MMA
#undef AT_MMB
#undef AT_RD
#undef AT_WT
#undef AT_MM
    const float inv = (MODE == 0) ? __builtin_amdgcn_rcpf(l_run) : 1.f;
    const int lane_e = LANE_ID_ASM(), hi_e = lane_e >> 5;
    bf16* orow = Op + (size_t)(P0 + 32 * wid + (lane_e & 31)) * ldo;
#pragma unroll
    for (int d = 0; d < 4 * NV; ++d)
#pragma unroll
        for (int rg = 0; rg < 4; ++rg) { v2u w; w.x = pk2(o[d][4 * rg] * inv, o[d][4 * rg + 1] * inv); w.y = pk2(o[d][4 * rg + 2] * inv, o[d][4 * rg + 3] * inv);
            *(v2u*)(orow + 32 * d + 8 * rg + 4 * hi_e) = w; }
#undef AT_DMAK
#undef AT_DMAV
#undef AT_KRD
#undef AT_KWT
#undef AT_KMM
#undef AT_JT
}
template <int MODE, int ABL = 0>
__device__ __forceinline__ void attn_phase(const Frame& F_in, gu32* qhead, const bf16* proj, bf16* outp) { PHASE_ENTRY(F);
    volatile LAS unsigned* slot = (volatile LAS unsigned*)(F.lds + MISC_OFF + 64);
    constexpr int NU = 512;
    for (;;) {
        __syncthreads();
        if (F.tid == 0) *slot = __hip_atomic_fetch_add(qhead, 1u, RLX_AGENT);
        __syncthreads();
        const int u = (int)*slot;
        if (u >= NU) break;
        const int qb = 63 - (u >> 3), h = u & 7;
        if (MODE == 0)
            attn_unit<0, 2, 1, ABL>(F.lds, F.wave, proj + h * 128, proj + 1024 + h * 128, proj + 2048 + (h >> 1) * 256, NIN, qb, outp + h * 256, 2048);
        else
            attn_unit<1, 1, 0>(F.lds, F.wave, proj + 3072 + h * 128, proj + 4096 + h * 128, proj + 5120 + h * 128, NIN, qb, outp + 1024 + h * 128, NMIX);
    }
}

constexpr float LIN_SC = 0.08838834764831845f;
constexpr int LK_STR = 320, LV_STR = 576;
struct LinArgs {
    const bf16* proj; bf16* qkc; const float* gpre; const float* b_i; const float* b_f; const float* wconv; const float* bconv; const float* gnorm;
    float* chs; bf16* dC; bf16* CH;
    float* dn; float* nh; bf16* ymix;
};
__device__ __forceinline__ float wave_prefix_sum(float v, int lane, LAS float* scr) { scr[lane] = v; LDS_WAIT(); asm volatile("" ::: "memory"); float b = 0.f;
    for (int s = 0; s < 64; ++s) { const float x = scr[s]; b += (s <= lane) ? x : 0.f; } LDS_WAIT(); asm volatile("" ::: "memory"); return b; }
__device__ __forceinline__ float wave_prefix_max(float v, int lane, LAS float* scr) { scr[lane] = v; LDS_WAIT(); asm volatile("" ::: "memory"); float b = v;
    for (int s = 0; s < 64; ++s) { const float x = scr[s]; b = (s <= lane) ? fmaxf(b, x) : b; } LDS_WAIT(); asm volatile("" ::: "memory"); return b; }
template <bool ML>
__device__ __forceinline__ void lin_gates(const LinArgs& A, int t0, int h, int lane, LAS float* scr, float& li, float& b) {
    if (ML) { const float f = A.gpre[(size_t)(t0 + lane) * 8 + 4 + h] + A.b_f[h]; li = A.gpre[(size_t)(t0 + lane) * 8 + h] + A.b_i[h];
        const float lf = fminf(f, 0.f) - __logf(1.f + __expf(-fabsf(f))); b = wave_prefix_sum(lf, lane, scr);
    } else { const float lg = (h == 0) ? -0.0317486983145803f : (h == 1) ? -0.015748356968139168f : (h == 2) ? -0.007843177461025893f : -0.003913899321136329f;   li = 0.f; b = (float)(lane + 1) * lg; }
}
template <bool ML>
__device__ __forceinline__ void lin_local(const Frame& F_in, const LinArgs& A) { PHASE_ENTRY(F);
    LAS unsigned char* lds = F.lds; const int tid = F.tid, lane = F.lane, wid = F.wave, hi = lane >> 5;
    LAS unsigned char* Kt = lds; LAS unsigned char* Vt = lds + 64 * LK_STR; LAS float* wks = (LAS float*)(lds + 64 * LK_STR + 64 * LV_STR);
    const int sr = tid >> 4, sc = (tid & 15) * 8;
    for (int u = F.bid; u < NCH * 4; u += F.G) { const int c = u >> 2, h = u & 3, t0 = c * 64;
        __syncthreads();
        if (wid == 0) { float li, b; lin_gates<ML>(A, t0, h, lane, wks, li, b); wks[lane] = b; LDS_WAIT(); asm volatile("" ::: "memory"); const float bl = wks[63]; LDS_WAIT(); asm volatile("" ::: "memory"); const float g = bl - b + li; const float a = ML ? wave_max(g) : 0.f;
            wks[lane] = __expf(g - a) * LIN_SC; if (lane == 0) { A.chs[c * 4 + h] = bl; A.chs[NCH * 4 + c * 4 + h] = a; } }
        __syncthreads();
#pragma unroll
        for (int rr = 0; rr < 2; ++rr) { const int s = sr + 32 * rr, t = t0 + s; const float wk = wks[s];
            if (ML) {
#pragma unroll
                for (int X = 0; X < 2; ++X) { const int ch = X * 512 + 128 * h + sc; float y[8];
#pragma unroll
                    for (int e = 0; e < 8; ++e) y[e] = A.bconv[ch + e];
#pragma unroll
                    for (int tap = 0; tap < 4; ++tap) { const int tt = t - 3 + tap; v4u x = (v4u){0u, 0u, 0u, 0u}; if (tt >= 0) x = *(const v4u*)(A.proj + (size_t)tt * NIN + 3072 + ch);
                        const f32x4 w0 = *(const f32x4*)(A.wconv + (size_t)tap * 1024 + ch), w1 = *(const f32x4*)(A.wconv + (size_t)tap * 1024 + ch + 4);
                        y[0] += w0[0] * bflo(x.x); y[1] += w0[1] * bfhi(x.x); y[2] += w0[2] * bflo(x.y); y[3] += w0[3] * bfhi(x.y);
                        y[4] += w1[0] * bflo(x.z); y[5] += w1[1] * bfhi(x.z); y[6] += w1[2] * bflo(x.w); y[7] += w1[3] * bfhi(x.w); }
#pragma unroll
                    for (int e = 0; e < 8; ++e) y[e] = y[e] * __builtin_amdgcn_rcpf(1.f + __expf(-y[e]));
                    v4u o; o.x = pk2(y[0], y[1]); o.y = pk2(y[2], y[3]); o.z = pk2(y[4], y[5]); o.w = pk2(y[6], y[7]);
                    *(v4u*)(A.qkc + (size_t)t * 1024 + ch) = o;
                    if (X == 1) { v4u k; k.x = pk2(y[0] * wk, y[1] * wk); k.y = pk2(y[2] * wk, y[3] * wk); k.z = pk2(y[4] * wk, y[5] * wk); k.w = pk2(y[6] * wk, y[7] * wk);
                        *(LAS v4u*)(Kt + s * LK_STR + sc * 2) = k; } }
            } else { const v4u x = *(const v4u*)(A.proj + (size_t)t * NIN + 512 + 128 * h + sc);
                v4u k; k.x = pk2(bflo(x.x) * wk, bfhi(x.x) * wk); k.y = pk2(bflo(x.y) * wk, bfhi(x.y) * wk); k.z = pk2(bflo(x.z) * wk, bfhi(x.z) * wk); k.w = pk2(bflo(x.w) * wk, bfhi(x.w) * wk);
                *(LAS v4u*)(Kt + s * LK_STR + sc * 2) = k; }
            const bf16* vp = A.proj + (size_t)t * NIN + (ML ? 4096 : 1024) + 256 * h + sc;
            *(LAS v4u*)(Vt + s * LV_STR + sc * 2) = *(const v4u*)vp; *(LAS v4u*)(Vt + s * LV_STR + (128 + sc) * 2) = *(const v4u*)(vp + 128); }
        __syncthreads();
        const unsigned rowb = (unsigned)(8 * hi + ((lane >> 2) & 3)), colb = (unsigned)(16 * ((lane >> 4) & 1) + 4 * (lane & 3));
        const unsigned vb = (unsigned)(uintptr_t)Vt + rowb * LV_STR + (32 * wid + colb) * 2, kbs = (unsigned)(uintptr_t)Kt + rowb * LK_STR + colb * 2;
        bf16x8 av[4];
#define L1_A(ks) do { s16x4 l_, h_; TRRD(l_, vb, (ks) * 16 * LV_STR); TRRD(h_, vb, ((ks) * 16 + 4) * LV_STR); asm volatile("s_waitcnt lgkmcnt(0)" : "+v"(l_), "+v"(h_) :: "memory"); av[ks] = mk8(l_, h_); } while (0)
        L1_A(0); L1_A(1); L1_A(2); L1_A(3);
#undef L1_A
        f32x16 acc[4];
#pragma unroll
        for (int d = 0; d < 4; ++d)
#pragma unroll
            for (int r = 0; r < 16; ++r) acc[d][r] = 0.f;
#define L1_B(d0, ks) do { s16x4 l_, h_; TRRD(l_, kbs, (ks) * 16 * LK_STR + (d0) * 64); TRRD(h_, kbs, ((ks) * 16 + 4) * LK_STR + (d0) * 64); asm volatile("s_waitcnt lgkmcnt(0)" : "+v"(l_), "+v"(h_) :: "memory"); \
            acc[d0] = MFMA32(av[ks], mk8(l_, h_), acc[d0]); } while (0)
#define L1_BD(d0) do { L1_B(d0, 0); L1_B(d0, 1); L1_B(d0, 2); L1_B(d0, 3); } while (0)
        L1_BD(0); L1_BD(1); L1_BD(2); L1_BD(3);
#undef L1_BD
#undef L1_B
        bf16* dcp = A.dC + ((size_t)(c * 4 + h) * 128) * 256;
#pragma unroll
        for (int d0 = 0; d0 < 4; ++d0)
#pragma unroll
            for (int rg = 0; rg < 4; ++rg) { v2u w; w.x = pk2(acc[d0][4 * rg], acc[d0][4 * rg + 1]); w.y = pk2(acc[d0][4 * rg + 2], acc[d0][4 * rg + 3]); *(v2u*)(dcp + (size_t)(32 * d0 + (lane & 31)) * 256 + 32 * wid + 8 * rg + 4 * hi) = w; }
        if (ML && tid < 128) { float s = 0.f;
#pragma unroll 8
            for (int q = 0; q < 64; ++q) s += h2f(*(const LAS unsigned short*)(Kt + q * LK_STR + tid * 2));
            A.dn[(size_t)(c * 4 + h) * 128 + tid] = s; }
    }
}
template <bool ML>
__device__ __forceinline__ void lin_scan(const Frame& F_in, const LinArgs& A) { PHASE_ENTRY(F);
    LAS float* decs = (LAS float*)F.lds; LAS float* inws = decs + NCH; LAS float* bls = decs + 2 * NCH; LAS float* acs = decs + 3 * NCH; LAS float* mss = decs + 4 * NCH;
    for (int blk = F.bid; blk < 256; blk += F.G) { const int h = blk >> 6, idx = (blk & 63) * 512 + F.tid; const bool lead = (blk & 63) == 0;
        __syncthreads();
        if (F.tid < NCH) { bls[F.tid] = A.chs[F.tid * 4 + h]; acs[F.tid] = A.chs[NCH * 4 + F.tid * 4 + h]; }
        __syncthreads();
        if (F.tid == 0) { float m = 0.f;
            for (int c0 = 0; c0 < NCH; c0 += 8) { float bl[8], aa[8];
#pragma unroll
                for (int i = 0; i < 8; ++i) { bl[i] = bls[c0 + i]; aa[i] = acs[c0 + i]; }
#pragma unroll
                for (int i = 0; i < 8; ++i) { mss[c0 + i] = m; m = fmaxf(bl[i] + m, aa[i]); } }
            mss[NCH] = m; }
        __syncthreads();
        if (F.tid < NCH) { const float m = mss[F.tid], mn = mss[F.tid + 1], bl = bls[F.tid], a = acs[F.tid]; decs[F.tid] = __expf(bl + m - mn); inws[F.tid] = __expf(a - mn); }
        __syncthreads();
        if (lead && F.tid < NCH) A.chs[2 * NCH * 4 + F.tid * 4 + h] = mss[F.tid];
        float C = 0.f;
        for (int c0 = 0; c0 < NCH; c0 += 32) { bf16 x[32];
#pragma unroll
            for (int u = 0; u < 32; ++u) x[u] = A.dC[(size_t)((c0 + u) * 4 + h) * 32768 + idx];
#pragma unroll
            for (int u = 0; u < 32; ++u) { const int c = c0 + u; A.CH[(size_t)(c * 4 + h) * 32768 + idx] = (bf16)f2bf(C); C = decs[c] * C + inws[c] * h2f(x[u]); } }
        if (ML && lead && F.tid < 128) { float n = 0.f;
            for (int c0 = 0; c0 < NCH; c0 += 32) { float x[32];
#pragma unroll
                for (int u = 0; u < 32; ++u) x[u] = A.dn[(size_t)((c0 + u) * 4 + h) * 128 + F.tid];
#pragma unroll
                for (int u = 0; u < 32; ++u) { const int c = c0 + u; A.nh[(size_t)(c * 4 + h) * 128 + F.tid] = n; n = decs[c] * n + inws[c] * x[u]; } } }
    }
}
template <bool ML>
__device__ __forceinline__ void lin_out(const Frame& F_in, const LinArgs& A) { PHASE_ENTRY(F);
    LAS unsigned char* lds = F.lds; const int tid = F.tid, lane = F.lane, wid = F.wave, r32 = lane & 31, hi = lane >> 5;
    LAS unsigned char* Kt = lds; LAS unsigned char* Vt = lds + 16384; LAS unsigned char* Ct = lds + 16384 + 64 * LV_STR;
    LAS float* vs = (LAS float*)(lds + 126976); LAS float* Mt = vs + 64; LAS float* Bt = vs + 128; LAS float* nhs = vs + 192; LAS float* ssq = vs + 320;
    const int sr = tid >> 4, sc = (tid & 15) * 8, tb = wid & 1, eq = wid >> 1, tl = 32 * tb + r32;
    for (int u = F.bid; u < NCH * 4; u += F.G) { const int c = u >> 2, h = u & 3, t0 = c * 64;
        const float mc = ML ? A.chs[2 * NCH * 4 + c * 4 + h] : 0.f;
        __syncthreads();
        const bf16* kp = ML ? A.qkc + (size_t)t0 * 1024 + 512 + 128 * h : A.proj + (size_t)t0 * NIN + 512 + 128 * h; const int kld = ML ? 1024 : NIN;
        v4u tk[2], tv[2][2], tc[8];
#pragma unroll
        for (int rr = 0; rr < 2; ++rr) { const int s = sr + 32 * rr;
            tk[rr] = *(const v4u*)(kp + (size_t)s * kld + sc);
            const bf16* vp = A.proj + (size_t)(t0 + s) * NIN + (ML ? 4096 : 1024) + 256 * h + sc;
            tv[rr][0] = *(const v4u*)vp; tv[rr][1] = *(const v4u*)(vp + 128); }
        const bf16* chp = A.CH + (size_t)(c * 4 + h) * 32768;
#pragma unroll
        for (int i = 0; i < 8; ++i) { const int ck = tid + 512 * i, d = ck >> 5, e0 = (ck & 31) * 8; tc[i] = *(const v4u*)(chp + (size_t)d * 256 + e0); }
        const bf16* qp = (ML ? A.qkc + (size_t)(t0 + tl) * 1024 + 128 * h : A.proj + (size_t)(t0 + tl) * NIN + 128 * h) + 8 * hi;
        bf16x8 qr[8];
#pragma unroll
        for (int s = 0; s < 8; ++s) qr[s] = *(const bf16x8*)(qp + 16 * s);
        asm volatile("" ::: "memory");
        if (wid == 0) { float li, b; lin_gates<ML>(A, t0, h, lane, ssq, li, b); const float v = li - b, uu = wave_prefix_max(v, lane, ssq); vs[lane] = v; Mt[lane] = fmaxf(mc, uu); Bt[lane] = b; }
        if (ML && wid >= 2 && wid < 4) nhs[tid - 128] = A.nh[(size_t)(c * 4 + h) * 128 + tid - 128];
#pragma unroll
        for (int rr = 0; rr < 2; ++rr) { const int s = sr + 32 * rr;
            *(LAS v4u*)(Kt + KSWZ(s, sc * 2)) = tk[rr];
            *(LAS v4u*)(Vt + s * LV_STR + sc * 2) = tv[rr][0]; *(LAS v4u*)(Vt + s * LV_STR + (128 + sc) * 2) = tv[rr][1]; }
#pragma unroll
        for (int i = 0; i < 8; ++i) { const int ck = tid + 512 * i, d = ck >> 5, e0 = (ck & 31) * 8; *(LAS v4u*)(Ct + d * LV_STR + e0 * 2) = tc[i]; }
        __syncthreads();
        const float Mme = Mt[tl], bme = Bt[tl], wint = __expf(mc - Mme);
        f32x16 p[2]; float nq = 0.f;
#pragma unroll
        for (int sb = 0; sb < 2; ++sb) {
#pragma unroll
            for (int r = 0; r < 16; ++r) p[sb][r] = 0.f;
            if (sb <= tb) {
#pragma unroll
                for (int d0 = 0; d0 < 8; ++d0) { const bf16x8 kf = *(const LAS bf16x8*)(Kt + KSWZ(32 * sb + r32, (16 * d0 + 8 * hi) * 2)); p[sb] = MFMA32(kf, qr[d0], p[sb]); }
#pragma unroll
                for (int r = 0; r < 16; ++r) { const int s = 32 * sb + crow(r, hi); const float w = (s <= tl) ? __expf(vs[s] - Mme) * LIN_SC : 0.f; p[sb][r] *= w; nq += p[sb][r]; }
            }
        }
        bf16x8 pk[4];
        { v4u w;
          w.x = pk2(p[0][0], p[0][1]); w.y = pk2(p[0][2], p[0][3]); w.z = pk2(p[0][4], p[0][5]); w.w = pk2(p[0][6], p[0][7]); pk[0] = __builtin_bit_cast(bf16x8, w);
          w.x = pk2(p[0][8], p[0][9]); w.y = pk2(p[0][10], p[0][11]); w.z = pk2(p[0][12], p[0][13]); w.w = pk2(p[0][14], p[0][15]); pk[1] = __builtin_bit_cast(bf16x8, w);
          w.x = pk2(p[1][0], p[1][1]); w.y = pk2(p[1][2], p[1][3]); w.z = pk2(p[1][4], p[1][5]); w.w = pk2(p[1][6], p[1][7]); pk[2] = __builtin_bit_cast(bf16x8, w);
          w.x = pk2(p[1][8], p[1][9]); w.y = pk2(p[1][10], p[1][11]); w.z = pk2(p[1][12], p[1][13]); w.w = pk2(p[1][14], p[1][15]); pk[3] = __builtin_bit_cast(bf16x8, w); }
        bf16x8 qw[8]; float qn = 0.f;
#pragma unroll
        for (int s = 0; s < 8; ++s) { const v4u x = __builtin_bit_cast(v4u, qr[s]); float f[8] = {bflo(x.x), bfhi(x.x), bflo(x.y), bfhi(x.y), bflo(x.z), bfhi(x.z), bflo(x.w), bfhi(x.w)};
            if (ML) {
#pragma unroll
                for (int e = 0; e < 8; ++e) qn += f[e] * nhs[16 * s + 8 * hi + e]; }
#pragma unroll
            for (int e = 0; e < 8; ++e) f[e] *= wint;
            qw[s] = pack8f(f); }
        nq = swap_sum(nq) + wint * swap_sum(qn);
        const unsigned q4 = (unsigned)((lane >> 2) & 3), colb = (unsigned)(16 * ((lane >> 4) & 1) + 4 * (lane & 3));
        const unsigned vb = (unsigned)(uintptr_t)Vt + (4 * hi + q4) * LV_STR + (64 * eq + colb) * 2;
        const unsigned cb0 = (unsigned)(uintptr_t)Ct + (8 * hi + q4) * LV_STR + (64 * eq + colb) * 2, cb1 = cb0 + 64 * LV_STR;
        f32x16 acc[2];
#pragma unroll
        for (int eb = 0; eb < 2; ++eb)
#pragma unroll
            for (int r = 0; r < 16; ++r) acc[eb][r] = 0.f;
        const bf16* gp = A.proj + (size_t)(t0 + tl) * NIN + (ML ? 5120 : 2048) + 256 * h;
        v2u gwv[2][4];
#pragma unroll
        for (int eb = 0; eb < 2; ++eb)
#pragma unroll
            for (int rg = 0; rg < 4; ++rg) { const int e = 64 * eq + 32 * eb + 8 * rg + 4 * hi; gwv[eb][rg] = *(const v2u*)(gp + e); }
#define L3_RV(i, eb, ks) do { TRRD(fl_[i], vb, (ks) * 16 * LV_STR + (eb) * 64); TRRD(fh_[i], vb, ((ks) * 16 + 8) * LV_STR + (eb) * 64); } while (0)
#define L3_RC(i, eb, base, so) do { TRRD(fl_[i], base, (so) * 16 * LV_STR + (eb) * 64); TRRD(fh_[i], base, ((so) * 16 + 4) * LV_STR + (eb) * 64); } while (0)
#define L3_W4() asm volatile("s_waitcnt lgkmcnt(0)" : "+v"(fl_[0]), "+v"(fh_[0]), "+v"(fl_[1]), "+v"(fh_[1]), "+v"(fl_[2]), "+v"(fh_[2]), "+v"(fl_[3]), "+v"(fh_[3]) :: "memory")
#define L3_W2() asm volatile("s_waitcnt lgkmcnt(0)" : "+v"(fl_[0]), "+v"(fh_[0]), "+v"(fl_[1]), "+v"(fh_[1]) :: "memory")
#define L3_E(eb) do { s16x4 fl_[4], fh_[4]; \
            if (tb) { L3_RV(0, eb, 0); L3_RV(1, eb, 1); L3_RV(2, eb, 2); L3_RV(3, eb, 3); L3_W4(); \
                acc[eb] = MFMA32(mk8(fl_[0], fh_[0]), pk[0], acc[eb]); acc[eb] = MFMA32(mk8(fl_[1], fh_[1]), pk[1], acc[eb]); acc[eb] = MFMA32(mk8(fl_[2], fh_[2]), pk[2], acc[eb]); acc[eb] = MFMA32(mk8(fl_[3], fh_[3]), pk[3], acc[eb]); } \
            else { L3_RV(0, eb, 0); L3_RV(1, eb, 1); L3_W2(); acc[eb] = MFMA32(mk8(fl_[0], fh_[0]), pk[0], acc[eb]); acc[eb] = MFMA32(mk8(fl_[1], fh_[1]), pk[1], acc[eb]); } \
            L3_RC(0, eb, cb0, 0); L3_RC(1, eb, cb0, 1); L3_RC(2, eb, cb0, 2); L3_RC(3, eb, cb0, 3); L3_W4(); \
            acc[eb] = MFMA32(mk8(fl_[0], fh_[0]), qw[0], acc[eb]); acc[eb] = MFMA32(mk8(fl_[1], fh_[1]), qw[1], acc[eb]); acc[eb] = MFMA32(mk8(fl_[2], fh_[2]), qw[2], acc[eb]); acc[eb] = MFMA32(mk8(fl_[3], fh_[3]), qw[3], acc[eb]); \
            L3_RC(0, eb, cb1, 0); L3_RC(1, eb, cb1, 1); L3_RC(2, eb, cb1, 2); L3_RC(3, eb, cb1, 3); L3_W4(); \
            acc[eb] = MFMA32(mk8(fl_[0], fh_[0]), qw[4], acc[eb]); acc[eb] = MFMA32(mk8(fl_[1], fh_[1]), qw[5], acc[eb]); acc[eb] = MFMA32(mk8(fl_[2], fh_[2]), qw[6], acc[eb]); acc[eb] = MFMA32(mk8(fl_[3], fh_[3]), qw[7], acc[eb]); } while (0)
        L3_E(0); L3_E(1);
#undef L3_RV
#undef L3_RC
#undef L3_W4
#undef L3_W2
#undef L3_E
        float dinv = 1.f;
        if (ML) dinv = __builtin_amdgcn_rcpf(fmaxf(fabsf(nq), __expf(-(bme + Mme))));
        float ss = 0.f;
#pragma unroll
        for (int eb = 0; eb < 2; ++eb)
#pragma unroll
            for (int r = 0; r < 16; ++r) { acc[eb][r] *= dinv; ss += acc[eb][r] * acc[eb][r]; }
        ss = swap_sum(ss);
        if (hi == 0) ssq[eq * 64 + tl] = ss;
        __syncthreads();
        const float rn = rsqrtf(((ssq[tl] + ssq[64 + tl]) + (ssq[128 + tl] + ssq[192 + tl])) * (1.f / 256.f) + EPS_);
        bf16* yp = A.ymix + (size_t)(t0 + tl) * NMIX + (ML ? 1024 : 0) + 256 * h;
#pragma unroll
        for (int eb = 0; eb < 2; ++eb)
#pragma unroll
            for (int rg = 0; rg < 4; ++rg) { const int e = 64 * eq + 32 * eb + 8 * rg + 4 * hi; const v2u gw = gwv[eb][rg]; const f32x4 gn = *(const f32x4*)(A.gnorm + e);
                float gt[4] = {bflo(gw.x), bfhi(gw.x), bflo(gw.y), bfhi(gw.y)}, o[4];
#pragma unroll
                for (int k = 0; k < 4; ++k) { const float sg = __builtin_amdgcn_rcpf(1.f + __expf(-gt[k])); const float gate = ML ? sg : gt[k] * sg; o[k] = acc[eb][4 * rg + k] * rn * gn[k] * gate; }
                v2u w; w.x = pk2(o[0], o[1]); w.y = pk2(o[2], o[3]); *(v2u*)(yp + e) = w; }
    }
}

#ifndef MK_SPLIT
#define MK_SPLIT 0
#endif
constexpr int PH_PER_LAYER = 16, N_PHASES = 1 + PH_PER_LAYER * DEPTH_;
__global__ void __launch_bounds__(NWAVES * 64, 2) fwd_kernel(Params P) {
    extern __shared__ __attribute__((aligned(16))) unsigned char lds_raw[];
    Frame F0; F0.lds = (LAS unsigned char*)lds_raw; F0.tid = threadIdx.x; F0.lane = F0.tid & 63; F0.wave = __builtin_amdgcn_readfirstlane(F0.tid >> 6); F0.G = gridDim.x; F0.bid = blockIdx.x;
    volatile LAS unsigned* MISC = (volatile LAS unsigned*)(F0.lds + MISC_OFF);
    for (int u = F0.tid; u < (LDS_BYTES - LDSCTL_OFF) / 4; u += NWAVES * 64) ((LAS unsigned*)(F0.lds + LDSCTL_OFF))[u] = 0u;
    __syncthreads();
    gu32* ctl = (gu32*)(P.ws + WS_CTL);
    XcdBarrier bar; bar.bar = (unsigned*)ctl + CW_BAR; bar.x = 0; bar.st = nullptr;
    if (!MK_SPLIT) bar = xcd_barrier_post((unsigned*)ctl + CW_BAR, MISC + 8);
    const int lo = P.ph_lo, hi = P.ph_hi;
#ifndef PHMASK
#define PHMASK 0xffffffffu
#endif
#ifndef DUPMASK
#define DUPMASK (0u)
#endif
#define DUPN(n) for (int rep_ = 0; rep_ < (((DUPMASK >> (n)) & 1u) ? 2 : 1); ++rep_)
#define IN(k) (lo <= (k) && (k) < hi)
#define INM(k, n) (((PHMASK >> (n)) & 1u) && IN(k))
#ifndef DBG_TIME
#define DBG_TIME 0
#endif
#if DBG_TIME
#define SEAM(k) do { if (!MK_SPLIT && lo <= (k) && (k) + 1 < hi) xcd_barrier(bar); if (F0.bid == 0 && F0.tid == 0) ((unsigned long long*)(P.ws + 768 * 1024))[(k) + 1] = wall_clock64(); } while (0)
#else
#define SEAM(k) do { if (!MK_SPLIT && lo <= (k) && (k) + 1 < hi) xcd_barrier(bar); } while (0)
#endif
#define PHASE_PTRS() KParams Pk = (KParams)__builtin_amdgcn_kernarg_segment_ptr(); Frame F = F0; asm volatile("; PHASE_PTRS" : "+s"(Pk), "+s"(F.G), "+s"(F.bid), "+s"(F.wave)); unsigned char* ws = Pk->ws; float* out = Pk->out; \
    bf16* hb = (bf16*)(ws + WS_HB); bf16* proj = (bf16*)(ws + WS_PROJ); bf16* ymix = (bf16*)(ws + WS_YMIX); bf16* mixo = (bf16*)(ws + WS_MIXO); bf16* upb = (bf16*)(ws + WS_UP); \
    bf16* act = (bf16*)(ws + WS_ACT); bf16* od = (bf16*)(ws + WS_OD); bf16* g1 = (bf16*)(ws + WS_G1); bf16* qkc = (bf16*)(ws + WS_QKC); \
    float* rin = (float*)(ws + WS_RIN); float* ssp = (float*)(ws + WS_SSP); float* gpre = (float*)(ws + WS_GPRE); \
    const float* cst = (const float*)(ws + WS_COS); const float* snt = (const float*)(ws + WS_SIN); \
    (void)out; (void)hb; (void)proj; (void)ymix; (void)mixo; (void)upb; (void)act; (void)od; (void)g1; (void)qkc; (void)rin; (void)ssp; (void)gpre; (void)cst; (void)snt
#define LIN_ARGS() LinArgs LA; LA.proj = proj; LA.qkc = qkc; LA.gpre = gpre; LA.b_i = Pk->in[I_BIG] + j * 4; LA.b_f = Pk->in[I_BFG] + j * 4; LA.wconv = Pk->in[I_WCQK] + (size_t)j * 4096; LA.bconv = Pk->in[I_BCQK] + (size_t)j * 1024; \
    LA.gnorm = ev ? Pk->in[I_GML] + j * 256 : Pk->in[I_GRET] + j * 256; LA.chs = (float*)(ws + WS_CHS); LA.dC = (bf16*)(ws + WS_DC); LA.CH = (bf16*)(ws + WS_CH); LA.dn = (float*)(ws + WS_DN); LA.nh = (float*)(ws + WS_NH); LA.ymix = ymix

#if DBG_TIME
    if (F0.bid == 0 && F0.tid == 0) ((unsigned long long*)(P.ws + 768 * 1024))[0] = wall_clock64();
#endif
    if (INM(0, 31)) DUPN(31) { PHASE_PTRS(); p0_prologue(F, Pk); }
    SEAM(0);
#pragma unroll 1
    for (int L = 0; L < DEPTH_; ++L) {
        const int pbase = 1 + PH_PER_LAYER * L, j = L >> 1; const bool ev = (L & 1) == 0;
        if (INM(pbase + 0, 0)) DUPN(0) { PHASE_PTRS();
            if (ev) gates_pass(F, hb, (const bf16*)(ws + WS_WG) + (size_t)j * 8 * DM, rin, gpre);
            pg8::Gemm g{hb, (const bf16*)(ws + WS_WIN) + (size_t)L * NIN * DM, S_, NIN, DM, 0, 0}; pg8::StaticOrder S; S.init(S_, NIN, F.G, F.bid);
            pg8::EpiProj E{proj, NIN, rin, cst, snt, ev ? 8 : 4};
            pg8::gemm_phase<pg8::EpiProj, pg8::StaticOrder, true, true>(F.lds, g, S, E, F.wave);
        }
        SEAM(pbase + 0);
        if (INM(pbase + 1, 1)) DUPN(1) { PHASE_PTRS(); LIN_ARGS(); if (ev) lin_local<true>(F, LA); else lin_local<false>(F, LA); }
        SEAM(pbase + 1);
        if (INM(pbase + 2, 2)) DUPN(2) { PHASE_PTRS(); LIN_ARGS(); if (ev) lin_scan<true>(F, LA); else lin_scan<false>(F, LA); }
        SEAM(pbase + 2);
        if (INM(pbase + 3, 3)) DUPN(3) { PHASE_PTRS(); LIN_ARGS();
#ifndef P3MASK
#define P3MASK 15
#endif
#ifndef P3ABL
#define P3ABL 0
#endif
#ifndef P3DUP
#define P3DUP 15
#endif
            const int p3m = rep_ ? (P3MASK & P3DUP) : P3MASK;
            if (ev) { if (p3m & 1) lin_out<true>(F, LA); if (p3m & 2) { if (rep_) attn_phase<0, P3ABL>(F, ctl + CW_Q + 64 * (L + 4 * rep_), proj, (bf16*)(ws + WS_UP)); else attn_phase<0>(F, ctl + CW_Q + 64 * (L + 4 * rep_), proj, od); } }
            else { if (p3m & 4) lin_out<false>(F, LA); if (p3m & 8) attn_phase<1>(F, ctl + CW_Q + 64 * (L + 4 * rep_), proj, ymix); }
        }
        SEAM(pbase + 3);
        if (ev) { if (INM(pbase + 4, 4)) DUPN(4) { PHASE_PTRS(); diffcomb_pass(F, od, Pk->in[I_GDIFF] + j * 256, (const float*)(ws + WS_LAM) + 2 * j, ymix); } SEAM(pbase + 4); }
        if (INM(pbase + 5, 5)) DUPN(5) { PHASE_PTRS();
            pg8::Gemm g{ymix, (const bf16*)(ws + WS_WOUT) + (size_t)L * DM * NMIX, S_, DM, NMIX, 0, 0}; pg8::StaticOrder S; S.init(S_, DM, F.G, F.bid);
            pg8::EpiY E{mixo, DM, ssp};
            pg8::gemm_phase<pg8::EpiY, pg8::StaticOrder, true, true>(F.lds, g, S, E, F.wave);
        }
        SEAM(pbase + 5);
        if (INM(pbase + 6, 6)) DUPN(6) { PHASE_PTRS(); resid_pass(F, (RES_LO && L == 0) ? Pk->in[I_X] : (const float*)nullptr, mixo, ssp, Pk->in[I_GMPOST] + (size_t)L * DM, hb, (bf16*)(ws + WS_LO), rin); }
        SEAM(pbase + 6);
        if (INM(pbase + 7, 7)) DUPN(7) { PHASE_PTRS();
            pg8::Gemm g{hb, (const bf16*)(ws + WS_WUP) + (size_t)L * NUP * DM, S_, NUP, DM, 0, 0}; pg8::StaticOrder S; S.init(S_, NUP, F.G, F.bid);
            pg8::EpiProj E{upb, NUP, rin, cst, snt, 0};
            pg8::gemm_phase<pg8::EpiProj, pg8::StaticOrder, true, true>(F.lds, g, S, E, F.wave);
        }
        SEAM(pbase + 7);
        if (INM(pbase + 8, 8)) DUPN(8) { PHASE_PTRS(); convffn_pass(F, upb, Pk->in[I_WFC] + (size_t)L * 3 * NUP, Pk->in[I_BFC] + (size_t)L * NUP, act); }
        SEAM(pbase + 8);
        if (INM(pbase + 9, 9)) DUPN(9) { PHASE_PTRS();
            pg8::Gemm g{act, (const bf16*)(ws + WS_WDN) + (size_t)L * DM * DM, S_, DM, DM, 0, 0}; pg8::StaticOrder S; S.init(S_, DM, F.G, F.bid);
            pg8::EpiY E{mixo, DM, ssp};
            pg8::gemm_phase<pg8::EpiY, pg8::StaticOrder, true, true>(F.lds, g, S, E, F.wave);
        }
        SEAM(pbase + 9);
        if (INM(pbase + 10, 10)) DUPN(10) { PHASE_PTRS(); resid_pass(F, (const float*)nullptr, mixo, ssp, Pk->in[I_GFPOST] + (size_t)L * DM, hb, (bf16*)(ws + WS_LO), rin); }
        SEAM(pbase + 10);
        if (INM(pbase + 11, 11)) DUPN(11) { PHASE_PTRS();
            pg8::Gemm g{hb, (const bf16*)(ws + WS_WPD) + (size_t)L * PLED * DM, S_, PLED, DM / 4, (long)(DM / 4) * 2, (long)(DM / 4) * 2, DM}; pg8::SplitKOrder S{F.G, F.bid, (S_ / 256) * 4};
            pg8::EpiPart E{(bf16*)(ws + WS_UP)};
            pg8::gemm_phase<pg8::EpiPart, pg8::SplitKOrder, true, true>(F.lds, g, S, E, F.wave);
        }
        SEAM(pbase + 11);
        if (INM(pbase + 12, 12)) DUPN(12) { PHASE_PTRS(); pled_combine(F, (const bf16*)(ws + WS_UP), rin, g1); }
        SEAM(pbase + 12);
        if (INM(pbase + 13, 13)) DUPN(13) { PHASE_PTRS();
            int Kp = PLED; asm volatile("; opaque K (keeps the K-loop rolled)" : "+s"(Kp));
            pg8::Gemm g{g1, (const bf16*)(ws + WS_WPU) + (size_t)L * DM * PLED, S_, DM, Kp, (long)(WS_PB - WS_G1) + (long)L * S_ * PLED * 2, (long)(WS_WPP - WS_WPU)};
#ifndef DBG_PLE_PLAIN
#define DBG_PLE_PLAIN 0
#endif
#if DBG_PLE_PLAIN == 1
            pg8::StaticOrder S; S.init(S_, DM, F.G, F.bid); pg8::EpiY E{mixo, DM, ssp};
            pg8::gemm_phase<pg8::EpiY, pg8::StaticOrder, true, true>(F.lds, g, S, E, F.wave);
#elif DBG_PLE_PLAIN == 2
            pg8::PleOrder S{F.G, F.bid, (S_ / 256) * (DM / 256)}; pg8::EpiPleDbg E{mixo, act};
            pg8::gemm_phase<pg8::EpiPleDbg, pg8::PleOrder, true, true>(F.lds, g, S, E, F.wave);
#else
            pg8::PleOrder S{F.G, F.bid, (S_ / 256) * (DM / 256)};
            pg8::EpiPle E{mixo, hb, (bf16*)(ws + WS_LO), L == DEPTH_ - 1 ? out : (float*)nullptr, ssp};
            pg8::gemm_phase<pg8::EpiPle, pg8::PleOrder, true, true>(F.lds, g, S, E, F.wave);
#endif
        }
        SEAM(pbase + 13);
        if (L + 1 < DEPTH_) { if (INM(pbase + 14, 14)) DUPN(14) { PHASE_PTRS(); rin_pass(F, ssp, rin); } SEAM(pbase + 14); }
    }
#undef IN
#undef INM
#undef SEAM
}

#ifndef DBG_STOP
#define DBG_STOP 0
#endif
#if DBG_STOP
__global__ void dbg_fold(const unsigned* ws, size_t nwords, float* out, int keep_out) {
    for (size_t i = (size_t)blockIdx.x * blockDim.x + threadIdx.x; i < (size_t)S_ * DM; i += (size_t)gridDim.x * blockDim.x) { float acc = keep_out ? out[i] : 0.f;
        for (size_t w = (1u << 18) + i; w < nwords; w += (size_t)S_ * DM) { const unsigned x = ws[w]; acc += (float)(x & 0xffffu) * (1.f / 65536.f) + (float)(x >> 16) * (1.f / 65536.f); }
        out[i] = acc; }
}
#endif
#ifndef DBG_CHECK
#define DBG_CHECK 0
#endif
#ifndef DBG_LAYER
#define DBG_LAYER 0
#endif

#if DBG_CHECK
__global__ void chk_rin(const float* h, const float* rin, float* errs, int code) { __shared__ float sh[8]; const int row = hsh(2020 + blockIdx.x) % S_; float ss = 0.f;
    for (int k = threadIdx.x; k < DM; k += blockDim.x) { const float a = h[(size_t)row * DM + k]; ss += a * a; } ss = blk_sum(ss, sh); if (threadIdx.x == 0) rep_err(errs, code, rin[row], rsqrtf(ss / DM + EPS_), 1e-3f); }
static void dbg_checks(int k, int before, void* const* d_in, void* d_out, void* d_ws, hipStream_t st) {
    const int r = (k - 1) % PH_PER_LAYER, L = (k - 1) / PH_PER_LAYER, j = L >> 1; const bool ev = (L & 1) == 0;
    if (k < 1 || L != DBG_LAYER) return;
    unsigned char* ws = (unsigned char*)d_ws; float* errs = (float*)(ws + 512 * 1024); float* out = (float*)d_out; float* tmp = (float*)(ws + WS_UP);
    const float* const* in = (const float* const*)d_in;
    bf16* proj = (bf16*)(ws + WS_PROJ); bf16* ymix = (bf16*)(ws + WS_YMIX); bf16* mixo = (bf16*)(ws + WS_MIXO); bf16* hb = (bf16*)(ws + WS_HB); bf16* upb = (bf16*)(ws + WS_UP); bf16* act = (bf16*)(ws + WS_ACT);
    bf16* od = (bf16*)(ws + WS_OD); bf16* g1 = (bf16*)(ws + WS_G1); float* rin = (float*)(ws + WS_RIN); float* ssp = (float*)(ws + WS_SSP); float* gpre = (float*)(ws + WS_GPRE);
    const float* cst = (const float*)(ws + WS_COS); const float* snt = (const float*)(ws + WS_SIN);
    const float* hin0 = (L == 0) ? in[I_X] : (const float*)out;
    if (before) { if ((DBG_CHECK == 1 && r == 6 && L > 0) || (DBG_CHECK == 2 && (r == 10 || r == 12))) (void)hipMemcpyAsync(tmp, out, (size_t)S_ * DM * 4, hipMemcpyDeviceToDevice, st); return; }
    if (DBG_CHECK == 1) {
        if (r == 0) { const float* W = ev ? in[I_WINE] + (size_t)j * DM * 6152 : in[I_WINO] + (size_t)j * DM * 6144;
            hipLaunchKernelGGL(chk_gemm, dim3(16384), dim3(256), 0, st, hin0, (const bf16*)nullptr, DM, in[I_GMPRE] + (size_t)L * DM, (const float*)nullptr, 1, W, ev ? 6152 : 6144, NIN, ev ? 2048 : 1024, cst, snt, (const bf16*)proj, NIN, errs, 1, 11u);
            if (ev) hipLaunchKernelGGL(chk_gates, dim3(4096), dim3(256), 0, st, hin0, in[I_GMPRE] + (size_t)L * DM, in[I_WINE] + (size_t)j * DM * 6152, (const float*)gpre, errs, 2); }
        if (r == 3) { float* hn = (float*)(ws + WS_UP); float* scr = (float*)(ws + WS_UP + 128 * MiB);
            if (ev) { hipLaunchKernelGGL(chk_diffattn, dim3(1024), dim3(256), 0, st, (const bf16*)proj, (const bf16*)od, scr, errs, 3);
                hipLaunchKernelGGL(chk_lin_naive, dim3(256, 4), dim3(128), 0, st, (const bf16*)proj, (const float*)gpre, in[I_BIG] + j * 4, in[I_BFG] + j * 4, in[I_WCQK] + (size_t)j * 4096, in[I_BCQK] + (size_t)j * 1024, 1, hn);
                hipLaunchKernelGGL(chk_lin_cmp, dim3(8192), dim3(256), 0, st, (const float*)hn, (const bf16*)proj, in[I_GML] + j * 256, 1, (const bf16*)ymix, errs, 4);
            } else { hipLaunchKernelGGL(chk_stick, dim3(1024), dim3(128), 0, st, (const bf16*)proj, (const bf16*)ymix, errs, 3);
                hipLaunchKernelGGL(chk_lin_naive, dim3(256, 4), dim3(128), 0, st, (const bf16*)proj, (const float*)gpre, in[I_BIG], in[I_BFG], in[I_WCQK], in[I_BCQK], 0, hn);
                hipLaunchKernelGGL(chk_lin_cmp, dim3(8192), dim3(256), 0, st, (const float*)hn, (const bf16*)proj, in[I_GRET] + j * 256, 0, (const bf16*)ymix, errs, 4); } }
        if (r == 4 && ev) hipLaunchKernelGGL(chk_diffcomb, dim3(8192), dim3(256), 0, st, (const bf16*)od, in[I_DLAM] + (size_t)j * 512, in[I_GDIFF] + j * 256, 0.8f - 0.6f * expf(-0.3f * (float)L), (const bf16*)ymix, errs, 5);
        if (r == 5) { const float* W = (ev ? in[I_WOUTE] : in[I_WOUTO]) + (size_t)j * NMIX * DM;
            hipLaunchKernelGGL(chk_gemm, dim3(16384), dim3(256), 0, st, (const float*)nullptr, (const bf16*)ymix, NMIX, (const float*)nullptr, (const float*)nullptr, 0, W, DM, DM, 0, cst, snt, (const bf16*)mixo, DM, errs, 6, 22u);
            hipLaunchKernelGGL(chk_ssp, dim3(4096), dim3(256), 0, st, (const bf16*)mixo, (const float*)ssp, errs, 6); }
        if (r == 6) hipLaunchKernelGGL(chk_resid, dim3(4096), dim3(256), 0, st, L == 0 ? in[I_X] : (const float*)tmp, (const bf16*)mixo, in[I_GMPOST] + (size_t)L * DM, (const float*)out, (const float*)rin, errs, 7);
        if (r == 7) hipLaunchKernelGGL(chk_gemm, dim3(16384), dim3(256), 0, st, (const float*)nullptr, (const bf16*)hb, DM, in[I_GFPRE] + (size_t)L * DM, (const float*)rin, 0, in[I_WUP] + (size_t)L * DM * NUP, NUP, NUP, 0, cst, snt, (const bf16*)upb, NUP, errs, 8, 33u);
        if (r == 8) hipLaunchKernelGGL(chk_conv, dim3(4096), dim3(256), 0, st, (const bf16*)upb, in[I_WFC] + (size_t)L * 3 * NUP, in[I_BFC] + (size_t)L * NUP, (const bf16*)act, errs, 9);
    } else {
        if (r == 9) { hipLaunchKernelGGL(chk_gemm, dim3(16384), dim3(256), 0, st, (const float*)nullptr, (const bf16*)act, DM, (const float*)nullptr, (const float*)nullptr, 0, in[I_WDN] + (size_t)L * DM * DM, DM, DM, 0, cst, snt, (const bf16*)mixo, DM, errs, 1, 44u);
            hipLaunchKernelGGL(chk_ssp, dim3(4096), dim3(256), 0, st, (const bf16*)mixo, (const float*)ssp, errs, 1); }
        if (r == 10) hipLaunchKernelGGL(chk_resid, dim3(4096), dim3(256), 0, st, (const float*)tmp, (const bf16*)mixo, in[I_GFPOST] + (size_t)L * DM, (const float*)out, (const float*)rin, errs, 2);
        if (r == 11) hipLaunchKernelGGL(chk_gemm, dim3(16384), dim3(256), 0, st, (const float*)nullptr, (const bf16*)hb, DM, in[I_GPLE] + (size_t)L * DM, (const float*)rin, 0, in[I_WPD] + (size_t)L * DM * PLED, PLED, PLED, 0, cst, snt, (const bf16*)g1, PLED, errs, 3, 55u);
        if (r == 12 && DBG_PLE_PLAIN == 2) hipLaunchKernelGGL(chk_gemm, dim3(16384), dim3(256), 0, st, (const float*)nullptr, (const bf16*)(ws + WS_PB) + (size_t)L * S_ * PLED, PLED, (const float*)nullptr, (const float*)nullptr, 0, in[I_WPP] + (size_t)L * PLED * DM, DM, DM, 0, cst, snt, (const bf16*)act, DM, errs, 5, 77u);
        if (r == 12 && DBG_PLE_PLAIN) hipLaunchKernelGGL(chk_gemm, dim3(16384), dim3(256), 0, st, (const float*)nullptr, (const bf16*)g1, PLED, (const float*)nullptr, (const float*)nullptr, 0, in[I_WPU] + (size_t)L * PLED * DM, DM, DM, 0, cst, snt, (const bf16*)mixo, DM, errs, 4, 66u);
        if (r == 12 && !DBG_PLE_PLAIN) { hipLaunchKernelGGL(chk_ple2, dim3(16384), dim3(256), 0, st, (const float*)tmp, (const bf16*)g1, in[I_WPU] + (size_t)L * PLED * DM, in[I_P] + (size_t)L * S_ * PLED, in[I_WPP] + (size_t)L * PLED * DM, (const float*)out, (const bf16*)mixo, errs, 4);
            hipLaunchKernelGGL(chk_ple, dim3(16384), dim3(256), 0, st, (const float*)tmp, (const bf16*)g1, in[I_WPU] + (size_t)L * PLED * DM, in[I_P] + (size_t)L * S_ * PLED, in[I_WPP] + (size_t)L * PLED * DM, (const float*)out, errs, 5); }
        if (r == 13) hipLaunchKernelGGL(chk_rin, dim3(4096), dim3(256), 0, st, (const float*)out, (const float*)rin, errs, 7);
    }
}
#endif
#ifndef DBG_NOPERT
#define DBG_NOPERT 0
#endif
#if DBG_PERTURB
__global__ void dbg_save(const float* out, bf16* sav) { for (size_t i = (size_t)blockIdx.x * blockDim.x + threadIdx.x; i < (size_t)S_ * DM; i += (size_t)gridDim.x * blockDim.x) sav[i] = (bf16)f2bf(out[i]); }
__global__ void dbg_cmp(const float* out, const bf16* sav, float* res) {
    __shared__ float sh[8]; const int row = blockIdx.x; float m = 0.f;
    for (int k = threadIdx.x; k < DM; k += blockDim.x) m = fmaxf(m, fabsf(out[(size_t)row * DM + k] - h2f(sav[(size_t)row * DM + k])));
    m = wave_max(m); __syncthreads(); if ((threadIdx.x & 63) == 0) sh[threadIdx.x >> 6] = m; __syncthreads();
    if (threadIdx.x == 0) { m = fmaxf(fmaxf(sh[0], sh[1]), fmaxf(sh[2], sh[3])); res[16 + row] = m; atomicMax((int*)res, __float_as_int(m)); }
}
__global__ void dbg_ysave(const bf16* ymix, bf16* sav) { for (int i = blockIdx.x * blockDim.x + threadIdx.x; i < 64 * NMIX; i += gridDim.x * blockDim.x) sav[i] = ymix[i]; }
__global__ void dbg_ycmp(const bf16* ymix, const bf16* sav, float* res, int L) {
    for (int i = blockIdx.x * blockDim.x + threadIdx.x; i < 64 * NMIX; i += gridDim.x * blockDim.x) { const float d = fabsf(h2f(ymix[i]) - h2f(sav[i]));
        atomicMax((int*)res + 1 + L, __float_as_int(d)); if (L == 0) atomicMax((unsigned long long*)(res + 1000), ((unsigned long long)__float_as_uint(d) << 32) | (unsigned)i); atomicMax((int*)res + 100 + L * 8 + ((i % NMIX) >> 8), __float_as_int(d)); atomicMax((int*)res + 200 + L * 64 + i / NMIX, __float_as_int(d)); }
}
__global__ void dbg_fetch(const bf16* ymix, float* res) { const unsigned i = ((const unsigned*)res)[1000]; res[1002] = h2f(ymix[i]); }
__global__ void dbg_rep(const float* res, float* out) {
    __shared__ float cc; if (threadIdx.x == 0) { const float mx = res[0]; int rw = 0; for (int r = 0; r < S_; ++r) if (res[16 + r] == mx) { rw = r; break; }
        int cnt = 0; for (int r = 0; r < S_; ++r) if (res[16 + r] > 0.5f * mx) ++cnt;
        if (DBG_PERTURB >= 5) { int Lf = 9, cb = 0, rw2 = 0; float md = 0.f; for (int L = 0; L < 4; ++L) if (res[1 + L] > 0.1f) { Lf = L; break; }
            if (Lf < 4) { for (int b = 0; b < 8; ++b) if (res[100 + Lf * 8 + b] > md) { md = res[100 + Lf * 8 + b]; cb = b; } md = 0.f; for (int r = 0; r < 64; ++r) if (res[200 + Lf * 64 + r] > md) { md = res[200 + Lf * 64 + r]; rw2 = r; } }
            cc = (DBG_PERTURB == 5) ? 1000.f * (Lf + 1) + 100.f * cb : (DBG_PERTURB == 6) ? 1000.f * (Lf + 1) + 100.f * fminf(9.f, (float)rw2) : (DBG_PERTURB == 11) ? 1000.f + 100.f * (float)rw2 : (DBG_PERTURB == 12) ? 1000.f + 30.f * (float)(((const unsigned*)res)[1000] % NMIX & 255) : (DBG_PERTURB == 13) ? 1000.f + 1000.f * fabsf(res[1002]) : 1000.f + 1000.f * res[1 + (DBG_PERTURB - 7)]; }
        else cc = (DBG_PERTURB == 1) ? 1000.f + mx * 1000.f : (DBG_PERTURB == 2) ? 1000.f + (float)rw * (9000.f / 16384.f) : (DBG_PERTURB == 3) ? 1000.f + (float)(rw & 1023) * (9000.f / 1024.f) : 1000.f + (float)cnt * 10.f; }
    __syncthreads(); const float c = cc;
    for (size_t i = (size_t)blockIdx.x * blockDim.x + threadIdx.x; i < (size_t)S_ * DM; i += (size_t)gridDim.x * blockDim.x) out[i] = c;
}
#endif
#if DBG_TIME
__global__ void dbg_time_rep(const unsigned long long* st, float* out) {
    __shared__ float cc; if (threadIdx.x == 0) { double us = 0.0; const int kind = DBG_TIME - 1;
        if (kind == 0) us = (double)(st[1] - st[0]) * 0.01; else if (kind == 20) us = (double)(st[1 + PH_PER_LAYER * (DEPTH_ - 1) + 13] - st[0]) * 0.01;
        else if (kind >= 30) { const int L = kind - 30; us = (double)(st[1 + 1 + PH_PER_LAYER * L + 3] - st[1 + PH_PER_LAYER * L + 3]) * 0.01; }
        else { const int r = kind - 1; for (int L = 0; L < DEPTH_; ++L) { const int k = 1 + PH_PER_LAYER * L + r; if ((r == 4 && (L & 1)) || (r == 13 && L == DEPTH_ - 1)) continue; unsigned long long prev = st[k]; int kp = k; while (prev == 0ull && kp > 0) prev = st[--kp]; us += (double)(st[k + 1] - prev) * 0.01; } }
        cc = (float)(us * 100.0); }
    __syncthreads(); const float c = cc;
    for (size_t i = (size_t)blockIdx.x * blockDim.x + threadIdx.x; i < (size_t)S_ * DM; i += (size_t)gridDim.x * blockDim.x) out[i] = c;
}
#endif
extern "C" void kernel_launch(void* const* d_in, const int* in_sizes, int n_in, void* d_out, int out_size, void* d_ws, size_t ws_size, hipStream_t stream) {
    static int grid = 0;
    if (grid == 0) {
        if (n_in != 26 || out_size != S_ * DM || ws_size < WS_END) { fprintf(stderr, "kernel_launch: unexpected shapes (n_in %d, out %d, ws %zu < %zu); nothing launched\n", n_in, out_size, ws_size, (size_t)WS_END); grid = -1; return; }
        int dev = 0, cus = 0, per_cu = 0;
        if (hipGetDevice(&dev) != hipSuccess || hipDeviceGetAttribute(&cus, hipDeviceAttributeMultiprocessorCount, dev) != hipSuccess) { grid = -1; return; }
        if (hipFuncSetAttribute((const void*)fwd_kernel, hipFuncAttributeMaxDynamicSharedMemorySize, LDS_BYTES) != hipSuccess) { fprintf(stderr, "kernel_launch: hipFuncSetAttribute failed\n"); grid = -1; return; }
        if (hipOccupancyMaxActiveBlocksPerMultiprocessor(&per_cu, (const void*)fwd_kernel, NWAVES * 64, LDS_BYTES) != hipSuccess || per_cu < 1) { fprintf(stderr, "kernel_launch: occupancy query says %d blocks per CU\n", per_cu); (void)hipGetLastError(); }
        grid = cus;
    }
    if (grid < 0) return;
    (void)hipMemsetAsync((char*)d_ws + WS_CTL, 0, CTL_ZERO_BYTES, stream);
    Params p{};
    for (int i = 0; i < 26; ++i) p.in[i] = (const float*)d_in[i];
    p.out = (float*)d_out; p.ws = (unsigned char*)d_ws;
#if MK_SPLIT
#if DBG_PERTURB
    for (int rep = 0; rep < 2; ++rep) { p.pert = DBG_NOPERT ? 0 : rep;
#endif
    for (int k = 0; k < N_PHASES; ++k) { const int r = (k - 1) % PH_PER_LAYER, L = (k - 1) / PH_PER_LAYER;
        if (k > 0 && (r > 14 || (r == 4 && (L & 1)) || (r == 14 && L == DEPTH_ - 1))) continue;
        if (DBG_STOP && k >= DBG_STOP) break;
#if DBG_CHECK
        dbg_checks(k, 1, d_in, d_out, d_ws, stream);
#endif
        p.ph_lo = k; p.ph_hi = k + 1; hipLaunchKernelGGL(fwd_kernel, dim3(grid), dim3(NWAVES * 64), LDS_BYTES, stream, p);
#if DBG_CHECK
        dbg_checks(k, 0, d_in, d_out, d_ws, stream);
#endif
#if DBG_PERTURB
        { const int r_ = (k - 1) % PH_PER_LAYER, L_ = (k - 1) / PH_PER_LAYER; if (k >= 1 && ((r_ == 4 && !(L_ & 1)) || (r_ == 3 && (L_ & 1)))) { bf16* ys = (bf16*)((char*)d_ws + WS_END + 128 * MiB) + (size_t)L_ * 64 * NMIX;
            if (rep == 0) hipLaunchKernelGGL(dbg_ysave, dim3(64), dim3(256), 0, stream, (const bf16*)((char*)d_ws + WS_YMIX), ys);
            else { hipLaunchKernelGGL(dbg_ycmp, dim3(64), dim3(256), 0, stream, (const bf16*)((char*)d_ws + WS_YMIX), (const bf16*)ys, (float*)((char*)d_ws + 512 * 1024), L_); if (L_ == 0) hipLaunchKernelGGL(dbg_fetch, dim3(1), dim3(1), 0, stream, (const bf16*)((char*)d_ws + WS_YMIX), (float*)((char*)d_ws + 512 * 1024)); } } }
#endif
    }
#if DBG_PERTURB
    if (rep == 0) { (void)hipMemsetAsync((char*)d_ws + WS_CTL, 0, CTL_ZERO_BYTES, stream); hipLaunchKernelGGL(dbg_save, dim3(2048), dim3(256), 0, stream, (const float*)d_out, (bf16*)((char*)d_ws + WS_END)); }
    else { float* res = (float*)((char*)d_ws + 512 * 1024); hipLaunchKernelGGL(dbg_cmp, dim3(S_), dim3(256), 0, stream, (const float*)d_out, (const bf16*)((char*)d_ws + WS_END), res); hipLaunchKernelGGL(dbg_rep, dim3(2048), dim3(256), 0, stream, (const float*)res, (float*)d_out); }
    }
#endif
#if DBG_CHECK
    hipLaunchKernelGGL(chk_final, dim3(2048), dim3(256), 0, stream, (const float*)((char*)d_ws + 512 * 1024), (float*)d_out, DBG_TOL);
#endif
#else
    p.ph_lo = 0; p.ph_hi = N_PHASES;
    hipLaunchKernelGGL(fwd_kernel, dim3(grid), dim3(NWAVES * 64), LDS_BYTES, stream, p);
#endif
#if DBG_STOP
    hipLaunchKernelGGL(dbg_fold, dim3(2048), dim3(256), 0, stream, (const unsigned*)d_ws, (size_t)(WS_END / 4), (float*)d_out, DBG_STOP > 7 ? 1 : 0);
#endif
#if DBG_TIME
    hipLaunchKernelGGL(dbg_time_rep, dim3(2048), dim3(256), 0, stream, (const unsigned long long*)((char*)d_ws + 768 * 1024), (float*)d_out);
#endif
    const hipError_t le = hipPeekAtLastError();
    if (le != hipSuccess) fprintf(stderr, "kernel_launch: launch failed: %s\n", hipGetErrorName(le));
}
```
